# Optimizing an MI355X kernel written in HIP

```python
import jax
import jax.numpy as jnp
from jax import lax
import numpy as np

D_MODEL = 1024
BATCH = 8
SEQ = 2048
DEPTH = 2
DEC_BATCH = 128
DEC_SEQ = 1
PAST_LEN = 16384
PAGE_SIZE = 128

N_EVEN = (DEPTH + 1) // 2
N_ODD = DEPTH // 2
EPS = 1e-6

A_WIDTH = D_MODEL
A_HEAD_DIM = 64
A_HEADS = A_WIDTH // A_HEAD_DIM
A_GROUPS = 2
A_STATE = 128
A_CONV = 4
A_CONV_DIM = A_WIDTH + 2 * A_GROUPS * A_STATE
SSD_CHUNK = 128

B_WIDTH = D_MODEL
B_CHUNK = 128
B_GROUPS = B_WIDTH // 128

C_WIDTH = D_MODEL
C_CONV = 31

D_WIDTH = D_MODEL
D_HEADS = 16
D_BLOCK = D_WIDTH // D_HEADS
D_CONV = 4
LRU_C = 8.0

EVEN_IN = 2 * A_WIDTH + 2 * A_GROUPS * A_STATE + A_HEADS + 3 * B_WIDTH
EVEN_MIX = A_WIDTH + B_WIDTH
EVEN_SPLITS = [A_WIDTH, A_WIDTH + A_CONV_DIM, A_WIDTH + A_CONV_DIM + A_HEADS,
               A_WIDTH + A_CONV_DIM + A_HEADS + B_WIDTH,
               A_WIDTH + A_CONV_DIM + A_HEADS + 2 * B_WIDTH]
ODD_IN = 3 * C_WIDTH + 2 * D_WIDTH
ODD_MIX = C_WIDTH + D_WIDTH
ODD_SPLITS = [C_WIDTH, 2 * C_WIDTH, 3 * C_WIDTH, 3 * C_WIDTH + D_WIDTH]

kernel_name = 'hybrid_ssd_gmlp_conformer_rglru_step'


def _rmsnorm(x, g):
    xf = x.astype(jnp.float32)
    y = xf * lax.rsqrt(jnp.mean(xf * xf, axis=-1, keepdims=True) + EPS)
    return (y * g.astype(jnp.float32)).astype(x.dtype)


def _layernorm(x, g, b):
    xf = x.astype(jnp.float32)
    mu = jnp.mean(xf, axis=-1, keepdims=True)
    xc = xf - mu
    var = jnp.mean(xc * xc, axis=-1, keepdims=True)
    return (xc * lax.rsqrt(var + EPS) * g.astype(jnp.float32) + b.astype(jnp.float32)).astype(x.dtype)


def _causal_dwconv(x, buf, w, b):
    xp = jnp.concatenate([buf.astype(x.dtype), x], axis=1)
    y = lax.conv_general_dilated(xp, w[:, None, :].astype(x.dtype), window_strides=(1,),
                                 padding='VALID', dimension_numbers=('NWC', 'WIO', 'NWC'),
                                 feature_group_count=x.shape[-1])
    return y + b.astype(x.dtype), xp[:, -(w.shape[0] - 1):]


def _segsum(a):
    cs = jnp.cumsum(a, axis=-1)
    diff = cs[..., :, None] - cs[..., None, :]
    n = a.shape[-1]
    return jnp.where(jnp.tril(jnp.ones((n, n), dtype=bool)), diff, -jnp.inf)


def _ssd_scan(xh, dt, a, bm, cm, h0):
    bsz, L, H, P = xh.shape
    G, N = bm.shape[2], bm.shape[3]
    E = H // G
    T = min(SSD_CHUNK, L)
    pad = (-L) % T
    if pad:
        xh = jnp.pad(xh, ((0, 0), (0, pad), (0, 0), (0, 0)))
        dt = jnp.pad(dt, ((0, 0), (0, pad), (0, 0)))
        bm = jnp.pad(bm, ((0, 0), (0, pad), (0, 0), (0, 0)))
        cm = jnp.pad(cm, ((0, 0), (0, pad), (0, 0), (0, 0)))
    nc = (L + pad) // T
    xs = (xh * dt[..., None]).reshape(bsz, nc, T, G, E, P)
    da = jnp.transpose((dt * a).reshape(bsz, nc, T, G, E), (0, 1, 3, 4, 2))
    bm = bm.reshape(bsz, nc, T, G, N)
    cm = cm.reshape(bsz, nc, T, G, N)
    cs = jnp.cumsum(da, axis=-1)
    lmat = jnp.exp(_segsum(da))
    cb = jnp.einsum('bclgn,bcsgn->bcgls', cm, bm)
    y_diag = jnp.einsum('bcgels,bcsgep->bclgep', cb[:, :, :, None] * lmat, xs)
    decay_states = jnp.exp(cs[..., -1:] - cs)
    states = jnp.einsum('bclgn,bcgel,bclgep->bcgepn', bm, decay_states, xs)
    states = jnp.concatenate([h0.reshape(bsz, 1, G, E, P, N), states], axis=1)
    chunk_tot = jnp.pad(jnp.transpose(cs[..., -1], (0, 2, 3, 1)), ((0, 0), (0, 0), (0, 0), (1, 0)))
    decay_chunk = jnp.exp(_segsum(chunk_tot))
    new_states = jnp.einsum('bgezc,bcgepn->bzgepn', decay_chunk, states)
    y_off = jnp.einsum('bclgn,bcgepn,bcgel->bclgep', cm, new_states[:, :-1], jnp.exp(cs))
    y = (y_diag + y_off).reshape(bsz, nc * T, H, P)[:, :L]
    return y, new_states[:, -1].reshape(bsz, H, P, N)


def _ssd_mixer(z, xbc, dt_raw, conv_buf, h0, conv_w, conv_b, dt_bias, a_log, d_skip, gnorm_g):
    bsz, L, _ = z.shape
    xbc_c, buf_new = _causal_dwconv(xbc, conv_buf, conv_w, conv_b)
    xbc_c = jax.nn.silu(xbc_c.astype(jnp.float32))
    xs, bm, cm = jnp.split(xbc_c, [A_WIDTH, A_WIDTH + A_GROUPS * A_STATE], axis=-1)
    xh = xs.reshape(bsz, L, A_HEADS, A_HEAD_DIM)
    bm = bm.reshape(bsz, L, A_GROUPS, A_STATE)
    cm = cm.reshape(bsz, L, A_GROUPS, A_STATE)
    dt = jax.nn.softplus(dt_raw.astype(jnp.float32) + dt_bias.astype(jnp.float32))
    a = -jnp.exp(a_log.astype(jnp.float32))
    y, h_last = _ssd_scan(xh, dt, a, bm, cm, h0.astype(jnp.float32))
    y = y + xh * d_skip.astype(jnp.float32)[:, None]
    gw = A_WIDTH // A_GROUPS
    y = y.reshape(bsz, L, A_GROUPS, gw) * jax.nn.silu(z.astype(jnp.float32)).reshape(bsz, L, A_GROUPS, gw)
    y = _rmsnorm(y, gnorm_g.reshape(A_GROUPS, gw)).reshape(bsz, L, A_WIDTH)
    return y.astype(z.dtype), h_last.astype(h0.dtype), buf_new


def _chunk_gmlp_mixer(u, v, ln_g, ln_b, w_s, b_s):
    bsz, L, _ = v.shape
    u = jax.nn.gelu(u)
    vn = _layernorm(jax.nn.gelu(v), ln_g, ln_b)
    T = min(B_CHUNK, L)
    pad = (-L) % T
    vp = jnp.pad(vn, ((0, 0), (0, pad), (0, 0)))
    nc = (L + pad) // T
    vg = vp.reshape(bsz, nc, T, B_GROUPS, B_WIDTH // B_GROUPS)
    w = jnp.where(jnp.tril(jnp.ones((T, T), dtype=bool)), w_s[:, :T, :T], 0.0).astype(v.dtype)
    mixed = jnp.einsum('gts,bcsgd->bctgd', w, vg) + b_s[:, :T].T.astype(v.dtype)[None, None, :, :, None]
    mixed = mixed.reshape(bsz, nc * T, B_WIDTH)[:, :L]
    return u * mixed, vn


def _conformer_conv_mixer(ga, gb, conv_buf, conv_w, conv_b, ln_g, ln_b):
    glu = ga * jax.nn.sigmoid(gb)
    c, buf_new = _causal_dwconv(glu, conv_buf, conv_w, conv_b)
    return jax.nn.silu(_layernorm(c, ln_g, ln_b)), buf_new


def _rglru_mixer(xd, conv_buf, h0, conv_w, conv_b, wa, ba, wx, bx, lam):
    xc, buf_new = _causal_dwconv(xd, conv_buf, conv_w, conv_b)
    bsz, L, W = xc.shape
    xf = xc.astype(jnp.float32)
    xb = xf.reshape(bsz, L, D_HEADS, D_BLOCK)
    r = jax.nn.sigmoid(jnp.einsum('blhi,hij->blhj', xb, wa.astype(jnp.float32)).reshape(bsz, L, W) + ba.astype(jnp.float32))
    i = jax.nn.sigmoid(jnp.einsum('blhi,hij->blhj', xb, wx.astype(jnp.float32)).reshape(bsz, L, W) + bx.astype(jnp.float32))
    log_a = -LRU_C * r * jax.nn.softplus(-lam.astype(jnp.float32))
    a = jnp.exp(log_a)
    bterm = jnp.sqrt(-jnp.expm1(2.0 * log_a)) * (i * xf)
    bterm = bterm.at[:, 0].add(a[:, 0] * h0.astype(jnp.float32))

    def combine(e1, e2):
        a1, b1 = e1
        a2, b2 = e2
        return a1 * a2, a2 * b1 + b2

    _, h = lax.associative_scan(combine, (a, bterm), axis=1)
    return h.astype(xd.dtype), h[:, -1].astype(h0.dtype), buf_new


def _trunk(x, ssm0, ssdbuf0, cbuf0, lbuf0, lru0,
           norm_even, w_in_even, ssd_conv_w, ssd_conv_b, ssd_dt_bias, ssd_a_log, ssd_d, ssd_norm,
           gmlp_ln_g, gmlp_ln_b, gmlp_w_s, gmlp_b_s, w_out_even,
           norm_odd, w_in_odd, ccv_w, ccv_b, ccv_ln_g, ccv_ln_b,
           lru_conv_w, lru_conv_b, lru_wa, lru_ba, lru_wx, lru_bx, lru_lambda, w_out_odd, final_norm):
    ssm_n, ssdbuf_n, v_n, cbuf_n, lbuf_n, lru_n = [], [], [], [], [], []
    for layer in range(DEPTH):
        k = layer // 2
        if layer % 2 == 0:
            hn = _rmsnorm(x, norm_even[k])
            proj = jnp.einsum('bld,de->ble', hn, w_in_even[k])
            z, xbc, dt_raw, u, v, g = jnp.split(proj, EVEN_SPLITS, axis=-1)
            ya, ssm_new, sbuf_new = _ssd_mixer(z, xbc, dt_raw, ssdbuf0[k], ssm0[k], ssd_conv_w[k], ssd_conv_b[k],
                                               ssd_dt_bias[k], ssd_a_log[k], ssd_d[k], ssd_norm[k])
            yb, v_rows = _chunk_gmlp_mixer(u, v, gmlp_ln_g[k], gmlp_ln_b[k], gmlp_w_s[k], gmlp_b_s[k])
            mix = jnp.concatenate([ya, yb * jax.nn.silu(g)], axis=-1)
            x = x + jnp.einsum('ble,ed->bld', mix, w_out_even[k])
            ssm_n.append(ssm_new)
            ssdbuf_n.append(sbuf_new)
            v_n.append(v_rows)
        else:
            hn = _rmsnorm(x, norm_odd[k])
            proj = jnp.einsum('bld,de->ble', hn, w_in_odd[k])
            ga, gb, gc, xd, gd = jnp.split(proj, ODD_SPLITS, axis=-1)
            yc, cbuf_new = _conformer_conv_mixer(ga, gb, cbuf0[k], ccv_w[k], ccv_b[k], ccv_ln_g[k], ccv_ln_b[k])
            yd, h_last, lbuf_new = _rglru_mixer(xd, lbuf0[k], lru0[k], lru_conv_w[k], lru_conv_b[k],
                                                lru_wa[k], lru_ba[k], lru_wx[k], lru_bx[k], lru_lambda[k])
            mix = jnp.concatenate([yc * jax.nn.silu(gc), yd * jax.nn.silu(gd)], axis=-1)
            x = x + jnp.einsum('ble,ed->bld', mix, w_out_odd[k])
            cbuf_n.append(cbuf_new)
            lbuf_n.append(lbuf_new)
            lru_n.append(h_last)
    return (_rmsnorm(x, final_norm), jnp.stack(ssm_n), jnp.stack(ssdbuf_n), jnp.stack(v_n),
            jnp.stack(cbuf_n), jnp.stack(lbuf_n), jnp.stack(lru_n))


def setup_inputs(seed: int = 0) -> dict:
    key = jax.random.key(seed)
    ks = iter(jax.random.split(key, 48))

    def nrm(shape, scale=1.0):
        return scale * jax.random.normal(next(ks), shape, jnp.float32)

    def unif(shape, lo, hi):
        return jax.random.uniform(next(ks), shape, jnp.float32, lo, hi)

    dt0 = jnp.exp(unif((N_EVEN, A_HEADS), float(np.log(1e-3)), float(np.log(1e-1))))
    a_c = unif((N_ODD, D_WIDTH), 0.9, 0.999)
    s = a_c ** (1.0 / LRU_C)
    return {
        'x_prompt': nrm((BATCH, SEQ, D_MODEL)),
        'x_sample': nrm((DEC_BATCH, DEC_SEQ, D_MODEL)),
        'state_ssm': nrm((N_EVEN, DEC_BATCH, A_HEADS, A_HEAD_DIM, A_STATE), 0.1),
        'state_ssd_conv': nrm((N_EVEN, DEC_BATCH, A_CONV - 1, A_CONV_DIM)),
        'state_ccv': nrm((N_ODD, DEC_BATCH, C_CONV - 1, C_WIDTH), 0.5),
        'state_lru_conv': nrm((N_ODD, DEC_BATCH, D_CONV - 1, D_WIDTH)),
        'state_lru': nrm((N_ODD, DEC_BATCH, D_WIDTH), 0.5),
        'norm_even': 1.0 + nrm((N_EVEN, D_MODEL), 0.1),
        'w_in_even': nrm((N_EVEN, D_MODEL, EVEN_IN), D_MODEL ** -0.5),
        'ssd_conv_w': nrm((N_EVEN, A_CONV, A_CONV_DIM), A_CONV ** -0.5),
        'ssd_conv_b': nrm((N_EVEN, A_CONV_DIM), 0.02),
        'ssd_dt_bias': dt0 + jnp.log(-jnp.expm1(-dt0)),
        'ssd_a_log': jnp.log(unif((N_EVEN, A_HEADS), 1.0, 16.0)),
        'ssd_d': 1.0 + nrm((N_EVEN, A_HEADS), 0.1),
        'ssd_norm': 1.0 + nrm((N_EVEN, A_WIDTH), 0.1),
        'gmlp_ln_g': 1.0 + nrm((N_EVEN, B_WIDTH), 0.1),
        'gmlp_ln_b': nrm((N_EVEN, B_WIDTH), 0.02),
        'gmlp_w_s': nrm((N_EVEN, B_GROUPS, B_CHUNK, B_CHUNK), B_CHUNK ** -0.5),
        'gmlp_b_s': 1.0 + nrm((N_EVEN, B_GROUPS, B_CHUNK), 0.1),
        'w_out_even': nrm((N_EVEN, EVEN_MIX, D_MODEL), EVEN_MIX ** -0.5),
        'norm_odd': 1.0 + nrm((N_ODD, D_MODEL), 0.1),
        'w_in_odd': nrm((N_ODD, D_MODEL, ODD_IN), D_MODEL ** -0.5),
        'ccv_w': nrm((N_ODD, C_CONV, C_WIDTH), C_CONV ** -0.5),
        'ccv_b': nrm((N_ODD, C_WIDTH), 0.02),
        'ccv_ln_g': 1.0 + nrm((N_ODD, C_WIDTH), 0.1),
        'ccv_ln_b': nrm((N_ODD, C_WIDTH), 0.02),
        'lru_conv_w': nrm((N_ODD, D_CONV, D_WIDTH), D_CONV ** -0.5),
        'lru_conv_b': nrm((N_ODD, D_WIDTH), 0.02),
        'lru_wa': nrm((N_ODD, D_HEADS, D_BLOCK, D_BLOCK), D_BLOCK ** -0.5),
        'lru_ba': nrm((N_ODD, D_WIDTH), 0.02),
        'lru_wx': nrm((N_ODD, D_HEADS, D_BLOCK, D_BLOCK), D_BLOCK ** -0.5),
        'lru_bx': nrm((N_ODD, D_WIDTH), 0.02),
        'lru_lambda': jnp.log(s) - jnp.log1p(-s),
        'w_out_odd': nrm((N_ODD, ODD_MIX, D_MODEL), ODD_MIX ** -0.5),
        'final_norm': 1.0 + nrm((D_MODEL,), 0.1),
    }


def reference(x_prompt, x_sample, state_ssm, state_ssd_conv, state_ccv, state_lru_conv, state_lru,
              norm_even, w_in_even, ssd_conv_w, ssd_conv_b, ssd_dt_bias, ssd_a_log, ssd_d, ssd_norm,
              gmlp_ln_g, gmlp_ln_b, gmlp_w_s, gmlp_b_s, w_out_even,
              norm_odd, w_in_odd, ccv_w, ccv_b, ccv_ln_g, ccv_ln_b,
              lru_conv_w, lru_conv_b, lru_wa, lru_ba, lru_wx, lru_bx, lru_lambda, w_out_odd, final_norm):
    params = (norm_even, w_in_even, ssd_conv_w, ssd_conv_b, ssd_dt_bias, ssd_a_log, ssd_d, ssd_norm,
              gmlp_ln_g, gmlp_ln_b, gmlp_w_s, gmlp_b_s, w_out_even,
              norm_odd, w_in_odd, ccv_w, ccv_b, ccv_ln_g, ccv_ln_b,
              lru_conv_w, lru_conv_b, lru_wa, lru_ba, lru_wx, lru_bx, lru_lambda, w_out_odd, final_norm)
    dt = x_prompt.dtype
    y_prompt, ssm_p, ssdbuf_p, _, cbuf_p, lbuf_p, lru_p = _trunk(
        x_prompt,
        jnp.zeros((N_EVEN, BATCH, A_HEADS, A_HEAD_DIM, A_STATE), dt),
        jnp.zeros((N_EVEN, BATCH, A_CONV - 1, A_CONV_DIM), dt),
        jnp.zeros((N_ODD, BATCH, C_CONV - 1, C_WIDTH), dt),
        jnp.zeros((N_ODD, BATCH, D_CONV - 1, D_WIDTH), dt),
        jnp.zeros((N_ODD, BATCH, D_WIDTH), dt),
        *params)
    y_sample, ssm_s, ssdbuf_s, v_s, cbuf_s, lbuf_s, lru_s = _trunk(
        x_sample, state_ssm, state_ssd_conv, state_ccv, state_lru_conv, state_lru, *params)
    return (y_prompt, y_sample, ssm_p, ssm_s, ssdbuf_p, ssdbuf_s, v_s, cbuf_p, cbuf_s, lbuf_p, lbuf_s, lru_p, lru_s)
```

```cpp
#include <hip/hip_runtime.h>
#include <hip/hip_cooperative_groups.h>
#include <cstdio>
#include <cstdint>
namespace cg = cooperative_groups;
namespace pg8 {
#define PG8_LAS __attribute__((address_space(3)))
typedef unsigned short bf16_t;
typedef short bf16x8 __attribute__((ext_vector_type(8)));
typedef float f32x4 __attribute__((ext_vector_type(4)));
typedef unsigned u32x4 __attribute__((ext_vector_type(4)));
constexpr int BM = 256, BK = 64, HALF = 128, HTB = HALF * BK * 2  , STAGE_BYTES = 8 * HTB, NXCD = 8, WGM = 8;

__host__ __device__ __forceinline__ int lds_byte(int r, int c) { const int st = (r >> 4) * 2 + (c >> 5), rr = r & 15, cc = c & 31, ob = rr * 64 + cc * 2; return st * 1024 + (ob ^ (((ob >> 9) & 1) << 5)); }
__host__ __device__ __forceinline__ void stage_rc(int b, int& R, int& C) { const int st = b / 1024, sb = b % 1024, swz = sb ^ (((sb >> 9) & 1) << 5); R = (st >> 1) * 16 + swz / 64; C = (st & 1) * 32 + (swz % 64) / 2; }
__host__ __device__ __forceinline__ int perm32(int rho) { const int n = rho >> 4, i = rho & 15; return 8 * (i >> 2) + 4 * n + (i & 3); }

struct Unit { int pm, pn; };
struct Gemm { const bf16_t* A; const bf16_t* Bt; int M, N, K; };

struct StaticOrder {
    int nM, nN, nwg, G, c;
    __host__ __device__ void init(int M, int N, int G_, int c_) { nM = M / BM; nN = N / BM; nwg = nM * nN; G = G_; c = c_; }
    __host__ __device__ bool next(int i, Unit& u) const {
        const long L = (long)i * G + c; if (L >= nwg) return false;
        int wgid = (int)L; { const int q = nwg / NXCD, r = nwg % NXCD, xcd = wgid % NXCD, off = wgid / NXCD; wgid = (xcd < r ? xcd * (q + 1) : r * (q + 1) + (xcd - r) * q) + off; }
        const int nig = WGM * nN, gid = wgid / nig, fm = gid * WGM, gsz = (nM - fm) < WGM ? (nM - fm) : WGM;
        u.pm = fm + ((wgid % nig) % gsz); u.pn = (wgid % nig) / gsz; return true;
    }
    __device__ __forceinline__ void a_ready(const Unit&) const {}
    __device__ __forceinline__ void done(const Unit&) const {}
};

__device__ __forceinline__ unsigned cvt_pk_bf16(float lo, float hi) { unsigned r; asm volatile("v_cvt_pk_bf16_f32 %0, %1, %2" : "=v"(r) : "v"(lo), "v"(hi)); return r; }
template <class Epi, class Sched, class Hook, bool ALIGN_EPI = false, bool SP2 = false>
__device__ __forceinline__ void gemm_phase(PG8_LAS unsigned char* lds, const Gemm g, const Sched& S, const Epi& E, const Hook& H) {
    const int tid = threadIdx.x, wid = __builtin_amdgcn_readfirstlane(tid >> 6), lane = tid & 63, wr = wid >> 2, wc = wid & 3, fr = lane & 15, fq = lane >> 4;
    const int K = g.K, nt = K / BK;
    unsigned voffA[2], voffB[2];
#pragma unroll
    for (int i = 0; i < 2; ++i) { int R, C; stage_rc(tid * 16 + i * 8192, R, C); const int Rb = Epi::PERM ? ((R & ~31) + perm32(R & 31)) : R;
        voffA[i] = (unsigned)(R * K + C) * 2u; voffB[i] = (unsigned)(Rb * K + C) * 2u; }
    const size_t kstep = (size_t)(BK * 2);
    const size_t hstep = (size_t)HALF * K * 2;
    const size_t tstep = 2 * hstep;
    const unsigned ldsw = (unsigned)wid * 1024u;
    const int aoff = lds_byte(wr * 64 + fr, fq * 8), boff = lds_byte(wc * 32 + fr, fq * 8);
#define PG8_SA(b, h) (((b) * 2 + (h)) * HTB)
#define PG8_SB(b, h) ((4 + (b) * 2 + (h)) * HTB)
#define PG8_STAGE(bufoff, gbase, voff) do { _Pragma("unroll") for (int _i = 0; _i < 2; ++_i) \
        __builtin_amdgcn_global_load_lds((const unsigned*)((const char*)(gbase) + (voff)[_i]), (PG8_LAS unsigned*)(lds + (bufoff) + ldsw + _i * 8192), 16, 0, 0); } while (0)
#define PG8_LDA(dst, b, h) do { _Pragma("unroll") for (int m = 0; m < 4; ++m) _Pragma("unroll") for (int k = 0; k < 2; ++k) dst[m][k] = *(const PG8_LAS bf16x8*)(lds + PG8_SA(b, h) + aoff + m * 2048 + k * 1024); } while (0)
#define PG8_LDB(dst, b, h) do { _Pragma("unroll") for (int n = 0; n < 2; ++n) _Pragma("unroll") for (int k = 0; k < 2; ++k) dst[n][k] = *(const PG8_LAS bf16x8*)(lds + PG8_SB(b, h) + boff + n * 2048 + k * 1024); } while (0)
#define PG8_MMA(ai, bj, At, Bt) do { __builtin_amdgcn_s_setprio(1); _Pragma("unroll") for (int m = 0; m < 4; ++m) _Pragma("unroll") for (int n = 0; n < 2; ++n) _Pragma("unroll") for (int k = 0; k < 2; ++k) \
        acc[ai][bj][m][n] = __builtin_amdgcn_mfma_f32_16x16x32_bf16(Bt[n][k], At[m][k], acc[ai][bj][m][n], 0, 0, 0); __builtin_amdgcn_s_setprio(0); } while (0)
#define PG8_WAIT_V(n) asm volatile("s_waitcnt vmcnt(" #n ")" ::: "memory")
#define PG8_WAIT_L(n) asm volatile("s_waitcnt lgkmcnt(" #n ")" ::: "memory")
#define PG8_BAR __builtin_amdgcn_s_barrier()
#define PG8_SCHED __builtin_amdgcn_sched_barrier(0)
    Unit cur, nxt; int ui = 0;
    if (!S.next(0, cur)) return;
    f32x4 acc[2][2][4][2];
#pragma unroll
    for (int a = 0; a < 2; ++a)
#pragma unroll
        for (int b = 0; b < 2; ++b)
#pragma unroll
            for (int m = 0; m < 4; ++m)
#pragma unroll
                for (int n = 0; n < 2; ++n) acc[a][b][m][n] = (f32x4){0.f, 0.f, 0.f, 0.f};
    bf16x8 At[4][2], B0[2][2], B1[2][2];
    const char* cA = (const char*)g.A + (size_t)cur.pm * tstep; const char* cB = (const char*)g.Bt + (size_t)cur.pn * tstep;
    S.a_ready(cur);
    if constexpr (SP2) {
        PG8_STAGE(PG8_SB(0, 0), cB, voffB); PG8_STAGE(PG8_SB(0, 1), cB + hstep, voffB); PG8_STAGE(PG8_SA(0, 0), cA, voffA); PG8_STAGE(PG8_SA(0, 1), cA + hstep, voffA);
        if (wr == 1) PG8_BAR;
        PG8_WAIT_V(2); PG8_BAR;
        PG8_STAGE(PG8_SB(1, 0), cB + kstep, voffB); PG8_STAGE(PG8_SA(1, 0), cA + kstep, voffA); PG8_STAGE(PG8_SB(1, 1), cB + hstep + kstep, voffB);
        PG8_WAIT_V(6); PG8_BAR;
    } else {
        PG8_STAGE(PG8_SB(0, 0), cB, voffB); PG8_STAGE(PG8_SA(0, 0), cA, voffA); PG8_STAGE(PG8_SB(0, 1), cB + hstep, voffB); PG8_STAGE(PG8_SA(0, 1), cA + hstep, voffA);
        if (wr == 1) PG8_BAR;
        PG8_WAIT_V(4); PG8_BAR;
        PG8_STAGE(PG8_SB(1, 0), cB + kstep, voffB); PG8_STAGE(PG8_SA(1, 0), cA + kstep, voffA); PG8_STAGE(PG8_SB(1, 1), cB + hstep + kstep, voffB);
        PG8_WAIT_V(6); PG8_BAR;
    }
    for (;;) {
        const bool has_next = S.next(ui + 1, nxt);
        const char* nA = has_next ? (const char*)g.A + (size_t)nxt.pm * tstep : cA; const char* nB = has_next ? (const char*)g.Bt + (size_t)nxt.pn * tstep : cB;
        for (int t = 0; t < nt; t += 2) {
            const bool last = (t == nt - 2);
            const char* a1 = cA + (size_t)(t + 1) * kstep;
            const char* a2 = last ? nA : cA + (size_t)(t + 2) * kstep; const char* b2 = last ? nB : cB + (size_t)(t + 2) * kstep;
            const char* a3 = a2 + kstep; const char* b3 = b2 + kstep;
            if (last && has_next) S.a_ready(nxt);
            H(acc, t, wr, fr);
            if constexpr (SP2) {
            PG8_LDB(B0, 0, 0); PG8_LDB(B1, 0, 1); PG8_SCHED; PG8_LDA(At, 0, 0); PG8_STAGE(PG8_SA(1, 1), a1 + hstep, voffA);
            PG8_WAIT_V(8); PG8_WAIT_L(0); PG8_BAR; PG8_MMA(0, 0, At, B0); PG8_MMA(0, 1, At, B1); PG8_BAR; PG8_SCHED;
            PG8_LDA(At, 0, 1); PG8_STAGE(PG8_SB(0, 0), b2, voffB); PG8_STAGE(PG8_SB(0, 1), b2 + hstep, voffB); PG8_STAGE(PG8_SA(0, 0), a2, voffA);
            PG8_WAIT_V(8); PG8_WAIT_L(0); PG8_BAR; PG8_MMA(1, 0, At, B0); PG8_MMA(1, 1, At, B1); PG8_BAR; PG8_SCHED;
            PG8_LDB(B0, 1, 0); PG8_LDB(B1, 1, 1); PG8_SCHED; PG8_LDA(At, 1, 0); PG8_STAGE(PG8_SA(0, 1), a2 + hstep, voffA);
            PG8_WAIT_V(8); PG8_WAIT_L(0); PG8_BAR; PG8_MMA(0, 0, At, B0); PG8_MMA(0, 1, At, B1); PG8_BAR; PG8_SCHED;
            PG8_LDA(At, 1, 1); PG8_STAGE(PG8_SB(1, 0), b3, voffB); PG8_STAGE(PG8_SB(1, 1), b3 + hstep, voffB); PG8_STAGE(PG8_SA(1, 0), a3, voffA);
            PG8_WAIT_V(8); PG8_WAIT_L(0); PG8_BAR; PG8_MMA(1, 0, At, B0); PG8_MMA(1, 1, At, B1); PG8_BAR; PG8_SCHED;
            } else {
            PG8_LDB(B0, 0, 0); PG8_SCHED; PG8_LDA(At, 0, 0); PG8_STAGE(PG8_SA(1, 1), a1 + hstep, voffA);
            PG8_WAIT_L(8); PG8_BAR; PG8_WAIT_L(0); PG8_MMA(0, 0, At, B0); PG8_BAR; PG8_SCHED;
            PG8_LDB(B1, 0, 1); PG8_STAGE(PG8_SB(0, 0), b2, voffB);
            PG8_BAR; PG8_WAIT_L(0); PG8_MMA(0, 1, At, B1); PG8_BAR;
            PG8_LDA(At, 0, 1); PG8_STAGE(PG8_SA(0, 0), a2, voffA);
            PG8_BAR; PG8_WAIT_L(0); PG8_MMA(1, 0, At, B0); PG8_BAR; PG8_SCHED;
            PG8_STAGE(PG8_SB(0, 1), b2 + hstep, voffB);
            PG8_WAIT_V(6); PG8_BAR; PG8_MMA(1, 1, At, B1); PG8_BAR;
            PG8_LDB(B0, 1, 0); PG8_SCHED; PG8_LDA(At, 1, 0); PG8_STAGE(PG8_SA(0, 1), a2 + hstep, voffA);
            PG8_WAIT_L(8); PG8_BAR; PG8_WAIT_L(0); PG8_MMA(0, 0, At, B0); PG8_BAR; PG8_SCHED;
            PG8_LDB(B1, 1, 1); PG8_STAGE(PG8_SB(1, 0), b3, voffB);
            PG8_BAR; PG8_WAIT_L(0); PG8_MMA(0, 1, At, B1); PG8_BAR;
            PG8_LDA(At, 1, 1); PG8_STAGE(PG8_SA(1, 0), a3, voffA);
            PG8_BAR; PG8_WAIT_L(0); PG8_MMA(1, 0, At, B0); PG8_BAR; PG8_SCHED;
            PG8_STAGE(PG8_SB(1, 1), b3 + hstep, voffB);
            PG8_WAIT_V(6); PG8_BAR; PG8_MMA(1, 1, At, B1); PG8_BAR;
            }
        }
        if constexpr (ALIGN_EPI) { if (wr == 0) PG8_BAR; }
        if constexpr (!Epi::AFTER_DRAIN) { E(acc, cur, wr, wc, fr, fq); S.done(cur); }
        if (!has_next) break;
#pragma unroll
        for (int a = 0; a < 2; ++a)
#pragma unroll
            for (int b = 0; b < 2; ++b)
#pragma unroll
                for (int m = 0; m < 4; ++m)
#pragma unroll
                    for (int n = 0; n < 2; ++n) acc[a][b][m][n] = (f32x4){0.f, 0.f, 0.f, 0.f};
        cur = nxt; cA = nA; cB = nB; ++ui;
        if constexpr (ALIGN_EPI) { if (wr == 1) PG8_BAR; }
    }
    PG8_WAIT_V(0);
    if constexpr (!ALIGN_EPI) { if (wr == 0) PG8_BAR; }
    PG8_BAR;
    if constexpr (Epi::AFTER_DRAIN) { E.fused(acc, cur, wr, wc, fr, fq, lds, wid, lane); S.done(cur); }
#undef PG8_SA
#undef PG8_SB
#undef PG8_STAGE
#undef PG8_LDA
#undef PG8_LDB
#undef PG8_MMA
#undef PG8_WAIT_V
#undef PG8_WAIT_L
#undef PG8_BAR
#undef PG8_SCHED
}
}

using pg8::f32x4; using pg8::bf16x8; using pg8::Unit;
typedef unsigned short bf16;
typedef unsigned u32x2 __attribute__((ext_vector_type(2)));
typedef unsigned u32x4 __attribute__((ext_vector_type(4)));
typedef float f32x2 __attribute__((ext_vector_type(2)));
#define LAS3 __attribute__((address_space(3)))

constexpr int NP = 16384, NS = 128, NT = NP + NS, MP = 16640, SEQ = 2048;
constexpr int N1 = 5888, N3 = 5120;
constexpr float EPS = 1e-6f;
constexpr int LDS_BYTES = 147456;

constexpr size_t O_SSM_P = (size_t)NT * 1024;
constexpr size_t O_SSM_S = O_SSM_P + (size_t)8 * 16 * 64 * 128;
constexpr size_t O_SCONV_P = O_SSM_S + (size_t)128 * 16 * 64 * 128;
constexpr size_t O_SCONV_S = O_SCONV_P + 8 * 3 * 1536;
constexpr size_t O_GV_S = O_SCONV_S + 128 * 3 * 1536;
constexpr size_t O_CCV_P = O_GV_S + 128 * 1024;
constexpr size_t O_CCV_S = O_CCV_P + 8 * 30 * 1024;
constexpr size_t O_LCONV_P = O_CCV_S + 128 * 30 * 1024;
constexpr size_t O_LCONV_S = O_LCONV_P + 8 * 3 * 1024;
constexpr size_t O_LRU_P = O_LCONV_S + 128 * 3 * 1024;
constexpr size_t O_LRU_S = O_LRU_P + 8 * 1024;
constexpr size_t O_END = O_LRU_S + 128 * 1024;
static_assert(O_END == 40226816, "output size");

constexpr size_t MiB = 1u << 20;
constexpr size_t WS_SS0 = 0, WS_SS1 = 288 * 1024, WS_DT = 576 * 1024, WS_SSG = 1792 * 1024;
constexpr size_t WS_W4 = 4 * MiB, WS_W3 = 8 * MiB, WS_W2 = 18 * MiB, WS_XN = 22 * MiB, WS_W1 = 54 * MiB + 512 * 1024, WS_MIX = 66 * MiB, WS_XBC = 131 * MiB, WS_GV = 180 * MiB, WS_END = 213 * MiB;
static_assert(WS_XN + (size_t)MP * 1024 * 2 <= WS_W1 && WS_W1 + (size_t)N1 * 1024 * 2 <= WS_MIX && WS_MIX + (size_t)MP * 2048 * 2 <= WS_XBC && WS_XBC + (size_t)MP * 1536 * 2 <= WS_GV && WS_GV + (size_t)MP * 1024 * 2 <= WS_END, "ws map");
static_assert(WS_SS0 + (size_t)MP * 16 <= WS_SS1 && WS_SS1 + (size_t)MP * 16 <= WS_DT && WS_DT + (size_t)MP * 64 <= WS_SSG && WS_SSG + (size_t)NP * 128 <= WS_W4, "ws map small");

struct Ctx {
    const float *x_prompt, *x_sample, *state_ssm, *state_ssd_conv, *state_ccv, *state_lru_conv, *state_lru;
    const float *norm_even, *w_in_even, *ssd_conv_w, *ssd_conv_b, *ssd_dt_bias, *ssd_a_log, *ssd_d, *ssd_norm, *gmlp_ln_g, *gmlp_ln_b, *gmlp_w_s, *gmlp_b_s, *w_out_even;
    const float *norm_odd, *w_in_odd, *ccv_w, *ccv_b, *ccv_ln_g, *ccv_ln_b, *lru_conv_w, *lru_conv_b, *lru_wa, *lru_ba, *lru_wx, *lru_bx, *lru_lambda, *w_out_odd, *final_norm;
    float* out;
    float *ss0, *ss1, *DT, *ssg;
    bf16 *W1t, *W2t, *W3t, *W4t, *XN, *MIX, *XBC, *GV, *GLU, *XD;
};

__device__ __forceinline__ float bf2f(unsigned b) { return __uint_as_float(b << 16); }
__device__ __forceinline__ float bflo(unsigned w) { return __uint_as_float(w << 16); }
__device__ __forceinline__ float bfhi(unsigned w) { return __uint_as_float(w & 0xffff0000u); }
__device__ __forceinline__ unsigned pk2(float lo, float hi) { return pg8::cvt_pk_bf16(lo, hi); }
__device__ __forceinline__ float sigmoidf_(float x) { return __builtin_amdgcn_rcpf(1.f + __expf(-x)); }
__device__ __forceinline__ float siluf_(float x) { return x * sigmoidf_(x); }
__device__ __forceinline__ float geluf_(float x) { const float y = 1.5957691216057308f * (x + 0.044715f * x * x * x); return x * sigmoidf_(y); }
__device__ __forceinline__ float softplusf_(float x) { return fmaxf(x, 0.f) + log1pf(__expf(-fabsf(x))); }
__device__ __forceinline__ float wave_sum(float v) {
#pragma unroll
    for (int o = 1; o < 64; o <<= 1) v += __shfl_xor(v, o);
    return v;
}
__device__ __forceinline__ float block_sum(float v, float* red) {
    v = wave_sum(v);
    __syncthreads();
    if ((threadIdx.x & 63) == 0) red[threadIdx.x >> 6] = v;
    __syncthreads();
    float s = 0.f;
#pragma unroll
    for (int i = 0; i < 8; ++i) s += red[i];
    return s;
}
template <int CTRL> __device__ __forceinline__ float dpp_mov(float v) { return __int_as_float(__builtin_amdgcn_update_dpp(0, __float_as_int(v), CTRL, 0xf, 0xf, true)); }
__device__ __forceinline__ float row16_sum(float y) {
    y += dpp_mov<0x128>(y); y += dpp_mov<0x124>(y); y += dpp_mov<0x122>(y); y += dpp_mov<0x121>(y); return y;
}
__device__ __forceinline__ float rstd_from(const float* ss, int row) { const f32x4 s = *(const f32x4*)(ss + (size_t)row * 4); return rsqrtf(((s[0] + s[1]) + (s[2] + s[3])) * (1.f / 1024.f) + EPS); }
__device__ __forceinline__ u32x4 pack8(const f32x4 a, const f32x4 b) { u32x4 w; w.x = pk2(a[0], a[1]); w.y = pk2(a[2], a[3]); w.z = pk2(b[0], b[1]); w.w = pk2(b[2], b[3]); return w; }
__device__ __forceinline__ void unpack8(const u32x4 w, float (&f)[8]) { f[0] = bflo(w.x); f[1] = bfhi(w.x); f[2] = bflo(w.y); f[3] = bfhi(w.y); f[4] = bflo(w.z); f[5] = bfhi(w.z); f[6] = bflo(w.w); f[7] = bfhi(w.w); }

struct NoHook { __device__ __forceinline__ void operator()(f32x4 (&)[2][2][4][2], int, int, int) const {} };
struct HookScale {
    const LAS3 float* tab;
    __device__ __forceinline__ void operator()(f32x4 (&acc)[2][2][4][2], int t, int wr, int fr) const {
        if (t == 8 || t == 16) {
            const int j = (t == 16) ? 1 : 0;
#pragma unroll
            for (int ai = 0; ai < 2; ++ai)
#pragma unroll
                for (int m = 0; m < 4; ++m) { const float f = tab[(ai * 128 + wr * 64 + m * 16 + fr) * 2 + j];
#pragma unroll
                    for (int bj = 0; bj < 2; ++bj)
#pragma unroll
                        for (int n = 0; n < 2; ++n) acc[ai][bj][m][n] *= f; }
        }
    }
};

struct Epi1 {
    static constexpr bool PERM = true, AFTER_DRAIN = false;
    const float* ss; bf16* MIX; bf16* XBC; bf16* GV; float* DT;
    __device__ __forceinline__ void operator()(const f32x4 (&acc)[2][2][4][2], const Unit& u, int wr, int wc, int fr, int fq) const {
        const int row0 = u.pm * 256 + wr * 64 + fr, pn = u.pn, cl = wc * 32 + 8 * fq;
        float rs[2][4];
#pragma unroll
        for (int ai = 0; ai < 2; ++ai)
#pragma unroll
            for (int m = 0; m < 4; ++m) rs[ai][m] = rstd_from(ss, row0 + ai * 128 + m * 16);
        if (pn < 4) {
#pragma unroll
            for (int ai = 0; ai < 2; ++ai)
#pragma unroll
                for (int m = 0; m < 4; ++m) { bf16* rp = MIX + (size_t)(row0 + ai * 128 + m * 16) * 2048 + pn * 256 + cl; const float r = rs[ai][m];
#pragma unroll
                    for (int bj = 0; bj < 2; ++bj) { f32x4 v0 = acc[ai][bj][m][0] * r, v1 = acc[ai][bj][m][1] * r;
#pragma unroll
                        for (int j = 0; j < 4; ++j) { v0[j] = siluf_(v0[j]); v1[j] = siluf_(v1[j]); }
                        *(u32x4*)(rp + bj * 128) = pack8(v0, v1); } }
        } else if (pn < 10) {
#pragma unroll
            for (int ai = 0; ai < 2; ++ai)
#pragma unroll
                for (int m = 0; m < 4; ++m) { bf16* rp = XBC + (size_t)(row0 + ai * 128 + m * 16) * 1536 + (pn - 4) * 256 + cl; const float r = rs[ai][m];
#pragma unroll
                    for (int bj = 0; bj < 2; ++bj) *(u32x4*)(rp + bj * 128) = pack8(acc[ai][bj][m][0] * r, acc[ai][bj][m][1] * r); }
        } else if (pn < 18) {
#pragma unroll
            for (int ai = 0; ai < 2; ++ai)
#pragma unroll
                for (int m = 0; m < 4; ++m) { bf16* rp = MIX + (size_t)(row0 + ai * 128 + m * 16) * 2048 + 1024 + (pn - 10) * 128 + cl; const float r = rs[ai][m];
                    f32x4 o[2];
#pragma unroll
                    for (int n = 0; n < 2; ++n) { const f32x4 uu = acc[ai][0][m][n] * r, gg = acc[ai][1][m][n] * r;
#pragma unroll
                        for (int j = 0; j < 4; ++j) o[n][j] = geluf_(uu[j]) * siluf_(gg[j]); }
                    *(u32x4*)rp = pack8(o[0], o[1]); }
        } else if (pn < 22) {
#pragma unroll
            for (int ai = 0; ai < 2; ++ai)
#pragma unroll
                for (int m = 0; m < 4; ++m) { bf16* rp = GV + (size_t)(row0 + ai * 128 + m * 16) * 1024 + (pn - 18) * 256 + cl; const float r = rs[ai][m];
#pragma unroll
                    for (int bj = 0; bj < 2; ++bj) { f32x4 v0 = acc[ai][bj][m][0] * r, v1 = acc[ai][bj][m][1] * r;
#pragma unroll
                        for (int j = 0; j < 4; ++j) { v0[j] = geluf_(v0[j]); v1[j] = geluf_(v1[j]); }
                        *(u32x4*)(rp + bj * 128) = pack8(v0, v1); } }
        } else {
            if (wc == 0 && fq < 2) {
#pragma unroll
                for (int ai = 0; ai < 2; ++ai)
#pragma unroll
                    for (int m = 0; m < 4; ++m) { float* rp = DT + (size_t)(row0 + ai * 128 + m * 16) * 16 + 8 * fq; const float r = rs[ai][m];
#pragma unroll
                        for (int n = 0; n < 2; ++n) *(f32x4*)(rp + 4 * n) = acc[ai][0][m][n] * r; }
            }
        }
    }
};
struct Epi3 {
    static constexpr bool PERM = true, AFTER_DRAIN = false;
    const float* ss; bf16* MIX; bf16* GLU; bf16* XD;
    __device__ __forceinline__ void operator()(const f32x4 (&acc)[2][2][4][2], const Unit& u, int wr, int wc, int fr, int fq) const {
        const int row0 = u.pm * 256 + wr * 64 + fr, pn = u.pn, cl = wc * 32 + 8 * fq;
        float rs[2][4];
#pragma unroll
        for (int ai = 0; ai < 2; ++ai)
#pragma unroll
            for (int m = 0; m < 4; ++m) rs[ai][m] = rstd_from(ss, row0 + ai * 128 + m * 16);
        if (pn < 8) {
#pragma unroll
            for (int ai = 0; ai < 2; ++ai)
#pragma unroll
                for (int m = 0; m < 4; ++m) { bf16* rp = GLU + (size_t)(row0 + ai * 128 + m * 16) * 1024 + pn * 128 + cl; const float r = rs[ai][m];
                    f32x4 o[2];
#pragma unroll
                    for (int n = 0; n < 2; ++n) { const f32x4 aa = acc[ai][0][m][n] * r, bb = acc[ai][1][m][n] * r;
#pragma unroll
                        for (int j = 0; j < 4; ++j) o[n][j] = aa[j] * sigmoidf_(bb[j]); }
                    *(u32x4*)rp = pack8(o[0], o[1]); }
        } else if (pn >= 12 && pn < 16) {
#pragma unroll
            for (int ai = 0; ai < 2; ++ai)
#pragma unroll
                for (int m = 0; m < 4; ++m) { bf16* rp = XD + (size_t)(row0 + ai * 128 + m * 16) * 1024 + (pn - 12) * 256 + cl; const float r = rs[ai][m];
#pragma unroll
                    for (int bj = 0; bj < 2; ++bj) *(u32x4*)(rp + bj * 128) = pack8(acc[ai][bj][m][0] * r, acc[ai][bj][m][1] * r); }
        } else {
            const int cb = pn < 12 ? (pn - 8) * 256 : 1024 + (pn - 16) * 256;
#pragma unroll
            for (int ai = 0; ai < 2; ++ai)
#pragma unroll
                for (int m = 0; m < 4; ++m) { bf16* rp = MIX + (size_t)(row0 + ai * 128 + m * 16) * 2048 + cb + cl; const float r = rs[ai][m];
#pragma unroll
                    for (int bj = 0; bj < 2; ++bj) { f32x4 v0 = acc[ai][bj][m][0] * r, v1 = acc[ai][bj][m][1] * r;
#pragma unroll
                        for (int j = 0; j < 4; ++j) { v0[j] = siluf_(v0[j]); v1[j] = siluf_(v1[j]); }
                        *(u32x4*)(rp + bj * 128) = pack8(v0, v1); } }
        }
    }
};
struct EpiOut {
    static constexpr bool PERM = false, AFTER_DRAIN = true;
    const float* xold; float* xnew; bf16* XN; const float* gn; float* ss;
    __device__ __forceinline__ void operator()(const f32x4 (&)[2][2][4][2], const Unit&, int, int, int, int) const {}
    __device__ __forceinline__ void fused(f32x4 (&acc)[2][2][4][2], const Unit& u, int wr, int wc, int fr, int fq, PG8_LAS unsigned char* lds, int wid, int lane) const {
        const int col0 = u.pn * 256 + wc * 32 + 4 * fq;
        PG8_LAS float* red = (PG8_LAS float*)lds;
#pragma unroll
        for (int ai = 0; ai < 2; ++ai)
#pragma unroll
            for (int m = 0; m < 4; ++m) { const int rl = ai * 128 + wr * 64 + m * 16 + fr; const size_t off = (size_t)(u.pm * 256 + rl) * 1024 + col0; float q = 0.f;
#pragma unroll
                for (int bj = 0; bj < 2; ++bj)
#pragma unroll
                    for (int n = 0; n < 2; ++n) { const size_t o2 = off + bj * 128 + n * 16; const f32x4 v = *(const f32x4*)(xold + o2) + acc[ai][bj][m][n]; *(f32x4*)(xnew + o2) = v;
                        if (XN) { const f32x4 g = *(const f32x4*)(gn + col0 + bj * 128 + n * 16); u32x2 w; w.x = pk2(v[0] * g[0], v[1] * g[1]); w.y = pk2(v[2] * g[2], v[3] * g[3]); *(u32x2*)(XN + o2) = w;
                            q += (v[0] * v[0] + v[1] * v[1]) + (v[2] * v[2] + v[3] * v[3]); } }
                if (XN) { q += __shfl_xor(q, 16); q += __shfl_xor(q, 32); if (fq == 0) red[rl * 4 + wc] = q; }
                asm volatile("" ::: "memory"); }
        if (XN) {
            __syncthreads();
            const int t = wid * 64 + lane;
            if (t < 256) ss[(size_t)(u.pm * 256 + t) * 4 + u.pn] = (red[t * 4 + 0] + red[t * 4 + 1]) + (red[t * 4 + 2] + red[t * 4 + 3]);
        }
    }
};

template <int MODE> __device__ __forceinline__ int src_col(int n) {
    const int tile = n >> 8, cl = n & 255;
    if (MODE == 1) {
        if (tile < 10) return n;
        if (tile < 18) { const int q = tile - 10; return cl < 128 ? 2576 + 128 * q + cl : 4624 + 128 * q + (cl - 128); }
        if (tile < 22) return 3600 + (n - 18 * 256);
        return cl < 16 ? 2560 + cl : -1;
    } else if (MODE == 3) {
        if (tile < 8) return cl < 128 ? 128 * tile + cl : 1024 + 128 * tile + (cl - 128);
        return n;
    }
    return n;
}
template <int MODE> __device__ __forceinline__ void transpose_item(const float* W, int K, int Nsrc, bf16* WT, const float* kscale, float* scr, int item, int nblk, int lane) {
    const int kb = item / nblk, nb = item % nblk, k0 = 64 * kb, n0 = 32 * nb;
    const int sc = src_col<MODE>(n0 + (lane & 31));
#pragma unroll 8
    for (int i = 0; i < 32; ++i) { const int kk = 2 * i + (lane >> 5); float v = sc >= 0 ? W[(size_t)(k0 + kk) * Nsrc + sc] : 0.f; if (kscale != nullptr && (k0 + kk) < 1024) v *= kscale[k0 + kk]; scr[kk * 33 + (lane & 31)] = v; }
    asm volatile("s_waitcnt lgkmcnt(0)" ::: "memory");
    const int c = lane & 7;
#pragma unroll
    for (int j = 0; j < 4; ++j) { const int n = (lane >> 3) + 8 * j; const float* s = scr + (8 * c) * 33 + n;
        u32x4 o; o.x = pk2(s[0 * 33], s[1 * 33]); o.y = pk2(s[2 * 33], s[3 * 33]); o.z = pk2(s[4 * 33], s[5 * 33]); o.w = pk2(s[6 * 33], s[7 * 33]);
        *(u32x4*)(WT + (size_t)(n0 + n) * K + k0 + 8 * c) = o; }
    asm volatile("s_waitcnt lgkmcnt(0)" ::: "memory");
}
__device__ __forceinline__ void p0_prologue(const Ctx& c, unsigned char* sm) {
    const int tid = threadIdx.x, lane = tid & 63, wave = tid >> 6;
    const int gw = blockIdx.x * 8 + wave, NGW = gridDim.x * 8;
    float* scr = (float*)(sm + wave * 16384);
    constexpr int I1 = 16 * (N1 / 32), I2 = 32 * 32, I3 = 16 * (N3 / 32), I4 = 32 * 32;
    for (int it = gw; it < I1 + I2 + I3 + I4; it += NGW) {
        int r = it;
        if (r < I1) { transpose_item<1>(c.w_in_even, 1024, 5648, c.W1t, nullptr, scr, r, N1 / 32, lane); continue; } r -= I1;
        if (r < I2) { transpose_item<0>(c.w_out_even, 2048, 1024, c.W2t, c.ssd_norm, scr, r, 32, lane); continue; } r -= I2;
        if (r < I3) { transpose_item<3>(c.w_in_odd, 1024, 5120, c.W3t, nullptr, scr, r, N3 / 32, lane); continue; } r -= I3;
        transpose_item<0>(c.w_out_odd, 2048, 1024, c.W4t, nullptr, scr, r, 32, lane);
    }
    for (int m = gw; m < MP; m += NGW) {
        unsigned long long* o8 = (unsigned long long*)(c.XN + (size_t)m * 1024) + lane;
        if (m < NT) {
            const float* xr = m < NP ? c.x_prompt + (size_t)m * 1024 : c.x_sample + (size_t)(m - NP) * 1024;
            f32x4 v[4]; float s = 0.f;
#pragma unroll
            for (int j = 0; j < 4; ++j) { v[j] = ((const f32x4*)xr)[lane + 64 * j]; s += (v[j][0] * v[j][0] + v[j][1] * v[j][1]) + (v[j][2] * v[j][2] + v[j][3] * v[j][3]); }
            s = wave_sum(s);
#pragma unroll
            for (int j = 0; j < 4; ++j) { const f32x4 g = ((const f32x4*)c.norm_even)[lane + 64 * j]; o8[64 * j] = (unsigned long long)pk2(v[j][0] * g[0], v[j][1] * g[1]) | ((unsigned long long)pk2(v[j][2] * g[2], v[j][3] * g[3]) << 32); }
            if (lane == 0) *(f32x4*)(c.ss0 + (size_t)m * 4) = (f32x4){s, 0.f, 0.f, 0.f};
        } else {
#pragma unroll
            for (int j = 0; j < 4; ++j) o8[64 * j] = 0ull;
            if (lane == 0) *(f32x4*)(c.ss0 + (size_t)m * 4) = (f32x4){0.f, 0.f, 0.f, 0.f};
        }
        if (m >= NP && lane == 0) *(f32x4*)(c.ss1 + (size_t)m * 4) = (f32x4){0.f, 0.f, 0.f, 0.f};
    }
}

__device__ __forceinline__ void ssd_scan_unit(const Ctx& c, int u, unsigned char* sm) {
    const int tid = threadIdx.x;
    const int b = u >> 5, h = (u >> 1) & 15, ph = u & 1, g = h >> 3;
    float* xs = (float*)sm;
    float* Bs = (float*)(sm + 16384);
    float* Cs = (float*)(sm + 49152);
    float* dts = (float*)(sm + 81920);
    float* dAs = dts + 64;
    float* ys = (float*)(sm + 82944);
    const int o = tid % 36, run = tid / 36;
    int ch; if (o < 4) ch = h * 64 + ph * 32 + o * 8; else if (o < 20) ch = 1024 + g * 128 + (o - 4) * 8; else ch = 1280 + g * 128 + (o - 20) * 8;
    float w[4][8], bias[8];
    if (tid < 288) {
#pragma unroll
        for (int k = 0; k < 4; ++k) { const f32x4 a = *(const f32x4*)(c.ssd_conv_w + k * 1536 + ch), bq = *(const f32x4*)(c.ssd_conv_w + k * 1536 + ch + 4);
#pragma unroll
            for (int e = 0; e < 4; ++e) { w[k][e] = a[e]; w[k][4 + e] = bq[e]; } }
        const f32x4 a = *(const f32x4*)(c.ssd_conv_b + ch), bq = *(const f32x4*)(c.ssd_conv_b + ch + 4);
#pragma unroll
        for (int e = 0; e < 4; ++e) { bias[e] = a[e]; bias[4 + e] = bq[e]; }
    }
    const float a_h = -__expf(c.ssd_a_log[h]), dtb = c.ssd_dt_bias[h], Dh = c.ssd_d[h];
    const int pl = tid >> 4, nq = tid & 15;
    float hst[8];
#pragma unroll
    for (int j = 0; j < 8; ++j) hst[j] = 0.f;
    for (int tile = 0; tile <= 32; ++tile) {
        if (tile < 32) {
            const int t0 = tile * 64;
            if (tid < 288) {
                float* xsb = xs + (tile & 1) * 2048;
                float raw[11][8];
#pragma unroll
                for (int j = 0; j < 11; ++j) { const int t = t0 + run * 8 - 3 + j;
                    if (t >= 0) { const u32x4 v = *(const u32x4*)(c.XBC + (size_t)(b * SEQ + t) * 1536 + ch); unpack8(v, raw[j]); }
                    else {
#pragma unroll
                        for (int e = 0; e < 8; ++e) raw[j][e] = 0.f; } }
#pragma unroll
                for (int i = 0; i < 8; ++i) { float r8[8];
#pragma unroll
                    for (int e = 0; e < 8; ++e) { float s = bias[e];
#pragma unroll
                        for (int k = 0; k < 4; ++k) s += w[k][e] * raw[i + k][e];
                        r8[e] = siluf_(s); }
                    const int tl = run * 8 + i;
                    float* dst = o < 4 ? xsb + tl * 32 + o * 8 : (o < 20 ? Bs + tl * 128 + (o - 4) * 8 : Cs + tl * 128 + (o - 20) * 8);
                    *(f32x4*)dst = (f32x4){r8[0], r8[1], r8[2], r8[3]}; *(f32x4*)(dst + 4) = (f32x4){r8[4], r8[5], r8[6], r8[7]}; }
            } else if (tid < 352) {
                const int tl = tid - 288;
                const float dt = softplusf_(c.DT[(size_t)(b * SEQ + t0 + tl) * 16 + h] + dtb);
                dts[tl] = dt; dAs[tl] = __expf(dt * a_h);
            }
        }
        if (tile >= 1) {
            const float* xsp = xs + ((tile - 1) & 1) * 2048;
            const int tl = tid >> 3, c4 = (tid & 7) * 4;
            const int row = b * SEQ + (tile - 1) * 64 + tl;
            bf16* p = c.MIX + (size_t)row * 2048 + h * 64 + ph * 32 + c4;
            const u32x2 zz = *(const u32x2*)p;
            const float y0 = (ys[tl * 32 + c4 + 0] + Dh * xsp[tl * 32 + c4 + 0]) * bflo(zz.x);
            const float y1 = (ys[tl * 32 + c4 + 1] + Dh * xsp[tl * 32 + c4 + 1]) * bfhi(zz.x);
            const float y2 = (ys[tl * 32 + c4 + 2] + Dh * xsp[tl * 32 + c4 + 2]) * bflo(zz.y);
            const float y3 = (ys[tl * 32 + c4 + 3] + Dh * xsp[tl * 32 + c4 + 3]) * bfhi(zz.y);
            u32x2 wv; wv.x = pk2(y0, y1); wv.y = pk2(y2, y3); *(u32x2*)p = wv;
            float q = (y0 * y0 + y1 * y1) + (y2 * y2 + y3 * y3);
            q += __shfl_xor(q, 1); q += __shfl_xor(q, 2); q += __shfl_xor(q, 4);
            if ((tid & 7) == 0) c.ssg[((size_t)row * 2 + g) * 16 + (h & 7) * 2 + ph] = q;
        }
        __syncthreads();
        if (tile < 32) {
            const float* xsb = xs + (tile & 1) * 2048;
#pragma unroll 4
            for (int tl = 0; tl < 64; ++tl) {
                const float dA = dAs[tl], dtx = dts[tl] * xsb[tl * 32 + pl];
                const f32x4 b0 = *(const f32x4*)(Bs + tl * 128 + nq * 8), b1 = *(const f32x4*)(Bs + tl * 128 + nq * 8 + 4);
                const f32x4 c0 = *(const f32x4*)(Cs + tl * 128 + nq * 8), c1 = *(const f32x4*)(Cs + tl * 128 + nq * 8 + 4);
#pragma unroll
                for (int j = 0; j < 4; ++j) { hst[j] = fmaf(dA, hst[j], dtx * b0[j]); hst[4 + j] = fmaf(dA, hst[4 + j], dtx * b1[j]); }
                float y = ((c0[0] * hst[0] + c0[1] * hst[1]) + (c0[2] * hst[2] + c0[3] * hst[3])) + ((c1[0] * hst[4] + c1[1] * hst[5]) + (c1[2] * hst[6] + c1[3] * hst[7]));
                y = row16_sum(y);
                if (nq == 0) ys[tl * 32 + pl] = y;
            }
        }
        __syncthreads();
    }
    float* so = c.out + O_SSM_P + ((size_t)(b * 16 + h) * 64 + ph * 32 + pl) * 128 + nq * 8;
    *(f32x4*)so = (f32x4){hst[0], hst[1], hst[2], hst[3]}; *(f32x4*)(so + 4) = (f32x4){hst[4], hst[5], hst[6], hst[7]};
}

__device__ __forceinline__ void gmlp_unit(const Ctx& c, int u, unsigned char* sm) {
    const int tid = threadIdx.x, lane = tid & 63, w = tid >> 6, fr = lane & 15, fq = lane >> 4;
    const int b = u >> 5, ck = (u >> 1) & 15, gh = u & 1;
    const int r0 = b * SEQ + ck * 128;
    float* stat = (float*)sm;
    unsigned char* vbase = sm + 1024;
    for (int i = 0; i < 16; ++i) {
        const int tk = w * 16 + i;
        const u32x4* gp = (const u32x4*)(c.GV + (size_t)(r0 + tk) * 1024 + lane * 16);
        float f0[8], f1[8]; unpack8(gp[0], f0); unpack8(gp[1], f1);
        float s = 0.f, q = 0.f;
#pragma unroll
        for (int e = 0; e < 8; ++e) { s += f0[e] + f1[e]; q += f0[e] * f0[e] + f1[e] * f1[e]; }
        s = wave_sum(s); q = wave_sum(q);
        if (lane == 0) { const float mean = s * (1.f / 1024.f); const float var = fmaxf(q * (1.f / 1024.f) - mean * mean, 0.f); stat[tk * 2] = mean; stat[tk * 2 + 1] = rsqrtf(var + EPS); }
    }
    __syncthreads();
    for (int gi = 0; gi < 4; ++gi) {
        const int grp = gh * 4 + gi;
        unsigned char* vnT = vbase + (gi & 1) * 34816;
#pragma unroll
        for (int it = 0; it < 2; ++it) {
            const int item = tid + 512 * it, sp = item & 63, d8 = item >> 6;
            const int s0 = 2 * sp, chn = grp * 128 + d8 * 8;
            float a[8], bq[8]; unpack8(*(const u32x4*)(c.GV + (size_t)(r0 + s0) * 1024 + chn), a); unpack8(*(const u32x4*)(c.GV + (size_t)(r0 + s0 + 1) * 1024 + chn), bq);
            const float m0 = stat[s0 * 2], rs0 = stat[s0 * 2 + 1], m1 = stat[s0 * 2 + 2], rs1 = stat[s0 * 2 + 3];
            const f32x4 lg0 = *(const f32x4*)(c.gmlp_ln_g + chn), lg1 = *(const f32x4*)(c.gmlp_ln_g + chn + 4), lb0 = *(const f32x4*)(c.gmlp_ln_b + chn), lb1 = *(const f32x4*)(c.gmlp_ln_b + chn + 4);
#pragma unroll
            for (int e = 0; e < 8; ++e) { const float lg = e < 4 ? lg0[e & 3] : lg1[e & 3], lb = e < 4 ? lb0[e & 3] : lb1[e & 3];
                const float v0 = (a[e] - m0) * rs0 * lg + lb, v1 = (bq[e] - m1) * rs1 * lg + lb;
                *(unsigned*)(vnT + (d8 * 8 + e) * 272 + sp * 4) = pk2(v0, v1); }
        }
        __syncthreads();
        f32x4 acc[8];
#pragma unroll
        for (int dt = 0; dt < 8; ++dt) acc[dt] = (f32x4){0.f, 0.f, 0.f, 0.f};
        const int t = 16 * w + fr;
        const float* wrow = c.gmlp_w_s + ((size_t)grp * 128 + t) * 128;
        const int nk = (w >> 1) + 1;
        for (int kk = 0; kk < nk; ++kk) {
            const int sb = kk * 32 + fq * 8;
            const f32x4 w0 = *(const f32x4*)(wrow + sb), w1 = *(const f32x4*)(wrow + sb + 4);
            f32x4 m0, m1;
#pragma unroll
            for (int e = 0; e < 4; ++e) { m0[e] = (sb + e <= t) ? w0[e] : 0.f; m1[e] = (sb + 4 + e <= t) ? w1[e] : 0.f; }
            const u32x4 wp = pack8(m0, m1);
            const bf16x8 wf = __builtin_bit_cast(bf16x8, wp);
#pragma unroll
            for (int dt = 0; dt < 8; ++dt) {
                const bf16x8 vf = *(const bf16x8*)(vnT + (dt * 16 + fr) * 272 + sb * 2);
                acc[dt] = __builtin_amdgcn_mfma_f32_16x16x32_bf16(vf, wf, acc[dt], 0, 0, 0);
            }
        }
        const float bs = c.gmlp_b_s[grp * 128 + t];
        bf16* mp = c.MIX + (size_t)(r0 + t) * 2048 + 1024 + grp * 128 + 4 * fq;
#pragma unroll
        for (int dt = 0; dt < 8; ++dt) { const u32x2 ug = *(const u32x2*)(mp + dt * 16);
            u32x2 o; o.x = pk2((acc[dt][0] + bs) * bflo(ug.x), (acc[dt][1] + bs) * bfhi(ug.x)); o.y = pk2((acc[dt][2] + bs) * bflo(ug.y), (acc[dt][3] + bs) * bfhi(ug.y));
            *(u32x2*)(mp + dt * 16) = o; }
    }
    __syncthreads();
}

__device__ __forceinline__ void sample_even_unit(const Ctx& c, int u, unsigned char* sm) {
    const int tid = threadIdx.x;
    const int bs = u >> 1, g = u & 1, row = NP + bs;
    float* xcs = (float*)sm;
    float* ygs = xcs + 768;
    float* red = ygs + 512;
    const float* buf = c.state_ssd_conv + (size_t)bs * 3 * 1536;
    for (int i = tid; i < 768; i += 512) {
        const int ch = i < 512 ? g * 512 + i : (i < 640 ? 1024 + g * 128 + (i - 512) : 1280 + g * 128 + (i - 640));
        const float xn = bf2f(c.XBC[(size_t)row * 1536 + ch]);
        float s = c.ssd_conv_b[ch] + c.ssd_conv_w[ch] * buf[ch] + c.ssd_conv_w[1536 + ch] * buf[1536 + ch] + c.ssd_conv_w[2 * 1536 + ch] * buf[2 * 1536 + ch] + c.ssd_conv_w[3 * 1536 + ch] * xn;
        xcs[i] = siluf_(s);
        float* so = c.out + O_SCONV_S + (size_t)bs * 3 * 1536;
        so[ch] = buf[1536 + ch]; so[1536 + ch] = buf[2 * 1536 + ch]; so[2 * 1536 + ch] = xn;
    }
    __syncthreads();
    const int p = tid >> 3, nq = tid & 7;
    for (int hh = 0; hh < 8; ++hh) {
        const int h = g * 8 + hh;
        const float dt = softplusf_(c.DT[(size_t)row * 16 + h] + c.ssd_dt_bias[h]);
        const float dA = __expf(-dt * __expf(c.ssd_a_log[h]));
        const float xv = xcs[hh * 64 + p], dtx = dt * xv;
        const size_t so = ((size_t)(bs * 16 + h) * 64 + p) * 128 + nq * 16;
        float y = 0.f;
#pragma unroll
        for (int j = 0; j < 4; ++j) {
            const f32x4 s = *(const f32x4*)(c.state_ssm + so + 4 * j);
            const f32x4 bv = *(const f32x4*)(xcs + 512 + nq * 16 + 4 * j), cv = *(const f32x4*)(xcs + 640 + nq * 16 + 4 * j);
            f32x4 hn;
#pragma unroll
            for (int e = 0; e < 4; ++e) { hn[e] = dA * s[e] + dtx * bv[e]; y += cv[e] * hn[e]; }
            *(f32x4*)(c.out + O_SSM_S + so + 4 * j) = hn;
        }
        y += __shfl_xor(y, 1); y += __shfl_xor(y, 2); y += __shfl_xor(y, 4);
        if (nq == 0) { y += c.ssd_d[h] * xv; ygs[hh * 64 + p] = y * bf2f(c.MIX[(size_t)row * 2048 + h * 64 + p]); }
    }
    __syncthreads();
    {
        const float v = ygs[tid];
        const float q = block_sum(v * v, red);
        c.MIX[(size_t)row * 2048 + g * 512 + tid] = (bf16)pk2(v * rsqrtf(q * (1.f / 512.f) + EPS), 0.f);
    }
    {
        const unsigned gv2 = *(const unsigned*)(c.GV + (size_t)row * 1024 + 2 * tid);
        const float a0 = bflo(gv2), a1 = bfhi(gv2);
        const float s = block_sum(a0 + a1, red);
        const float q = block_sum(a0 * a0 + a1 * a1, red);
        const float mean = s * (1.f / 1024.f), rstd = rsqrtf(fmaxf(q * (1.f / 1024.f) - mean * mean, 0.f) + EPS);
        const int chn = g * 512 + tid, grp = chn >> 7;
        const float vn = (bf2f(c.GV[(size_t)row * 1024 + chn]) - mean) * rstd * c.gmlp_ln_g[chn] + c.gmlp_ln_b[chn];
        c.out[O_GV_S + (size_t)bs * 1024 + chn] = vn;
        const float mixed = c.gmlp_w_s[(size_t)grp * 128 * 128] * vn + c.gmlp_b_s[grp * 128];
        bf16* mp = c.MIX + (size_t)row * 2048 + 1024 + chn;
        *mp = (bf16)pk2(bf2f(*mp) * mixed, 0.f);
    }
    __syncthreads();
}

__device__ __forceinline__ void p2_even_mixers(const Ctx& c, unsigned char* sm) {
    const int G = gridDim.x, bx = blockIdx.x;
    for (int u = bx; u < 256; u += G) ssd_scan_unit(c, u, sm);
    for (int u = bx; u < 256; u += G) gmlp_unit(c, u, sm);
    for (int u = bx; u < 256; u += G) sample_even_unit(c, u, sm);
    for (int i = bx * 512 + threadIdx.x; i < 8 * 3 * 1536; i += G * 512) { const int b = i / (3 * 1536), r = i % (3 * 1536), k = r / 1536, ch = r % 1536;
        c.out[O_SCONV_P + i] = bf2f(c.XBC[(size_t)(b * SEQ + SEQ - 3 + k) * 1536 + ch]); }
}

__device__ __forceinline__ void sample_outproj(const bf16* A, const bf16* Wt, const float* xold, float* xnew, bf16* XN, const float* gn, float* ss, unsigned char* sm) {
    const int tid = threadIdx.x, lane = tid & 63, w = tid >> 6, fr = lane & 15, fq = lane >> 4;
    f32x4* red = (f32x4*)sm;
    for (int u = blockIdx.x; u < 256; u += gridDim.x) {
        const int tg = u >> 5, cgp = u & 31;
        const bf16* ap = A + (size_t)(tg * 16 + fr) * 2048 + w * 256 + fq * 8;
        const bf16* bp0 = Wt + (size_t)(cgp * 32 + fr) * 2048 + w * 256 + fq * 8;
        const bf16* bp1 = bp0 + 16 * 2048;
        f32x4 a0 = (f32x4){0.f, 0.f, 0.f, 0.f}, a1 = a0;
#pragma unroll
        for (int kk = 0; kk < 8; ++kk) {
            const bf16x8 af = *(const bf16x8*)(ap + kk * 32), b0 = *(const bf16x8*)(bp0 + kk * 32), b1 = *(const bf16x8*)(bp1 + kk * 32);
            a0 = __builtin_amdgcn_mfma_f32_16x16x32_bf16(b0, af, a0, 0, 0, 0);
            a1 = __builtin_amdgcn_mfma_f32_16x16x32_bf16(b1, af, a1, 0, 0, 0);
        }
        red[(w * 2 + 0) * 64 + lane] = a0; red[(w * 2 + 1) * 64 + lane] = a1;
        __syncthreads();
        if (tid < 128) {
            const int ct = tid >> 6;
            f32x4 s = (f32x4){0.f, 0.f, 0.f, 0.f};
#pragma unroll
            for (int w2 = 0; w2 < 8; ++w2) s += red[(w2 * 2 + ct) * 64 + lane];
            const int trow = tg * 16 + fr, col = cgp * 32 + ct * 16 + 4 * fq;
            const size_t off = (size_t)trow * 1024 + col;
            const f32x4 v = *(const f32x4*)(xold + off) + s;
            *(f32x4*)(xnew + off) = v;
            if (XN) {
                const f32x4 g = *(const f32x4*)(gn + col);
                u32x2 wv; wv.x = pk2(v[0] * g[0], v[1] * g[1]); wv.y = pk2(v[2] * g[2], v[3] * g[3]); *(u32x2*)(XN + off) = wv;
                float q = (v[0] * v[0] + v[1] * v[1]) + (v[2] * v[2] + v[3] * v[3]);
                q += __shfl_xor(q, 16); q += __shfl_xor(q, 32);
                if (fq == 0) atomicAdd(ss + (size_t)trow * 4 + (cgp >> 3), q);
            }
        }
        __syncthreads();
    }
}

__device__ __forceinline__ void ccv_unit(const Ctx& c, int u, unsigned char* sm) {
    const int tid = threadIdx.x, lane = tid & 63, wv = tid >> 6;
    const int b = u >> 5, t0 = (u & 31) * 64, ch = 2 * tid;
    float* red = (float*)sm;
    f32x2 w[31];
#pragma unroll
    for (int k = 0; k < 31; ++k) w[k] = *(const f32x2*)(c.ccv_w + k * 1024 + ch);
    const f32x2 bias = *(const f32x2*)(c.ccv_b + ch), lg = *(const f32x2*)(c.ccv_ln_g + ch), lb = *(const f32x2*)(c.ccv_ln_b + ch);
    for (int og = 0; og < 8; ++og) {
        f32x2 acc[8];
#pragma unroll
        for (int o = 0; o < 8; ++o) acc[o] = bias;
        const int tb = t0 + og * 8 - 30;
#pragma unroll
        for (int j = 0; j < 38; ++j) {
            const int t = tb + j;
            f32x2 gl = (f32x2){0.f, 0.f};
            if (t >= 0) { const unsigned gw = *(const unsigned*)(c.GLU + (size_t)(b * SEQ + t) * 1024 + ch); gl[0] = bflo(gw); gl[1] = bfhi(gw); }
#pragma unroll
            for (int o = 0; o < 8; ++o) { const int k = j - o; if (k >= 0 && k <= 30) acc[o] += w[k] * gl; }
        }
        float* rb = red + (og & 1) * 128;
#pragma unroll
        for (int o = 0; o < 8; ++o) { const float s = wave_sum(acc[o][0] + acc[o][1]), q = wave_sum(acc[o][0] * acc[o][0] + acc[o][1] * acc[o][1]); if (lane == 0) { rb[wv * 16 + o] = s; rb[wv * 16 + 8 + o] = q; } }
        __syncthreads();
#pragma unroll
        for (int o = 0; o < 8; ++o) {
            float s = 0.f, q = 0.f;
#pragma unroll
            for (int i = 0; i < 8; ++i) { s += rb[i * 16 + o]; q += rb[i * 16 + 8 + o]; }
            const float mean = s * (1.f / 1024.f), rstd = rsqrtf(fmaxf(q * (1.f / 1024.f) - mean * mean, 0.f) + EPS);
            const float y0 = siluf_((acc[o][0] - mean) * rstd * lg[0] + lb[0]), y1 = siluf_((acc[o][1] - mean) * rstd * lg[1] + lb[1]);
            unsigned* mp = (unsigned*)(c.MIX + (size_t)(b * SEQ + t0 + og * 8 + o) * 2048 + ch);
            const unsigned gc = *mp;
            *mp = pk2(y0 * bflo(gc), y1 * bfhi(gc));
        }
    }
    if ((u & 31) == 31) {
        for (int i = tid; i < 30 * 1024; i += 512) { const int k = i >> 10, cc = i & 1023; c.out[O_CCV_P + (size_t)b * 30 * 1024 + i] = bf2f(c.GLU[(size_t)(b * SEQ + SEQ - 30 + k) * 1024 + cc]); }
    }
    __syncthreads();
}
__device__ __forceinline__ void ccv_sample_unit(const Ctx& c, int bs, unsigned char* sm) {
    const int tid = threadIdx.x, ch = 2 * tid, row = NP + bs;
    float* red = (float*)sm;
    const float* buf = c.state_ccv + (size_t)bs * 30 * 1024;
    const unsigned gw = *(const unsigned*)(c.GLU + (size_t)row * 1024 + ch);
    const f32x2 gl = (f32x2){bflo(gw), bfhi(gw)};
    f32x2 acc = *(const f32x2*)(c.ccv_b + ch);
    float* so = c.out + O_CCV_S + (size_t)bs * 30 * 1024;
#pragma unroll 6
    for (int k = 0; k < 30; ++k) { const f32x2 bv = *(const f32x2*)(buf + k * 1024 + ch); acc += *(const f32x2*)(c.ccv_w + k * 1024 + ch) * bv; if (k >= 1) *(f32x2*)(so + (k - 1) * 1024 + ch) = bv; }
    acc += *(const f32x2*)(c.ccv_w + 30 * 1024 + ch) * gl;
    *(f32x2*)(so + 29 * 1024 + ch) = gl;
    const float s = block_sum(acc[0] + acc[1], red);
    const float q = block_sum(acc[0] * acc[0] + acc[1] * acc[1], red);
    const float mean = s * (1.f / 1024.f), rstd = rsqrtf(fmaxf(q * (1.f / 1024.f) - mean * mean, 0.f) + EPS);
    const f32x2 lg = *(const f32x2*)(c.ccv_ln_g + ch), lb = *(const f32x2*)(c.ccv_ln_b + ch);
    const float y0 = siluf_((acc[0] - mean) * rstd * lg[0] + lb[0]), y1 = siluf_((acc[1] - mean) * rstd * lg[1] + lb[1]);
    unsigned* mp = (unsigned*)(c.MIX + (size_t)row * 2048 + ch);
    const unsigned gc = *mp;
    *mp = pk2(y0 * bflo(gc), y1 * bfhi(gc));
    __syncthreads();
}

__device__ __forceinline__ void lru_unit(const Ctx& c, int u, unsigned char* sm) {
    const int tid = threadIdx.x, lane = tid & 63, w = tid >> 6, fr = lane & 15, fq = lane >> 4;
    const int b = u >> 5, h = (u >> 1) & 15, jh = u & 1;
    float* xcf = (float*)sm;
    unsigned char* xcb = sm + 32768;
    float* as = (float*)(sm + 51200);
    float* bs = (float*)(sm + 67584);
    bf16x8 wfa[2][2], wfx[2][2];
#pragma unroll
    for (int ct = 0; ct < 2; ++ct)
#pragma unroll
        for (int kk = 0; kk < 2; ++kk) { float fa[8], fx[8];
#pragma unroll
            for (int e = 0; e < 8; ++e) { const size_t o = ((size_t)h * 64 + kk * 32 + fq * 8 + e) * 64 + jh * 32 + ct * 16 + fr; fa[e] = c.lru_wa[o]; fx[e] = c.lru_wx[o]; }
            u32x4 pa, px; pa.x = pk2(fa[0], fa[1]); pa.y = pk2(fa[2], fa[3]); pa.z = pk2(fa[4], fa[5]); pa.w = pk2(fa[6], fa[7]); px.x = pk2(fx[0], fx[1]); px.y = pk2(fx[2], fx[3]); px.z = pk2(fx[4], fx[5]); px.w = pk2(fx[6], fx[7]);
            wfa[ct][kk] = __builtin_bit_cast(bf16x8, pa); wfx[ct][kk] = __builtin_bit_cast(bf16x8, px); }
    float ba[2], bx[2], sp[2];
#pragma unroll
    for (int ct = 0; ct < 2; ++ct) { const int j = h * 64 + jh * 32 + ct * 16 + fr; ba[ct] = c.lru_ba[j]; bx[ct] = c.lru_bx[j]; sp[ct] = softplusf_(-c.lru_lambda[j]); }
    const int o8 = tid & 7, run = tid >> 3, chc = h * 64 + o8 * 8;
    float cw[4][8], cb[8];
#pragma unroll
    for (int k = 0; k < 4; ++k) { const f32x4 a = *(const f32x4*)(c.lru_conv_w + k * 1024 + chc), bq = *(const f32x4*)(c.lru_conv_w + k * 1024 + chc + 4);
#pragma unroll
        for (int e = 0; e < 4; ++e) { cw[k][e] = a[e]; cw[k][4 + e] = bq[e]; } }
    { const f32x4 a = *(const f32x4*)(c.lru_conv_b + chc), bq = *(const f32x4*)(c.lru_conv_b + chc + 4);
#pragma unroll
      for (int e = 0; e < 4; ++e) { cb[e] = a[e]; cb[4 + e] = bq[e]; } }
    float hcar = 0.f;
    for (int tile = 0; tile < 16; ++tile) {
        const int t0 = tile * 128;
        {
            float raw[5][8];
#pragma unroll
            for (int j = 0; j < 5; ++j) { const int t = t0 + 2 * run - 3 + j;
                if (t >= 0) unpack8(*(const u32x4*)(c.XD + (size_t)(b * SEQ + t) * 1024 + chc), raw[j]);
                else {
#pragma unroll
                    for (int e = 0; e < 8; ++e) raw[j][e] = 0.f; } }
#pragma unroll
            for (int i = 0; i < 2; ++i) { float r8[8];
#pragma unroll
                for (int e = 0; e < 8; ++e) { float s = cb[e];
#pragma unroll
                    for (int k = 0; k < 4; ++k) s += cw[k][e] * raw[i + k][e];
                    r8[e] = s; }
                const int tl = 2 * run + i;
                *(f32x4*)(xcf + tl * 64 + o8 * 8) = (f32x4){r8[0], r8[1], r8[2], r8[3]}; *(f32x4*)(xcf + tl * 64 + o8 * 8 + 4) = (f32x4){r8[4], r8[5], r8[6], r8[7]};
                *(u32x4*)(xcb + tl * 144 + o8 * 16) = pack8((f32x4){r8[0], r8[1], r8[2], r8[3]}, (f32x4){r8[4], r8[5], r8[6], r8[7]}); }
        }
        __syncthreads();
        {
            bf16x8 af[2];
#pragma unroll
            for (int kk = 0; kk < 2; ++kk) af[kk] = *(const bf16x8*)(xcb + (16 * w + fr) * 144 + (kk * 32 + fq * 8) * 2);
#pragma unroll
            for (int ct = 0; ct < 2; ++ct) {
                f32x4 dr = (f32x4){0.f, 0.f, 0.f, 0.f}, di = dr;
#pragma unroll
                for (int kk = 0; kk < 2; ++kk) { dr = __builtin_amdgcn_mfma_f32_16x16x32_bf16(af[kk], wfa[ct][kk], dr, 0, 0, 0); di = __builtin_amdgcn_mfma_f32_16x16x32_bf16(af[kk], wfx[ct][kk], di, 0, 0, 0); }
#pragma unroll
                for (int e = 0; e < 4; ++e) {
                    const int tl = 16 * w + 4 * fq + e, jl = ct * 16 + fr;
                    const float r = sigmoidf_(dr[e] + ba[ct]), ig = sigmoidf_(di[e] + bx[ct]);
                    const float la = -8.f * r * sp[ct];
                    const float a = __expf(la);
                    const float bt = sqrtf(fmaxf(-expm1f(2.f * la), 0.f)) * (ig * xcf[tl * 64 + jh * 32 + jl]);
                    as[tl * 32 + jl] = a; bs[tl * 32 + jl] = bt;
                }
            }
        }
        __syncthreads();
        if (tid < 32) {
            float hh = hcar;
#pragma unroll 16
            for (int tl = 0; tl < 128; ++tl) { hh = fmaf(as[tl * 32 + tid], hh, bs[tl * 32 + tid]); bs[tl * 32 + tid] = hh; }
            hcar = hh;
        }
        __syncthreads();
        {
            const int tl = tid >> 2, c8 = (tid & 3) * 8;
            u32x4* mp = (u32x4*)(c.MIX + (size_t)(b * SEQ + t0 + tl) * 2048 + 1024 + h * 64 + jh * 32 + c8);
            float gd[8]; unpack8(*mp, gd);
            const f32x4 h0 = *(const f32x4*)(bs + tl * 32 + c8), h1 = *(const f32x4*)(bs + tl * 32 + c8 + 4);
            *mp = pack8((f32x4){h0[0] * gd[0], h0[1] * gd[1], h0[2] * gd[2], h0[3] * gd[3]}, (f32x4){h1[0] * gd[4], h1[1] * gd[5], h1[2] * gd[6], h1[3] * gd[7]});
        }
        __syncthreads();
    }
    if (tid < 32) {
        const int j = h * 64 + jh * 32 + tid;
        c.out[O_LRU_P + (size_t)b * 1024 + j] = hcar;
#pragma unroll
        for (int k = 0; k < 3; ++k) c.out[O_LCONV_P + ((size_t)b * 3 + k) * 1024 + j] = bf2f(c.XD[(size_t)(b * SEQ + SEQ - 3 + k) * 1024 + j]);
    }
}
__device__ __forceinline__ void lru_sample_unit(const Ctx& c, int bs, unsigned char* sm) {
    const int tid = threadIdx.x, row = NP + bs;
    float* xcs = (float*)sm;
    const float* buf = c.state_lru_conv + (size_t)bs * 3 * 1024;
    float* so = c.out + O_LCONV_S + (size_t)bs * 3 * 1024;
#pragma unroll
    for (int i = 0; i < 2; ++i) { const int ch = tid + 512 * i;
        const float xn = bf2f(c.XD[(size_t)row * 1024 + ch]);
        xcs[ch] = c.lru_conv_b[ch] + c.lru_conv_w[ch] * buf[ch] + c.lru_conv_w[1024 + ch] * buf[1024 + ch] + c.lru_conv_w[2048 + ch] * buf[2048 + ch] + c.lru_conv_w[3072 + ch] * xn;
        so[ch] = buf[1024 + ch]; so[1024 + ch] = buf[2048 + ch]; so[2048 + ch] = xn; }
    __syncthreads();
#pragma unroll
    for (int i = 0; i < 2; ++i) { const int j = tid + 512 * i, h = j >> 6, jl = j & 63;
        float sr = c.lru_ba[j], si = c.lru_bx[j];
        const float* wa = c.lru_wa + (size_t)h * 4096 + jl; const float* wx = c.lru_wx + (size_t)h * 4096 + jl;
#pragma unroll 8
        for (int ii = 0; ii < 64; ++ii) { const float xv = xcs[h * 64 + ii]; sr += xv * wa[ii * 64]; si += xv * wx[ii * 64]; }
        const float r = sigmoidf_(sr), ig = sigmoidf_(si);
        const float la = -8.f * r * softplusf_(-c.lru_lambda[j]);
        const float a = __expf(la);
        const float hn = a * c.state_lru[(size_t)bs * 1024 + j] + sqrtf(fmaxf(-expm1f(2.f * la), 0.f)) * (ig * xcs[j]);
        c.out[O_LRU_S + (size_t)bs * 1024 + j] = hn;
        bf16* mp = c.MIX + (size_t)row * 2048 + 1024 + j;
        *mp = (bf16)pk2(hn * bf2f(*mp), 0.f); }
    __syncthreads();
}
__device__ __forceinline__ void p5_odd_mixers(const Ctx& c, unsigned char* sm) {
    const int G = gridDim.x, bx = blockIdx.x;
    for (int u = bx; u < 256; u += G) lru_unit(c, u, sm);
    for (int u = bx; u < 256; u += G) ccv_unit(c, u, sm);
    for (int u = bx; u < 256; u += G) { if (u < 128) ccv_sample_unit(c, u, sm); else lru_sample_unit(c, u - 128, sm); }
}

__device__ __forceinline__ void p7_final_norm(const Ctx& c) {
    const int lane = threadIdx.x & 63, gw = blockIdx.x * 8 + (threadIdx.x >> 6), NGW = gridDim.x * 8;
    for (int m = gw; m < NT; m += NGW) {
        f32x4* xr = (f32x4*)(c.out + (size_t)m * 1024);
        f32x4 v[4]; float s = 0.f;
#pragma unroll
        for (int j = 0; j < 4; ++j) { v[j] = xr[lane + 64 * j]; s += (v[j][0] * v[j][0] + v[j][1] * v[j][1]) + (v[j][2] * v[j][2] + v[j][3] * v[j][3]); }
        const float rstd = rsqrtf(wave_sum(s) * (1.f / 1024.f) + EPS);
#pragma unroll
        for (int j = 0; j < 4; ++j) xr[lane + 64 * j] = v[j] * rstd * ((const f32x4*)c.final_norm)[lane + 64 * j];
    }
}

#ifndef MK_COOP
#define MK_COOP 1
#endif
struct Params { const float* in[35]; float* out; unsigned char* ws; int lo, hi; };
constexpr int N_PHASES = 8;

__global__ void __launch_bounds__(512, 2) hybrid_fwd(Params P) {
    extern __shared__ __attribute__((aligned(16))) unsigned char lds[];
    Ctx c;
    c.x_prompt = P.in[0]; c.x_sample = P.in[1]; c.state_ssm = P.in[2]; c.state_ssd_conv = P.in[3]; c.state_ccv = P.in[4]; c.state_lru_conv = P.in[5]; c.state_lru = P.in[6];
    c.norm_even = P.in[7]; c.w_in_even = P.in[8]; c.ssd_conv_w = P.in[9]; c.ssd_conv_b = P.in[10]; c.ssd_dt_bias = P.in[11]; c.ssd_a_log = P.in[12]; c.ssd_d = P.in[13]; c.ssd_norm = P.in[14];
    c.gmlp_ln_g = P.in[15]; c.gmlp_ln_b = P.in[16]; c.gmlp_w_s = P.in[17]; c.gmlp_b_s = P.in[18]; c.w_out_even = P.in[19];
    c.norm_odd = P.in[20]; c.w_in_odd = P.in[21]; c.ccv_w = P.in[22]; c.ccv_b = P.in[23]; c.ccv_ln_g = P.in[24]; c.ccv_ln_b = P.in[25];
    c.lru_conv_w = P.in[26]; c.lru_conv_b = P.in[27]; c.lru_wa = P.in[28]; c.lru_ba = P.in[29]; c.lru_wx = P.in[30]; c.lru_bx = P.in[31]; c.lru_lambda = P.in[32]; c.w_out_odd = P.in[33]; c.final_norm = P.in[34];
    c.out = P.out;
    unsigned char* ws = P.ws;
    c.ss0 = (float*)(ws + WS_SS0); c.ss1 = (float*)(ws + WS_SS1); c.DT = (float*)(ws + WS_DT); c.ssg = (float*)(ws + WS_SSG);
    c.W1t = (bf16*)(ws + WS_W1); c.W2t = (bf16*)(ws + WS_W2); c.W3t = (bf16*)(ws + WS_W3); c.W4t = (bf16*)(ws + WS_W4);
    c.XN = (bf16*)(ws + WS_XN); c.MIX = (bf16*)(ws + WS_MIX); c.XBC = (bf16*)(ws + WS_XBC); c.GV = (bf16*)(ws + WS_GV); c.GLU = (bf16*)(ws + WS_XBC); c.XD = (bf16*)(ws + WS_GV);
    PG8_LAS unsigned char* l3 = (PG8_LAS unsigned char*)lds;
    const int lo = P.lo, hi = P.hi;
#define IN(k) (lo <= (k) && (k) < hi)
#if MK_COOP
#define SEAM(k) do { if (IN(k) && IN((k) + 1)) cg::this_grid().sync(); } while (0)
#else
#define SEAM(k) do { } while (0)
#endif
    if (IN(0)) { p0_prologue(c, lds); } SEAM(0);
    if (IN(1)) {
        pg8::Gemm g{c.XN, c.W1t, MP, N1, 1024}; pg8::StaticOrder S; S.init(MP, N1, (int)gridDim.x, (int)blockIdx.x);
        Epi1 E{c.ss0, c.MIX, c.XBC, c.GV, c.DT};
        pg8::gemm_phase<Epi1, pg8::StaticOrder, NoHook, true, true>(l3, g, S, E, NoHook{});
    } SEAM(1);
    if (IN(2)) { p2_even_mixers(c, lds); } SEAM(2);
    if (IN(3)) {
        sample_outproj(c.MIX + (size_t)NP * 2048, c.W2t, c.x_sample, c.out + (size_t)NP * 1024, c.XN + (size_t)NP * 1024, c.norm_odd, c.ss1 + (size_t)NP * 4, lds);
        pg8::Gemm g{c.MIX, c.W2t, NP, 1024, 2048}; pg8::StaticOrder S; S.init(NP, 1024, (int)gridDim.x, (int)blockIdx.x);
        Unit u0;
        if (S.next(0, u0)) {
            float* tab = (float*)(lds + 131072);
            if (threadIdx.x < 256) { const float* sp = c.ssg + (size_t)(u0.pm * 256 + threadIdx.x) * 32; float s0 = 0.f, s1 = 0.f;
#pragma unroll
                for (int i = 0; i < 16; ++i) { s0 += sp[i]; s1 += sp[16 + i]; }
                const float r0 = rsqrtf(s0 * (1.f / 512.f) + EPS), r1 = rsqrtf(s1 * (1.f / 512.f) + EPS);
                tab[threadIdx.x * 2] = r0 / r1; tab[threadIdx.x * 2 + 1] = r1; }
        }
        __syncthreads();
        EpiOut E{c.x_prompt, c.out, c.XN, c.norm_odd, c.ss1};
        HookScale H{(const LAS3 float*)(l3 + 131072)};
        pg8::gemm_phase<EpiOut, pg8::StaticOrder, HookScale, false, true>(l3, g, S, E, H);
    } SEAM(3);
    if (IN(4)) {
        pg8::Gemm g{c.XN, c.W3t, MP, N3, 1024}; pg8::StaticOrder S; S.init(MP, N3, (int)gridDim.x, (int)blockIdx.x);
        Epi3 E{c.ss1, c.MIX, c.GLU, c.XD};
        pg8::gemm_phase<Epi3, pg8::StaticOrder, NoHook, true, true>(l3, g, S, E, NoHook{});
    } SEAM(4);
    if (IN(5)) { p5_odd_mixers(c, lds); } SEAM(5);
    if (IN(6)) {
        sample_outproj(c.MIX + (size_t)NP * 2048, c.W4t, c.out + (size_t)NP * 1024, c.out + (size_t)NP * 1024, nullptr, nullptr, nullptr, lds);
        pg8::Gemm g{c.MIX, c.W4t, NP, 1024, 2048}; pg8::StaticOrder S; S.init(NP, 1024, (int)gridDim.x, (int)blockIdx.x);
        EpiOut E{c.out, c.out, nullptr, nullptr, nullptr};
        pg8::gemm_phase<EpiOut, pg8::StaticOrder, NoHook, false, true>(l3, g, S, E, NoHook{});
    } SEAM(6);
    if (IN(7)) { p7_final_norm(c); }
#undef IN
#undef SEAM
}

extern "C" void kernel_launch(void* const* d_in, const int* in_sizes, int n_in, void* d_out, int out_size, void* d_ws, size_t ws_size, hipStream_t stream) {
    static int grid = 0;
    if (grid == 0) {
        if (n_in != 35 || out_size != (int)O_END || ws_size < WS_END) { fprintf(stderr, "kernel_launch: unexpected problem (n_in %d out %d ws %zu)\n", n_in, out_size, ws_size); grid = -1; return; }
        int dev = 0, cus = 0, per_cu = 0;
        (void)hipGetDevice(&dev); (void)hipDeviceGetAttribute(&cus, hipDeviceAttributeMultiprocessorCount, dev);
        if (hipFuncSetAttribute((const void*)hybrid_fwd, hipFuncAttributeMaxDynamicSharedMemorySize, LDS_BYTES) != hipSuccess) { fprintf(stderr, "kernel_launch: hipFuncSetAttribute failed\n"); grid = -1; return; }
        if (hipOccupancyMaxActiveBlocksPerMultiprocessor(&per_cu, (const void*)hybrid_fwd, 512, LDS_BYTES) != hipSuccess || per_cu < 1) { fprintf(stderr, "kernel_launch: occupancy query says %d blocks per CU\n", per_cu); (void)hipGetLastError(); per_cu = 1; }
        grid = cus < 256 ? cus : 256;
        if (grid != 256) fprintf(stderr, "kernel_launch: %d CUs; this kernel is built for 256\n", cus);
    }
    if (grid < 0) return;
    Params p{};
    for (int i = 0; i < 35; ++i) p.in[i] = (const float*)d_in[i];
    p.out = (float*)d_out; p.ws = (unsigned char*)d_ws;
#if MK_COOP
    p.lo = 0; p.hi = N_PHASES;
    void* args[] = {&p};
    hipError_t e = hipLaunchCooperativeKernel((const void*)hybrid_fwd, dim3(grid), dim3(512), args, LDS_BYTES, stream);
    if (e != hipSuccess) fprintf(stderr, "kernel_launch: cooperative launch failed: %s\n", hipGetErrorString(e));
#else
    for (int ph = 0; ph < N_PHASES; ++ph) { p.lo = ph; p.hi = ph + 1; hipLaunchKernelGGL(hybrid_fwd, dim3(grid), dim3(512), LDS_BYTES, stream, p); }
#endif
}
```

```cpp
#include <hip/hip_runtime.h>
#include <hip/hip_cooperative_groups.h>
#include <cstdio>
#include <cstdint>
namespace cg = cooperative_groups;
namespace pg8 {
#define PG8_LAS __attribute__((address_space(3)))
typedef unsigned short bf16_t;
typedef short bf16x8 __attribute__((ext_vector_type(8)));
typedef float f32x4 __attribute__((ext_vector_type(4)));
typedef unsigned u32x4 __attribute__((ext_vector_type(4)));
constexpr int BM = 256, BK = 64, HALF = 128, HTB = HALF * BK * 2  , STAGE_BYTES = 8 * HTB, NXCD = 8, WGM = 8;

__host__ __device__ __forceinline__ int lds_byte(int r, int c) { const int st = (r >> 4) * 2 + (c >> 5), rr = r & 15, cc = c & 31, ob = rr * 64 + cc * 2; return st * 1024 + (ob ^ (((ob >> 9) & 1) << 5)); }
__host__ __device__ __forceinline__ void stage_rc(int b, int& R, int& C) { const int st = b / 1024, sb = b % 1024, swz = sb ^ (((sb >> 9) & 1) << 5); R = (st >> 1) * 16 + swz / 64; C = (st & 1) * 32 + (swz % 64) / 2; }
__host__ __device__ __forceinline__ int perm32(int rho) { const int n = rho >> 4, i = rho & 15; return 8 * (i >> 2) + 4 * n + (i & 3); }

struct Unit { int pm, pn; };
struct Gemm { const bf16_t* A; const bf16_t* Bt; int M, N, K; };

struct StaticOrder {
    int nM, nN, nwg, G, c;
    __host__ __device__ void init(int M, int N, int G_, int c_) { nM = M / BM; nN = N / BM; nwg = nM * nN; G = G_; c = c_; }
    __host__ __device__ bool next(int i, Unit& u) const {
        const long L = (long)i * G + c; if (L >= nwg) return false;
        int wgid = (int)L; { const int q = nwg / NXCD, r = nwg % NXCD, xcd = wgid % NXCD, off = wgid / NXCD; wgid = (xcd < r ? xcd * (q + 1) : r * (q + 1) + (xcd - r) * q) + off; }
        const int nig = WGM * nN, gid = wgid / nig, fm = gid * WGM, gsz = (nM - fm) < WGM ? (nM - fm) : WGM;
        u.pm = fm + ((wgid % nig) % gsz); u.pn = (wgid % nig) / gsz; return true;
    }
    __device__ __forceinline__ void a_ready(const Unit&) const {}
    __device__ __forceinline__ void done(const Unit&) const {}
};

__device__ __forceinline__ unsigned cvt_pk_bf16(float lo, float hi) { unsigned r; asm volatile("v_cvt_pk_bf16_f32 %0, %1, %2" : "=v"(r) : "v"(lo), "v"(hi)); return r; }
template <class Epi, class Sched, class Hook, bool ALIGN_EPI = false, bool SP2 = false>
__device__ __forceinline__ void gemm_phase(PG8_LAS unsigned char* lds, const Gemm g, const Sched& S, const Epi& E, const Hook& H) {
    const int tid = threadIdx.x, wid = __builtin_amdgcn_readfirstlane(tid >> 6), lane = tid & 63, wr = wid >> 2, wc = wid & 3, fr = lane & 15, fq = lane >> 4;
    const int K = g.K, nt = K / BK;
    unsigned voffA[2], voffB[2];
#pragma unroll
    for (int i = 0; i < 2; ++i) { int R, C; stage_rc(tid * 16 + i * 8192, R, C); const int Rb = Epi::PERM ? ((R & ~31) + perm32(R & 31)) : R;
        voffA[i] = (unsigned)(R * K + C) * 2u; voffB[i] = (unsigned)(Rb * K + C) * 2u; }
    const size_t kstep = (size_t)(BK * 2);
    const size_t hstep = (size_t)HALF * K * 2;
    const size_t tstep = 2 * hstep;
    const unsigned ldsw = (unsigned)wid * 1024u;
    const int aoff = lds_byte(wr * 64 + fr, fq * 8), boff = lds_byte(wc * 32 + fr, fq * 8);
#define PG8_SA(b, h) (((b) * 2 + (h)) * HTB)
#define PG8_SB(b, h) ((4 + (b) * 2 + (h)) * HTB)
#define PG8_STAGE(bufoff, gbase, voff) do { _Pragma("unroll") for (int _i = 0; _i < 2; ++_i) \
        __builtin_amdgcn_global_load_lds((const unsigned*)((const char*)(gbase) + (voff)[_i]), (PG8_LAS unsigned*)(lds + (bufoff) + ldsw + _i * 8192), 16, 0, 0); } while (0)
#define PG8_LDA(dst, b, h) do { _Pragma("unroll") for (int m = 0; m < 4; ++m) _Pragma("unroll") for (int k = 0; k < 2; ++k) dst[m][k] = *(const PG8_LAS bf16x8*)(lds + PG8_SA(b, h) + aoff + m * 2048 + k * 1024); } while (0)
#define PG8_LDB(dst, b, h) do { _Pragma("unroll") for (int n = 0; n < 2; ++n) _Pragma("unroll") for (int k = 0; k < 2; ++k) dst[n][k] = *(const PG8_LAS bf16x8*)(lds + PG8_SB(b, h) + boff + n * 2048 + k * 1024); } while (0)
#define PG8_MMA(ai, bj, At, Bt) do { __builtin_amdgcn_s_setprio(1); _Pragma("unroll") for (int m = 0; m < 4; ++m) _Pragma("unroll") for (int n = 0; n < 2; ++n) _Pragma("unroll") for (int k = 0; k < 2; ++k) \
        acc[ai][bj][m][n] = __builtin_amdgcn_mfma_f32_16x16x32_bf16(Bt[n][k], At[m][k], acc[ai][bj][m][n], 0, 0, 0); __builtin_amdgcn_s_setprio(0); } while (0)
#define PG8_WAIT_V(n) asm volatile("s_waitcnt vmcnt(" #n ")" ::: "memory")
#define PG8_WAIT_L(n) asm volatile("s_waitcnt lgkmcnt(" #n ")" ::: "memory")
#define PG8_BAR __builtin_amdgcn_s_barrier()
#define PG8_SCHED __builtin_amdgcn_sched_barrier(0)
    Unit cur, nxt; int ui = 0;
    if (!S.next(0, cur)) return;
    f32x4 acc[2][2][4][2];
#pragma unroll
    for (int a = 0; a < 2; ++a)
#pragma unroll
        for (int b = 0; b < 2; ++b)
#pragma unroll
            for (int m = 0; m < 4; ++m)
#pragma unroll
                for (int n = 0; n < 2; ++n) acc[a][b][m][n] = (f32x4){0.f, 0.f, 0.f, 0.f};
    bf16x8 At[4][2], B0[2][2], B1[2][2];
    const char* cA = (const char*)g.A + (size_t)cur.pm * tstep; const char* cB = (const char*)g.Bt + (size_t)cur.pn * tstep;
    S.a_ready(cur);
    if constexpr (SP2) {
        PG8_STAGE(PG8_SB(0, 0), cB, voffB); PG8_STAGE(PG8_SB(0, 1), cB + hstep, voffB); PG8_STAGE(PG8_SA(0, 0), cA, voffA); PG8_STAGE(PG8_SA(0, 1), cA + hstep, voffA);
        if (wr == 1) PG8_BAR;
        PG8_WAIT_V(2); PG8_BAR;
        PG8_STAGE(PG8_SB(1, 0), cB + kstep, voffB); PG8_STAGE(PG8_SA(1, 0), cA + kstep, voffA); PG8_STAGE(PG8_SB(1, 1), cB + hstep + kstep, voffB);
        PG8_WAIT_V(6); PG8_BAR;
    } else {
        PG8_STAGE(PG8_SB(0, 0), cB, voffB); PG8_STAGE(PG8_SA(0, 0), cA, voffA); PG8_STAGE(PG8_SB(0, 1), cB + hstep, voffB); PG8_STAGE(PG8_SA(0, 1), cA + hstep, voffA);
        if (wr == 1) PG8_BAR;
        PG8_WAIT_V(4); PG8_BAR;
        PG8_STAGE(PG8_SB(1, 0), cB + kstep, voffB); PG8_STAGE(PG8_SA(1, 0), cA + kstep, voffA); PG8_STAGE(PG8_SB(1, 1), cB + hstep + kstep, voffB);
        PG8_WAIT_V(6); PG8_BAR;
    }
    for (;;) {
        const bool has_next = S.next(ui + 1, nxt);
        const char* nA = has_next ? (const char*)g.A + (size_t)nxt.pm * tstep : cA; const char* nB = has_next ? (const char*)g.Bt + (size_t)nxt.pn * tstep : cB;
        for (int t = 0; t < nt; t += 2) {
            const bool last = (t == nt - 2);
            const char* a1 = cA + (size_t)(t + 1) * kstep;
            const char* a2 = last ? nA : cA + (size_t)(t + 2) * kstep; const char* b2 = last ? nB : cB + (size_t)(t + 2) * kstep;
            const char* a3 = a2 + kstep; const char* b3 = b2 + kstep;
            if (last && has_next) S.a_ready(nxt);
            H(acc, t, wr, fr);
            if constexpr (SP2) {
            PG8_LDB(B0, 0, 0); PG8_LDB(B1, 0, 1); PG8_SCHED; PG8_LDA(At, 0, 0); PG8_STAGE(PG8_SA(1, 1), a1 + hstep, voffA);
            PG8_WAIT_V(8); PG8_WAIT_L(0); PG8_BAR; PG8_MMA(0, 0, At, B0); PG8_MMA(0, 1, At, B1); PG8_BAR; PG8_SCHED;
            PG8_LDA(At, 0, 1); PG8_STAGE(PG8_SB(0, 0), b2, voffB); PG8_STAGE(PG8_SB(0, 1), b2 + hstep, voffB); PG8_STAGE(PG8_SA(0, 0), a2, voffA);
            PG8_WAIT_V(8); PG8_WAIT_L(0); PG8_BAR; PG8_MMA(1, 0, At, B0); PG8_MMA(1, 1, At, B1); PG8_BAR; PG8_SCHED;
            PG8_LDB(B0, 1, 0); PG8_LDB(B1, 1, 1); PG8_SCHED; PG8_LDA(At, 1, 0); PG8_STAGE(PG8_SA(0, 1), a2 + hstep, voffA);
            PG8_WAIT_V(8); PG8_WAIT_L(0); PG8_BAR; PG8_MMA(0, 0, At, B0); PG8_MMA(0, 1, At, B1); PG8_BAR; PG8_SCHED;
            PG8_LDA(At, 1, 1); PG8_STAGE(PG8_SB(1, 0), b3, voffB); PG8_STAGE(PG8_SB(1, 1), b3 + hstep, voffB); PG8_STAGE(PG8_SA(1, 0), a3, voffA);
            PG8_WAIT_V(8); PG8_WAIT_L(0); PG8_BAR; PG8_MMA(1, 0, At, B0); PG8_MMA(1, 1, At, B1); PG8_BAR; PG8_SCHED;
            } else {
            PG8_LDB(B0, 0, 0); PG8_SCHED; PG8_LDA(At, 0, 0); PG8_STAGE(PG8_SA(1, 1), a1 + hstep, voffA);
            PG8_WAIT_L(8); PG8_BAR; PG8_WAIT_L(0); PG8_MMA(0, 0, At, B0); PG8_BAR; PG8_SCHED;
            PG8_LDB(B1, 0, 1); PG8_STAGE(PG8_SB(0, 0), b2, voffB);
            PG8_BAR; PG8_WAIT_L(0); PG8_MMA(0, 1, At, B1); PG8_BAR;
            PG8_LDA(At, 0, 1); PG8_STAGE(PG8_SA(0, 0), a2, voffA);
            PG8_BAR; PG8_WAIT_L(0); PG8_MMA(1, 0, At, B0); PG8_BAR; PG8_SCHED;
            PG8_STAGE(PG8_SB(0, 1), b2 + hstep, voffB);
            PG8_WAIT_V(6); PG8_BAR; PG8_MMA(1, 1, At, B1); PG8_BAR;
            PG8_LDB(B0, 1, 0); PG8_SCHED; PG8_LDA(At, 1, 0); PG8_STAGE(PG8_SA(0, 1), a2 + hstep, voffA);
            PG8_WAIT_L(8); PG8_BAR; PG8_WAIT_L(0); PG8_MMA(0, 0, At, B0); PG8_BAR; PG8_SCHED;
            PG8_LDB(B1, 1, 1); PG8_STAGE(PG8_SB(1, 0), b3, voffB);
            PG8_BAR; PG8_WAIT_L(0); PG8_MMA(0, 1, At, B1); PG8_BAR;
            PG8_LDA(At, 1, 1); PG8_STAGE(PG8_SA(1, 0), a3, voffA);
            PG8_BAR; PG8_WAIT_L(0); PG8_MMA(1, 0, At, B0); PG8_BAR; PG8_SCHED;
            PG8_STAGE(PG8_SB(1, 1), b3 + hstep, voffB);
            PG8_WAIT_V(6); PG8_BAR; PG8_MMA(1, 1, At, B1); PG8_BAR;
            }
        }
        if constexpr (ALIGN_EPI) { if (wr == 0) PG8_BAR; }
        if constexpr (!Epi::AFTER_DRAIN) { E(acc, cur, wr, wc, fr, fq); S.done(cur); }
        if (!has_next) break;
#pragma unroll
        for (int a = 0; a < 2; ++a)
#pragma unroll
            for (int b = 0; b < 2; ++b)
#pragma unroll
                for (int m = 0; m < 4; ++m)
#pragma unroll
                    for (int n = 0; n < 2; ++n) acc[a][b][m][n] = (f32x4){0.f, 0.f, 0.f, 0.f};
        cur = nxt; cA = nA; cB = nB; ++ui;
        if constexpr (ALIGN_EPI) { if (wr == 1) PG8_BAR; }
    }
    PG8_WAIT_V(0);
    if constexpr (!ALIGN_EPI) { if (wr == 0) PG8_BAR; }
    PG8_BAR;
    if constexpr (Epi::AFTER_DRAIN) { E.fused(acc, cur, wr, wc, fr, fq, lds, wid, lane); S.done(cur); }
#undef PG8_SA
#undef PG8_SB
#undef PG8_STAGE
#undef PG8_LDA
#undef PG8_LDB
#undef PG8_MMA
#undef PG8_WAIT_V
#undef PG8_WAIT_L
#undef PG8_BAR
#undef PG8_SCHED
}
}

using pg8::f32x4; using pg8::bf16x8; using pg8::Unit;
typedef unsigned short bf16;
typedef unsigned u32x2 __attribute__((ext_vector_type(2)));
typedef unsigned u32x4 __attribute__((ext_vector_type(4)));
typedef float f32x2 __attribute__((ext_vector_type(2)));
#define LAS3 __attribute__((address_space(3)))

constexpr int NP = 16384, NS = 128, NT = NP + NS, MP = 16640, SEQ = 2048;
constexpr int N1 = 5888, N3 = 5120;
constexpr float EPS = 1e-6f;
constexpr int LDS_BYTES = 147456;

constexpr size_t O_SSM_P = (size_t)NT * 1024;
constexpr size_t O_SSM_S = O_SSM_P + (size_t)8 * 16 * 64 * 128;
constexpr size_t O_SCONV_P = O_SSM_S + (size_t)128 * 16 * 64 * 128;
constexpr size_t O_SCONV_S = O_SCONV_P + 8 * 3 * 1536;
constexpr size_t O_GV_S = O_SCONV_S + 128 * 3 * 1536;
constexpr size_t O_CCV_P = O_GV_S + 128 * 1024;
constexpr size_t O_CCV_S = O_CCV_P + 8 * 30 * 1024;
constexpr size_t O_LCONV_P = O_CCV_S + 128 * 30 * 1024;
constexpr size_t O_LCONV_S = O_LCONV_P + 8 * 3 * 1024;
constexpr size_t O_LRU_P = O_LCONV_S + 128 * 3 * 1024;
constexpr size_t O_LRU_S = O_LRU_P + 8 * 1024;
constexpr size_t O_END = O_LRU_S + 128 * 1024;
static_assert(O_END == 40226816, "output size");

constexpr size_t MiB = 1u << 20;
constexpr size_t WS_SS0 = 0, WS_SS1 = 288 * 1024, WS_DT = 576 * 1024, WS_SSG = 1792 * 1024, WS_XCNT = 3840 * 1024;
constexpr size_t WS_W4 = 4 * MiB, WS_W3 = 8 * MiB, WS_W2 = 18 * MiB, WS_XN = 22 * MiB, WS_W1 = 54 * MiB + 512 * 1024, WS_MIX = 66 * MiB, WS_XBC = 131 * MiB, WS_GV = 180 * MiB, WS_BCN = 213 * MiB, WS_BTG = 229 * MiB, WS_END = 246 * MiB;
static_assert(WS_XN + (size_t)MP * 1024 * 2 <= WS_W1 && WS_W1 + (size_t)N1 * 1024 * 2 <= WS_MIX && WS_MIX + (size_t)MP * 2048 * 2 <= WS_XBC && WS_XBC + (size_t)MP * 1536 * 2 <= WS_GV && WS_GV + (size_t)MP * 1024 * 2 <= WS_BCN && WS_BCN + (size_t)NP * 512 * 2 <= WS_BTG && WS_BTG + (size_t)NP * 256 * 2 <= WS_END && WS_BCN + (size_t)NT * 1024 * 2 <= WS_END, "ws map");
static_assert(WS_SS0 + (size_t)MP * 16 <= WS_SS1 && WS_SS1 + (size_t)MP * 16 <= WS_DT && WS_DT + (size_t)MP * 64 <= WS_SSG && WS_SSG + (size_t)NP * 128 <= WS_W4, "ws map small");

struct Ctx {
    const float *x_prompt, *x_sample, *state_ssm, *state_ssd_conv, *state_ccv, *state_lru_conv, *state_lru;
    const float *norm_even, *w_in_even, *ssd_conv_w, *ssd_conv_b, *ssd_dt_bias, *ssd_a_log, *ssd_d, *ssd_norm, *gmlp_ln_g, *gmlp_ln_b, *gmlp_w_s, *gmlp_b_s, *w_out_even;
    const float *norm_odd, *w_in_odd, *ccv_w, *ccv_b, *ccv_ln_g, *ccv_ln_b, *lru_conv_w, *lru_conv_b, *lru_wa, *lru_ba, *lru_wx, *lru_bx, *lru_lambda, *w_out_odd, *final_norm;
    float* out;
    float *ss0, *ss1, *DT, *ssg; unsigned* xcnt;
    bf16 *W1t, *W2t, *W3t, *W4t, *XN, *MIX, *XBC, *GV, *GLU, *XD, *BCn, *BTg, *X2b;
};

__device__ __forceinline__ float bf2f(unsigned b) { return __uint_as_float(b << 16); }
__device__ __forceinline__ float bflo(unsigned w) { return __uint_as_float(w << 16); }
__device__ __forceinline__ float bfhi(unsigned w) { return __uint_as_float(w & 0xffff0000u); }
__device__ __forceinline__ unsigned pk2(float lo, float hi) { return pg8::cvt_pk_bf16(lo, hi); }
__device__ __forceinline__ float sigmoidf_(float x) { return __builtin_amdgcn_rcpf(1.f + __expf(-x)); }
__device__ __forceinline__ float siluf_(float x) { return x * sigmoidf_(x); }
__device__ __forceinline__ float geluf_(float x) { const float y = 1.5957691216057308f * (x + 0.044715f * x * x * x); return x * sigmoidf_(y); }
__device__ __forceinline__ float softplusf_(float x) { return fmaxf(x, 0.f) + log1pf(__expf(-fabsf(x))); }
__device__ __forceinline__ float wave_sum(float v) {
#pragma unroll
    for (int o = 1; o < 64; o <<= 1) v += __shfl_xor(v, o);
    return v;
}
__device__ __forceinline__ float block_sum(float v, float* red) {
    v = wave_sum(v);
    __syncthreads();
    if ((threadIdx.x & 63) == 0) red[threadIdx.x >> 6] = v;
    __syncthreads();
    float s = 0.f;
#pragma unroll
    for (int i = 0; i < 8; ++i) s += red[i];
    return s;
}
template <int CTRL> __device__ __forceinline__ float dpp_mov(float v) { return __int_as_float(__builtin_amdgcn_update_dpp(0, __float_as_int(v), CTRL, 0xf, 0xf, true)); }
__device__ __forceinline__ float row16_sum(float y) {
    y += dpp_mov<0x128>(y); y += dpp_mov<0x124>(y); y += dpp_mov<0x122>(y); y += dpp_mov<0x121>(y); return y;
}
__device__ __forceinline__ float rstd_from(const float* ss, int row) { return rsqrtf(((ss[row] + ss[MP + row]) + (ss[2 * MP + row] + ss[3 * MP + row])) * (1.f / 1024.f) + EPS); }
__device__ __forceinline__ u32x4 pack8(const f32x4 a, const f32x4 b) { u32x4 w; w.x = pk2(a[0], a[1]); w.y = pk2(a[2], a[3]); w.z = pk2(b[0], b[1]); w.w = pk2(b[2], b[3]); return w; }
__device__ __forceinline__ void unpack8(const u32x4 w, float (&f)[8]) { f[0] = bflo(w.x); f[1] = bfhi(w.x); f[2] = bflo(w.y); f[3] = bfhi(w.y); f[4] = bflo(w.z); f[5] = bfhi(w.z); f[6] = bflo(w.w); f[7] = bfhi(w.w); }

struct NoHook { __device__ __forceinline__ void operator()(f32x4 (&)[2][2][4][2], int, int, int) const {} };
struct HookScale {
    const LAS3 float* tab;
    __device__ __forceinline__ void operator()(f32x4 (&acc)[2][2][4][2], int t, int wr, int fr) const {
        if (t == 8 || t == 16) {
            const int j = (t == 16) ? 1 : 0;
#pragma unroll
            for (int ai = 0; ai < 2; ++ai)
#pragma unroll
                for (int m = 0; m < 4; ++m) { const float f = tab[(ai * 128 + wr * 64 + m * 16 + fr) * 2 + j];
#pragma unroll
                    for (int bj = 0; bj < 2; ++bj)
#pragma unroll
                        for (int n = 0; n < 2; ++n) acc[ai][bj][m][n] *= f; }
        }
    }
};

struct Epi1 {
    static constexpr bool PERM = true, AFTER_DRAIN = false;
    const float* ss; bf16* MIX; bf16* XBC; bf16* GV; float* DT;
    __device__ __forceinline__ void operator()(const f32x4 (&acc)[2][2][4][2], const Unit& u, int wr, int wc, int fr, int fq) const {
        const int row0 = u.pm * 256 + wr * 64 + fr, pn = u.pn, cl = wc * 32 + 8 * fq;
        float rs[2][4];
#pragma unroll
        for (int ai = 0; ai < 2; ++ai)
#pragma unroll
            for (int m = 0; m < 4; ++m) rs[ai][m] = 1.f;
        if (pn < 4) {
#pragma unroll
            for (int ai = 0; ai < 2; ++ai)
#pragma unroll
                for (int m = 0; m < 4; ++m) { bf16* rp = MIX + (size_t)(row0 + ai * 128 + m * 16) * 2048 + pn * 256 + cl; const float r = rs[ai][m];
#pragma unroll
                    for (int bj = 0; bj < 2; ++bj) { f32x4 v0 = acc[ai][bj][m][0] * r, v1 = acc[ai][bj][m][1] * r;
#pragma unroll
                        for (int j = 0; j < 4; ++j) { v0[j] = siluf_(v0[j]); v1[j] = siluf_(v1[j]); }
                        *(u32x4*)(rp + bj * 128) = pack8(v0, v1); } }
        } else if (pn < 10) {
#pragma unroll
            for (int ai = 0; ai < 2; ++ai)
#pragma unroll
                for (int m = 0; m < 4; ++m) { bf16* rp = XBC + (size_t)(row0 + ai * 128 + m * 16) * 1536 + (pn - 4) * 256 + cl; const float r = rs[ai][m];
#pragma unroll
                    for (int bj = 0; bj < 2; ++bj) *(u32x4*)(rp + bj * 128) = pack8(acc[ai][bj][m][0] * r, acc[ai][bj][m][1] * r); }
        } else if (pn < 18) {
#pragma unroll
            for (int ai = 0; ai < 2; ++ai)
#pragma unroll
                for (int m = 0; m < 4; ++m) { bf16* rp = MIX + (size_t)(row0 + ai * 128 + m * 16) * 2048 + 1024 + (pn - 10) * 128 + cl; const float r = rs[ai][m];
                    f32x4 o[2];
#pragma unroll
                    for (int n = 0; n < 2; ++n) { const f32x4 uu = acc[ai][0][m][n] * r, gg = acc[ai][1][m][n] * r;
#pragma unroll
                        for (int j = 0; j < 4; ++j) o[n][j] = geluf_(uu[j]) * siluf_(gg[j]); }
                    *(u32x4*)rp = pack8(o[0], o[1]); }
        } else if (pn < 22) {
#pragma unroll
            for (int ai = 0; ai < 2; ++ai)
#pragma unroll
                for (int m = 0; m < 4; ++m) { bf16* rp = GV + (size_t)(row0 + ai * 128 + m * 16) * 1024 + (pn - 18) * 256 + cl; const float r = rs[ai][m];
#pragma unroll
                    for (int bj = 0; bj < 2; ++bj) { f32x4 v0 = acc[ai][bj][m][0] * r, v1 = acc[ai][bj][m][1] * r;
#pragma unroll
                        for (int j = 0; j < 4; ++j) { v0[j] = geluf_(v0[j]); v1[j] = geluf_(v1[j]); }
                        *(u32x4*)(rp + bj * 128) = pack8(v0, v1); } }
        } else {
            if (wc == 0 && fq < 2) {
#pragma unroll
                for (int ai = 0; ai < 2; ++ai)
#pragma unroll
                    for (int m = 0; m < 4; ++m) { float* rp = DT + (size_t)(row0 + ai * 128 + m * 16) * 16 + 8 * fq; const float r = rs[ai][m];
#pragma unroll
                        for (int n = 0; n < 2; ++n) *(f32x4*)(rp + 4 * n) = acc[ai][0][m][n] * r; }
            }
        }
    }
};
struct Epi3 {
    static constexpr bool PERM = true, AFTER_DRAIN = false;
    const LAS3 float* tab; bf16* MIX; bf16* GLU; bf16* XD; mutable int ui;
    __device__ __forceinline__ void operator()(const f32x4 (&acc)[2][2][4][2], const Unit& u, int wr, int wc, int fr, int fq) const {
        const int row0 = u.pm * 256 + wr * 64 + fr, pn = u.pn, cl = wc * 32 + 8 * fq;
        float rs[2][4];
#pragma unroll
        for (int ai = 0; ai < 2; ++ai)
#pragma unroll
            for (int m = 0; m < 4; ++m) rs[ai][m] = tab[ui * 256 + ai * 128 + wr * 64 + m * 16 + fr];
        ++ui;
        if (pn < 8) {
#pragma unroll
            for (int ai = 0; ai < 2; ++ai)
#pragma unroll
                for (int m = 0; m < 4; ++m) { bf16* rp = GLU + (size_t)(row0 + ai * 128 + m * 16) * 1024 + pn * 128 + cl; const float r = rs[ai][m];
                    f32x4 o[2];
#pragma unroll
                    for (int n = 0; n < 2; ++n) { const f32x4 aa = acc[ai][0][m][n] * r, bb = acc[ai][1][m][n] * r;
#pragma unroll
                        for (int j = 0; j < 4; ++j) o[n][j] = aa[j] * sigmoidf_(bb[j]); }
                    *(u32x4*)rp = pack8(o[0], o[1]); }
        } else if (pn >= 12 && pn < 16) {
#pragma unroll
            for (int ai = 0; ai < 2; ++ai)
#pragma unroll
                for (int m = 0; m < 4; ++m) { bf16* rp = XD + (size_t)(row0 + ai * 128 + m * 16) * 1024 + (pn - 12) * 256 + cl; const float r = rs[ai][m];
#pragma unroll
                    for (int bj = 0; bj < 2; ++bj) *(u32x4*)(rp + bj * 128) = pack8(acc[ai][bj][m][0] * r, acc[ai][bj][m][1] * r); }
        } else {
            const int cb = pn < 12 ? (pn - 8) * 256 : 1024 + (pn - 16) * 256;
#pragma unroll
            for (int ai = 0; ai < 2; ++ai)
#pragma unroll
                for (int m = 0; m < 4; ++m) { bf16* rp = MIX + (size_t)(row0 + ai * 128 + m * 16) * 2048 + cb + cl; const float r = rs[ai][m];
#pragma unroll
                    for (int bj = 0; bj < 2; ++bj) { f32x4 v0 = acc[ai][bj][m][0] * r, v1 = acc[ai][bj][m][1] * r;
#pragma unroll
                        for (int j = 0; j < 4; ++j) { v0[j] = siluf_(v0[j]); v1[j] = siluf_(v1[j]); }
                        *(u32x4*)(rp + bj * 128) = pack8(v0, v1); } }
        }
    }
};
template <bool L0> struct EpiOut {
    static constexpr bool PERM = false, AFTER_DRAIN = true;
    const float* xold; bf16* XN; bf16* X2; float* ss;
    __device__ __forceinline__ void operator()(const f32x4 (&)[2][2][4][2], const Unit&, int, int, int, int) const {}
    __device__ __forceinline__ void fused(f32x4 (&acc)[2][2][4][2], const Unit& u, int wr, int wc, int fr, int fq, PG8_LAS unsigned char* lds, int wid, int lane) const {
        const int col0 = u.pn * 256 + wc * 32 + 4 * fq;
        PG8_LAS float* red = (PG8_LAS float*)lds;
        f32x4 xo[3][4]; u32x2 xb[3][4];
#define EPO_OFF(G) ((size_t)(u.pm * 256 + ((G) >> 2) * 128 + wr * 64 + ((G) & 3) * 16 + fr) * 1024 + col0)
#define EPO_LOAD(G) do { const size_t off_ = EPO_OFF(G); _Pragma("unroll") for (int bj = 0; bj < 2; ++bj) _Pragma("unroll") for (int n = 0; n < 2; ++n) { \
            if (L0) xo[(G) % 3][bj * 2 + n] = *(const f32x4*)(xold + off_ + bj * 128 + n * 16); else xb[(G) % 3][bj * 2 + n] = *(const u32x2*)(XN + off_ + bj * 128 + n * 16); } } while (0)
        EPO_LOAD(0); EPO_LOAD(1);
#pragma unroll
        for (int gq = 0; gq < 8; ++gq) {
            const int ai = gq >> 2, m = gq & 3;
            if (gq + 2 < 8) EPO_LOAD(gq + 2);
            const int rl = ai * 128 + wr * 64 + m * 16 + fr; const size_t off = EPO_OFF(gq); float q = 0.f;
#pragma unroll
            for (int bj = 0; bj < 2; ++bj)
#pragma unroll
                for (int n = 0; n < 2; ++n) { const size_t o2 = off + bj * 128 + n * 16;
                    if (L0) { const f32x4 v = xo[gq % 3][bj * 2 + n] + acc[ai][bj][m][n];
                        u32x2 w; w.x = pk2(v[0], v[1]); w.y = pk2(v[2], v[3]); *(u32x2*)(XN + o2) = w;
                        q += (v[0] * v[0] + v[1] * v[1]) + (v[2] * v[2] + v[3] * v[3]); }
                    else { const u32x2 xw = xb[gq % 3][bj * 2 + n]; const f32x4 v = (f32x4){bflo(xw.x), bfhi(xw.x), bflo(xw.y), bfhi(xw.y)} + acc[ai][bj][m][n]; u32x2 w; w.x = pk2(v[0], v[1]); w.y = pk2(v[2], v[3]); *(u32x2*)(X2 + o2) = w; } }
            if (L0) { q += __shfl_xor(q, 16); q += __shfl_xor(q, 32); if (fq == 0) red[rl * 4 + wc] = q; }
        }
#undef EPO_LOAD
#undef EPO_OFF
        if (L0) {
            __syncthreads();
            const int t = wid * 64 + lane;
            if (t < 256) ss[(size_t)u.pn * MP + u.pm * 256 + t] = (red[t * 4 + 0] + red[t * 4 + 1]) + (red[t * 4 + 2] + red[t * 4 + 3]);
        }
    }
};

template <int MODE> __device__ __forceinline__ int src_col(int n) {
    const int tile = n >> 8, cl = n & 255;
    if (MODE == 1) {
        if (tile < 10) return n;
        if (tile < 18) { const int q = tile - 10; return cl < 128 ? 2576 + 128 * q + cl : 4624 + 128 * q + (cl - 128); }
        if (tile < 22) return 3600 + (n - 18 * 256);
        return cl < 16 ? 2560 + cl : -1;
    } else if (MODE == 3) {
        if (tile < 8) return cl < 128 ? 128 * tile + cl : 1024 + 128 * tile + (cl - 128);
        return n;
    }
    return n;
}
template <int MODE> __device__ __forceinline__ void transpose_item(const float* W, int K, int Nsrc, bf16* WT, const float* kscale, float* scr, int item, int nblk, int lane) {
    const int kb = item / nblk, nb = item % nblk, k0 = 64 * kb, n0 = 32 * nb;
    const int sc = src_col<MODE>(n0 + (lane & 31));
    float tv[32];
#pragma unroll
    for (int i = 0; i < 32; ++i) { const int kk = 2 * i + (lane >> 5); tv[i] = sc >= 0 ? W[(size_t)(k0 + kk) * Nsrc + sc] : 0.f; }
    if (kscale != nullptr && k0 < 1024) {
#pragma unroll
        for (int i = 0; i < 32; ++i) tv[i] *= kscale[k0 + 2 * i + (lane >> 5)];
    }
#pragma unroll
    for (int i = 0; i < 32; ++i) scr[(2 * i + (lane >> 5)) * 33 + (lane & 31)] = tv[i];
    asm volatile("s_waitcnt lgkmcnt(0)" ::: "memory");
    const int c = lane & 7;
#pragma unroll
    for (int j = 0; j < 4; ++j) { const int n = (lane >> 3) + 8 * j; const float* s = scr + (8 * c) * 33 + n;
        u32x4 o; o.x = pk2(s[0 * 33], s[1 * 33]); o.y = pk2(s[2 * 33], s[3 * 33]); o.z = pk2(s[4 * 33], s[5 * 33]); o.w = pk2(s[6 * 33], s[7 * 33]);
        *(u32x4*)(WT + (size_t)(n0 + n) * K + k0 + 8 * c) = o; }
    asm volatile("s_waitcnt lgkmcnt(0)" ::: "memory");
}
__device__ __forceinline__ void p0_prologue(const Ctx& c, unsigned char* sm) {
    const int tid = threadIdx.x, lane = tid & 63, wave = tid >> 6;
    const int gw = blockIdx.x * 8 + wave, NGW = gridDim.x * 8;
    float* scr = (float*)(sm + wave * 16384);
    if (blockIdx.x == 0 && tid < 8) c.xcnt[tid] = 0u;
    constexpr int I1 = 16 * (N1 / 32), I2 = 32 * 32, I3 = 16 * (N3 / 32), I4 = 32 * 32;
    for (int it = gw; it < I1 + I2 + I3 + I4; it += NGW) {
        int r = it;
        if (r < I1) { transpose_item<1>(c.w_in_even, 1024, 5648, c.W1t, nullptr, scr, r, N1 / 32, lane); continue; } r -= I1;
        if (r < I2) { transpose_item<0>(c.w_out_even, 2048, 1024, c.W2t, c.ssd_norm, scr, r, 32, lane); continue; } r -= I2;
        if (r < I3) { transpose_item<3>(c.w_in_odd, 1024, 5120, c.W3t, c.norm_odd, scr, r, N3 / 32, lane); continue; } r -= I3;
        transpose_item<0>(c.w_out_odd, 2048, 1024, c.W4t, nullptr, scr, r, 32, lane);
    }
    for (int m = gw; m < MP; m += NGW) {
        unsigned long long* o8 = (unsigned long long*)(c.XN + (size_t)m * 1024) + lane;
        if (m < NT) {
            const float* xr = m < NP ? c.x_prompt + (size_t)m * 1024 : c.x_sample + (size_t)(m - NP) * 1024;
            f32x4 v[4]; float s = 0.f;
#pragma unroll
            for (int j = 0; j < 4; ++j) { v[j] = ((const f32x4*)xr)[lane + 64 * j]; s += (v[j][0] * v[j][0] + v[j][1] * v[j][1]) + (v[j][2] * v[j][2] + v[j][3] * v[j][3]); }
            const float rstd = rsqrtf(wave_sum(s) * (1.f / 1024.f) + EPS);
#pragma unroll
            for (int j = 0; j < 4; ++j) { const f32x4 g = ((const f32x4*)c.norm_even)[lane + 64 * j] * rstd; o8[64 * j] = (unsigned long long)pk2(v[j][0] * g[0], v[j][1] * g[1]) | ((unsigned long long)pk2(v[j][2] * g[2], v[j][3] * g[3]) << 32); }
        } else {
#pragma unroll
            for (int j = 0; j < 4; ++j) o8[64 * j] = 0ull;
        }
        if (m >= NP && lane < 4) c.ss1[(size_t)lane * MP + m] = 0.f;
    }
}

__device__ __forceinline__ void bc_prepass(const Ctx& c) {
    const int G = gridDim.x;
    for (int item = blockIdx.x * 512 + threadIdx.x; item < 2048 * 64; item += G * 512) {
        const int oc = item & 63, trun = item >> 6;
        const int tg = trun * 8, b = tg >> 11, t0 = tg & 2047;
        const int ch = 1024 + oc * 8;
        u32x4 raw[11];
#pragma unroll
        for (int j = 0; j < 11; ++j) { const int t = t0 - 3 + j; raw[j] = (t >= 0) ? *(const u32x4*)(c.XBC + (size_t)(b * SEQ + t) * 1536 + ch) : (u32x4){0u, 0u, 0u, 0u}; }
#pragma unroll
        for (int hf = 0; hf < 2; ++hf) {
            f32x4 wk[5];
#pragma unroll
            for (int k = 0; k < 4; ++k) wk[k] = *(const f32x4*)(c.ssd_conv_w + k * 1536 + ch + 4 * hf);
            wk[4] = *(const f32x4*)(c.ssd_conv_b + ch + 4 * hf);
            float v[8][4];
#pragma unroll
            for (int i = 0; i < 8; ++i)
#pragma unroll
                for (int e = 0; e < 4; ++e) { const int ee = 4 * hf + e; float s = wk[4][e];
#pragma unroll
                    for (int k = 0; k < 4; ++k) { const unsigned wd = raw[i + k][ee >> 1]; s += wk[k][e] * ((ee & 1) ? bfhi(wd) : bflo(wd)); }
                    v[i][e] = siluf_(s); }
#pragma unroll
            for (int i = 0; i < 8; ++i) { u32x2 o; o.x = pk2(v[i][0], v[i][1]); o.y = pk2(v[i][2], v[i][3]); *(u32x2*)(c.BCn + (size_t)(tg + i) * 512 + oc * 8 + 4 * hf) = o; }
            if (oc < 32) {
                const int g = oc >> 4, n0 = (oc & 15) * 8 + 4 * hf, ck = t0 >> 7, l0 = t0 & 127;
#pragma unroll
                for (int e = 0; e < 4; ++e) *(u32x4*)(c.BTg + ((size_t)((b * 16 + ck) * 2 + g) * 128 + n0 + e) * 128 + l0) = pack8((f32x4){v[0][e], v[1][e], v[2][e], v[3][e]}, (f32x4){v[4][e], v[5][e], v[6][e], v[7][e]});
            }
        }
    }
}

__device__ __forceinline__ void ssd_chunk_unit(const Ctx& c, int u, unsigned char* sm) {
    const int tid = threadIdx.x, lane = tid & 63, w = tid >> 6, fr = lane & 15, fq = lane >> 4;
    const int pair = u >> 4, sub = u & 15;
    const int b = pair >> 1, g = pair & 1, h = g * 8 + (sub >> 1), ph = sub & 1;
    constexpr int RS = 272;
    unsigned char* Bn = sm;
    unsigned char* Cn = sm + 34816;
    unsigned char* BT = sm + 69632;
    unsigned char* XT = sm + 104448;
    unsigned char* XdT = sm + 113152;
    unsigned char* Sb = sm + 121856;
    unsigned char* Xn = sm + 130560;
    float* csA = (float*)(sm + 138752);
    float* dtA = (float*)(sm + 139776);
    float* wx = (float*)(sm + 140800);
    const int ox = tid & 3, lx = tid >> 2;
    const int chx = h * 64 + ph * 32 + ox * 8;
    if (tid < 160) { const int k = tid >> 5, cc = tid & 31; wx[tid] = k < 4 ? c.ssd_conv_w[k * 1536 + h * 64 + ph * 32 + cc] : c.ssd_conv_b[h * 64 + ph * 32 + cc]; }
    const float a_h = -__expf(c.ssd_a_log[h]), dtb = c.ssd_dt_bias[h], Dh = c.ssd_d[h];
    f32x4 accS[2];
    accS[0] = (f32x4){0.f, 0.f, 0.f, 0.f}; accS[1] = accS[0];
    u32x4 rB[4], rC[4], rT[4], rx[4]; u32x2 zz[2]; float dr0 = 0.f, dr1 = 0.f;
    const int lrow = 16 * w + fr;
    const int prow = tid >> 4, pc16 = tid & 15;
#define SSD_LOAD_B(CK) do { const int t0_ = (CK) * 128; \
        _Pragma("unroll") for (int i = 0; i < 4; ++i) rB[i] = *(const u32x4*)(c.BCn + (size_t)(b * SEQ + t0_ + prow + 32 * i) * 512 + g * 128 + pc16 * 8); } while (0)
#define SSD_LOAD_C(CK) do { const int t0_ = (CK) * 128; \
        _Pragma("unroll") for (int i = 0; i < 4; ++i) rC[i] = *(const u32x4*)(c.BCn + (size_t)(b * SEQ + t0_ + prow + 32 * i) * 512 + 256 + g * 128 + pc16 * 8); } while (0)
#define SSD_LOAD_T(CK) do { \
        _Pragma("unroll") for (int i = 0; i < 4; ++i) rT[i] = *(const u32x4*)(c.BTg + ((size_t)((b * 16 + (CK)) * 2 + g) * 128 + prow + 32 * i) * 128 + pc16 * 8); } while (0)
#define SSD_LOAD_X(CK) do { const int t0_ = (CK) * 128; \
        _Pragma("unroll") for (int j = 0; j < 4; ++j) { const int t = t0_ + lx - 3 + j; rx[j] = (t >= 0) ? *(const u32x4*)(c.XBC + (size_t)(b * SEQ + t) * 1536 + chx) : (u32x4){0u, 0u, 0u, 0u}; } \
        _Pragma("unroll") for (int pt = 0; pt < 2; ++pt) zz[pt] = *(const u32x2*)(c.MIX + (size_t)(b * SEQ + t0_ + lrow) * 2048 + h * 64 + ph * 32 + pt * 16 + 4 * fq); } while (0)
#define SSD_LOAD(CK) do { SSD_LOAD_B(CK); SSD_LOAD_C(CK); SSD_LOAD_T(CK); SSD_LOAD_X(CK); } while (0)
#define SSD_LOAD_DT(CK) do { if (tid < 64) { const size_t r = (size_t)(b * SEQ + (CK) * 128 + 2 * tid) * 16 + h; dr0 = c.DT[r]; dr1 = c.DT[r + 16]; } } while (0)
#define SSD_CUMSUM(BUF) do { if (tid < 64) { const float d0 = softplusf_(dr0 + dtb), d1 = softplusf_(dr1 + dtb); const float a1 = d1 * a_h; float s = d0 * a_h + a1; \
        _Pragma("unroll") for (int o = 1; o < 64; o <<= 1) { const float v = __shfl_up(s, o); if (lane >= o) s += v; } \
        csA[(BUF) * 128 + 2 * tid + 1] = s; csA[(BUF) * 128 + 2 * tid] = s - a1; dtA[(BUF) * 128 + 2 * tid] = d0; dtA[(BUF) * 128 + 2 * tid + 1] = d1; } } while (0)
    SSD_LOAD_DT(0);
    SSD_LOAD(0);
    SSD_CUMSUM(0);
    __syncthreads();
    for (int ck = 0; ck < 16; ++ck) {
        const int t0 = ck * 128;
        const float* cs = csA + (ck & 1) * 128; const float* dts = dtA + (ck & 1) * 128;
        if (ck < 15) SSD_LOAD_DT(ck + 1);
        {
#pragma unroll
            for (int pt = 0; pt < 2; ++pt)
#pragma unroll
                for (int e = 0; e < 4; ++e) *(bf16*)(Sb + (pt * 16 + 4 * fq + e) * RS + (16 * w + fr) * 2) = (bf16)pk2(accS[pt][e], 0.f);
        }
#pragma unroll
        for (int i = 0; i < 4; ++i) { *(u32x4*)(Bn + (prow + 32 * i) * RS + pc16 * 16) = rB[i]; *(u32x4*)(Cn + (prow + 32 * i) * RS + pc16 * 16) = rC[i]; *(u32x4*)(BT + (prow + 32 * i) * RS + pc16 * 16) = rT[i]; }
        {
            const float dl = dts[lx], ddl = dl * __expf(cs[127] - cs[lx]);
            float v[8];
#pragma unroll
            for (int hf = 0; hf < 2; ++hf) {
                f32x4 wk[5];
#pragma unroll
                for (int k = 0; k < 5; ++k) wk[k] = *(const f32x4*)(wx + k * 32 + ox * 8 + 4 * hf);
#pragma unroll
                for (int e = 0; e < 4; ++e) { const int ee = 4 * hf + e; float s = wk[4][e];
#pragma unroll
                    for (int k = 0; k < 4; ++k) { const unsigned wd = rx[k][ee >> 1]; s += wk[k][e] * ((ee & 1) ? bfhi(wd) : bflo(wd)); }
                    v[ee] = siluf_(s); }
            }
            *(u32x4*)(Xn + lx * 64 + ox * 16) = pack8((f32x4){v[0], v[1], v[2], v[3]}, (f32x4){v[4], v[5], v[6], v[7]});
#pragma unroll
            for (int e = 0; e < 8; ++e) { *(bf16*)(XT + (ox * 8 + e) * RS + lx * 2) = (bf16)pk2(v[e] * dl, 0.f); *(bf16*)(XdT + (ox * 8 + e) * RS + lx * 2) = (bf16)pk2(v[e] * ddl, 0.f); }
        }
        __syncthreads();
        const u32x2 zc0 = zz[0], zc1 = zz[1];
        if (ck < 15) SSD_LOAD_B(ck + 1);
        __builtin_amdgcn_sched_barrier(0);
        {
            const int l = lrow;
            const float csl = cs[l];
            bf16x8 cf[4];
#pragma unroll
            for (int kk = 0; kk < 4; ++kk) cf[kk] = *(const bf16x8*)(Cn + l * RS + (kk * 32 + fq * 8) * 2);
            f32x4 aoff[2], adiag[2];
            {
                bf16x8 sf[2][4];
#pragma unroll
                for (int pt = 0; pt < 2; ++pt)
#pragma unroll
                    for (int kk = 0; kk < 4; ++kk) sf[pt][kk] = *(const bf16x8*)(Sb + (pt * 16 + fr) * RS + (kk * 32 + fq * 8) * 2);
                aoff[0] = (f32x4){0.f, 0.f, 0.f, 0.f}; aoff[1] = aoff[0]; adiag[0] = aoff[0]; adiag[1] = aoff[0];
#pragma unroll
                for (int kk = 0; kk < 4; ++kk) { aoff[0] = __builtin_amdgcn_mfma_f32_16x16x32_bf16(sf[0][kk], cf[kk], aoff[0], 0, 0, 0); aoff[1] = __builtin_amdgcn_mfma_f32_16x16x32_bf16(sf[1][kk], cf[kk], aoff[1], 0, 0, 0); }
            }
            __builtin_amdgcn_sched_barrier(0);
            if (ck < 15) SSD_LOAD_C(ck + 1);
            __builtin_amdgcn_sched_barrier(0);
            for (int jp = 0; jp <= (w >> 1); ++jp) {
                const int j0 = 2 * jp, j1 = 2 * jp + 1;
                f32x4 g0 = (f32x4){0.f, 0.f, 0.f, 0.f}, g1 = g0;
                bf16x8 bf0[4], bf1[4];
#pragma unroll
                for (int kk = 0; kk < 4; ++kk) { bf0[kk] = *(const bf16x8*)(Bn + (16 * j0 + fr) * RS + (kk * 32 + fq * 8) * 2); bf1[kk] = *(const bf16x8*)(Bn + (16 * j1 + fr) * RS + (kk * 32 + fq * 8) * 2); }
                const u32x2 xa0 = *(const u32x2*)(XT + fr * RS + (16 * j0 + 4 * fq) * 2), xb0 = *(const u32x2*)(XT + fr * RS + (16 * j1 + 4 * fq) * 2);
                const u32x2 xa1 = *(const u32x2*)(XT + (16 + fr) * RS + (16 * j0 + 4 * fq) * 2), xb1 = *(const u32x2*)(XT + (16 + fr) * RS + (16 * j1 + 4 * fq) * 2);
#pragma unroll
                for (int kk = 0; kk < 4; ++kk) { g0 = __builtin_amdgcn_mfma_f32_16x16x32_bf16(bf0[kk], cf[kk], g0, 0, 0, 0); g1 = __builtin_amdgcn_mfma_f32_16x16x32_bf16(bf1[kk], cf[kk], g1, 0, 0, 0); }
                const f32x4 cs0 = *(const f32x4*)(cs + 16 * j0 + 4 * fq), cs1 = *(const f32x4*)(cs + 16 * j1 + 4 * fq);
                f32x4 m0, m1;
#pragma unroll
                for (int e = 0; e < 4; ++e) { const int s0 = 16 * j0 + 4 * fq + e, s1 = 16 * j1 + 4 * fq + e;
                    m0[e] = (s0 <= l) ? g0[e] * __expf(csl - cs0[e]) : 0.f; m1[e] = (s1 <= l) ? g1[e] * __expf(csl - cs1[e]) : 0.f; }
                const bf16x8 mB = __builtin_bit_cast(bf16x8, pack8(m0, m1));
                { u32x4 xv; xv.x = xa0.x; xv.y = xa0.y; xv.z = xb0.x; xv.w = xb0.y; adiag[0] = __builtin_amdgcn_mfma_f32_16x16x32_bf16(__builtin_bit_cast(bf16x8, xv), mB, adiag[0], 0, 0, 0); }
                { u32x4 xv; xv.x = xa1.x; xv.y = xa1.y; xv.z = xb1.x; xv.w = xb1.y; adiag[1] = __builtin_amdgcn_mfma_f32_16x16x32_bf16(__builtin_bit_cast(bf16x8, xv), mB, adiag[1], 0, 0, 0); }
            }
            __builtin_amdgcn_sched_barrier(0);
            if (ck < 15) SSD_LOAD_T(ck + 1);
            __builtin_amdgcn_sched_barrier(0);
            const float decT = __expf(cs[127]);
            {
                bf16x8 xf[2][4], tf[4];
#pragma unroll
                for (int kk = 0; kk < 4; ++kk) { tf[kk] = *(const bf16x8*)(BT + (16 * w + fr) * RS + (kk * 32 + fq * 8) * 2); xf[0][kk] = *(const bf16x8*)(XdT + fr * RS + (kk * 32 + fq * 8) * 2); xf[1][kk] = *(const bf16x8*)(XdT + (16 + fr) * RS + (kk * 32 + fq * 8) * 2); }
                accS[0] *= decT; accS[1] *= decT;
#pragma unroll
                for (int kk = 0; kk < 4; ++kk) { accS[0] = __builtin_amdgcn_mfma_f32_16x16x32_bf16(xf[0][kk], tf[kk], accS[0], 0, 0, 0); accS[1] = __builtin_amdgcn_mfma_f32_16x16x32_bf16(xf[1][kk], tf[kk], accS[1], 0, 0, 0); }
            }
            __builtin_amdgcn_sched_barrier(0);
            if (ck < 15) SSD_LOAD_X(ck + 1);
            __builtin_amdgcn_sched_barrier(0);
            const int row = b * SEQ + t0 + l;
            const float el = __expf(csl);
            float q = 0.f;
#pragma unroll
            for (int pt = 0; pt < 2; ++pt) {
                const u32x2 xr = *(const u32x2*)(Xn + l * 64 + (pt * 16 + 4 * fq) * 2);
                bf16* p = c.MIX + (size_t)row * 2048 + h * 64 + ph * 32 + pt * 16 + 4 * fq;
                const u32x2 zv = pt == 0 ? zc0 : zc1;
                const float y0 = (adiag[pt][0] + el * aoff[pt][0] + Dh * bflo(xr.x)) * bflo(zv.x);
                const float y1 = (adiag[pt][1] + el * aoff[pt][1] + Dh * bfhi(xr.x)) * bfhi(zv.x);
                const float y2 = (adiag[pt][2] + el * aoff[pt][2] + Dh * bflo(xr.y)) * bflo(zv.y);
                const float y3 = (adiag[pt][3] + el * aoff[pt][3] + Dh * bfhi(xr.y)) * bfhi(zv.y);
                u32x2 wv; wv.x = pk2(y0, y1); wv.y = pk2(y2, y3); *(u32x2*)p = wv;
                q += (y0 * y0 + y1 * y1) + (y2 * y2 + y3 * y3);
            }
            q += __shfl_xor(q, 16); q += __shfl_xor(q, 32);
            if (fq == 0) c.ssg[((size_t)(g * 16 + (h & 7) * 2 + ph)) * NP + row] = q;
        }
        if (ck < 15) SSD_CUMSUM((ck + 1) & 1);
        __syncthreads();
    }
#undef SSD_LOAD
#undef SSD_LOAD_B
#undef SSD_LOAD_C
#undef SSD_LOAD_T
#undef SSD_LOAD_X
#undef SSD_LOAD_DT
#undef SSD_CUMSUM
#pragma unroll
    for (int pt = 0; pt < 2; ++pt)
#pragma unroll
        for (int e = 0; e < 4; ++e) c.out[O_SSM_P + ((size_t)(b * 16 + h) * 64 + ph * 32 + pt * 16 + 4 * fq + e) * 128 + 16 * w + fr] = accS[pt][e];
}

__device__ __forceinline__ void gmlp_unit(const Ctx& c, int u, unsigned char* sm) {
    const int tid = threadIdx.x, lane = tid & 63, w = tid >> 6, fr = lane & 15, fq = lane >> 4;
    const int b = u >> 5, ck = (u >> 1) & 15, gh = u & 1;
    const int r0 = b * SEQ + ck * 128;
    float* stat = (float*)sm;
    unsigned char* vbase = sm + 1024;
    {
        u32x4 gq[16][2];
#pragma unroll
        for (int i = 0; i < 16; ++i) { const u32x4* gp = (const u32x4*)(c.GV + (size_t)(r0 + w * 16 + i) * 1024 + lane * 16); gq[i][0] = gp[0]; gq[i][1] = gp[1]; }
#pragma unroll
        for (int i = 0; i < 16; ++i) {
            const int tk = w * 16 + i;
            float f0[8], f1[8]; unpack8(gq[i][0], f0); unpack8(gq[i][1], f1);
            float s = 0.f, q = 0.f;
#pragma unroll
            for (int e = 0; e < 8; ++e) { s += f0[e] + f1[e]; q += f0[e] * f0[e] + f1[e] * f1[e]; }
            s = wave_sum(s); q = wave_sum(q);
            if (lane == 0) { const float mean = s * (1.f / 1024.f); const float var = fmaxf(q * (1.f / 1024.f) - mean * mean, 0.f); stat[tk * 2] = mean; stat[tk * 2 + 1] = rsqrtf(var + EPS); }
        }
    }
    u32x4 gva[2], gvb[2];
#define GMLP_LOADV(GRP) do { _Pragma("unroll") for (int it = 0; it < 2; ++it) { const int item = tid + 512 * it, sp = item & 63, d8 = item >> 6; \
        gva[it] = *(const u32x4*)(c.GV + (size_t)(r0 + 2 * sp) * 1024 + (GRP) * 128 + d8 * 8); gvb[it] = *(const u32x4*)(c.GV + (size_t)(r0 + 2 * sp + 1) * 1024 + (GRP) * 128 + d8 * 8); } } while (0)
    GMLP_LOADV(gh * 4);
    __syncthreads();
    for (int gi = 0; gi < 4; ++gi) {
        const int grp = gh * 4 + gi;
        unsigned char* vnT = vbase + (gi & 1) * 34816;
        const int t = 16 * w + fr, nk = (w >> 1) + 1;
        const float* wrow = c.gmlp_w_s + ((size_t)grp * 128 + t) * 128;
        f32x4 wq[4][2];
#pragma unroll
        for (int kk = 0; kk < 4; ++kk) { if (kk < nk) { wq[kk][0] = *(const f32x4*)(wrow + kk * 32 + fq * 8); wq[kk][1] = *(const f32x4*)(wrow + kk * 32 + fq * 8 + 4); } else { wq[kk][0] = (f32x4){0.f, 0.f, 0.f, 0.f}; wq[kk][1] = wq[kk][0]; } }
        bf16* mp = c.MIX + (size_t)(r0 + t) * 2048 + 1024 + grp * 128 + 4 * fq;
        u32x2 ugv[8];
#pragma unroll
        for (int dt = 0; dt < 8; ++dt) ugv[dt] = *(const u32x2*)(mp + dt * 16);
        const float bs = c.gmlp_b_s[grp * 128 + t];
#pragma unroll
        for (int it = 0; it < 2; ++it) {
            const int item = tid + 512 * it, sp = item & 63, d8 = item >> 6;
            const int s0 = 2 * sp, chn = grp * 128 + d8 * 8;
            float a[8], bq[8]; unpack8(gva[it], a); unpack8(gvb[it], bq);
            const float m0 = stat[s0 * 2], rs0 = stat[s0 * 2 + 1], m1 = stat[s0 * 2 + 2], rs1 = stat[s0 * 2 + 3];
            const f32x4 lg0 = *(const f32x4*)(c.gmlp_ln_g + chn), lg1 = *(const f32x4*)(c.gmlp_ln_g + chn + 4), lb0 = *(const f32x4*)(c.gmlp_ln_b + chn), lb1 = *(const f32x4*)(c.gmlp_ln_b + chn + 4);
#pragma unroll
            for (int e = 0; e < 8; ++e) { const float lg = e < 4 ? lg0[e & 3] : lg1[e & 3], lb = e < 4 ? lb0[e & 3] : lb1[e & 3];
                const float v0 = (a[e] - m0) * rs0 * lg + lb, v1 = (bq[e] - m1) * rs1 * lg + lb;
                *(unsigned*)(vnT + (d8 * 8 + e) * 272 + sp * 4) = pk2(v0, v1); }
        }
        if (gi < 3) GMLP_LOADV(grp + 1);
        __syncthreads();
        f32x4 acc[8];
#pragma unroll
        for (int dt = 0; dt < 8; ++dt) acc[dt] = (f32x4){0.f, 0.f, 0.f, 0.f};
#pragma unroll
        for (int kk = 0; kk < 4; ++kk) {
            if (kk < nk) {
                const int sb = kk * 32 + fq * 8;
                f32x4 m0, m1;
#pragma unroll
                for (int e = 0; e < 4; ++e) { m0[e] = (sb + e <= t) ? wq[kk][0][e] : 0.f; m1[e] = (sb + 4 + e <= t) ? wq[kk][1][e] : 0.f; }
                const bf16x8 wf = __builtin_bit_cast(bf16x8, pack8(m0, m1));
#pragma unroll
                for (int dt = 0; dt < 8; ++dt) {
                    const bf16x8 vf = *(const bf16x8*)(vnT + (dt * 16 + fr) * 272 + sb * 2);
                    acc[dt] = __builtin_amdgcn_mfma_f32_16x16x32_bf16(vf, wf, acc[dt], 0, 0, 0);
                }
            }
        }
#pragma unroll
        for (int dt = 0; dt < 8; ++dt) { const u32x2 ug = ugv[dt];
            u32x2 o; o.x = pk2((acc[dt][0] + bs) * bflo(ug.x), (acc[dt][1] + bs) * bfhi(ug.x)); o.y = pk2((acc[dt][2] + bs) * bflo(ug.y), (acc[dt][3] + bs) * bfhi(ug.y));
            *(u32x2*)(mp + dt * 16) = o; }
    }
#undef GMLP_LOADV
    __syncthreads();
}

__device__ __forceinline__ void sample_even_unit(const Ctx& c, int u, unsigned char* sm) {
    const int tid = threadIdx.x;
    const int bs = u >> 1, g = u & 1, row = NP + bs;
    float* xcs = (float*)sm;
    float* ygs = xcs + 768;
    float* red = ygs + 512;
    float* hsc = red + 8;
    const int p = tid >> 3, nq = tid & 7;
    f32x4 st[8][4];
#pragma unroll
    for (int hh = 0; hh < 8; ++hh)
#pragma unroll
        for (int j = 0; j < 4; ++j) st[hh][j] = __builtin_nontemporal_load((const f32x4*)(c.state_ssm + ((size_t)(bs * 16 + g * 8 + hh) * 64 + p) * 128 + j * 32 + nq * 4));
    const float* buf = c.state_ssd_conv + (size_t)bs * 3 * 1536;
    for (int i = tid; i < 768; i += 512) {
        const int ch = i < 512 ? g * 512 + i : (i < 640 ? 1024 + g * 128 + (i - 512) : 1280 + g * 128 + (i - 640));
        const float xn = bf2f(c.XBC[(size_t)row * 1536 + ch]);
        const float b0 = buf[ch], b1 = buf[1536 + ch], b2 = buf[2 * 1536 + ch];
        float s = c.ssd_conv_b[ch] + c.ssd_conv_w[ch] * b0 + c.ssd_conv_w[1536 + ch] * b1 + c.ssd_conv_w[2 * 1536 + ch] * b2 + c.ssd_conv_w[3 * 1536 + ch] * xn;
        xcs[i] = siluf_(s);
        float* so = c.out + O_SCONV_S + (size_t)bs * 3 * 1536;
        so[ch] = b1; so[1536 + ch] = b2; so[2 * 1536 + ch] = xn;
    }
    if (tid < 8) { const int h = g * 8 + tid; const float dt = softplusf_(c.DT[(size_t)row * 16 + h] + c.ssd_dt_bias[h]); hsc[tid * 4] = dt; hsc[tid * 4 + 1] = __expf(-dt * __expf(c.ssd_a_log[h])); hsc[tid * 4 + 2] = c.ssd_d[h]; }
    float zv[8];
    if (nq == 0) {
#pragma unroll
        for (int hh = 0; hh < 8; ++hh) zv[hh] = bf2f(c.MIX[(size_t)row * 2048 + (g * 8 + hh) * 64 + p]);
    }
    const unsigned gv2 = *(const unsigned*)(c.GV + (size_t)row * 1024 + 2 * tid);
    const int chn = g * 512 + tid, grp = chn >> 7;
    const float gvc = bf2f(c.GV[(size_t)row * 1024 + chn]), lng = c.gmlp_ln_g[chn], lnb = c.gmlp_ln_b[chn], ws0 = c.gmlp_w_s[(size_t)grp * 128 * 128], bs0 = c.gmlp_b_s[grp * 128];
    bf16* mpu = c.MIX + (size_t)row * 2048 + 1024 + chn;
    const float ugv = bf2f(*mpu);
    __syncthreads();
    f32x4 bv[4], cv[4];
#pragma unroll
    for (int j = 0; j < 4; ++j) { bv[j] = *(const f32x4*)(xcs + 512 + j * 32 + nq * 4); cv[j] = *(const f32x4*)(xcs + 640 + j * 32 + nq * 4); }
#pragma unroll
    for (int hh = 0; hh < 8; ++hh) {
        const int h = g * 8 + hh;
        const size_t so = ((size_t)(bs * 16 + h) * 64 + p) * 128 + nq * 4;
        const float dt = hsc[hh * 4], dA = hsc[hh * 4 + 1];
        const float xv = xcs[hh * 64 + p], dtx = dt * xv;
        float y = 0.f;
#pragma unroll
        for (int j = 0; j < 4; ++j) {
            f32x4 hn;
#pragma unroll
            for (int e = 0; e < 4; ++e) { hn[e] = dA * st[hh][j][e] + dtx * bv[j][e]; y += cv[j][e] * hn[e]; }
            __builtin_nontemporal_store(hn, (f32x4*)(c.out + O_SSM_S + so + 32 * j));
        }
        y += __shfl_xor(y, 1); y += __shfl_xor(y, 2); y += __shfl_xor(y, 4);
        if (nq == 0) { y += hsc[hh * 4 + 2] * xv; ygs[hh * 64 + p] = y * zv[hh]; }
    }
    __syncthreads();
    {
        const float v = ygs[tid];
        const float q = block_sum(v * v, red);
        c.MIX[(size_t)row * 2048 + g * 512 + tid] = (bf16)pk2(v * rsqrtf(q * (1.f / 512.f) + EPS), 0.f);
    }
    {
        const float a0 = bflo(gv2), a1 = bfhi(gv2);
        const float s = block_sum(a0 + a1, red);
        const float q = block_sum(a0 * a0 + a1 * a1, red);
        const float mean = s * (1.f / 1024.f), rstd = rsqrtf(fmaxf(q * (1.f / 1024.f) - mean * mean, 0.f) + EPS);
        const float vn = (gvc - mean) * rstd * lng + lnb;
        c.out[O_GV_S + (size_t)bs * 1024 + chn] = vn;
        *mpu = (bf16)pk2(ugv * (ws0 * vn + bs0), 0.f);
    }
    __syncthreads();
}

__device__ __forceinline__ void p2_even_mixers(const Ctx& c, unsigned char* sm) {
    const int G = gridDim.x, bx = blockIdx.x;
    for (int u = bx; u < 256; u += G) ssd_chunk_unit(c, u, sm);
    for (int u = bx; u < 256; u += G) gmlp_unit(c, u, sm);
    for (int u = bx; u < 256; u += G) sample_even_unit(c, u, sm);
    for (int i = bx * 512 + threadIdx.x; i < 8 * 3 * 1536; i += G * 512) { const int b = i / (3 * 1536), r = i % (3 * 1536), k = r / 1536, ch = r % 1536;
        c.out[O_SCONV_P + i] = bf2f(c.XBC[(size_t)(b * SEQ + SEQ - 3 + k) * 1536 + ch]); }
}

template <bool L0> __device__ __forceinline__ void sample_outproj(const bf16* A, const bf16* Wt, const float* xold, bf16* XNs, bf16* X2s, float* ss, unsigned char* sm) {
    const int tid = threadIdx.x, lane = tid & 63, w = tid >> 6, fr = lane & 15, fq = lane >> 4;
    f32x4* red = (f32x4*)sm;
    for (int u = blockIdx.x; u < 256; u += gridDim.x) {
        const int tg = u & 7, cgp = u >> 3;
        const bf16* ap = A + (size_t)(tg * 16 + fr) * 2048 + w * 256 + fq * 8;
        const bf16* bp0 = Wt + (size_t)(cgp * 32 + fr) * 2048 + w * 256 + fq * 8;
        const bf16* bp1 = bp0 + 16 * 2048;
        f32x4 a0 = (f32x4){0.f, 0.f, 0.f, 0.f}, a1 = a0;
#pragma unroll
        for (int kk = 0; kk < 8; ++kk) {
            const bf16x8 af = *(const bf16x8*)(ap + kk * 32), b0 = *(const bf16x8*)(bp0 + kk * 32), b1 = *(const bf16x8*)(bp1 + kk * 32);
            a0 = __builtin_amdgcn_mfma_f32_16x16x32_bf16(b0, af, a0, 0, 0, 0);
            a1 = __builtin_amdgcn_mfma_f32_16x16x32_bf16(b1, af, a1, 0, 0, 0);
        }
        red[(w * 2 + 0) * 64 + lane] = a0; red[(w * 2 + 1) * 64 + lane] = a1;
        __syncthreads();
        if (tid < 128) {
            const int ct = tid >> 6;
            f32x4 s = (f32x4){0.f, 0.f, 0.f, 0.f};
#pragma unroll
            for (int w2 = 0; w2 < 8; ++w2) s += red[(w2 * 2 + ct) * 64 + lane];
            const int trow = tg * 16 + fr, col = cgp * 32 + ct * 16 + 4 * fq;
            const size_t off = (size_t)trow * 1024 + col;
            if (L0) {
                const f32x4 v = *(const f32x4*)(xold + off) + s;
                u32x2 wv; wv.x = pk2(v[0], v[1]); wv.y = pk2(v[2], v[3]); *(u32x2*)(XNs + off) = wv;
                float q = (v[0] * v[0] + v[1] * v[1]) + (v[2] * v[2] + v[3] * v[3]);
                q += __shfl_xor(q, 16); q += __shfl_xor(q, 32);
                if (fq == 0) atomicAdd(ss + (size_t)(cgp >> 3) * MP + trow, q);
            } else {
                const u32x2 xw = *(const u32x2*)(XNs + off);
                const f32x4 v = (f32x4){bflo(xw.x), bfhi(xw.x), bflo(xw.y), bfhi(xw.y)} + s;
                u32x2 wv; wv.x = pk2(v[0], v[1]); wv.y = pk2(v[2], v[3]); *(u32x2*)(X2s + off) = wv;
            }
        }
        __syncthreads();
    }
}

__device__ __forceinline__ void ccv_unit(const Ctx& c, int u, unsigned char* sm) {
    const int tid = threadIdx.x, lane = tid & 63, wv = tid >> 6;
    const int b = u >> 5, t0 = (u & 31) * 64, ch = 2 * tid;
    float* red = (float*)sm;
    f32x2 w[31];
#pragma unroll
    for (int k = 0; k < 31; ++k) w[k] = *(const f32x2*)(c.ccv_w + k * 1024 + ch);
    const f32x2 bias = *(const f32x2*)(c.ccv_b + ch), lg = *(const f32x2*)(c.ccv_ln_g + ch), lb = *(const f32x2*)(c.ccv_ln_b + ch);
    unsigned gwin[38];
#pragma unroll
    for (int j = 0; j < 38; ++j) { const int t = t0 - 30 + j; gwin[j] = (t >= 0) ? *(const unsigned*)(c.GLU + (size_t)(b * SEQ + t) * 1024 + ch) : 0u; }
    for (int og = 0; og < 8; ++og) {
        unsigned nxt[8], gcv[8];
#pragma unroll
        for (int j = 0; j < 8; ++j) { gcv[j] = *(const unsigned*)(c.MIX + (size_t)(b * SEQ + t0 + og * 8 + j) * 2048 + ch);
            nxt[j] = (og < 7) ? *(const unsigned*)(c.GLU + (size_t)(b * SEQ + t0 + og * 8 + 8 + j) * 1024 + ch) : 0u; }
        f32x2 acc[8];
#pragma unroll
        for (int o = 0; o < 8; ++o) acc[o] = bias;
#pragma unroll
        for (int j = 0; j < 38; ++j) {
            const f32x2 gl = (f32x2){bflo(gwin[j]), bfhi(gwin[j])};
#pragma unroll
            for (int o = 0; o < 8; ++o) { const int k = j - o; if (k >= 0 && k <= 30) acc[o] += w[k] * gl; }
        }
        float* rb = red + (og & 1) * 512;
        {
            float mine = 0.f;
#pragma unroll
            for (int o = 0; o < 8; ++o) { const float s = row16_sum(acc[o][0] + acc[o][1]), q = row16_sum(acc[o][0] * acc[o][0] + acc[o][1] * acc[o][1]);
                mine = ((lane & 15) == o) ? s : mine; mine = ((lane & 15) == 8 + o) ? q : mine; }
            rb[(wv * 4 + (lane >> 4)) * 16 + (lane & 15)] = mine;
        }
        __syncthreads();
        float tot;
        {
            float s = 0.f;
#pragma unroll
            for (int i = 0; i < 8; ++i) s += rb[((lane >> 4) * 8 + i) * 16 + (lane & 15)];
            s += __shfl_xor(s, 16); s += __shfl_xor(s, 32);
            tot = s;
        }
#pragma unroll
        for (int o = 0; o < 8; ++o) {
            const float s = __builtin_bit_cast(float, __builtin_amdgcn_readlane(__builtin_bit_cast(int, tot), o)), q = __builtin_bit_cast(float, __builtin_amdgcn_readlane(__builtin_bit_cast(int, tot), 8 + o));
            const float mean = s * (1.f / 1024.f), rstd = rsqrtf(fmaxf(q * (1.f / 1024.f) - mean * mean, 0.f) + EPS);
            const float y0 = siluf_((acc[o][0] - mean) * rstd * lg[0] + lb[0]), y1 = siluf_((acc[o][1] - mean) * rstd * lg[1] + lb[1]);
            *(unsigned*)(c.MIX + (size_t)(b * SEQ + t0 + og * 8 + o) * 2048 + ch) = pk2(y0 * bflo(gcv[o]), y1 * bfhi(gcv[o]));
        }
#pragma unroll
        for (int j = 0; j < 30; ++j) gwin[j] = gwin[j + 8];
#pragma unroll
        for (int j = 0; j < 8; ++j) gwin[30 + j] = nxt[j];
    }
    __syncthreads();
}
__device__ __forceinline__ void ccv_sample_unit(const Ctx& c, int bs, unsigned char* sm) {
    const int tid = threadIdx.x, ch = 2 * tid, row = NP + bs;
    float* red = (float*)sm;
    const float* buf = c.state_ccv + (size_t)bs * 30 * 1024;
    const unsigned gw = *(const unsigned*)(c.GLU + (size_t)row * 1024 + ch);
    const f32x2 gl = (f32x2){bflo(gw), bfhi(gw)};
    f32x2 acc = *(const f32x2*)(c.ccv_b + ch);
    float* so = c.out + O_CCV_S + (size_t)bs * 30 * 1024;
    unsigned* mp = (unsigned*)(c.MIX + (size_t)row * 2048 + ch);
    const unsigned gc = *mp;
    const f32x2 lg = *(const f32x2*)(c.ccv_ln_g + ch), lb = *(const f32x2*)(c.ccv_ln_b + ch);
    f32x2 bvv[30], wv[31];
#pragma unroll
    for (int k = 0; k < 30; ++k) bvv[k] = *(const f32x2*)(buf + k * 1024 + ch);
#pragma unroll
    for (int k = 0; k < 31; ++k) wv[k] = *(const f32x2*)(c.ccv_w + k * 1024 + ch);
#pragma unroll
    for (int k = 0; k < 30; ++k) acc += wv[k] * bvv[k];
    acc += wv[30] * gl;
#pragma unroll
    for (int k = 1; k < 30; ++k) *(f32x2*)(so + (k - 1) * 1024 + ch) = bvv[k];
    *(f32x2*)(so + 29 * 1024 + ch) = gl;
    const float s = block_sum(acc[0] + acc[1], red);
    const float q = block_sum(acc[0] * acc[0] + acc[1] * acc[1], red);
    const float mean = s * (1.f / 1024.f), rstd = rsqrtf(fmaxf(q * (1.f / 1024.f) - mean * mean, 0.f) + EPS);
    const float y0 = siluf_((acc[0] - mean) * rstd * lg[0] + lb[0]), y1 = siluf_((acc[1] - mean) * rstd * lg[1] + lb[1]);
    *mp = pk2(y0 * bflo(gc), y1 * bfhi(gc));
    __syncthreads();
}

__device__ __forceinline__ float neg_expm1_fast(float x) {
    const float p = -x * (1.f + x * (0.5f + x * (0.16666667f + x * (0.041666668f + x * 0.0083333338f))));
    return x > -0.25f ? p : 1.f - __expf(x);
}
__device__ __forceinline__ void lru_unit(const Ctx& c, int u, unsigned char* sm) {
    const int tid = threadIdx.x, lane = tid & 63, w = tid >> 6, fr = lane & 15, fq = lane >> 4;
    const int pairi = (u & 7) * 16 + ((u >> 3) >> 1), jh = (u >> 3) & 1;
    const int b = pairi >> 4, h = pairi & 15;
    float* xcf = (float*)sm;
    unsigned char* xcb = sm + 32768;
    float* as = (float*)(sm + 51200);
    float* bs = (float*)(sm + 67584);
    float* Pseg = (float*)(sm + 83968);
    float* Hseg = (float*)(sm + 86016);
    float* hcar = (float*)(sm + 88064);
    bf16x8 wfa[2][2], wfx[2][2];
#pragma unroll
    for (int ct = 0; ct < 2; ++ct)
#pragma unroll
        for (int kk = 0; kk < 2; ++kk) { float fa[8], fx[8];
#pragma unroll
            for (int e = 0; e < 8; ++e) { const size_t o = ((size_t)h * 64 + kk * 32 + fq * 8 + e) * 64 + jh * 32 + ct * 16 + fr; fa[e] = c.lru_wa[o]; fx[e] = c.lru_wx[o]; }
            u32x4 pa, px; pa.x = pk2(fa[0], fa[1]); pa.y = pk2(fa[2], fa[3]); pa.z = pk2(fa[4], fa[5]); pa.w = pk2(fa[6], fa[7]); px.x = pk2(fx[0], fx[1]); px.y = pk2(fx[2], fx[3]); px.z = pk2(fx[4], fx[5]); px.w = pk2(fx[6], fx[7]);
            wfa[ct][kk] = __builtin_bit_cast(bf16x8, pa); wfx[ct][kk] = __builtin_bit_cast(bf16x8, px); }
    float ba[2], bx[2], sp[2];
#pragma unroll
    for (int ct = 0; ct < 2; ++ct) { const int j = h * 64 + jh * 32 + ct * 16 + fr; ba[ct] = c.lru_ba[j]; bx[ct] = c.lru_bx[j]; sp[ct] = softplusf_(-c.lru_lambda[j]); }
    const int o8 = tid & 7, run = tid >> 3, chc = h * 64 + o8 * 8;
    float cw[4][8], cb[8];
#pragma unroll
    for (int k = 0; k < 4; ++k) { const f32x4 a = *(const f32x4*)(c.lru_conv_w + k * 1024 + chc), bq = *(const f32x4*)(c.lru_conv_w + k * 1024 + chc + 4);
#pragma unroll
        for (int e = 0; e < 4; ++e) { cw[k][e] = a[e]; cw[k][4 + e] = bq[e]; } }
    { const f32x4 a = *(const f32x4*)(c.lru_conv_b + chc), bq = *(const f32x4*)(c.lru_conv_b + chc + 4);
#pragma unroll
      for (int e = 0; e < 4; ++e) { cb[e] = a[e]; cb[4 + e] = bq[e]; } }
    const int jl = tid & 31, sgm = tid >> 5;
    const int tl4 = tid >> 2, c8 = (tid & 3) * 8;
    u32x4 rw[5], gdv;
#define LRU_LOAD(TILE) do { const int t0_ = (TILE) * 128; \
        _Pragma("unroll") for (int j = 0; j < 5; ++j) { const int t = t0_ + 2 * run - 3 + j; rw[j] = (t >= 0) ? *(const u32x4*)(c.XD + (size_t)(b * SEQ + t) * 1024 + chc) : (u32x4){0u, 0u, 0u, 0u}; } \
        gdv = *(const u32x4*)(c.MIX + (size_t)(b * SEQ + t0_ + tl4) * 2048 + 1024 + h * 64 + jh * 32 + c8); } while (0)
    LRU_LOAD(0);
    if (tid < 32) hcar[tid] = 0.f;
    for (int tile = 0; tile < 16; ++tile) {
        const int t0 = tile * 128;
        {
#pragma unroll
            for (int i = 0; i < 2; ++i) { float r8[8];
#pragma unroll
                for (int e = 0; e < 8; ++e) { float s = cb[e];
#pragma unroll
                    for (int k = 0; k < 4; ++k) { const unsigned wd = rw[i + k][e >> 1]; s += cw[k][e] * ((e & 1) ? bfhi(wd) : bflo(wd)); }
                    r8[e] = s; }
                const int tl = 2 * run + i;
                *(f32x4*)(xcf + tl * 64 + o8 * 8) = (f32x4){r8[0], r8[1], r8[2], r8[3]}; *(f32x4*)(xcf + tl * 64 + o8 * 8 + 4) = (f32x4){r8[4], r8[5], r8[6], r8[7]};
                *(u32x4*)(xcb + tl * 144 + o8 * 16) = pack8((f32x4){r8[0], r8[1], r8[2], r8[3]}, (f32x4){r8[4], r8[5], r8[6], r8[7]}); }
        }
        __syncthreads();
        const u32x4 gdc = gdv;
        if (tile < 15) LRU_LOAD(tile + 1);
        {
            bf16x8 af[2];
#pragma unroll
            for (int kk = 0; kk < 2; ++kk) af[kk] = *(const bf16x8*)(xcb + (16 * w + fr) * 144 + (kk * 32 + fq * 8) * 2);
#pragma unroll
            for (int ct = 0; ct < 2; ++ct) {
                f32x4 dr = (f32x4){0.f, 0.f, 0.f, 0.f}, di = dr;
#pragma unroll
                for (int kk = 0; kk < 2; ++kk) { dr = __builtin_amdgcn_mfma_f32_16x16x32_bf16(af[kk], wfa[ct][kk], dr, 0, 0, 0); di = __builtin_amdgcn_mfma_f32_16x16x32_bf16(af[kk], wfx[ct][kk], di, 0, 0, 0); }
#pragma unroll
                for (int e = 0; e < 4; ++e) {
                    const int tl = 16 * w + 4 * fq + e, jj = ct * 16 + fr;
                    const float r = sigmoidf_(dr[e] + ba[ct]), ig = sigmoidf_(di[e] + bx[ct]);
                    const float la = -8.f * r * sp[ct];
                    const float a = __expf(la);
                    const float bt = sqrtf(fmaxf(neg_expm1_fast(2.f * la), 0.f)) * (ig * xcf[tl * 64 + jh * 32 + jj]);
                    as[tl * 32 + jj] = a; bs[tl * 32 + jj] = bt;
                }
            }
        }
        __syncthreads();
        {
            float p = 1.f, hl = 0.f;
#pragma unroll
            for (int i = 0; i < 8; ++i) { const int t = 8 * sgm + i; const float a = as[t * 32 + jl]; hl = fmaf(a, hl, bs[t * 32 + jl]); p *= a; as[t * 32 + jl] = p; bs[t * 32 + jl] = hl; }
            Pseg[sgm * 32 + jl] = p; Hseg[sgm * 32 + jl] = hl;
        }
        __syncthreads();
        {
            float cin = hcar[(tile & 1) * 32 + jl];
#pragma unroll
            for (int s2 = 0; s2 < 15; ++s2) { const float nc = fmaf(Pseg[s2 * 32 + jl], cin, Hseg[s2 * 32 + jl]); cin = (s2 < sgm) ? nc : cin; }
            if (sgm == 15) hcar[((tile + 1) & 1) * 32 + jl] = fmaf(Pseg[15 * 32 + jl], cin, Hseg[15 * 32 + jl]);
#pragma unroll
            for (int i = 0; i < 8; ++i) { const int t = 8 * sgm + i; bs[t * 32 + jl] = fmaf(as[t * 32 + jl], cin, bs[t * 32 + jl]); }
        }
        __syncthreads();
        {
            u32x4* mp = (u32x4*)(c.MIX + (size_t)(b * SEQ + t0 + tl4) * 2048 + 1024 + h * 64 + jh * 32 + c8);
            float gd[8]; unpack8(gdc, gd);
            const f32x4 h0 = *(const f32x4*)(bs + tl4 * 32 + c8), h1 = *(const f32x4*)(bs + tl4 * 32 + c8 + 4);
            *mp = pack8((f32x4){h0[0] * gd[0], h0[1] * gd[1], h0[2] * gd[2], h0[3] * gd[3]}, (f32x4){h1[0] * gd[4], h1[1] * gd[5], h1[2] * gd[6], h1[3] * gd[7]});
        }
    }
#undef LRU_LOAD
    __syncthreads();
    if (tid < 32) {
        const int j = h * 64 + jh * 32 + tid;
        c.out[O_LRU_P + (size_t)b * 1024 + j] = hcar[tid];
#pragma unroll
        for (int k = 0; k < 3; ++k) c.out[O_LCONV_P + ((size_t)b * 3 + k) * 1024 + j] = bf2f(c.XD[(size_t)(b * SEQ + SEQ - 3 + k) * 1024 + j]);
    }
    __syncthreads();
}
__device__ __forceinline__ void lru_sample_unit(const Ctx& c, int u, unsigned char* sm) {
    const int tid = threadIdx.x, h = u >> 3, tg = u & 7;
    float* wal = (float*)sm;
    float* wxl = wal + 4096;
    float* xcs = wxl + 4096;
    const int tk = tid >> 5, jq = tid & 31, bs = tg * 16 + tk, row = NP + bs, j0 = h * 64 + 2 * jq;
    const f32x2 h0 = *(const f32x2*)(c.state_lru + (size_t)bs * 1024 + j0);
    unsigned* mp = (unsigned*)(c.MIX + (size_t)row * 2048 + 1024 + j0);
    const unsigned gdw = *mp;
    const f32x2 bav = *(const f32x2*)(c.lru_ba + j0), bxv = *(const f32x2*)(c.lru_bx + j0), lam = *(const f32x2*)(c.lru_lambda + j0);
#pragma unroll
    for (int i = 0; i < 2; ++i) { const int idx = tid + 512 * i; ((f32x4*)wal)[idx] = ((const f32x4*)(c.lru_wa + (size_t)h * 4096))[idx]; ((f32x4*)wxl)[idx] = ((const f32x4*)(c.lru_wx + (size_t)h * 4096))[idx]; }
#pragma unroll
    for (int it = 0; it < 2; ++it) {
        const int item = tid + 512 * it, t2 = item >> 6, cc = item & 63, bs2 = tg * 16 + t2, ch = h * 64 + cc;
        const float* buf = c.state_lru_conv + (size_t)bs2 * 3 * 1024;
        const float xn = bf2f(c.XD[(size_t)(NP + bs2) * 1024 + ch]);
        const float b0 = buf[ch], b1 = buf[1024 + ch], b2 = buf[2048 + ch];
        xcs[t2 * 64 + cc] = c.lru_conv_b[ch] + c.lru_conv_w[ch] * b0 + c.lru_conv_w[1024 + ch] * b1 + c.lru_conv_w[2048 + ch] * b2 + c.lru_conv_w[3072 + ch] * xn;
        float* so = c.out + O_LCONV_S + (size_t)bs2 * 3 * 1024;
        so[ch] = b1; so[1024 + ch] = b2; so[2048 + ch] = xn;
    }
    __syncthreads();
    f32x2 sr = bav, si = bxv;
#pragma unroll 16
    for (int ii = 0; ii < 64; ++ii) { const float xv = xcs[tk * 64 + ii]; const f32x2 a2 = *(const f32x2*)(wal + ii * 64 + 2 * jq), x2 = *(const f32x2*)(wxl + ii * 64 + 2 * jq); sr += a2 * xv; si += x2 * xv; }
    float hn[2];
#pragma unroll
    for (int e = 0; e < 2; ++e) {
        const float r = sigmoidf_(sr[e]), ig = sigmoidf_(si[e]);
        const float la = -8.f * r * softplusf_(-lam[e]);
        const float a = __expf(la);
        hn[e] = a * h0[e] + sqrtf(fmaxf(neg_expm1_fast(2.f * la), 0.f)) * (ig * xcs[tk * 64 + 2 * jq + e]);
    }
    *(f32x2*)(c.out + O_LRU_S + (size_t)bs * 1024 + j0) = (f32x2){hn[0], hn[1]};
    *mp = pk2(hn[0] * bflo(gdw), hn[1] * bfhi(gdw));
    __syncthreads();
}
__device__ __forceinline__ void p5_odd_mixers(const Ctx& c, unsigned char* sm) {
    const int G = gridDim.x, bx = blockIdx.x;
    for (int u = bx; u < 256; u += G) lru_unit(c, u, sm);
    for (int u = bx; u < 256; u += G) ccv_unit(c, u, sm);
    for (int u = bx; u < 256; u += G) { if (u < 128) ccv_sample_unit(c, u, sm); else lru_sample_unit(c, u - 128, sm); }
}

__device__ __forceinline__ void p7_final_norm(const Ctx& c) {
    const int lane = threadIdx.x & 63, gw = blockIdx.x * 8 + (threadIdx.x >> 6), NGW = gridDim.x * 8;
    f32x4 fn[4];
#pragma unroll
    for (int j = 0; j < 4; ++j) fn[j] = ((const f32x4*)c.final_norm)[lane + 64 * j];
    for (int m = gw; m < NT; m += NGW) {
        const u32x2* xr = (const u32x2*)(c.X2b + (size_t)m * 1024);
        f32x4 v[4]; float s = 0.f;
#pragma unroll
        for (int j = 0; j < 4; ++j) { const u32x2 xw = xr[lane + 64 * j]; v[j] = (f32x4){bflo(xw.x), bfhi(xw.x), bflo(xw.y), bfhi(xw.y)}; s += (v[j][0] * v[j][0] + v[j][1] * v[j][1]) + (v[j][2] * v[j][2] + v[j][3] * v[j][3]); }
        const float rstd = rsqrtf(wave_sum(s) * (1.f / 1024.f) + EPS);
        f32x4* yo = (f32x4*)(c.out + (size_t)m * 1024);
#pragma unroll
        for (int j = 0; j < 4; ++j) yo[lane + 64 * j] = v[j] * rstd * fn[j];
    }
}

#ifndef MK_COOP
#define MK_COOP 1
#endif
struct Params { const float* in[35]; float* out; unsigned char* ws; int lo, hi; };
constexpr int N_PHASES = 8;

__global__ void __launch_bounds__(512, 2) hybrid_fwd(Params P) {
    extern __shared__ __attribute__((aligned(16))) unsigned char lds[];
    Ctx c;
    c.x_prompt = P.in[0]; c.x_sample = P.in[1]; c.state_ssm = P.in[2]; c.state_ssd_conv = P.in[3]; c.state_ccv = P.in[4]; c.state_lru_conv = P.in[5]; c.state_lru = P.in[6];
    c.norm_even = P.in[7]; c.w_in_even = P.in[8]; c.ssd_conv_w = P.in[9]; c.ssd_conv_b = P.in[10]; c.ssd_dt_bias = P.in[11]; c.ssd_a_log = P.in[12]; c.ssd_d = P.in[13]; c.ssd_norm = P.in[14];
    c.gmlp_ln_g = P.in[15]; c.gmlp_ln_b = P.in[16]; c.gmlp_w_s = P.in[17]; c.gmlp_b_s = P.in[18]; c.w_out_even = P.in[19];
    c.norm_odd = P.in[20]; c.w_in_odd = P.in[21]; c.ccv_w = P.in[22]; c.ccv_b = P.in[23]; c.ccv_ln_g = P.in[24]; c.ccv_ln_b = P.in[25];
    c.lru_conv_w = P.in[26]; c.lru_conv_b = P.in[27]; c.lru_wa = P.in[28]; c.lru_ba = P.in[29]; c.lru_wx = P.in[30]; c.lru_bx = P.in[31]; c.lru_lambda = P.in[32]; c.w_out_odd = P.in[33]; c.final_norm = P.in[34];
    c.out = P.out;
    unsigned char* ws = P.ws;
    c.ss0 = (float*)(ws + WS_SS0); c.ss1 = (float*)(ws + WS_SS1); c.DT = (float*)(ws + WS_DT); c.ssg = (float*)(ws + WS_SSG); c.xcnt = (unsigned*)(ws + WS_XCNT);
    c.W1t = (bf16*)(ws + WS_W1); c.W2t = (bf16*)(ws + WS_W2); c.W3t = (bf16*)(ws + WS_W3); c.W4t = (bf16*)(ws + WS_W4);
    c.XN = (bf16*)(ws + WS_XN); c.MIX = (bf16*)(ws + WS_MIX); c.XBC = (bf16*)(ws + WS_XBC); c.GV = (bf16*)(ws + WS_GV); c.GLU = (bf16*)(ws + WS_XBC); c.XD = (bf16*)(ws + WS_GV); c.BCn = (bf16*)(ws + WS_BCN); c.BTg = (bf16*)(ws + WS_BTG); c.X2b = (bf16*)(ws + WS_BCN);
    PG8_LAS unsigned char* l3 = (PG8_LAS unsigned char*)lds;
    const int lo = P.lo, hi = P.hi;
#ifdef PROBE_A
    unsigned long long ts[16];
#define STAMP(k) ts[k] = __builtin_amdgcn_s_memrealtime()
#else
#define STAMP(k) do { } while (0)
#endif
    STAMP(0);
#define IN(k) (lo <= (k) && (k) < hi)
#if MK_COOP
#define SEAM(k) do { if (IN(k) && IN((k) + 1)) cg::this_grid().sync(); } while (0)
#else
#define SEAM(k) do { } while (0)
#endif
    if (IN(0)) { p0_prologue(c, lds); } SEAM(0); STAMP(1);
    if (IN(1)) {
        pg8::Gemm g{c.XN, c.W1t, MP, N1, 1024}; pg8::StaticOrder S; S.init(MP, N1, (int)gridDim.x, (int)blockIdx.x);
        Epi1 E{c.ss0, c.MIX, c.XBC, c.GV, c.DT};
        pg8::gemm_phase<Epi1, pg8::StaticOrder, NoHook, true, true>(l3, g, S, E, NoHook{});
    } SEAM(1); STAMP(2);
    if (IN(2)) {
        const int G = gridDim.x, bx = blockIdx.x;
        {
            if (threadIdx.x == 0) { const unsigned x = (unsigned)__builtin_amdgcn_s_getreg((3 << 11) | 20) & 7u; const unsigned i = __hip_atomic_fetch_add(c.xcnt + x, 1u, __ATOMIC_RELAXED, __HIP_MEMORY_SCOPE_AGENT); *(unsigned*)(lds + 147300) = x | (i << 8); }
            __syncthreads();
        }
        bc_prepass(c);
        STAMP(9);
        for (int u = bx; u < 256; u += G) gmlp_unit(c, u, lds);
        STAMP(10);
        for (int u = bx; u < 256; u += G) sample_even_unit(c, u, lds);
        STAMP(11);
        for (int i = bx * 512 + threadIdx.x; i < 8 * 3 * 1536; i += G * 512) { const int b = i / (3 * 1536), r = i % (3 * 1536), k = r / 1536, ch = r % 1536;
            c.out[O_SCONV_P + i] = bf2f(c.XBC[(size_t)(b * SEQ + SEQ - 3 + k) * 1536 + ch]); }
    } SEAM(2); STAMP(3);
    {
        if (gridDim.x == 256) {
            const unsigned clm = *(const unsigned*)(lds + 147300);
            const int ssd_xcc = __builtin_amdgcn_readfirstlane((int)(clm & 255u)), ssd_idx = __builtin_amdgcn_readfirstlane((int)(clm >> 8));
            int x = ssd_xcc, i = ssd_idx;
            if (i >= 32) {
                int r = i - 32;
                for (int x2 = 0; x2 < 8; ++x2) { const int c2 = (int)__hip_atomic_load(c.xcnt + x2, __ATOMIC_RELAXED, __HIP_MEMORY_SCOPE_AGENT); if (x2 < ssd_xcc && c2 > 32) r += c2 - 32; }
                for (int x2 = 0; x2 < 8; ++x2) { int c2 = (int)__hip_atomic_load(c.xcnt + x2, __ATOMIC_RELAXED, __HIP_MEMORY_SCOPE_AGENT); c2 = c2 < 32 ? c2 : 32; if (r < 32 - c2) { x = x2; i = c2 + r; break; } r -= 32 - c2; }
            }
            ssd_chunk_unit(c, x * 32 + i, lds);
        } else { const int G = gridDim.x, bx = blockIdx.x; for (int u = bx; u < 256; u += G) ssd_chunk_unit(c, u, lds); }
        cg::this_grid().sync(); STAMP(15);
    }
    if (IN(3)) {
        sample_outproj<true>(c.MIX + (size_t)NP * 2048, c.W2t, c.x_sample, c.XN + (size_t)NP * 1024, nullptr, c.ss1 + (size_t)NP, lds);
        pg8::Gemm g{c.MIX, c.W2t, NP, 1024, 2048}; pg8::StaticOrder S; S.init(NP, 1024, (int)gridDim.x, (int)blockIdx.x);
        Unit u0;
        if (S.next(0, u0)) {
            float* tab = (float*)(lds + 131072);
            if (threadIdx.x < 256) { const float* sp = c.ssg + (size_t)(u0.pm * 256 + threadIdx.x); float s0 = 0.f, s1 = 0.f;
#pragma unroll
                for (int i = 0; i < 16; ++i) { s0 += sp[(size_t)i * NP]; s1 += sp[(size_t)(16 + i) * NP]; }
                const float r0 = rsqrtf(s0 * (1.f / 512.f) + EPS), r1 = rsqrtf(s1 * (1.f / 512.f) + EPS);
                tab[threadIdx.x * 2] = r0 / r1; tab[threadIdx.x * 2 + 1] = r1; }
        }
        __syncthreads();
        EpiOut<true> E{c.x_prompt, c.XN, nullptr, c.ss1};
        HookScale H{(const LAS3 float*)(l3 + 131072)};
        pg8::gemm_phase<EpiOut<true>, pg8::StaticOrder, HookScale, false, true>(l3, g, S, E, H);
    } SEAM(3); STAMP(4);
    if (IN(4)) {
        pg8::Gemm g{c.XN, c.W3t, MP, N3, 1024}; pg8::StaticOrder S; S.init(MP, N3, (int)gridDim.x, (int)blockIdx.x);
        {
            float* tab = (float*)(lds + 131072);
            Unit uu;
            for (int i = 0; i < 8; ++i) { if (!S.next(i, uu)) break; if (threadIdx.x < 256) tab[i * 256 + threadIdx.x] = rstd_from(c.ss1, uu.pm * 256 + (int)threadIdx.x); }
            __syncthreads();
        }
        Epi3 E{(const LAS3 float*)(l3 + 131072), c.MIX, c.GLU, c.XD, 0};
        pg8::gemm_phase<Epi3, pg8::StaticOrder, NoHook, true, true>(l3, g, S, E, NoHook{});
    } SEAM(4); STAMP(5);
    if (IN(5)) {
        const int G = gridDim.x, bx = blockIdx.x;
        for (int u = bx; u < 256; u += G) lru_unit(c, u, lds);
        STAMP(12);
        for (int u = bx; u < 256; u += G) ccv_unit(c, u, lds);
        STAMP(13);
        for (int u = bx; u < 256; u += G) { if (u < 128) ccv_sample_unit(c, u, lds); else lru_sample_unit(c, u - 128, lds); }
        STAMP(14);
        for (int i = bx * 512 + threadIdx.x; i < 8 * 30 * 1024; i += G * 512) { const int b = i / (30 * 1024), r = i % (30 * 1024); c.out[O_CCV_P + i] = bf2f(c.GLU[(size_t)(b * SEQ + SEQ - 30) * 1024 + r]); }
    } SEAM(5); STAMP(6);
    if (IN(6)) {
        sample_outproj<false>(c.MIX + (size_t)NP * 2048, c.W4t, nullptr, c.XN + (size_t)NP * 1024, c.X2b + (size_t)NP * 1024, nullptr, lds);
        pg8::Gemm g{c.MIX, c.W4t, NP, 1024, 2048}; pg8::StaticOrder S; S.init(NP, 1024, (int)gridDim.x, (int)blockIdx.x);
        EpiOut<false> E{nullptr, c.XN, c.X2b, nullptr};
        pg8::gemm_phase<EpiOut<false>, pg8::StaticOrder, NoHook, false, true>(l3, g, S, E, NoHook{});
    } SEAM(6); STAMP(7);
    if (IN(7)) { p7_final_norm(c); }
#ifdef PROBE_A
    STAMP(8);
    if (blockIdx.x == 0) {
        const float tot = (float)(ts[8] - ts[0]);
        const float f1 = (float)(ts[PROBE_A1] - ts[PROBE_A]) / tot, f2 = (float)(ts[PROBE_B1] - ts[PROBE_B]) / tot;
        __syncthreads();
        for (int i = threadIdx.x; i < 8192; i += 512) c.out[O_LRU_P + i] *= (1.03f + 0.1f * f1);
        if (threadIdx.x == 0) c.out[0] += 10.f + 90.f * f2;
    }
#endif
#undef IN
#undef SEAM
}

extern "C" void kernel_launch(void* const* d_in, const int* in_sizes, int n_in, void* d_out, int out_size, void* d_ws, size_t ws_size, hipStream_t stream) {
    static int grid = 0;
    if (grid == 0) {
        if (n_in != 35 || out_size != (int)O_END || ws_size < WS_END) { fprintf(stderr, "kernel_launch: unexpected problem (n_in %d out %d ws %zu)\n", n_in, out_size, ws_size); grid = -1; return; }
        int dev = 0, cus = 0, per_cu = 0;
        (void)hipGetDevice(&dev); (void)hipDeviceGetAttribute(&cus, hipDeviceAttributeMultiprocessorCount, dev);
        if (hipFuncSetAttribute((const void*)hybrid_fwd, hipFuncAttributeMaxDynamicSharedMemorySize, LDS_BYTES) != hipSuccess) { fprintf(stderr, "kernel_launch: hipFuncSetAttribute failed\n"); grid = -1; return; }
        if (hipOccupancyMaxActiveBlocksPerMultiprocessor(&per_cu, (const void*)hybrid_fwd, 512, LDS_BYTES) != hipSuccess || per_cu < 1) { fprintf(stderr, "kernel_launch: occupancy query says %d blocks per CU\n", per_cu); (void)hipGetLastError(); per_cu = 1; }
        grid = cus < 256 ? cus : 256;
        if (grid != 256) fprintf(stderr, "kernel_launch: %d CUs; this kernel is built for 256\n", cus);
    }
    if (grid < 0) return;
    Params p{};
    for (int i = 0; i < 35; ++i) p.in[i] = (const float*)d_in[i];
    p.out = (float*)d_out; p.ws = (unsigned char*)d_ws;
#if MK_COOP
    p.lo = 0; p.hi = N_PHASES;
    void* args[] = {&p};
    hipError_t e = hipLaunchCooperativeKernel((const void*)hybrid_fwd, dim3(grid), dim3(512), args, LDS_BYTES, stream);
    if (e != hipSuccess) fprintf(stderr, "kernel_launch: cooperative launch failed: %s\n", hipGetErrorString(e));
#else
    for (int ph = 0; ph < N_PHASES; ++ph) { p.lo = ph; p.hi = ph + 1; hipLaunchKernelGGL(hybrid_fwd, dim3(grid), dim3(512), LDS_BYTES, stream, p); }
#endif
}
```

```cpp
#include <hip/hip_runtime.h>
#include <hip/hip_cooperative_groups.h>
#include <cstdio>
#include <cstdint>
namespace cg = cooperative_groups;
namespace pg8 {
#define PG8_LAS __attribute__((address_space(3)))
typedef unsigned short bf16_t;
typedef short bf16x8 __attribute__((ext_vector_type(8)));
typedef float f32x4 __attribute__((ext_vector_type(4)));
typedef unsigned u32x4 __attribute__((ext_vector_type(4)));
constexpr int BM = 256, BK = 64, HALF = 128, HTB = HALF * BK * 2  , STAGE_BYTES = 8 * HTB, NXCD = 8, WGM = 8;

__host__ __device__ __forceinline__ int lds_byte(int r, int c) { const int st = (r >> 4) * 2 + (c >> 5), rr = r & 15, cc = c & 31, ob = rr * 64 + cc * 2; return st * 1024 + (ob ^ (((ob >> 9) & 1) << 5)); }
__host__ __device__ __forceinline__ void stage_rc(int b, int& R, int& C) { const int st = b / 1024, sb = b % 1024, swz = sb ^ (((sb >> 9) & 1) << 5); R = (st >> 1) * 16 + swz / 64; C = (st & 1) * 32 + (swz % 64) / 2; }
__host__ __device__ __forceinline__ int perm32(int rho) { const int n = rho >> 4, i = rho & 15; return 8 * (i >> 2) + 4 * n + (i & 3); }

struct Unit { int pm, pn; };
struct Gemm { const bf16_t* A; const bf16_t* Bt; int M, N, K; };

struct StaticOrder {
    int nM, nN, nwg, G, c;
    __host__ __device__ void init(int M, int N, int G_, int c_) { nM = M / BM; nN = N / BM; nwg = nM * nN; G = G_; c = c_; }
    __host__ __device__ bool next(int i, Unit& u) const {
        const long L = (long)i * G + c; if (L >= nwg) return false;
        int wgid = (int)L; { const int q = nwg / NXCD, r = nwg % NXCD, xcd = wgid % NXCD, off = wgid / NXCD; wgid = (xcd < r ? xcd * (q + 1) : r * (q + 1) + (xcd - r) * q) + off; }
        const int nig = WGM * nN, gid = wgid / nig, fm = gid * WGM, gsz = (nM - fm) < WGM ? (nM - fm) : WGM;
        u.pm = fm + ((wgid % nig) % gsz); u.pn = (wgid % nig) / gsz; return true;
    }
    __device__ __forceinline__ void a_ready(const Unit&) const {}
    __device__ __forceinline__ void done(const Unit&) const {}
};

__device__ __forceinline__ unsigned cvt_pk_bf16(float lo, float hi) { unsigned r; asm volatile("v_cvt_pk_bf16_f32 %0, %1, %2" : "=v"(r) : "v"(lo), "v"(hi)); return r; }
template <class Epi, class Sched, class Hook, bool ALIGN_EPI = false, bool SP2 = false>
__device__ __forceinline__ void gemm_phase(PG8_LAS unsigned char* lds, const Gemm g, const Sched& S, const Epi& E, const Hook& H) {
    const int tid = threadIdx.x, wid = __builtin_amdgcn_readfirstlane(tid >> 6), lane = tid & 63, wr = wid >> 2, wc = wid & 3, fr = lane & 15, fq = lane >> 4;
    const int K = g.K, nt = K / BK;
    unsigned voffA[2], voffB[2];
#pragma unroll
    for (int i = 0; i < 2; ++i) { int R, C; stage_rc(tid * 16 + i * 8192, R, C); const int Rb = Epi::PERM ? ((R & ~31) + perm32(R & 31)) : R;
        voffA[i] = (unsigned)(R * K + C) * 2u; voffB[i] = (unsigned)(Rb * K + C) * 2u; }
    const size_t kstep = (size_t)(BK * 2);
    const size_t hstep = (size_t)HALF * K * 2;
    const size_t tstep = 2 * hstep;
    const unsigned ldsw = (unsigned)wid * 1024u;
    const int aoff = lds_byte(wr * 64 + fr, fq * 8), boff = lds_byte(wc * 32 + fr, fq * 8);
#define PG8_SA(b, h) (((b) * 2 + (h)) * HTB)
#define PG8_SB(b, h) ((4 + (b) * 2 + (h)) * HTB)
#define PG8_STAGE(bufoff, gbase, voff) do { _Pragma("unroll") for (int _i = 0; _i < 2; ++_i) \
        __builtin_amdgcn_global_load_lds((const unsigned*)((const char*)(gbase) + (voff)[_i]), (PG8_LAS unsigned*)(lds + (bufoff) + ldsw + _i * 8192), 16, 0, 0); } while (0)
#define PG8_LDA(dst, b, h) do { _Pragma("unroll") for (int m = 0; m < 4; ++m) _Pragma("unroll") for (int k = 0; k < 2; ++k) dst[m][k] = *(const PG8_LAS bf16x8*)(lds + PG8_SA(b, h) + aoff + m * 2048 + k * 1024); } while (0)
#define PG8_LDB(dst, b, h) do { _Pragma("unroll") for (int n = 0; n < 2; ++n) _Pragma("unroll") for (int k = 0; k < 2; ++k) dst[n][k] = *(const PG8_LAS bf16x8*)(lds + PG8_SB(b, h) + boff + n * 2048 + k * 1024); } while (0)
#define PG8_MMA(ai, bj, At, Bt) do { __builtin_amdgcn_s_setprio(1); _Pragma("unroll") for (int m = 0; m < 4; ++m) _Pragma("unroll") for (int n = 0; n < 2; ++n) _Pragma("unroll") for (int k = 0; k < 2; ++k) \
        acc[ai][bj][m][n] = __builtin_amdgcn_mfma_f32_16x16x32_bf16(Bt[n][k], At[m][k], acc[ai][bj][m][n], 0, 0, 0); __builtin_amdgcn_s_setprio(0); } while (0)
#define PG8_WAIT_V(n) asm volatile("s_waitcnt vmcnt(" #n ")" ::: "memory")
#define PG8_WAIT_L(n) asm volatile("s_waitcnt lgkmcnt(" #n ")" ::: "memory")
#define PG8_BAR __builtin_amdgcn_s_barrier()
#define PG8_SCHED __builtin_amdgcn_sched_barrier(0)
    Unit cur, nxt; int ui = 0;
    if (!S.next(0, cur)) return;
    f32x4 acc[2][2][4][2];
#pragma unroll
    for (int a = 0; a < 2; ++a)
#pragma unroll
        for (int b = 0; b < 2; ++b)
#pragma unroll
            for (int m = 0; m < 4; ++m)
#pragma unroll
                for (int n = 0; n < 2; ++n) acc[a][b][m][n] = (f32x4){0.f, 0.f, 0.f, 0.f};
    bf16x8 At[4][2], B0[2][2], B1[2][2];
    const char* cA = (const char*)g.A + (size_t)cur.pm * tstep; const char* cB = (const char*)g.Bt + (size_t)cur.pn * tstep;
    S.a_ready(cur);
    if constexpr (SP2) {
        PG8_STAGE(PG8_SB(0, 0), cB, voffB); PG8_STAGE(PG8_SB(0, 1), cB + hstep, voffB); PG8_STAGE(PG8_SA(0, 0), cA, voffA); PG8_STAGE(PG8_SA(0, 1), cA + hstep, voffA);
        if (wr == 1) PG8_BAR;
        PG8_WAIT_V(2); PG8_BAR;
        PG8_STAGE(PG8_SB(1, 0), cB + kstep, voffB); PG8_STAGE(PG8_SA(1, 0), cA + kstep, voffA); PG8_STAGE(PG8_SB(1, 1), cB + hstep + kstep, voffB);
        PG8_WAIT_V(6); PG8_BAR;
    } else {
        PG8_STAGE(PG8_SB(0, 0), cB, voffB); PG8_STAGE(PG8_SA(0, 0), cA, voffA); PG8_STAGE(PG8_SB(0, 1), cB + hstep, voffB); PG8_STAGE(PG8_SA(0, 1), cA + hstep, voffA);
        if (wr == 1) PG8_BAR;
        PG8_WAIT_V(4); PG8_BAR;
        PG8_STAGE(PG8_SB(1, 0), cB + kstep, voffB); PG8_STAGE(PG8_SA(1, 0), cA + kstep, voffA); PG8_STAGE(PG8_SB(1, 1), cB + hstep + kstep, voffB);
        PG8_WAIT_V(6); PG8_BAR;
    }
    for (;;) {
        const bool has_next = S.next(ui + 1, nxt);
        const char* nA = has_next ? (const char*)g.A + (size_t)nxt.pm * tstep : cA; const char* nB = has_next ? (const char*)g.Bt + (size_t)nxt.pn * tstep : cB;
        for (int t = 0; t < nt; t += 2) {
            const bool last = (t == nt - 2);
            const char* a1 = cA + (size_t)(t + 1) * kstep;
            const char* a2 = last ? nA : cA + (size_t)(t + 2) * kstep; const char* b2 = last ? nB : cB + (size_t)(t + 2) * kstep;
            const char* a3 = a2 + kstep; const char* b3 = b2 + kstep;
            if (last && has_next) S.a_ready(nxt);
            H(acc, t, wr, fr);
            if constexpr (SP2) {
            PG8_LDB(B0, 0, 0); PG8_LDB(B1, 0, 1); PG8_SCHED; PG8_LDA(At, 0, 0); PG8_STAGE(PG8_SA(1, 1), a1 + hstep, voffA);
            PG8_WAIT_V(8); PG8_WAIT_L(0); PG8_BAR; PG8_MMA(0, 0, At, B0); PG8_MMA(0, 1, At, B1); PG8_BAR; PG8_SCHED;
            PG8_LDA(At, 0, 1); PG8_STAGE(PG8_SB(0, 0), b2, voffB); PG8_STAGE(PG8_SB(0, 1), b2 + hstep, voffB); PG8_STAGE(PG8_SA(0, 0), a2, voffA);
            PG8_WAIT_V(8); PG8_WAIT_L(0); PG8_BAR; PG8_MMA(1, 0, At, B0); PG8_MMA(1, 1, At, B1); PG8_BAR; PG8_SCHED;
            PG8_LDB(B0, 1, 0); PG8_LDB(B1, 1, 1); PG8_SCHED; PG8_LDA(At, 1, 0); PG8_STAGE(PG8_SA(0, 1), a2 + hstep, voffA);
            PG8_WAIT_V(8); PG8_WAIT_L(0); PG8_BAR; PG8_MMA(0, 0, At, B0); PG8_MMA(0, 1, At, B1); PG8_BAR; PG8_SCHED;
            PG8_LDA(At, 1, 1); PG8_STAGE(PG8_SB(1, 0), b3, voffB); PG8_STAGE(PG8_SB(1, 1), b3 + hstep, voffB); PG8_STAGE(PG8_SA(1, 0), a3, voffA);
            PG8_WAIT_V(8); PG8_WAIT_L(0); PG8_BAR; PG8_MMA(1, 0, At, B0); PG8_MMA(1, 1, At, B1); PG8_BAR; PG8_SCHED;
            } else {
            PG8_LDB(B0, 0, 0); PG8_SCHED; PG8_LDA(At, 0, 0); PG8_STAGE(PG8_SA(1, 1), a1 + hstep, voffA);
            PG8_WAIT_L(8); PG8_BAR; PG8_WAIT_L(0); PG8_MMA(0, 0, At, B0); PG8_BAR; PG8_SCHED;
            PG8_LDB(B1, 0, 1); PG8_STAGE(PG8_SB(0, 0), b2, voffB);
            PG8_BAR; PG8_WAIT_L(0); PG8_MMA(0, 1, At, B1); PG8_BAR;
            PG8_LDA(At, 0, 1); PG8_STAGE(PG8_SA(0, 0), a2, voffA);
            PG8_BAR; PG8_WAIT_L(0); PG8_MMA(1, 0, At, B0); PG8_BAR; PG8_SCHED;
            PG8_STAGE(PG8_SB(0, 1), b2 + hstep, voffB);
            PG8_WAIT_V(6); PG8_BAR; PG8_MMA(1, 1, At, B1); PG8_BAR;
            PG8_LDB(B0, 1, 0); PG8_SCHED; PG8_LDA(At, 1, 0); PG8_STAGE(PG8_SA(0, 1), a2 + hstep, voffA);
            PG8_WAIT_L(8); PG8_BAR; PG8_WAIT_L(0); PG8_MMA(0, 0, At, B0); PG8_BAR; PG8_SCHED;
            PG8_LDB(B1, 1, 1); PG8_STAGE(PG8_SB(1, 0), b3, voffB);
            PG8_BAR; PG8_WAIT_L(0); PG8_MMA(0, 1, At, B1); PG8_BAR;
            PG8_LDA(At, 1, 1); PG8_STAGE(PG8_SA(1, 0), a3, voffA);
            PG8_BAR; PG8_WAIT_L(0); PG8_MMA(1, 0, At, B0); PG8_BAR; PG8_SCHED;
            PG8_STAGE(PG8_SB(1, 1), b3 + hstep, voffB);
            PG8_WAIT_V(6); PG8_BAR; PG8_MMA(1, 1, At, B1); PG8_BAR;
            }
        }
        if constexpr (ALIGN_EPI) { if (wr == 0) PG8_BAR; }
        if constexpr (!Epi::AFTER_DRAIN) { E(acc, cur, wr, wc, fr, fq); S.done(cur); }
        if (!has_next) break;
#pragma unroll
        for (int a = 0; a < 2; ++a)
#pragma unroll
            for (int b = 0; b < 2; ++b)
#pragma unroll
                for (int m = 0; m < 4; ++m)
#pragma unroll
                    for (int n = 0; n < 2; ++n) acc[a][b][m][n] = (f32x4){0.f, 0.f, 0.f, 0.f};
        cur = nxt; cA = nA; cB = nB; ++ui;
        if constexpr (ALIGN_EPI) { if (wr == 1) PG8_BAR; }
    }
    PG8_WAIT_V(0);
    if constexpr (!ALIGN_EPI) { if (wr == 0) PG8_BAR; }
    PG8_BAR;
    if constexpr (Epi::AFTER_DRAIN) { E.fused(acc, cur, wr, wc, fr, fq, lds, wid, lane); S.done(cur); }
#undef PG8_SA
#undef PG8_SB
#undef PG8_STAGE
#undef PG8_LDA
#undef PG8_LDB
#undef PG8_MMA
#undef PG8_WAIT_V
#undef PG8_WAIT_L
#undef PG8_BAR
#undef PG8_SCHED
}
}

using pg8::f32x4; using pg8::bf16x8; using pg8::Unit;
typedef unsigned short bf16;
typedef unsigned u32x2 __attribute__((ext_vector_type(2)));
typedef unsigned u32x4 __attribute__((ext_vector_type(4)));
typedef float f32x2 __attribute__((ext_vector_type(2)));
#define LAS3 __attribute__((address_space(3)))

constexpr int NP = 16384, NS = 128, NT = NP + NS, MP = 16640, SEQ = 2048;
constexpr int N1 = 5888, N3 = 5120;
constexpr float EPS = 1e-6f;
constexpr int LDS_BYTES = 147456;

constexpr size_t O_SSM_P = (size_t)NT * 1024;
constexpr size_t O_SSM_S = O_SSM_P + (size_t)8 * 16 * 64 * 128;
constexpr size_t O_SCONV_P = O_SSM_S + (size_t)128 * 16 * 64 * 128;
constexpr size_t O_SCONV_S = O_SCONV_P + 8 * 3 * 1536;
constexpr size_t O_GV_S = O_SCONV_S + 128 * 3 * 1536;
constexpr size_t O_CCV_P = O_GV_S + 128 * 1024;
constexpr size_t O_CCV_S = O_CCV_P + 8 * 30 * 1024;
constexpr size_t O_LCONV_P = O_CCV_S + 128 * 30 * 1024;
constexpr size_t O_LCONV_S = O_LCONV_P + 8 * 3 * 1024;
constexpr size_t O_LRU_P = O_LCONV_S + 128 * 3 * 1024;
constexpr size_t O_LRU_S = O_LRU_P + 8 * 1024;
constexpr size_t O_END = O_LRU_S + 128 * 1024;
static_assert(O_END == 40226816, "output size");

constexpr size_t MiB = 1u << 20;
constexpr size_t WS_SS0 = 0, WS_SS1 = 288 * 1024, WS_DT = 576 * 1024, WS_SSG = 1792 * 1024, WS_XCNT = 3840 * 1024;
constexpr size_t WS_W4 = 4 * MiB, WS_W3 = 8 * MiB, WS_W2 = 18 * MiB, WS_XN = 22 * MiB, WS_W1 = 54 * MiB + 512 * 1024, WS_MIX = 66 * MiB, WS_XBC = 131 * MiB, WS_GV = 180 * MiB, WS_BCN = 213 * MiB, WS_BTG = 229 * MiB, WS_END = 246 * MiB;
static_assert(WS_XN + (size_t)MP * 1024 * 2 <= WS_W1 && WS_W1 + (size_t)N1 * 1024 * 2 <= WS_MIX && WS_MIX + (size_t)MP * 2048 * 2 <= WS_XBC && WS_XBC + (size_t)MP * 1536 * 2 <= WS_GV && WS_GV + (size_t)MP * 1024 * 2 <= WS_BCN && WS_BCN + (size_t)NP * 512 * 2 <= WS_BTG && WS_BTG + (size_t)NP * 256 * 2 <= WS_END && WS_BCN + (size_t)NT * 1024 * 2 <= WS_END, "ws map");
static_assert(WS_SS0 + (size_t)MP * 16 <= WS_SS1 && WS_SS1 + (size_t)MP * 16 <= WS_DT && WS_DT + (size_t)MP * 64 <= WS_SSG && WS_SSG + (size_t)NP * 128 <= WS_W4, "ws map small");

struct Ctx {
    const float *x_prompt, *x_sample, *state_ssm, *state_ssd_conv, *state_ccv, *state_lru_conv, *state_lru;
    const float *norm_even, *w_in_even, *ssd_conv_w, *ssd_conv_b, *ssd_dt_bias, *ssd_a_log, *ssd_d, *ssd_norm, *gmlp_ln_g, *gmlp_ln_b, *gmlp_w_s, *gmlp_b_s, *w_out_even;
    const float *norm_odd, *w_in_odd, *ccv_w, *ccv_b, *ccv_ln_g, *ccv_ln_b, *lru_conv_w, *lru_conv_b, *lru_wa, *lru_ba, *lru_wx, *lru_bx, *lru_lambda, *w_out_odd, *final_norm;
    float* out;
    float *ss0, *ss1, *DT, *ssg; unsigned* xcnt;
    bf16 *W1t, *W2t, *W3t, *W4t, *XN, *MIX, *XBC, *GV, *GLU, *XD, *BCn, *BTg, *X2b;
};

__device__ __forceinline__ float bf2f(unsigned b) { return __uint_as_float(b << 16); }
__device__ __forceinline__ float bflo(unsigned w) { return __uint_as_float(w << 16); }
__device__ __forceinline__ float bfhi(unsigned w) { return __uint_as_float(w & 0xffff0000u); }
__device__ __forceinline__ unsigned pk2(float lo, float hi) { return pg8::cvt_pk_bf16(lo, hi); }
__device__ __forceinline__ float sigmoidf_(float x) { return __builtin_amdgcn_rcpf(1.f + __expf(-x)); }
__device__ __forceinline__ float siluf_(float x) { return x * sigmoidf_(x); }
__device__ __forceinline__ float geluf_(float x) { const float y = 1.5957691216057308f * (x + 0.044715f * x * x * x); return x * sigmoidf_(y); }
__device__ __forceinline__ float softplusf_(float x) { return fmaxf(x, 0.f) + log1pf(__expf(-fabsf(x))); }
__device__ __forceinline__ float wave_sum(float v) {
#pragma unroll
    for (int o = 1; o < 64; o <<= 1) v += __shfl_xor(v, o);
    return v;
}
__device__ __forceinline__ float block_sum(float v, float* red) {
    v = wave_sum(v);
    __syncthreads();
    if ((threadIdx.x & 63) == 0) red[threadIdx.x >> 6] = v;
    __syncthreads();
    float s = 0.f;
#pragma unroll
    for (int i = 0; i < 8; ++i) s += red[i];
    return s;
}
template <int CTRL> __device__ __forceinline__ float dpp_mov(float v) { return __int_as_float(__builtin_amdgcn_update_dpp(0, __float_as_int(v), CTRL, 0xf, 0xf, true)); }
__device__ __forceinline__ float row16_sum(float y) {
    y += dpp_mov<0x128>(y); y += dpp_mov<0x124>(y); y += dpp_mov<0x122>(y); y += dpp_mov<0x121>(y); return y;
}
__device__ __forceinline__ float rstd_from(const float* ss, int row) { return rsqrtf(((ss[row] + ss[MP + row]) + (ss[2 * MP + row] + ss[3 * MP + row])) * (1.f / 1024.f) + EPS); }
__device__ __forceinline__ u32x4 pack8(const f32x4 a, const f32x4 b) { u32x4 w; w.x = pk2(a[0], a[1]); w.y = pk2(a[2], a[3]); w.z = pk2(b[0], b[1]); w.w = pk2(b[2], b[3]); return w; }
__device__ __forceinline__ void unpack8(const u32x4 w, float (&f)[8]) { f[0] = bflo(w.x); f[1] = bfhi(w.x); f[2] = bflo(w.y); f[3] = bfhi(w.y); f[4] = bflo(w.z); f[5] = bfhi(w.z); f[6] = bflo(w.w); f[7] = bfhi(w.w); }

struct NoHook { __device__ __forceinline__ void operator()(f32x4 (&)[2][2][4][2], int, int, int) const {} };
struct HookScale {
    const LAS3 float* tab;
    __device__ __forceinline__ void operator()(f32x4 (&acc)[2][2][4][2], int t, int wr, int fr) const {
        if (t == 8 || t == 16) {
            const int j = (t == 16) ? 1 : 0;
#pragma unroll
            for (int ai = 0; ai < 2; ++ai)
#pragma unroll
                for (int m = 0; m < 4; ++m) { const float f = tab[(ai * 128 + wr * 64 + m * 16 + fr) * 2 + j];
#pragma unroll
                    for (int bj = 0; bj < 2; ++bj)
#pragma unroll
                        for (int n = 0; n < 2; ++n) acc[ai][bj][m][n] *= f; }
        }
    }
};

struct Epi1 {
    static constexpr bool PERM = true, AFTER_DRAIN = false;
    const float* ss; bf16* MIX; bf16* XBC; bf16* GV; float* DT;
    __device__ __forceinline__ void operator()(const f32x4 (&acc)[2][2][4][2], const Unit& u, int wr, int wc, int fr, int fq) const {
        const int row0 = u.pm * 256 + wr * 64 + fr, pn = u.pn, cl = wc * 32 + 8 * fq;
        float rs[2][4];
#pragma unroll
        for (int ai = 0; ai < 2; ++ai)
#pragma unroll
            for (int m = 0; m < 4; ++m) rs[ai][m] = 1.f;
        if (pn < 4) {
#pragma unroll
            for (int ai = 0; ai < 2; ++ai)
#pragma unroll
                for (int m = 0; m < 4; ++m) { bf16* rp = MIX + (size_t)(row0 + ai * 128 + m * 16) * 2048 + pn * 256 + cl; const float r = rs[ai][m];
#pragma unroll
                    for (int bj = 0; bj < 2; ++bj) { f32x4 v0 = acc[ai][bj][m][0] * r, v1 = acc[ai][bj][m][1] * r;
#pragma unroll
                        for (int j = 0; j < 4; ++j) { v0[j] = siluf_(v0[j]); v1[j] = siluf_(v1[j]); }
                        *(u32x4*)(rp + bj * 128) = pack8(v0, v1); } }
        } else if (pn < 10) {
#pragma unroll
            for (int ai = 0; ai < 2; ++ai)
#pragma unroll
                for (int m = 0; m < 4; ++m) { bf16* rp = XBC + (size_t)(row0 + ai * 128 + m * 16) * 1536 + (pn - 4) * 256 + cl; const float r = rs[ai][m];
#pragma unroll
                    for (int bj = 0; bj < 2; ++bj) *(u32x4*)(rp + bj * 128) = pack8(acc[ai][bj][m][0] * r, acc[ai][bj][m][1] * r); }
        } else if (pn < 18) {
#pragma unroll
            for (int ai = 0; ai < 2; ++ai)
#pragma unroll
                for (int m = 0; m < 4; ++m) { bf16* rp = MIX + (size_t)(row0 + ai * 128 + m * 16) * 2048 + 1024 + (pn - 10) * 128 + cl; const float r = rs[ai][m];
                    f32x4 o[2];
#pragma unroll
                    for (int n = 0; n < 2; ++n) { const f32x4 uu = acc[ai][0][m][n] * r, gg = acc[ai][1][m][n] * r;
#pragma unroll
                        for (int j = 0; j < 4; ++j) o[n][j] = geluf_(uu[j]) * siluf_(gg[j]); }
                    *(u32x4*)rp = pack8(o[0], o[1]); }
        } else if (pn < 22) {
#pragma unroll
            for (int ai = 0; ai < 2; ++ai)
#pragma unroll
                for (int m = 0; m < 4; ++m) { bf16* rp = GV + (size_t)(row0 + ai * 128 + m * 16) * 1024 + (pn - 18) * 256 + cl; const float r = rs[ai][m];
#pragma unroll
                    for (int bj = 0; bj < 2; ++bj) { f32x4 v0 = acc[ai][bj][m][0] * r, v1 = acc[ai][bj][m][1] * r;
#pragma unroll
                        for (int j = 0; j < 4; ++j) { v0[j] = geluf_(v0[j]); v1[j] = geluf_(v1[j]); }
                        *(u32x4*)(rp + bj * 128) = pack8(v0, v1); } }
        } else {
            if (wc == 0 && fq < 2) {
#pragma unroll
                for (int ai = 0; ai < 2; ++ai)
#pragma unroll
                    for (int m = 0; m < 4; ++m) { float* rp = DT + (size_t)(row0 + ai * 128 + m * 16) * 16 + 8 * fq; const float r = rs[ai][m];
#pragma unroll
                        for (int n = 0; n < 2; ++n) *(f32x4*)(rp + 4 * n) = acc[ai][0][m][n] * r; }
            }
        }
    }
};
struct Epi3 {
    static constexpr bool PERM = true, AFTER_DRAIN = false;
    const LAS3 float* tab; bf16* MIX; bf16* GLU; bf16* XD; mutable int ui;
    __device__ __forceinline__ void operator()(const f32x4 (&acc)[2][2][4][2], const Unit& u, int wr, int wc, int fr, int fq) const {
        const int row0 = u.pm * 256 + wr * 64 + fr, pn = u.pn, cl = wc * 32 + 8 * fq;
        float rs[2][4];
#pragma unroll
        for (int ai = 0; ai < 2; ++ai)
#pragma unroll
            for (int m = 0; m < 4; ++m) rs[ai][m] = tab[ui * 256 + ai * 128 + wr * 64 + m * 16 + fr];
        ++ui;
        if (pn < 8) {
#pragma unroll
            for (int ai = 0; ai < 2; ++ai)
#pragma unroll
                for (int m = 0; m < 4; ++m) { bf16* rp = GLU + (size_t)(row0 + ai * 128 + m * 16) * 1024 + pn * 128 + cl; const float r = rs[ai][m];
                    f32x4 o[2];
#pragma unroll
                    for (int n = 0; n < 2; ++n) { const f32x4 aa = acc[ai][0][m][n] * r, bb = acc[ai][1][m][n] * r;
#pragma unroll
                        for (int j = 0; j < 4; ++j) o[n][j] = aa[j] * sigmoidf_(bb[j]); }
                    *(u32x4*)rp = pack8(o[0], o[1]); }
        } else if (pn >= 12 && pn < 16) {
#pragma unroll
            for (int ai = 0; ai < 2; ++ai)
#pragma unroll
                for (int m = 0; m < 4; ++m) { bf16* rp = XD + (size_t)(row0 + ai * 128 + m * 16) * 1024 + (pn - 12) * 256 + cl; const float r = rs[ai][m];
#pragma unroll
                    for (int bj = 0; bj < 2; ++bj) *(u32x4*)(rp + bj * 128) = pack8(acc[ai][bj][m][0] * r, acc[ai][bj][m][1] * r); }
        } else {
            const int cb = pn < 12 ? (pn - 8) * 256 : 1024 + (pn - 16) * 256;
#pragma unroll
            for (int ai = 0; ai < 2; ++ai)
#pragma unroll
                for (int m = 0; m < 4; ++m) { bf16* rp = MIX + (size_t)(row0 + ai * 128 + m * 16) * 2048 + cb + cl; const float r = rs[ai][m];
#pragma unroll
                    for (int bj = 0; bj < 2; ++bj) { f32x4 v0 = acc[ai][bj][m][0] * r, v1 = acc[ai][bj][m][1] * r;
#pragma unroll
                        for (int j = 0; j < 4; ++j) { v0[j] = siluf_(v0[j]); v1[j] = siluf_(v1[j]); }
                        *(u32x4*)(rp + bj * 128) = pack8(v0, v1); } }
        }
    }
};
template <bool L0> struct EpiOut {
    static constexpr bool PERM = false, AFTER_DRAIN = true;
    const float* xold; bf16* XN; bf16* X2; float* ss;
    __device__ __forceinline__ void operator()(const f32x4 (&)[2][2][4][2], const Unit&, int, int, int, int) const {}
    __device__ __forceinline__ void fused(f32x4 (&acc)[2][2][4][2], const Unit& u, int wr, int wc, int fr, int fq, PG8_LAS unsigned char* lds, int wid, int lane) const {
        const int col0 = u.pn * 256 + wc * 32 + 4 * fq;
        PG8_LAS float* red = (PG8_LAS float*)lds;
        f32x4 xo[3][4]; u32x2 xb[3][4];
#define EPO_OFF(G) ((size_t)(u.pm * 256 + ((G) >> 2) * 128 + wr * 64 + ((G) & 3) * 16 + fr) * 1024 + col0)
#define EPO_LOAD(G) do { const size_t off_ = EPO_OFF(G); _Pragma("unroll") for (int bj = 0; bj < 2; ++bj) _Pragma("unroll") for (int n = 0; n < 2; ++n) { \
            if (L0) xo[(G) % 3][bj * 2 + n] = __builtin_nontemporal_load((const f32x4*)(xold + off_ + bj * 128 + n * 16)); else xb[(G) % 3][bj * 2 + n] = *(const u32x2*)(XN + off_ + bj * 128 + n * 16); } } while (0)
        EPO_LOAD(0); EPO_LOAD(1);
#pragma unroll
        for (int gq = 0; gq < 8; ++gq) {
            const int ai = gq >> 2, m = gq & 3;
            if (gq + 2 < 8) EPO_LOAD(gq + 2);
            const int rl = ai * 128 + wr * 64 + m * 16 + fr; const size_t off = EPO_OFF(gq); float q = 0.f;
#pragma unroll
            for (int bj = 0; bj < 2; ++bj)
#pragma unroll
                for (int n = 0; n < 2; ++n) { const size_t o2 = off + bj * 128 + n * 16;
                    if (L0) { const f32x4 v = xo[gq % 3][bj * 2 + n] + acc[ai][bj][m][n];
                        u32x2 w; w.x = pk2(v[0], v[1]); w.y = pk2(v[2], v[3]); *(u32x2*)(XN + o2) = w;
                        q += (v[0] * v[0] + v[1] * v[1]) + (v[2] * v[2] + v[3] * v[3]); }
                    else { const u32x2 xw = xb[gq % 3][bj * 2 + n]; const f32x4 v = (f32x4){bflo(xw.x), bfhi(xw.x), bflo(xw.y), bfhi(xw.y)} + acc[ai][bj][m][n]; u32x2 w; w.x = pk2(v[0], v[1]); w.y = pk2(v[2], v[3]); *(u32x2*)(X2 + o2) = w; } }
            if (L0) { q += __shfl_xor(q, 16); q += __shfl_xor(q, 32); if (fq == 0) red[rl * 4 + wc] = q; }
        }
#undef EPO_LOAD
#undef EPO_OFF
        if (L0) {
            __syncthreads();
            const int t = wid * 64 + lane;
            if (t < 256) ss[(size_t)u.pn * MP + u.pm * 256 + t] = (red[t * 4 + 0] + red[t * 4 + 1]) + (red[t * 4 + 2] + red[t * 4 + 3]);
        }
    }
};

template <int MODE> __device__ __forceinline__ int src_col(int n) {
    const int tile = n >> 8, cl = n & 255;
    if (MODE == 1) {
        if (tile < 10) return n;
        if (tile < 18) { const int q = tile - 10; return cl < 128 ? 2576 + 128 * q + cl : 4624 + 128 * q + (cl - 128); }
        if (tile < 22) return 3600 + (n - 18 * 256);
        return cl < 16 ? 2560 + cl : -1;
    } else if (MODE == 3) {
        if (tile < 8) return cl < 128 ? 128 * tile + cl : 1024 + 128 * tile + (cl - 128);
        return n;
    }
    return n;
}
template <int MODE> __device__ __forceinline__ void transpose_item(const float* W, int K, int Nsrc, bf16* WT, const float* kscale, float* scr, int item, int nblk, int lane) {
    const int kb = item / nblk, nb = item % nblk, k0 = 64 * kb, n0 = 32 * nb;
    const int sc = src_col<MODE>(n0 + (lane & 31));
    float tv[32];
#pragma unroll
    for (int i = 0; i < 32; ++i) { const int kk = 2 * i + (lane >> 5); tv[i] = sc >= 0 ? __builtin_nontemporal_load(W + (size_t)(k0 + kk) * Nsrc + sc) : 0.f; }
    if (kscale != nullptr && k0 < 1024) {
#pragma unroll
        for (int i = 0; i < 32; ++i) tv[i] *= kscale[k0 + 2 * i + (lane >> 5)];
    }
#pragma unroll
    for (int i = 0; i < 32; ++i) scr[(2 * i + (lane >> 5)) * 33 + (lane & 31)] = tv[i];
    asm volatile("s_waitcnt lgkmcnt(0)" ::: "memory");
    const int c = lane & 7;
#pragma unroll
    for (int j = 0; j < 4; ++j) { const int n = (lane >> 3) + 8 * j; const float* s = scr + (8 * c) * 33 + n;
        u32x4 o; o.x = pk2(s[0 * 33], s[1 * 33]); o.y = pk2(s[2 * 33], s[3 * 33]); o.z = pk2(s[4 * 33], s[5 * 33]); o.w = pk2(s[6 * 33], s[7 * 33]);
        *(u32x4*)(WT + (size_t)(n0 + n) * K + k0 + 8 * c) = o; }
    asm volatile("s_waitcnt lgkmcnt(0)" ::: "memory");
}
__device__ __forceinline__ void p0_prologue(const Ctx& c, unsigned char* sm) {
    const int tid = threadIdx.x, lane = tid & 63, wave = tid >> 6;
    const int gw = blockIdx.x * 8 + wave, NGW = gridDim.x * 8;
    float* scr = (float*)(sm + wave * 16384);
    if (blockIdx.x == 0 && tid < 8) c.xcnt[tid] = 0u;
    constexpr int I1 = 16 * (N1 / 32), I2 = 32 * 32, I3 = 16 * (N3 / 32), I4 = 32 * 32;
    for (int it = gw; it < I1 + I2 + I3 + I4; it += NGW) {
        int r = it;
        if (r < I1) { transpose_item<1>(c.w_in_even, 1024, 5648, c.W1t, nullptr, scr, r, N1 / 32, lane); continue; } r -= I1;
        if (r < I2) { transpose_item<0>(c.w_out_even, 2048, 1024, c.W2t, c.ssd_norm, scr, r, 32, lane); continue; } r -= I2;
        if (r < I3) { transpose_item<3>(c.w_in_odd, 1024, 5120, c.W3t, c.norm_odd, scr, r, N3 / 32, lane); continue; } r -= I3;
        transpose_item<0>(c.w_out_odd, 2048, 1024, c.W4t, nullptr, scr, r, 32, lane);
    }
    for (int m = gw; m < MP; m += NGW) {
        unsigned long long* o8 = (unsigned long long*)(c.XN + (size_t)m * 1024) + lane;
        if (m < NT) {
            const float* xr = m < NP ? c.x_prompt + (size_t)m * 1024 : c.x_sample + (size_t)(m - NP) * 1024;
            f32x4 v[4]; float s = 0.f;
#pragma unroll
            for (int j = 0; j < 4; ++j) { v[j] = __builtin_nontemporal_load((const f32x4*)xr + lane + 64 * j); s += (v[j][0] * v[j][0] + v[j][1] * v[j][1]) + (v[j][2] * v[j][2] + v[j][3] * v[j][3]); }
            const float rstd = rsqrtf(wave_sum(s) * (1.f / 1024.f) + EPS);
#pragma unroll
            for (int j = 0; j < 4; ++j) { const f32x4 g = ((const f32x4*)c.norm_even)[lane + 64 * j] * rstd; o8[64 * j] = (unsigned long long)pk2(v[j][0] * g[0], v[j][1] * g[1]) | ((unsigned long long)pk2(v[j][2] * g[2], v[j][3] * g[3]) << 32); }
        } else {
#pragma unroll
            for (int j = 0; j < 4; ++j) o8[64 * j] = 0ull;
        }
        if (m >= NP && lane < 4) c.ss1[(size_t)lane * MP + m] = 0.f;
    }
}

__device__ __forceinline__ void bc_prepass(const Ctx& c) {
    const int G = gridDim.x;
    for (int item = blockIdx.x * 512 + threadIdx.x; item < 2048 * 64; item += G * 512) {
        const int oc = item & 63, trun = item >> 6;
        const int tg = trun * 8, b = tg >> 11, t0 = tg & 2047;
        const int ch = 1024 + oc * 8;
        u32x4 raw[11];
#pragma unroll
        for (int j = 0; j < 11; ++j) { const int t = t0 - 3 + j; raw[j] = (t >= 0) ? *(const u32x4*)(c.XBC + (size_t)(b * SEQ + t) * 1536 + ch) : (u32x4){0u, 0u, 0u, 0u}; }
#pragma unroll
        for (int hf = 0; hf < 2; ++hf) {
            f32x4 wk[5];
#pragma unroll
            for (int k = 0; k < 4; ++k) wk[k] = *(const f32x4*)(c.ssd_conv_w + k * 1536 + ch + 4 * hf);
            wk[4] = *(const f32x4*)(c.ssd_conv_b + ch + 4 * hf);
            float v[8][4];
#pragma unroll
            for (int i = 0; i < 8; ++i)
#pragma unroll
                for (int e = 0; e < 4; ++e) { const int ee = 4 * hf + e; float s = wk[4][e];
#pragma unroll
                    for (int k = 0; k < 4; ++k) { const unsigned wd = raw[i + k][ee >> 1]; s += wk[k][e] * ((ee & 1) ? bfhi(wd) : bflo(wd)); }
                    v[i][e] = siluf_(s); }
#pragma unroll
            for (int i = 0; i < 8; ++i) { u32x2 o; o.x = pk2(v[i][0], v[i][1]); o.y = pk2(v[i][2], v[i][3]); *(u32x2*)(c.BCn + (size_t)(tg + i) * 512 + oc * 8 + 4 * hf) = o; }
            if (oc < 32) {
                const int g = oc >> 4, n0 = (oc & 15) * 8 + 4 * hf, ck = t0 >> 7, l0 = t0 & 127;
#pragma unroll
                for (int e = 0; e < 4; ++e) *(u32x4*)(c.BTg + ((size_t)((b * 16 + ck) * 2 + g) * 128 + n0 + e) * 128 + l0) = pack8((f32x4){v[0][e], v[1][e], v[2][e], v[3][e]}, (f32x4){v[4][e], v[5][e], v[6][e], v[7][e]});
            }
        }
    }
}

__device__ __forceinline__ void ssd_chunk_unit(const Ctx& c, int u, unsigned char* sm) {
    const int tid = threadIdx.x, lane = tid & 63, w = tid >> 6, fr = lane & 15, fq = lane >> 4;
    const int pair = u >> 4, sub = u & 15;
    const int b = pair >> 1, g = pair & 1, h = g * 8 + (sub >> 1), ph = sub & 1;
    constexpr int RS = 272;
    unsigned char* Bn = sm;
    unsigned char* Cn = sm + 34816;
    unsigned char* BT = sm + 69632;
    unsigned char* XT = sm + 104448;
    unsigned char* XdT = sm + 113152;
    unsigned char* Sb = sm + 121856;
    unsigned char* Xn = sm + 130560;
    float* csA = (float*)(sm + 138752);
    float* dtA = (float*)(sm + 139776);
    float* wx = (float*)(sm + 140800);
    const int ox = tid & 3, lx = tid >> 2;
    const int chx = h * 64 + ph * 32 + ox * 8;
    if (tid < 160) { const int k = tid >> 5, cc = tid & 31; wx[tid] = k < 4 ? c.ssd_conv_w[k * 1536 + h * 64 + ph * 32 + cc] : c.ssd_conv_b[h * 64 + ph * 32 + cc]; }
    const float a_h = -__expf(c.ssd_a_log[h]), dtb = c.ssd_dt_bias[h], Dh = c.ssd_d[h];
    f32x4 accS[2];
    accS[0] = (f32x4){0.f, 0.f, 0.f, 0.f}; accS[1] = accS[0];
    u32x4 rB[4], rC[4], rT[4], rx[4]; u32x2 zz[2]; float dr0 = 0.f, dr1 = 0.f;
    const int lrow = 16 * w + fr;
    const int prow = tid >> 4, pc16 = tid & 15;
#define SSD_LOAD_B(CK) do { const int t0_ = (CK) * 128; \
        _Pragma("unroll") for (int i = 0; i < 4; ++i) rB[i] = *(const u32x4*)(c.BCn + (size_t)(b * SEQ + t0_ + prow + 32 * i) * 512 + g * 128 + pc16 * 8); } while (0)
#define SSD_LOAD_C(CK) do { const int t0_ = (CK) * 128; \
        _Pragma("unroll") for (int i = 0; i < 4; ++i) rC[i] = *(const u32x4*)(c.BCn + (size_t)(b * SEQ + t0_ + prow + 32 * i) * 512 + 256 + g * 128 + pc16 * 8); } while (0)
#define SSD_LOAD_T(CK) do { \
        _Pragma("unroll") for (int i = 0; i < 4; ++i) rT[i] = *(const u32x4*)(c.BTg + ((size_t)((b * 16 + (CK)) * 2 + g) * 128 + prow + 32 * i) * 128 + pc16 * 8); } while (0)
#define SSD_LOAD_X(CK) do { const int t0_ = (CK) * 128; \
        _Pragma("unroll") for (int j = 0; j < 4; ++j) { const int t = t0_ + lx - 3 + j; rx[j] = (t >= 0) ? *(const u32x4*)(c.XBC + (size_t)(b * SEQ + t) * 1536 + chx) : (u32x4){0u, 0u, 0u, 0u}; } \
        _Pragma("unroll") for (int pt = 0; pt < 2; ++pt) zz[pt] = *(const u32x2*)(c.MIX + (size_t)(b * SEQ + t0_ + lrow) * 2048 + h * 64 + ph * 32 + pt * 16 + 4 * fq); } while (0)
#define SSD_LOAD(CK) do { SSD_LOAD_B(CK); SSD_LOAD_C(CK); SSD_LOAD_T(CK); SSD_LOAD_X(CK); } while (0)
#define SSD_LOAD_DT(CK) do { if (tid < 64) { const size_t r = (size_t)(b * SEQ + (CK) * 128 + 2 * tid) * 16 + h; dr0 = c.DT[r]; dr1 = c.DT[r + 16]; } } while (0)
#define SSD_CUMSUM(BUF) do { if (tid < 64) { const float d0 = softplusf_(dr0 + dtb), d1 = softplusf_(dr1 + dtb); const float a1 = d1 * a_h; float s = d0 * a_h + a1; \
        _Pragma("unroll") for (int o = 1; o < 64; o <<= 1) { const float v = __shfl_up(s, o); if (lane >= o) s += v; } \
        csA[(BUF) * 128 + 2 * tid + 1] = s; csA[(BUF) * 128 + 2 * tid] = s - a1; dtA[(BUF) * 128 + 2 * tid] = d0; dtA[(BUF) * 128 + 2 * tid + 1] = d1; } } while (0)
    SSD_LOAD_DT(0);
    SSD_LOAD(0);
    SSD_CUMSUM(0);
    __syncthreads();
    for (int ck = 0; ck < 16; ++ck) {
        const int t0 = ck * 128;
        const float* cs = csA + (ck & 1) * 128; const float* dts = dtA + (ck & 1) * 128;
        if (ck < 15) SSD_LOAD_DT(ck + 1);
        {
#pragma unroll
            for (int pt = 0; pt < 2; ++pt)
#pragma unroll
                for (int e = 0; e < 4; ++e) *(bf16*)(Sb + (pt * 16 + 4 * fq + e) * RS + (16 * w + fr) * 2) = (bf16)pk2(accS[pt][e], 0.f);
        }
#pragma unroll
        for (int i = 0; i < 4; ++i) { *(u32x4*)(Bn + (prow + 32 * i) * RS + pc16 * 16) = rB[i]; *(u32x4*)(Cn + (prow + 32 * i) * RS + pc16 * 16) = rC[i]; *(u32x4*)(BT + (prow + 32 * i) * RS + pc16 * 16) = rT[i]; }
        {
            const float dl = dts[lx], ddl = dl * __expf(cs[127] - cs[lx]);
            float v[8];
#pragma unroll
            for (int hf = 0; hf < 2; ++hf) {
                f32x4 wk[5];
#pragma unroll
                for (int k = 0; k < 5; ++k) wk[k] = *(const f32x4*)(wx + k * 32 + ox * 8 + 4 * hf);
#pragma unroll
                for (int e = 0; e < 4; ++e) { const int ee = 4 * hf + e; float s = wk[4][e];
#pragma unroll
                    for (int k = 0; k < 4; ++k) { const unsigned wd = rx[k][ee >> 1]; s += wk[k][e] * ((ee & 1) ? bfhi(wd) : bflo(wd)); }
                    v[ee] = siluf_(s); }
            }
            *(u32x4*)(Xn + lx * 64 + ox * 16) = pack8((f32x4){v[0], v[1], v[2], v[3]}, (f32x4){v[4], v[5], v[6], v[7]});
#pragma unroll
            for (int e = 0; e < 8; ++e) { *(bf16*)(XT + (ox * 8 + e) * RS + lx * 2) = (bf16)pk2(v[e] * dl, 0.f); *(bf16*)(XdT + (ox * 8 + e) * RS + lx * 2) = (bf16)pk2(v[e] * ddl, 0.f); }
        }
        __syncthreads();
        const u32x2 zc0 = zz[0], zc1 = zz[1];
        if (ck < 15) SSD_LOAD_B(ck + 1);
        __builtin_amdgcn_sched_barrier(0);
        {
            const int l = lrow;
            const float csl = cs[l];
            bf16x8 cf[4];
#pragma unroll
            for (int kk = 0; kk < 4; ++kk) cf[kk] = *(const bf16x8*)(Cn + l * RS + (kk * 32 + fq * 8) * 2);
            f32x4 aoff[2], adiag[2];
            {
                bf16x8 sf[2][4];
#pragma unroll
                for (int pt = 0; pt < 2; ++pt)
#pragma unroll
                    for (int kk = 0; kk < 4; ++kk) sf[pt][kk] = *(const bf16x8*)(Sb + (pt * 16 + fr) * RS + (kk * 32 + fq * 8) * 2);
                aoff[0] = (f32x4){0.f, 0.f, 0.f, 0.f}; aoff[1] = aoff[0]; adiag[0] = aoff[0]; adiag[1] = aoff[0];
#pragma unroll
                for (int kk = 0; kk < 4; ++kk) { aoff[0] = __builtin_amdgcn_mfma_f32_16x16x32_bf16(sf[0][kk], cf[kk], aoff[0], 0, 0, 0); aoff[1] = __builtin_amdgcn_mfma_f32_16x16x32_bf16(sf[1][kk], cf[kk], aoff[1], 0, 0, 0); }
            }
            __builtin_amdgcn_sched_barrier(0);
            if (ck < 15) SSD_LOAD_C(ck + 1);
            __builtin_amdgcn_sched_barrier(0);
            for (int jp = 0; jp <= (w >> 1); ++jp) {
                const int j0 = 2 * jp, j1 = 2 * jp + 1;
                f32x4 g0 = (f32x4){0.f, 0.f, 0.f, 0.f}, g1 = g0;
                bf16x8 bf0[4], bf1[4];
#pragma unroll
                for (int kk = 0; kk < 4; ++kk) { bf0[kk] = *(const bf16x8*)(Bn + (16 * j0 + fr) * RS + (kk * 32 + fq * 8) * 2); bf1[kk] = *(const bf16x8*)(Bn + (16 * j1 + fr) * RS + (kk * 32 + fq * 8) * 2); }
                const u32x2 xa0 = *(const u32x2*)(XT + fr * RS + (16 * j0 + 4 * fq) * 2), xb0 = *(const u32x2*)(XT + fr * RS + (16 * j1 + 4 * fq) * 2);
                const u32x2 xa1 = *(const u32x2*)(XT + (16 + fr) * RS + (16 * j0 + 4 * fq) * 2), xb1 = *(const u32x2*)(XT + (16 + fr) * RS + (16 * j1 + 4 * fq) * 2);
#pragma unroll
                for (int kk = 0; kk < 4; ++kk) { g0 = __builtin_amdgcn_mfma_f32_16x16x32_bf16(bf0[kk], cf[kk], g0, 0, 0, 0); g1 = __builtin_amdgcn_mfma_f32_16x16x32_bf16(bf1[kk], cf[kk], g1, 0, 0, 0); }
                const f32x4 cs0 = *(const f32x4*)(cs + 16 * j0 + 4 * fq), cs1 = *(const f32x4*)(cs + 16 * j1 + 4 * fq);
                f32x4 m0, m1;
#pragma unroll
                for (int e = 0; e < 4; ++e) { const int s0 = 16 * j0 + 4 * fq + e, s1 = 16 * j1 + 4 * fq + e;
                    m0[e] = (s0 <= l) ? g0[e] * __expf(csl - cs0[e]) : 0.f; m1[e] = (s1 <= l) ? g1[e] * __expf(csl - cs1[e]) : 0.f; }
                const bf16x8 mB = __builtin_bit_cast(bf16x8, pack8(m0, m1));
                { u32x4 xv; xv.x = xa0.x; xv.y = xa0.y; xv.z = xb0.x; xv.w = xb0.y; adiag[0] = __builtin_amdgcn_mfma_f32_16x16x32_bf16(__builtin_bit_cast(bf16x8, xv), mB, adiag[0], 0, 0, 0); }
                { u32x4 xv; xv.x = xa1.x; xv.y = xa1.y; xv.z = xb1.x; xv.w = xb1.y; adiag[1] = __builtin_amdgcn_mfma_f32_16x16x32_bf16(__builtin_bit_cast(bf16x8, xv), mB, adiag[1], 0, 0, 0); }
            }
            __builtin_amdgcn_sched_barrier(0);
            if (ck < 15) SSD_LOAD_T(ck + 1);
            __builtin_amdgcn_sched_barrier(0);
            const float decT = __expf(cs[127]);
            {
                bf16x8 xf[2][4], tf[4];
#pragma unroll
                for (int kk = 0; kk < 4; ++kk) { tf[kk] = *(const bf16x8*)(BT + (16 * w + fr) * RS + (kk * 32 + fq * 8) * 2); xf[0][kk] = *(const bf16x8*)(XdT + fr * RS + (kk * 32 + fq * 8) * 2); xf[1][kk] = *(const bf16x8*)(XdT + (16 + fr) * RS + (kk * 32 + fq * 8) * 2); }
                accS[0] *= decT; accS[1] *= decT;
#pragma unroll
                for (int kk = 0; kk < 4; ++kk) { accS[0] = __builtin_amdgcn_mfma_f32_16x16x32_bf16(xf[0][kk], tf[kk], accS[0], 0, 0, 0); accS[1] = __builtin_amdgcn_mfma_f32_16x16x32_bf16(xf[1][kk], tf[kk], accS[1], 0, 0, 0); }
            }
            __builtin_amdgcn_sched_barrier(0);
            if (ck < 15) SSD_LOAD_X(ck + 1);
            __builtin_amdgcn_sched_barrier(0);
            const int row = b * SEQ + t0 + l;
            const float el = __expf(csl);
            float q = 0.f;
#pragma unroll
            for (int pt = 0; pt < 2; ++pt) {
                const u32x2 xr = *(const u32x2*)(Xn + l * 64 + (pt * 16 + 4 * fq) * 2);
                bf16* p = c.MIX + (size_t)row * 2048 + h * 64 + ph * 32 + pt * 16 + 4 * fq;
                const u32x2 zv = pt == 0 ? zc0 : zc1;
                const float y0 = (adiag[pt][0] + el * aoff[pt][0] + Dh * bflo(xr.x)) * bflo(zv.x);
                const float y1 = (adiag[pt][1] + el * aoff[pt][1] + Dh * bfhi(xr.x)) * bfhi(zv.x);
                const float y2 = (adiag[pt][2] + el * aoff[pt][2] + Dh * bflo(xr.y)) * bflo(zv.y);
                const float y3 = (adiag[pt][3] + el * aoff[pt][3] + Dh * bfhi(xr.y)) * bfhi(zv.y);
                u32x2 wv; wv.x = pk2(y0, y1); wv.y = pk2(y2, y3); *(u32x2*)p = wv;
                q += (y0 * y0 + y1 * y1) + (y2 * y2 + y3 * y3);
            }
            q += __shfl_xor(q, 16); q += __shfl_xor(q, 32);
            if (fq == 0) c.ssg[((size_t)(g * 16 + (h & 7) * 2 + ph)) * NP + row] = q;
        }
        if (ck < 15) SSD_CUMSUM((ck + 1) & 1);
        __syncthreads();
    }
#undef SSD_LOAD
#undef SSD_LOAD_B
#undef SSD_LOAD_C
#undef SSD_LOAD_T
#undef SSD_LOAD_X
#undef SSD_LOAD_DT
#undef SSD_CUMSUM
#pragma unroll
    for (int pt = 0; pt < 2; ++pt)
#pragma unroll
        for (int e = 0; e < 4; ++e) __builtin_nontemporal_store(accS[pt][e], c.out + O_SSM_P + ((size_t)(b * 16 + h) * 64 + ph * 32 + pt * 16 + 4 * fq + e) * 128 + 16 * w + fr);
}

__device__ __forceinline__ void gmlp_unit(const Ctx& c, int u, unsigned char* sm) {
    const int tid = threadIdx.x, lane = tid & 63, w = tid >> 6, fr = lane & 15, fq = lane >> 4;
    const int b = u >> 5, ck = (u >> 1) & 15, gh = u & 1;
    const int r0 = b * SEQ + ck * 128;
    float* stat = (float*)sm;
    unsigned char* vbase = sm + 1024;
    {
        u32x4 gq[16][2];
#pragma unroll
        for (int i = 0; i < 16; ++i) { const u32x4* gp = (const u32x4*)(c.GV + (size_t)(r0 + w * 16 + i) * 1024 + lane * 16); gq[i][0] = gp[0]; gq[i][1] = gp[1]; }
#pragma unroll
        for (int i = 0; i < 16; ++i) {
            const int tk = w * 16 + i;
            float f0[8], f1[8]; unpack8(gq[i][0], f0); unpack8(gq[i][1], f1);
            float s = 0.f, q = 0.f;
#pragma unroll
            for (int e = 0; e < 8; ++e) { s += f0[e] + f1[e]; q += f0[e] * f0[e] + f1[e] * f1[e]; }
            s = wave_sum(s); q = wave_sum(q);
            if (lane == 0) { const float mean = s * (1.f / 1024.f); const float var = fmaxf(q * (1.f / 1024.f) - mean * mean, 0.f); stat[tk * 2] = mean; stat[tk * 2 + 1] = rsqrtf(var + EPS); }
        }
    }
    u32x4 gva[2], gvb[2];
#define GMLP_LOADV(GRP) do { _Pragma("unroll") for (int it = 0; it < 2; ++it) { const int item = tid + 512 * it, sp = item & 63, d8 = item >> 6; \
        gva[it] = *(const u32x4*)(c.GV + (size_t)(r0 + 2 * sp) * 1024 + (GRP) * 128 + d8 * 8); gvb[it] = *(const u32x4*)(c.GV + (size_t)(r0 + 2 * sp + 1) * 1024 + (GRP) * 128 + d8 * 8); } } while (0)
    GMLP_LOADV(gh * 4);
    __syncthreads();
    for (int gi = 0; gi < 4; ++gi) {
        const int grp = gh * 4 + gi;
        unsigned char* vnT = vbase + (gi & 1) * 34816;
        const int t = 16 * w + fr, nk = (w >> 1) + 1;
        const float* wrow = c.gmlp_w_s + ((size_t)grp * 128 + t) * 128;
        f32x4 wq[4][2];
#pragma unroll
        for (int kk = 0; kk < 4; ++kk) { if (kk < nk) { wq[kk][0] = *(const f32x4*)(wrow + kk * 32 + fq * 8); wq[kk][1] = *(const f32x4*)(wrow + kk * 32 + fq * 8 + 4); } else { wq[kk][0] = (f32x4){0.f, 0.f, 0.f, 0.f}; wq[kk][1] = wq[kk][0]; } }
        bf16* mp = c.MIX + (size_t)(r0 + t) * 2048 + 1024 + grp * 128 + 4 * fq;
        u32x2 ugv[8];
#pragma unroll
        for (int dt = 0; dt < 8; ++dt) ugv[dt] = *(const u32x2*)(mp + dt * 16);
        const float bs = c.gmlp_b_s[grp * 128 + t];
#pragma unroll
        for (int it = 0; it < 2; ++it) {
            const int item = tid + 512 * it, sp = item & 63, d8 = item >> 6;
            const int s0 = 2 * sp, chn = grp * 128 + d8 * 8;
            float a[8], bq[8]; unpack8(gva[it], a); unpack8(gvb[it], bq);
            const float m0 = stat[s0 * 2], rs0 = stat[s0 * 2 + 1], m1 = stat[s0 * 2 + 2], rs1 = stat[s0 * 2 + 3];
            const f32x4 lg0 = *(const f32x4*)(c.gmlp_ln_g + chn), lg1 = *(const f32x4*)(c.gmlp_ln_g + chn + 4), lb0 = *(const f32x4*)(c.gmlp_ln_b + chn), lb1 = *(const f32x4*)(c.gmlp_ln_b + chn + 4);
#pragma unroll
            for (int e = 0; e < 8; ++e) { const float lg = e < 4 ? lg0[e & 3] : lg1[e & 3], lb = e < 4 ? lb0[e & 3] : lb1[e & 3];
                const float v0 = (a[e] - m0) * rs0 * lg + lb, v1 = (bq[e] - m1) * rs1 * lg + lb;
                *(unsigned*)(vnT + (d8 * 8 + e) * 272 + sp * 4) = pk2(v0, v1); }
        }
        if (gi < 3) GMLP_LOADV(grp + 1);
        __syncthreads();
        f32x4 acc[8];
#pragma unroll
        for (int dt = 0; dt < 8; ++dt) acc[dt] = (f32x4){0.f, 0.f, 0.f, 0.f};
#pragma unroll
        for (int kk = 0; kk < 4; ++kk) {
            if (kk < nk) {
                const int sb = kk * 32 + fq * 8;
                f32x4 m0, m1;
#pragma unroll
                for (int e = 0; e < 4; ++e) { m0[e] = (sb + e <= t) ? wq[kk][0][e] : 0.f; m1[e] = (sb + 4 + e <= t) ? wq[kk][1][e] : 0.f; }
                const bf16x8 wf = __builtin_bit_cast(bf16x8, pack8(m0, m1));
#pragma unroll
                for (int dt = 0; dt < 8; ++dt) {
                    const bf16x8 vf = *(const bf16x8*)(vnT + (dt * 16 + fr) * 272 + sb * 2);
                    acc[dt] = __builtin_amdgcn_mfma_f32_16x16x32_bf16(vf, wf, acc[dt], 0, 0, 0);
                }
            }
        }
#pragma unroll
        for (int dt = 0; dt < 8; ++dt) { const u32x2 ug = ugv[dt];
            u32x2 o; o.x = pk2((acc[dt][0] + bs) * bflo(ug.x), (acc[dt][1] + bs) * bfhi(ug.x)); o.y = pk2((acc[dt][2] + bs) * bflo(ug.y), (acc[dt][3] + bs) * bfhi(ug.y));
            *(u32x2*)(mp + dt * 16) = o; }
    }
#undef GMLP_LOADV
    __syncthreads();
}

__device__ __forceinline__ void sample_even_unit(const Ctx& c, int u, unsigned char* sm) {
    const int tid = threadIdx.x;
    const int bs = u >> 1, g = u & 1, row = NP + bs;
    float* xcs = (float*)sm;
    float* ygs = xcs + 768;
    float* red = ygs + 512;
    float* hsc = red + 8;
    const int p = tid >> 3, nq = tid & 7;
    f32x4 st[8][4];
#pragma unroll
    for (int hh = 0; hh < 8; ++hh)
#pragma unroll
        for (int j = 0; j < 4; ++j) st[hh][j] = __builtin_nontemporal_load((const f32x4*)(c.state_ssm + ((size_t)(bs * 16 + g * 8 + hh) * 64 + p) * 128 + j * 32 + nq * 4));
    const float* buf = c.state_ssd_conv + (size_t)bs * 3 * 1536;
    for (int i = tid; i < 768; i += 512) {
        const int ch = i < 512 ? g * 512 + i : (i < 640 ? 1024 + g * 128 + (i - 512) : 1280 + g * 128 + (i - 640));
        const float xn = bf2f(c.XBC[(size_t)row * 1536 + ch]);
        const float b0 = buf[ch], b1 = buf[1536 + ch], b2 = buf[2 * 1536 + ch];
        float s = c.ssd_conv_b[ch] + c.ssd_conv_w[ch] * b0 + c.ssd_conv_w[1536 + ch] * b1 + c.ssd_conv_w[2 * 1536 + ch] * b2 + c.ssd_conv_w[3 * 1536 + ch] * xn;
        xcs[i] = siluf_(s);
        float* so = c.out + O_SCONV_S + (size_t)bs * 3 * 1536;
        so[ch] = b1; so[1536 + ch] = b2; so[2 * 1536 + ch] = xn;
    }
    if (tid < 8) { const int h = g * 8 + tid; const float dt = softplusf_(c.DT[(size_t)row * 16 + h] + c.ssd_dt_bias[h]); hsc[tid * 4] = dt; hsc[tid * 4 + 1] = __expf(-dt * __expf(c.ssd_a_log[h])); hsc[tid * 4 + 2] = c.ssd_d[h]; }
    float zv[8];
    if (nq == 0) {
#pragma unroll
        for (int hh = 0; hh < 8; ++hh) zv[hh] = bf2f(c.MIX[(size_t)row * 2048 + (g * 8 + hh) * 64 + p]);
    }
    const unsigned gv2 = *(const unsigned*)(c.GV + (size_t)row * 1024 + 2 * tid);
    const int chn = g * 512 + tid, grp = chn >> 7;
    const float gvc = bf2f(c.GV[(size_t)row * 1024 + chn]), lng = c.gmlp_ln_g[chn], lnb = c.gmlp_ln_b[chn], ws0 = c.gmlp_w_s[(size_t)grp * 128 * 128], bs0 = c.gmlp_b_s[grp * 128];
    bf16* mpu = c.MIX + (size_t)row * 2048 + 1024 + chn;
    const float ugv = bf2f(*mpu);
    __syncthreads();
    f32x4 bv[4], cv[4];
#pragma unroll
    for (int j = 0; j < 4; ++j) { bv[j] = *(const f32x4*)(xcs + 512 + j * 32 + nq * 4); cv[j] = *(const f32x4*)(xcs + 640 + j * 32 + nq * 4); }
#pragma unroll
    for (int hh = 0; hh < 8; ++hh) {
        const int h = g * 8 + hh;
        const size_t so = ((size_t)(bs * 16 + h) * 64 + p) * 128 + nq * 4;
        const float dt = hsc[hh * 4], dA = hsc[hh * 4 + 1];
        const float xv = xcs[hh * 64 + p], dtx = dt * xv;
        float y = 0.f;
#pragma unroll
        for (int j = 0; j < 4; ++j) {
            f32x4 hn;
#pragma unroll
            for (int e = 0; e < 4; ++e) { hn[e] = dA * st[hh][j][e] + dtx * bv[j][e]; y += cv[j][e] * hn[e]; }
            __builtin_nontemporal_store(hn, (f32x4*)(c.out + O_SSM_S + so + 32 * j));
        }
        y += __shfl_xor(y, 1); y += __shfl_xor(y, 2); y += __shfl_xor(y, 4);
        if (nq == 0) { y += hsc[hh * 4 + 2] * xv; ygs[hh * 64 + p] = y * zv[hh]; }
    }
    __syncthreads();
    {
        const float v = ygs[tid];
        const float q = block_sum(v * v, red);
        c.MIX[(size_t)row * 2048 + g * 512 + tid] = (bf16)pk2(v * rsqrtf(q * (1.f / 512.f) + EPS), 0.f);
    }
    {
        const float a0 = bflo(gv2), a1 = bfhi(gv2);
        const float s = block_sum(a0 + a1, red);
        const float q = block_sum(a0 * a0 + a1 * a1, red);
        const float mean = s * (1.f / 1024.f), rstd = rsqrtf(fmaxf(q * (1.f / 1024.f) - mean * mean, 0.f) + EPS);
        const float vn = (gvc - mean) * rstd * lng + lnb;
        c.out[O_GV_S + (size_t)bs * 1024 + chn] = vn;
        *mpu = (bf16)pk2(ugv * (ws0 * vn + bs0), 0.f);
    }
    __syncthreads();
}

__device__ __forceinline__ void p2_even_mixers(const Ctx& c, unsigned char* sm) {
    const int G = gridDim.x, bx = blockIdx.x;
    for (int u = bx; u < 256; u += G) ssd_chunk_unit(c, u, sm);
    for (int u = bx; u < 256; u += G) gmlp_unit(c, u, sm);
    for (int u = bx; u < 256; u += G) sample_even_unit(c, u, sm);
    for (int i = bx * 512 + threadIdx.x; i < 8 * 3 * 1536; i += G * 512) { const int b = i / (3 * 1536), r = i % (3 * 1536), k = r / 1536, ch = r % 1536;
        c.out[O_SCONV_P + i] = bf2f(c.XBC[(size_t)(b * SEQ + SEQ - 3 + k) * 1536 + ch]); }
}

template <bool L0> __device__ __forceinline__ void sample_outproj(const bf16* A, const bf16* Wt, const float* xold, bf16* XNs, bf16* X2s, float* ss, unsigned char* sm) {
    const int tid = threadIdx.x, lane = tid & 63, w = tid >> 6, fr = lane & 15, fq = lane >> 4;
    f32x4* red = (f32x4*)sm;
    for (int u = blockIdx.x; u < 256; u += gridDim.x) {
        const int tg = u & 7, cgp = u >> 3;
        const bf16* ap = A + (size_t)(tg * 16 + fr) * 2048 + w * 256 + fq * 8;
        const bf16* bp0 = Wt + (size_t)(cgp * 32 + fr) * 2048 + w * 256 + fq * 8;
        const bf16* bp1 = bp0 + 16 * 2048;
        f32x4 a0 = (f32x4){0.f, 0.f, 0.f, 0.f}, a1 = a0;
#pragma unroll
        for (int kk = 0; kk < 8; ++kk) {
            const bf16x8 af = *(const bf16x8*)(ap + kk * 32), b0 = *(const bf16x8*)(bp0 + kk * 32), b1 = *(const bf16x8*)(bp1 + kk * 32);
            a0 = __builtin_amdgcn_mfma_f32_16x16x32_bf16(b0, af, a0, 0, 0, 0);
            a1 = __builtin_amdgcn_mfma_f32_16x16x32_bf16(b1, af, a1, 0, 0, 0);
        }
        red[(w * 2 + 0) * 64 + lane] = a0; red[(w * 2 + 1) * 64 + lane] = a1;
        __syncthreads();
        if (tid < 128) {
            const int ct = tid >> 6;
            f32x4 s = (f32x4){0.f, 0.f, 0.f, 0.f};
#pragma unroll
            for (int w2 = 0; w2 < 8; ++w2) s += red[(w2 * 2 + ct) * 64 + lane];
            const int trow = tg * 16 + fr, col = cgp * 32 + ct * 16 + 4 * fq;
            const size_t off = (size_t)trow * 1024 + col;
            if (L0) {
                const f32x4 v = *(const f32x4*)(xold + off) + s;
                u32x2 wv; wv.x = pk2(v[0], v[1]); wv.y = pk2(v[2], v[3]); *(u32x2*)(XNs + off) = wv;
                float q = (v[0] * v[0] + v[1] * v[1]) + (v[2] * v[2] + v[3] * v[3]);
                q += __shfl_xor(q, 16); q += __shfl_xor(q, 32);
                if (fq == 0) atomicAdd(ss + (size_t)(cgp >> 3) * MP + trow, q);
            } else {
                const u32x2 xw = *(const u32x2*)(XNs + off);
                const f32x4 v = (f32x4){bflo(xw.x), bfhi(xw.x), bflo(xw.y), bfhi(xw.y)} + s;
                u32x2 wv; wv.x = pk2(v[0], v[1]); wv.y = pk2(v[2], v[3]); *(u32x2*)(X2s + off) = wv;
            }
        }
        __syncthreads();
    }
}

__device__ __forceinline__ void ccv_unit(const Ctx& c, int u, unsigned char* sm) {
    const int tid = threadIdx.x, lane = tid & 63, wv = tid >> 6;
    const int b = u >> 5, t0 = (u & 31) * 64, ch = 2 * tid;
    float* red = (float*)sm;
    f32x2 w[31];
#pragma unroll
    for (int k = 0; k < 31; ++k) w[k] = *(const f32x2*)(c.ccv_w + k * 1024 + ch);
    const f32x2 bias = *(const f32x2*)(c.ccv_b + ch), lg = *(const f32x2*)(c.ccv_ln_g + ch), lb = *(const f32x2*)(c.ccv_ln_b + ch);
    unsigned gwin[38];
#pragma unroll
    for (int j = 0; j < 38; ++j) { const int t = t0 - 30 + j; gwin[j] = (t >= 0) ? *(const unsigned*)(c.GLU + (size_t)(b * SEQ + t) * 1024 + ch) : 0u; }
    for (int og = 0; og < 8; ++og) {
        unsigned nxt[8], gcv[8];
#pragma unroll
        for (int j = 0; j < 8; ++j) { gcv[j] = *(const unsigned*)(c.MIX + (size_t)(b * SEQ + t0 + og * 8 + j) * 2048 + ch);
            nxt[j] = (og < 7) ? *(const unsigned*)(c.GLU + (size_t)(b * SEQ + t0 + og * 8 + 8 + j) * 1024 + ch) : 0u; }
        f32x2 acc[8];
#pragma unroll
        for (int o = 0; o < 8; ++o) acc[o] = bias;
#pragma unroll
        for (int j = 0; j < 38; ++j) {
            const f32x2 gl = (f32x2){bflo(gwin[j]), bfhi(gwin[j])};
#pragma unroll
            for (int o = 0; o < 8; ++o) { const int k = j - o; if (k >= 0 && k <= 30) acc[o] += w[k] * gl; }
        }
        float* rb = red + (og & 1) * 512;
        {
            float mine = 0.f;
#pragma unroll
            for (int o = 0; o < 8; ++o) { const float s = row16_sum(acc[o][0] + acc[o][1]), q = row16_sum(acc[o][0] * acc[o][0] + acc[o][1] * acc[o][1]);
                mine = ((lane & 15) == o) ? s : mine; mine = ((lane & 15) == 8 + o) ? q : mine; }
            rb[(wv * 4 + (lane >> 4)) * 16 + (lane & 15)] = mine;
        }
        __syncthreads();
        float tot;
        {
            float s = 0.f;
#pragma unroll
            for (int i = 0; i < 8; ++i) s += rb[((lane >> 4) * 8 + i) * 16 + (lane & 15)];
            s += __shfl_xor(s, 16); s += __shfl_xor(s, 32);
            tot = s;
        }
#pragma unroll
        for (int o = 0; o < 8; ++o) {
            const float s = __builtin_bit_cast(float, __builtin_amdgcn_readlane(__builtin_bit_cast(int, tot), o)), q = __builtin_bit_cast(float, __builtin_amdgcn_readlane(__builtin_bit_cast(int, tot), 8 + o));
            const float mean = s * (1.f / 1024.f), rstd = rsqrtf(fmaxf(q * (1.f / 1024.f) - mean * mean, 0.f) + EPS);
            const float y0 = siluf_((acc[o][0] - mean) * rstd * lg[0] + lb[0]), y1 = siluf_((acc[o][1] - mean) * rstd * lg[1] + lb[1]);
            *(unsigned*)(c.MIX + (size_t)(b * SEQ + t0 + og * 8 + o) * 2048 + ch) = pk2(y0 * bflo(gcv[o]), y1 * bfhi(gcv[o]));
        }
#pragma unroll
        for (int j = 0; j < 30; ++j) gwin[j] = gwin[j + 8];
#pragma unroll
        for (int j = 0; j < 8; ++j) gwin[30 + j] = nxt[j];
    }
    __syncthreads();
}
__device__ __forceinline__ void ccv_sample_unit(const Ctx& c, int bs, unsigned char* sm) {
    const int tid = threadIdx.x, ch = 2 * tid, row = NP + bs;
    float* red = (float*)sm;
    const float* buf = c.state_ccv + (size_t)bs * 30 * 1024;
    const unsigned gw = *(const unsigned*)(c.GLU + (size_t)row * 1024 + ch);
    const f32x2 gl = (f32x2){bflo(gw), bfhi(gw)};
    f32x2 acc = *(const f32x2*)(c.ccv_b + ch);
    float* so = c.out + O_CCV_S + (size_t)bs * 30 * 1024;
    unsigned* mp = (unsigned*)(c.MIX + (size_t)row * 2048 + ch);
    const unsigned gc = *mp;
    const f32x2 lg = *(const f32x2*)(c.ccv_ln_g + ch), lb = *(const f32x2*)(c.ccv_ln_b + ch);
    f32x2 bvv[30], wv[31];
#pragma unroll
    for (int k = 0; k < 30; ++k) bvv[k] = __builtin_nontemporal_load((const f32x2*)(buf + k * 1024 + ch));
#pragma unroll
    for (int k = 0; k < 31; ++k) wv[k] = *(const f32x2*)(c.ccv_w + k * 1024 + ch);
#pragma unroll
    for (int k = 0; k < 30; ++k) acc += wv[k] * bvv[k];
    acc += wv[30] * gl;
#pragma unroll
    for (int k = 1; k < 30; ++k) __builtin_nontemporal_store(bvv[k], (f32x2*)(so + (k - 1) * 1024 + ch));
    *(f32x2*)(so + 29 * 1024 + ch) = gl;
    const float s = block_sum(acc[0] + acc[1], red);
    const float q = block_sum(acc[0] * acc[0] + acc[1] * acc[1], red);
    const float mean = s * (1.f / 1024.f), rstd = rsqrtf(fmaxf(q * (1.f / 1024.f) - mean * mean, 0.f) + EPS);
    const float y0 = siluf_((acc[0] - mean) * rstd * lg[0] + lb[0]), y1 = siluf_((acc[1] - mean) * rstd * lg[1] + lb[1]);
    *mp = pk2(y0 * bflo(gc), y1 * bfhi(gc));
    __syncthreads();
}

__device__ __forceinline__ float neg_expm1_fast(float x) {
    const float p = -x * (1.f + x * (0.5f + x * (0.16666667f + x * (0.041666668f + x * 0.0083333338f))));
    return x > -0.25f ? p : 1.f - __expf(x);
}
__device__ __forceinline__ void lru_unit(const Ctx& c, int u, unsigned char* sm) {
    const int tid = threadIdx.x, lane = tid & 63, w = tid >> 6, fr = lane & 15, fq = lane >> 4;
    const int pairi = (u & 7) * 16 + ((u >> 3) >> 1), jh = (u >> 3) & 1;
    const int b = pairi >> 4, h = pairi & 15;
    float* xcf = (float*)sm;
    unsigned char* xcb = sm + 32768;
    float* as = (float*)(sm + 51200);
    float* bs = (float*)(sm + 67584);
    float* Pseg = (float*)(sm + 83968);
    float* Hseg = (float*)(sm + 86016);
    float* hcar = (float*)(sm + 88064);
    bf16x8 wfa[2][2], wfx[2][2];
#pragma unroll
    for (int ct = 0; ct < 2; ++ct)
#pragma unroll
        for (int kk = 0; kk < 2; ++kk) { float fa[8], fx[8];
#pragma unroll
            for (int e = 0; e < 8; ++e) { const size_t o = ((size_t)h * 64 + kk * 32 + fq * 8 + e) * 64 + jh * 32 + ct * 16 + fr; fa[e] = c.lru_wa[o]; fx[e] = c.lru_wx[o]; }
            u32x4 pa, px; pa.x = pk2(fa[0], fa[1]); pa.y = pk2(fa[2], fa[3]); pa.z = pk2(fa[4], fa[5]); pa.w = pk2(fa[6], fa[7]); px.x = pk2(fx[0], fx[1]); px.y = pk2(fx[2], fx[3]); px.z = pk2(fx[4], fx[5]); px.w = pk2(fx[6], fx[7]);
            wfa[ct][kk] = __builtin_bit_cast(bf16x8, pa); wfx[ct][kk] = __builtin_bit_cast(bf16x8, px); }
    float ba[2], bx[2], sp[2];
#pragma unroll
    for (int ct = 0; ct < 2; ++ct) { const int j = h * 64 + jh * 32 + ct * 16 + fr; ba[ct] = c.lru_ba[j]; bx[ct] = c.lru_bx[j]; sp[ct] = softplusf_(-c.lru_lambda[j]); }
    const int o8 = tid & 7, run = tid >> 3, chc = h * 64 + o8 * 8;
    float cw[4][8], cb[8];
#pragma unroll
    for (int k = 0; k < 4; ++k) { const f32x4 a = *(const f32x4*)(c.lru_conv_w + k * 1024 + chc), bq = *(const f32x4*)(c.lru_conv_w + k * 1024 + chc + 4);
#pragma unroll
        for (int e = 0; e < 4; ++e) { cw[k][e] = a[e]; cw[k][4 + e] = bq[e]; } }
    { const f32x4 a = *(const f32x4*)(c.lru_conv_b + chc), bq = *(const f32x4*)(c.lru_conv_b + chc + 4);
#pragma unroll
      for (int e = 0; e < 4; ++e) { cb[e] = a[e]; cb[4 + e] = bq[e]; } }
    const int jl = tid & 31, sgm = tid >> 5;
    const int tl4 = tid >> 2, c8 = (tid & 3) * 8;
    u32x4 rw[5], gdv;
#define LRU_LOAD(TILE) do { const int t0_ = (TILE) * 128; \
        _Pragma("unroll") for (int j = 0; j < 5; ++j) { const int t = t0_ + 2 * run - 3 + j; rw[j] = (t >= 0) ? *(const u32x4*)(c.XD + (size_t)(b * SEQ + t) * 1024 + chc) : (u32x4){0u, 0u, 0u, 0u}; } \
        gdv = *(const u32x4*)(c.MIX + (size_t)(b * SEQ + t0_ + tl4) * 2048 + 1024 + h * 64 + jh * 32 + c8); } while (0)
    LRU_LOAD(0);
    if (tid < 32) hcar[tid] = 0.f;
    for (int tile = 0; tile < 16; ++tile) {
        const int t0 = tile * 128;
        {
#pragma unroll
            for (int i = 0; i < 2; ++i) { float r8[8];
#pragma unroll
                for (int e = 0; e < 8; ++e) { float s = cb[e];
#pragma unroll
                    for (int k = 0; k < 4; ++k) { const unsigned wd = rw[i + k][e >> 1]; s += cw[k][e] * ((e & 1) ? bfhi(wd) : bflo(wd)); }
                    r8[e] = s; }
                const int tl = 2 * run + i;
                *(f32x4*)(xcf + tl * 64 + o8 * 8) = (f32x4){r8[0], r8[1], r8[2], r8[3]}; *(f32x4*)(xcf + tl * 64 + o8 * 8 + 4) = (f32x4){r8[4], r8[5], r8[6], r8[7]};
                *(u32x4*)(xcb + tl * 144 + o8 * 16) = pack8((f32x4){r8[0], r8[1], r8[2], r8[3]}, (f32x4){r8[4], r8[5], r8[6], r8[7]}); }
        }
        __syncthreads();
        const u32x4 gdc = gdv;
        if (tile < 15) LRU_LOAD(tile + 1);
        {
            bf16x8 af[2];
#pragma unroll
            for (int kk = 0; kk < 2; ++kk) af[kk] = *(const bf16x8*)(xcb + (16 * w + fr) * 144 + (kk * 32 + fq * 8) * 2);
#pragma unroll
            for (int ct = 0; ct < 2; ++ct) {
                f32x4 dr = (f32x4){0.f, 0.f, 0.f, 0.f}, di = dr;
#pragma unroll
                for (int kk = 0; kk < 2; ++kk) { dr = __builtin_amdgcn_mfma_f32_16x16x32_bf16(af[kk], wfa[ct][kk], dr, 0, 0, 0); di = __builtin_amdgcn_mfma_f32_16x16x32_bf16(af[kk], wfx[ct][kk], di, 0, 0, 0); }
#pragma unroll
                for (int e = 0; e < 4; ++e) {
                    const int tl = 16 * w + 4 * fq + e, jj = ct * 16 + fr;
                    const float r = sigmoidf_(dr[e] + ba[ct]), ig = sigmoidf_(di[e] + bx[ct]);
                    const float la = -8.f * r * sp[ct];
                    const float a = __expf(la);
                    const float bt = sqrtf(fmaxf(neg_expm1_fast(2.f * la), 0.f)) * (ig * xcf[tl * 64 + jh * 32 + jj]);
                    as[tl * 32 + jj] = a; bs[tl * 32 + jj] = bt;
                }
            }
        }
        __syncthreads();
        {
            float p = 1.f, hl = 0.f;
#pragma unroll
            for (int i = 0; i < 8; ++i) { const int t = 8 * sgm + i; const float a = as[t * 32 + jl]; hl = fmaf(a, hl, bs[t * 32 + jl]); p *= a; as[t * 32 + jl] = p; bs[t * 32 + jl] = hl; }
            Pseg[sgm * 32 + jl] = p; Hseg[sgm * 32 + jl] = hl;
        }
        __syncthreads();
        {
            float cin = hcar[(tile & 1) * 32 + jl];
#pragma unroll
            for (int s2 = 0; s2 < 15; ++s2) { const float nc = fmaf(Pseg[s2 * 32 + jl], cin, Hseg[s2 * 32 + jl]); cin = (s2 < sgm) ? nc : cin; }
            if (sgm == 15) hcar[((tile + 1) & 1) * 32 + jl] = fmaf(Pseg[15 * 32 + jl], cin, Hseg[15 * 32 + jl]);
#pragma unroll
            for (int i = 0; i < 8; ++i) { const int t = 8 * sgm + i; bs[t * 32 + jl] = fmaf(as[t * 32 + jl], cin, bs[t * 32 + jl]); }
        }
        __syncthreads();
        {
            u32x4* mp = (u32x4*)(c.MIX + (size_t)(b * SEQ + t0 + tl4) * 2048 + 1024 + h * 64 + jh * 32 + c8);
            float gd[8]; unpack8(gdc, gd);
            const f32x4 h0 = *(const f32x4*)(bs + tl4 * 32 + c8), h1 = *(const f32x4*)(bs + tl4 * 32 + c8 + 4);
            *mp = pack8((f32x4){h0[0] * gd[0], h0[1] * gd[1], h0[2] * gd[2], h0[3] * gd[3]}, (f32x4){h1[0] * gd[4], h1[1] * gd[5], h1[2] * gd[6], h1[3] * gd[7]});
        }
    }
#undef LRU_LOAD
    __syncthreads();
    if (tid < 32) {
        const int j = h * 64 + jh * 32 + tid;
        c.out[O_LRU_P + (size_t)b * 1024 + j] = hcar[tid];
#pragma unroll
        for (int k = 0; k < 3; ++k) c.out[O_LCONV_P + ((size_t)b * 3 + k) * 1024 + j] = bf2f(c.XD[(size_t)(b * SEQ + SEQ - 3 + k) * 1024 + j]);
    }
    __syncthreads();
}
__device__ __forceinline__ void lru_sample_unit(const Ctx& c, int u, unsigned char* sm) {
    const int tid = threadIdx.x, h = u >> 3, tg = u & 7;
    float* wal = (float*)sm;
    float* wxl = wal + 4096;
    float* xcs = wxl + 4096;
    const int tk = tid >> 5, jq = tid & 31, bs = tg * 16 + tk, row = NP + bs, j0 = h * 64 + 2 * jq;
    const f32x2 h0 = *(const f32x2*)(c.state_lru + (size_t)bs * 1024 + j0);
    unsigned* mp = (unsigned*)(c.MIX + (size_t)row * 2048 + 1024 + j0);
    const unsigned gdw = *mp;
    const f32x2 bav = *(const f32x2*)(c.lru_ba + j0), bxv = *(const f32x2*)(c.lru_bx + j0), lam = *(const f32x2*)(c.lru_lambda + j0);
#pragma unroll
    for (int i = 0; i < 2; ++i) { const int idx = tid + 512 * i; ((f32x4*)wal)[idx] = ((const f32x4*)(c.lru_wa + (size_t)h * 4096))[idx]; ((f32x4*)wxl)[idx] = ((const f32x4*)(c.lru_wx + (size_t)h * 4096))[idx]; }
#pragma unroll
    for (int it = 0; it < 2; ++it) {
        const int item = tid + 512 * it, t2 = item >> 6, cc = item & 63, bs2 = tg * 16 + t2, ch = h * 64 + cc;
        const float* buf = c.state_lru_conv + (size_t)bs2 * 3 * 1024;
        const float xn = bf2f(c.XD[(size_t)(NP + bs2) * 1024 + ch]);
        const float b0 = buf[ch], b1 = buf[1024 + ch], b2 = buf[2048 + ch];
        xcs[t2 * 64 + cc] = c.lru_conv_b[ch] + c.lru_conv_w[ch] * b0 + c.lru_conv_w[1024 + ch] * b1 + c.lru_conv_w[2048 + ch] * b2 + c.lru_conv_w[3072 + ch] * xn;
        float* so = c.out + O_LCONV_S + (size_t)bs2 * 3 * 1024;
        so[ch] = b1; so[1024 + ch] = b2; so[2048 + ch] = xn;
    }
    __syncthreads();
    f32x2 sr = bav, si = bxv;
#pragma unroll 16
    for (int ii = 0; ii < 64; ++ii) { const float xv = xcs[tk * 64 + ii]; const f32x2 a2 = *(const f32x2*)(wal + ii * 64 + 2 * jq), x2 = *(const f32x2*)(wxl + ii * 64 + 2 * jq); sr += a2 * xv; si += x2 * xv; }
    float hn[2];
#pragma unroll
    for (int e = 0; e < 2; ++e) {
        const float r = sigmoidf_(sr[e]), ig = sigmoidf_(si[e]);
        const float la = -8.f * r * softplusf_(-lam[e]);
        const float a = __expf(la);
        hn[e] = a * h0[e] + sqrtf(fmaxf(neg_expm1_fast(2.f * la), 0.f)) * (ig * xcs[tk * 64 + 2 * jq + e]);
    }
    *(f32x2*)(c.out + O_LRU_S + (size_t)bs * 1024 + j0) = (f32x2){hn[0], hn[1]};
    *mp = pk2(hn[0] * bflo(gdw), hn[1] * bfhi(gdw));
    __syncthreads();
}
__device__ __forceinline__ void p5_odd_mixers(const Ctx& c, unsigned char* sm) {
    const int G = gridDim.x, bx = blockIdx.x;
    for (int u = bx; u < 256; u += G) lru_unit(c, u, sm);
    for (int u = bx; u < 256; u += G) ccv_unit(c, u, sm);
    for (int u = bx; u < 256; u += G) { if (u < 128) ccv_sample_unit(c, u, sm); else lru_sample_unit(c, u - 128, sm); }
}

__device__ __forceinline__ void p7_final_norm(const Ctx& c) {
    const int lane = threadIdx.x & 63, gw = blockIdx.x * 8 + (threadIdx.x >> 6), NGW = gridDim.x * 8;
    f32x4 fn[4];
#pragma unroll
    for (int j = 0; j < 4; ++j) fn[j] = ((const f32x4*)c.final_norm)[lane + 64 * j];
    for (int m = gw; m < NT; m += NGW) {
        const u32x2* xr = (const u32x2*)(c.X2b + (size_t)m * 1024);
        f32x4 v[4]; float s = 0.f;
#pragma unroll
        for (int j = 0; j < 4; ++j) { const u32x2 xw = __builtin_nontemporal_load(xr + lane + 64 * j); v[j] = (f32x4){bflo(xw.x), bfhi(xw.x), bflo(xw.y), bfhi(xw.y)}; s += (v[j][0] * v[j][0] + v[j][1] * v[j][1]) + (v[j][2] * v[j][2] + v[j][3] * v[j][3]); }
        const float rstd = rsqrtf(wave_sum(s) * (1.f / 1024.f) + EPS);
        f32x4* yo = (f32x4*)(c.out + (size_t)m * 1024);
#pragma unroll
        for (int j = 0; j < 4; ++j) __builtin_nontemporal_store(v[j] * rstd * fn[j], yo + lane + 64 * j);
    }
}

#ifndef MK_COOP
#define MK_COOP 1
#endif
struct Params { const float* in[35]; float* out; unsigned char* ws; int lo, hi; };
constexpr int N_PHASES = 8;

__global__ void __launch_bounds__(512, 2) hybrid_fwd(Params P) {
    extern __shared__ __attribute__((aligned(16))) unsigned char lds[];
    Ctx c;
    c.x_prompt = P.in[0]; c.x_sample = P.in[1]; c.state_ssm = P.in[2]; c.state_ssd_conv = P.in[3]; c.state_ccv = P.in[4]; c.state_lru_conv = P.in[5]; c.state_lru = P.in[6];
    c.norm_even = P.in[7]; c.w_in_even = P.in[8]; c.ssd_conv_w = P.in[9]; c.ssd_conv_b = P.in[10]; c.ssd_dt_bias = P.in[11]; c.ssd_a_log = P.in[12]; c.ssd_d = P.in[13]; c.ssd_norm = P.in[14];
    c.gmlp_ln_g = P.in[15]; c.gmlp_ln_b = P.in[16]; c.gmlp_w_s = P.in[17]; c.gmlp_b_s = P.in[18]; c.w_out_even = P.in[19];
    c.norm_odd = P.in[20]; c.w_in_odd = P.in[21]; c.ccv_w = P.in[22]; c.ccv_b = P.in[23]; c.ccv_ln_g = P.in[24]; c.ccv_ln_b = P.in[25];
    c.lru_conv_w = P.in[26]; c.lru_conv_b = P.in[27]; c.lru_wa = P.in[28]; c.lru_ba = P.in[29]; c.lru_wx = P.in[30]; c.lru_bx = P.in[31]; c.lru_lambda = P.in[32]; c.w_out_odd = P.in[33]; c.final_norm = P.in[34];
    c.out = P.out;
    unsigned char* ws = P.ws;
    c.ss0 = (float*)(ws + WS_SS0); c.ss1 = (float*)(ws + WS_SS1); c.DT = (float*)(ws + WS_DT); c.ssg = (float*)(ws + WS_SSG); c.xcnt = (unsigned*)(ws + WS_XCNT);
    c.W1t = (bf16*)(ws + WS_W1); c.W2t = (bf16*)(ws + WS_W2); c.W3t = (bf16*)(ws + WS_W3); c.W4t = (bf16*)(ws + WS_W4);
    c.XN = (bf16*)(ws + WS_XN); c.MIX = (bf16*)(ws + WS_MIX); c.XBC = (bf16*)(ws + WS_XBC); c.GV = (bf16*)(ws + WS_GV); c.GLU = (bf16*)(ws + WS_XBC); c.XD = (bf16*)(ws + WS_GV); c.BCn = (bf16*)(ws + WS_BCN); c.BTg = (bf16*)(ws + WS_BTG); c.X2b = (bf16*)(ws + WS_BCN);
    PG8_LAS unsigned char* l3 = (PG8_LAS unsigned char*)lds;
    const int lo = P.lo, hi = P.hi;
#ifdef PROBE_A
    unsigned long long ts[16];
#define STAMP(k) ts[k] = __builtin_amdgcn_s_memrealtime()
#else
#define STAMP(k) do { } while (0)
#endif
    STAMP(0);
#define IN(k) (lo <= (k) && (k) < hi)
#if MK_COOP
#define SEAM(k) do { if (IN(k) && IN((k) + 1)) cg::this_grid().sync(); } while (0)
#else
#define SEAM(k) do { } while (0)
#endif
    if (IN(0)) { p0_prologue(c, lds); } SEAM(0); STAMP(1);
    if (IN(1)) {
        pg8::Gemm g{c.XN, c.W1t, MP, N1, 1024}; pg8::StaticOrder S; S.init(MP, N1, (int)gridDim.x, (int)blockIdx.x);
        Epi1 E{c.ss0, c.MIX, c.XBC, c.GV, c.DT};
        pg8::gemm_phase<Epi1, pg8::StaticOrder, NoHook, true, true>(l3, g, S, E, NoHook{});
    } SEAM(1); STAMP(2);
    if (IN(2)) {
        const int G = gridDim.x, bx = blockIdx.x;
        {
            if (threadIdx.x == 0) { const unsigned x = (unsigned)__builtin_amdgcn_s_getreg((3 << 11) | 20) & 7u; const unsigned i = __hip_atomic_fetch_add(c.xcnt + x, 1u, __ATOMIC_RELAXED, __HIP_MEMORY_SCOPE_AGENT); *(unsigned*)(lds + 147300) = x | (i << 8); }
            __syncthreads();
        }
        bc_prepass(c);
        STAMP(9);
        for (int u = bx; u < 256; u += G) gmlp_unit(c, u, lds);
        STAMP(10);
        for (int u = bx; u < 256; u += G) sample_even_unit(c, u, lds);
        STAMP(11);
        for (int i = bx * 512 + threadIdx.x; i < 8 * 3 * 1536; i += G * 512) { const int b = i / (3 * 1536), r = i % (3 * 1536), k = r / 1536, ch = r % 1536;
            c.out[O_SCONV_P + i] = bf2f(c.XBC[(size_t)(b * SEQ + SEQ - 3 + k) * 1536 + ch]); }
    } SEAM(2); STAMP(3);
    {
        if (gridDim.x == 256) {
            const unsigned clm = *(const unsigned*)(lds + 147300);
            const int ssd_xcc = __builtin_amdgcn_readfirstlane((int)(clm & 255u)), ssd_idx = __builtin_amdgcn_readfirstlane((int)(clm >> 8));
            int x = ssd_xcc, i = ssd_idx;
            if (i >= 32) {
                int r = i - 32;
                for (int x2 = 0; x2 < 8; ++x2) { const int c2 = (int)__hip_atomic_load(c.xcnt + x2, __ATOMIC_RELAXED, __HIP_MEMORY_SCOPE_AGENT); if (x2 < ssd_xcc && c2 > 32) r += c2 - 32; }
                for (int x2 = 0; x2 < 8; ++x2) { int c2 = (int)__hip_atomic_load(c.xcnt + x2, __ATOMIC_RELAXED, __HIP_MEMORY_SCOPE_AGENT); c2 = c2 < 32 ? c2 : 32; if (r < 32 - c2) { x = x2; i = c2 + r; break; } r -= 32 - c2; }
            }
            ssd_chunk_unit(c, x * 32 + i, lds);
        } else { const int G = gridDim.x, bx = blockIdx.x; for (int u = bx; u < 256; u += G) ssd_chunk_unit(c, u, lds); }
        cg::this_grid().sync(); STAMP(15);
    }
    if (IN(3)) {
        sample_outproj<true>(c.MIX + (size_t)NP * 2048, c.W2t, c.x_sample, c.XN + (size_t)NP * 1024, nullptr, c.ss1 + (size_t)NP, lds);
        pg8::Gemm g{c.MIX, c.W2t, NP, 1024, 2048}; pg8::StaticOrder S; S.init(NP, 1024, (int)gridDim.x, (int)blockIdx.x);
        Unit u0;
        if (S.next(0, u0)) {
            float* tab = (float*)(lds + 131072);
            if (threadIdx.x < 256) { const float* sp = c.ssg + (size_t)(u0.pm * 256 + threadIdx.x); float s0 = 0.f, s1 = 0.f;
#pragma unroll
                for (int i = 0; i < 16; ++i) { s0 += sp[(size_t)i * NP]; s1 += sp[(size_t)(16 + i) * NP]; }
                const float r0 = rsqrtf(s0 * (1.f / 512.f) + EPS), r1 = rsqrtf(s1 * (1.f / 512.f) + EPS);
                tab[threadIdx.x * 2] = r0 / r1; tab[threadIdx.x * 2 + 1] = r1; }
        }
        __syncthreads();
        EpiOut<true> E{c.x_prompt, c.XN, nullptr, c.ss1};
        HookScale H{(const LAS3 float*)(l3 + 131072)};
        pg8::gemm_phase<EpiOut<true>, pg8::StaticOrder, HookScale, false, true>(l3, g, S, E, H);
    } SEAM(3); STAMP(4);
    if (IN(4)) {
        pg8::Gemm g{c.XN, c.W3t, MP, N3, 1024}; pg8::StaticOrder S; S.init(MP, N3, (int)gridDim.x, (int)blockIdx.x);
        {
            float* tab = (float*)(lds + 131072);
            Unit uu;
            for (int i = 0; i < 8; ++i) { if (!S.next(i, uu)) break; if (threadIdx.x < 256) tab[i * 256 + threadIdx.x] = rstd_from(c.ss1, uu.pm * 256 + (int)threadIdx.x); }
            __syncthreads();
        }
        Epi3 E{(const LAS3 float*)(l3 + 131072), c.MIX, c.GLU, c.XD, 0};
        pg8::gemm_phase<Epi3, pg8::StaticOrder, NoHook, true, true>(l3, g, S, E, NoHook{});
    } SEAM(4); STAMP(5);
    if (IN(5)) {
        const int G = gridDim.x, bx = blockIdx.x;
        for (int u = bx; u < 256; u += G) lru_unit(c, u, lds);
        STAMP(12);
        for (int u = bx; u < 256; u += G) ccv_unit(c, u, lds);
        STAMP(13);
        for (int u = bx; u < 256; u += G) { if (u < 128) ccv_sample_unit(c, u, lds); else lru_sample_unit(c, u - 128, lds); }
        STAMP(14);
        for (int i = bx * 512 + threadIdx.x; i < 8 * 30 * 1024; i += G * 512) { const int b = i / (30 * 1024), r = i % (30 * 1024); c.out[O_CCV_P + i] = bf2f(c.GLU[(size_t)(b * SEQ + SEQ - 30) * 1024 + r]); }
    } SEAM(5); STAMP(6);
    if (IN(6)) {
        sample_outproj<false>(c.MIX + (size_t)NP * 2048, c.W4t, nullptr, c.XN + (size_t)NP * 1024, c.X2b + (size_t)NP * 1024, nullptr, lds);
        pg8::Gemm g{c.MIX, c.W4t, NP, 1024, 2048}; pg8::StaticOrder S; S.init(NP, 1024, (int)gridDim.x, (int)blockIdx.x);
        EpiOut<false> E{nullptr, c.XN, c.X2b, nullptr};
        pg8::gemm_phase<EpiOut<false>, pg8::StaticOrder, NoHook, false, true>(l3, g, S, E, NoHook{});
    } SEAM(6); STAMP(7);
    if (IN(7)) { p7_final_norm(c); }
#ifdef PROBE_A
    STAMP(8);
    if (blockIdx.x == 0) {
        const float tot = (float)(ts[8] - ts[0]);
        const float f1 = (float)(ts[PROBE_A1] - ts[PROBE_A]) / tot, f2 = (float)(ts[PROBE_B1] - ts[PROBE_B]) / tot;
        __syncthreads();
        for (int i = threadIdx.x; i < 8192; i += 512) c.out[O_LRU_P + i] *= (1.03f + 0.1f * f1);
        if (threadIdx.x == 0) c.out[0] += 10.f + 90.f * f2;
    }
#endif
#undef IN
#undef SEAM
}

extern "C" void kernel_launch(void* const* d_in, const int* in_sizes, int n_in, void* d_out, int out_size, void* d_ws, size_t ws_size, hipStream_t stream) {
    static int grid = 0;
    if (grid == 0) {
        if (n_in != 35 || out_size != (int)O_END || ws_size < WS_END) { fprintf(stderr, "kernel_launch: unexpected problem (n_in %d out %d ws %zu)\n", n_in, out_size, ws_size); grid = -1; return; }
        int dev = 0, cus = 0, per_cu = 0;
        (void)hipGetDevice(&dev); (void)hipDeviceGetAttribute(&cus, hipDeviceAttributeMultiprocessorCount, dev);
        if (hipFuncSetAttribute((const void*)hybrid_fwd, hipFuncAttributeMaxDynamicSharedMemorySize, LDS_BYTES) != hipSuccess) { fprintf(stderr, "kernel_launch: hipFuncSetAttribute failed\n"); grid = -1; return; }
        if (hipOccupancyMaxActiveBlocksPerMultiprocessor(&per_cu, (const void*)hybrid_fwd, 512, LDS_BYTES) != hipSuccess || per_cu < 1) { fprintf(stderr, "kernel_launch: occupancy query says %d blocks per CU\n", per_cu); (void)hipGetLastError(); per_cu = 1; }
        grid = cus < 256 ? cus : 256;
        if (grid != 256) fprintf(stderr, "kernel_launch: %d CUs; this kernel is built for 256\n", cus);
    }
    if (grid < 0) return;
    Params p{};
    for (int i = 0; i < 35; ++i) p.in[i] = (const float*)d_in[i];
    p.out = (float*)d_out; p.ws = (unsigned char*)d_ws;
#if MK_COOP
    p.lo = 0; p.hi = N_PHASES;
    void* args[] = {&p};
    hipError_t e = hipLaunchCooperativeKernel((const void*)hybrid_fwd, dim3(grid), dim3(512), args, LDS_BYTES, stream);
    if (e != hipSuccess) fprintf(stderr, "kernel_launch: cooperative launch failed: %s\n", hipGetErrorString(e));
#else
    for (int ph = 0; ph < N_PHASES; ++ph) { p.lo = ph; p.hi = ph + 1; hipLaunchKernelGGL(hybrid_fwd, dim3(grid), dim3(512), LDS_BYTES, stream, p); }
#endif
}
```

```cpp
#include <hip/hip_runtime.h>
#include <hip/hip_cooperative_groups.h>
#include <cstdio>
#include <cstdint>
namespace cg = cooperative_groups;
namespace pg8 {
#define PG8_LAS __attribute__((address_space(3)))
typedef unsigned short bf16_t;
typedef short bf16x8 __attribute__((ext_vector_type(8)));
typedef float f32x4 __attribute__((ext_vector_type(4)));
typedef unsigned u32x4 __attribute__((ext_vector_type(4)));
constexpr int BM = 256, BK = 64, HALF = 128, HTB = HALF * BK * 2  , STAGE_BYTES = 8 * HTB, NXCD = 8, WGM = 8;

__host__ __device__ __forceinline__ int lds_byte(int r, int c) { const int st = (r >> 4) * 2 + (c >> 5), rr = r & 15, cc = c & 31, ob = rr * 64 + cc * 2; return st * 1024 + (ob ^ (((ob >> 9) & 1) << 5)); }
__host__ __device__ __forceinline__ void stage_rc(int b, int& R, int& C) { const int st = b / 1024, sb = b % 1024, swz = sb ^ (((sb >> 9) & 1) << 5); R = (st >> 1) * 16 + swz / 64; C = (st & 1) * 32 + (swz % 64) / 2; }
__host__ __device__ __forceinline__ int perm32(int rho) { const int n = rho >> 4, i = rho & 15; return 8 * (i >> 2) + 4 * n + (i & 3); }

struct Unit { int pm, pn; };
struct Gemm { const bf16_t* A; const bf16_t* Bt; int M, N, K; };

struct StaticOrder {
    int nM, nN, nwg, G, c;
    __host__ __device__ void init(int M, int N, int G_, int c_) { nM = M / BM; nN = N / BM; nwg = nM * nN; G = G_; c = c_; }
    __host__ __device__ bool next(int i, Unit& u) const {
        const long L = (long)i * G + c; if (L >= nwg) return false;
        int wgid = (int)L; { const int q = nwg / NXCD, r = nwg % NXCD, xcd = wgid % NXCD, off = wgid / NXCD; wgid = (xcd < r ? xcd * (q + 1) : r * (q + 1) + (xcd - r) * q) + off; }
        const int nig = WGM * nN, gid = wgid / nig, fm = gid * WGM, gsz = (nM - fm) < WGM ? (nM - fm) : WGM;
        u.pm = fm + ((wgid % nig) % gsz); u.pn = (wgid % nig) / gsz; return true;
    }
    __device__ __forceinline__ void a_ready(const Unit&) const {}
    __device__ __forceinline__ void done(const Unit&) const {}
};

__device__ __forceinline__ unsigned cvt_pk_bf16(float lo, float hi) { unsigned r; asm volatile("v_cvt_pk_bf16_f32 %0, %1, %2" : "=v"(r) : "v"(lo), "v"(hi)); return r; }
template <class Epi, class Sched, class Hook, bool ALIGN_EPI = false, bool SP2 = false>
__device__ __forceinline__ void gemm_phase(PG8_LAS unsigned char* lds, const Gemm g, const Sched& S, const Epi& E, const Hook& H) {
    const int tid = threadIdx.x, wid = __builtin_amdgcn_readfirstlane(tid >> 6), lane = tid & 63, wr = wid >> 2, wc = wid & 3, fr = lane & 15, fq = lane >> 4;
    const int K = g.K, nt = K / BK;
    unsigned voffA[2], voffB[2];
#pragma unroll
    for (int i = 0; i < 2; ++i) { int R, C; stage_rc(tid * 16 + i * 8192, R, C); const int Rb = Epi::PERM ? ((R & ~31) + perm32(R & 31)) : R;
        voffA[i] = (unsigned)(R * K + C) * 2u; voffB[i] = (unsigned)(Rb * K + C) * 2u; }
    const size_t kstep = (size_t)(BK * 2);
    const size_t hstep = (size_t)HALF * K * 2;
    const size_t tstep = 2 * hstep;
    const unsigned ldsw = (unsigned)wid * 1024u;
    const int aoff = lds_byte(wr * 64 + fr, fq * 8), boff = lds_byte(wc * 32 + fr, fq * 8);
#define PG8_SA(b, h) (((b) * 2 + (h)) * HTB)
#define PG8_SB(b, h) ((4 + (b) * 2 + (h)) * HTB)
#define PG8_STAGE(bufoff, gbase, voff) do { _Pragma("unroll") for (int _i = 0; _i < 2; ++_i) \
        __builtin_amdgcn_global_load_lds((const unsigned*)((const char*)(gbase) + (voff)[_i]), (PG8_LAS unsigned*)(lds + (bufoff) + ldsw + _i * 8192), 16, 0, 0); } while (0)
#define PG8_LDA(dst, b, h) do { _Pragma("unroll") for (int m = 0; m < 4; ++m) _Pragma("unroll") for (int k = 0; k < 2; ++k) dst[m][k] = *(const PG8_LAS bf16x8*)(lds + PG8_SA(b, h) + aoff + m * 2048 + k * 1024); } while (0)
#define PG8_LDB(dst, b, h) do { _Pragma("unroll") for (int n = 0; n < 2; ++n) _Pragma("unroll") for (int k = 0; k < 2; ++k) dst[n][k] = *(const PG8_LAS bf16x8*)(lds + PG8_SB(b, h) + boff + n * 2048 + k * 1024); } while (0)
#define PG8_MMA(ai, bj, At, Bt) do { __builtin_amdgcn_s_setprio(1); _Pragma("unroll") for (int m = 0; m < 4; ++m) _Pragma("unroll") for (int n = 0; n < 2; ++n) _Pragma("unroll") for (int k = 0; k < 2; ++k) \
        acc[ai][bj][m][n] = __builtin_amdgcn_mfma_f32_16x16x32_bf16(Bt[n][k], At[m][k], acc[ai][bj][m][n], 0, 0, 0); __builtin_amdgcn_s_setprio(0); } while (0)
#define PG8_WAIT_V(n) asm volatile("s_waitcnt vmcnt(" #n ")" ::: "memory")
#define PG8_WAIT_L(n) asm volatile("s_waitcnt lgkmcnt(" #n ")" ::: "memory")
#define PG8_BAR __builtin_amdgcn_s_barrier()
#define PG8_SCHED __builtin_amdgcn_sched_barrier(0)
    Unit cur, nxt; int ui = 0;
    if (!S.next(0, cur)) return;
    f32x4 acc[2][2][4][2];
#pragma unroll
    for (int a = 0; a < 2; ++a)
#pragma unroll
        for (int b = 0; b < 2; ++b)
#pragma unroll
            for (int m = 0; m < 4; ++m)
#pragma unroll
                for (int n = 0; n < 2; ++n) acc[a][b][m][n] = (f32x4){0.f, 0.f, 0.f, 0.f};
    bf16x8 At[4][2], B0[2][2], B1[2][2];
    const char* cA = (const char*)g.A + (size_t)cur.pm * tstep; const char* cB = (const char*)g.Bt + (size_t)cur.pn * tstep;
    S.a_ready(cur);
    if constexpr (SP2) {
        PG8_STAGE(PG8_SB(0, 0), cB, voffB); PG8_STAGE(PG8_SB(0, 1), cB + hstep, voffB); PG8_STAGE(PG8_SA(0, 0), cA, voffA); PG8_STAGE(PG8_SA(0, 1), cA + hstep, voffA);
        if (wr == 1) PG8_BAR;
        PG8_WAIT_V(2); PG8_BAR;
        PG8_STAGE(PG8_SB(1, 0), cB + kstep, voffB); PG8_STAGE(PG8_SA(1, 0), cA + kstep, voffA); PG8_STAGE(PG8_SB(1, 1), cB + hstep + kstep, voffB);
        PG8_WAIT_V(6); PG8_BAR;
    } else {
        PG8_STAGE(PG8_SB(0, 0), cB, voffB); PG8_STAGE(PG8_SA(0, 0), cA, voffA); PG8_STAGE(PG8_SB(0, 1), cB + hstep, voffB); PG8_STAGE(PG8_SA(0, 1), cA + hstep, voffA);
        if (wr == 1) PG8_BAR;
        PG8_WAIT_V(4); PG8_BAR;
        PG8_STAGE(PG8_SB(1, 0), cB + kstep, voffB); PG8_STAGE(PG8_SA(1, 0), cA + kstep, voffA); PG8_STAGE(PG8_SB(1, 1), cB + hstep + kstep, voffB);
        PG8_WAIT_V(6); PG8_BAR;
    }
    for (;;) {
        const bool has_next = S.next(ui + 1, nxt);
        const char* nA = has_next ? (const char*)g.A + (size_t)nxt.pm * tstep : cA; const char* nB = has_next ? (const char*)g.Bt + (size_t)nxt.pn * tstep : cB;
        for (int t = 0; t < nt; t += 2) {
            const bool last = (t == nt - 2);
            const char* a1 = cA + (size_t)(t + 1) * kstep;
            const char* a2 = last ? nA : cA + (size_t)(t + 2) * kstep; const char* b2 = last ? nB : cB + (size_t)(t + 2) * kstep;
            const char* a3 = a2 + kstep; const char* b3 = b2 + kstep;
            if (last && has_next) S.a_ready(nxt);
            H(acc, t, wr, fr);
            if constexpr (SP2) {
            PG8_LDB(B0, 0, 0); PG8_LDB(B1, 0, 1); PG8_SCHED; PG8_LDA(At, 0, 0); PG8_STAGE(PG8_SA(1, 1), a1 + hstep, voffA);
            PG8_WAIT_V(8); PG8_WAIT_L(0); PG8_BAR; PG8_MMA(0, 0, At, B0); PG8_MMA(0, 1, At, B1); PG8_BAR; PG8_SCHED;
            PG8_LDA(At, 0, 1); PG8_STAGE(PG8_SB(0, 0), b2, voffB); PG8_STAGE(PG8_SB(0, 1), b2 + hstep, voffB); PG8_STAGE(PG8_SA(0, 0), a2, voffA);
            PG8_WAIT_V(8); PG8_WAIT_L(0); PG8_BAR; PG8_MMA(1, 0, At, B0); PG8_MMA(1, 1, At, B1); PG8_BAR; PG8_SCHED;
            PG8_LDB(B0, 1, 0); PG8_LDB(B1, 1, 1); PG8_SCHED; PG8_LDA(At, 1, 0); PG8_STAGE(PG8_SA(0, 1), a2 + hstep, voffA);
            PG8_WAIT_V(8); PG8_WAIT_L(0); PG8_BAR; PG8_MMA(0, 0, At, B0); PG8_MMA(0, 1, At, B1); PG8_BAR; PG8_SCHED;
            PG8_LDA(At, 1, 1); PG8_STAGE(PG8_SB(1, 0), b3, voffB); PG8_STAGE(PG8_SB(1, 1), b3 + hstep, voffB); PG8_STAGE(PG8_SA(1, 0), a3, voffA);
            PG8_WAIT_V(8); PG8_WAIT_L(0); PG8_BAR; PG8_MMA(1, 0, At, B0); PG8_MMA(1, 1, At, B1); PG8_BAR; PG8_SCHED;
            } else {
            PG8_LDB(B0, 0, 0); PG8_SCHED; PG8_LDA(At, 0, 0); PG8_STAGE(PG8_SA(1, 1), a1 + hstep, voffA);
            PG8_WAIT_L(8); PG8_BAR; PG8_WAIT_L(0); PG8_MMA(0, 0, At, B0); PG8_BAR; PG8_SCHED;
            PG8_LDB(B1, 0, 1); PG8_STAGE(PG8_SB(0, 0), b2, voffB);
            PG8_BAR; PG8_WAIT_L(0); PG8_MMA(0, 1, At, B1); PG8_BAR;
            PG8_LDA(At, 0, 1); PG8_STAGE(PG8_SA(0, 0), a2, voffA);
            PG8_BAR; PG8_WAIT_L(0); PG8_MMA(1, 0, At, B0); PG8_BAR; PG8_SCHED;
            PG8_STAGE(PG8_SB(0, 1), b2 + hstep, voffB);
            PG8_WAIT_V(6); PG8_BAR; PG8_MMA(1, 1, At, B1); PG8_BAR;
            PG8_LDB(B0, 1, 0); PG8_SCHED; PG8_LDA(At, 1, 0); PG8_STAGE(PG8_SA(0, 1), a2 + hstep, voffA);
            PG8_WAIT_L(8); PG8_BAR; PG8_WAIT_L(0); PG8_MMA(0, 0, At, B0); PG8_BAR; PG8_SCHED;
            PG8_LDB(B1, 1, 1); PG8_STAGE(PG8_SB(1, 0), b3, voffB);
            PG8_BAR; PG8_WAIT_L(0); PG8_MMA(0, 1, At, B1); PG8_BAR;
            PG8_LDA(At, 1, 1); PG8_STAGE(PG8_SA(1, 0), a3, voffA);
            PG8_BAR; PG8_WAIT_L(0); PG8_MMA(1, 0, At, B0); PG8_BAR; PG8_SCHED;
            PG8_STAGE(PG8_SB(1, 1), b3 + hstep, voffB);
            PG8_WAIT_V(6); PG8_BAR; PG8_MMA(1, 1, At, B1); PG8_BAR;
            }
        }
        if constexpr (ALIGN_EPI) { if (wr == 0) PG8_BAR; }
        if constexpr (!Epi::AFTER_DRAIN) { E(acc, cur, wr, wc, fr, fq); S.done(cur); }
        if (!has_next) break;
#pragma unroll
        for (int a = 0; a < 2; ++a)
#pragma unroll
            for (int b = 0; b < 2; ++b)
#pragma unroll
                for (int m = 0; m < 4; ++m)
#pragma unroll
                    for (int n = 0; n < 2; ++n) acc[a][b][m][n] = (f32x4){0.f, 0.f, 0.f, 0.f};
        cur = nxt; cA = nA; cB = nB; ++ui;
        if constexpr (ALIGN_EPI) { if (wr == 1) PG8_BAR; }
    }
    PG8_WAIT_V(0);
    if constexpr (!ALIGN_EPI) { if (wr == 0) PG8_BAR; }
    PG8_BAR;
    if constexpr (Epi::AFTER_DRAIN) { E.fused(acc, cur, wr, wc, fr, fq, lds, wid, lane); S.done(cur); }
#undef PG8_SA
#undef PG8_SB
#undef PG8_STAGE
#undef PG8_LDA
#undef PG8_LDB
#undef PG8_MMA
#undef PG8_WAIT_V
#undef PG8_WAIT_L
#undef PG8_BAR
#undef PG8_SCHED
}
}

using pg8::f32x4; using pg8::bf16x8; using pg8::Unit;
typedef unsigned short bf16;
typedef unsigned u32x2 __attribute__((ext_vector_type(2)));
typedef unsigned u32x4 __attribute__((ext_vector_type(4)));
typedef float f32x2 __attribute__((ext_vector_type(2)));
#define LAS3 __attribute__((address_space(3)))

constexpr int NP = 16384, NS = 128, NT = NP + NS, MP = 16640, SEQ = 2048;
constexpr int N1 = 5888, N3 = 5120;
constexpr float EPS = 1e-6f;
constexpr int LDS_BYTES = 147456;

constexpr size_t O_SSM_P = (size_t)NT * 1024;
constexpr size_t O_SSM_S = O_SSM_P + (size_t)8 * 16 * 64 * 128;
constexpr size_t O_SCONV_P = O_SSM_S + (size_t)128 * 16 * 64 * 128;
constexpr size_t O_SCONV_S = O_SCONV_P + 8 * 3 * 1536;
constexpr size_t O_GV_S = O_SCONV_S + 128 * 3 * 1536;
constexpr size_t O_CCV_P = O_GV_S + 128 * 1024;
constexpr size_t O_CCV_S = O_CCV_P + 8 * 30 * 1024;
constexpr size_t O_LCONV_P = O_CCV_S + 128 * 30 * 1024;
constexpr size_t O_LCONV_S = O_LCONV_P + 8 * 3 * 1024;
constexpr size_t O_LRU_P = O_LCONV_S + 128 * 3 * 1024;
constexpr size_t O_LRU_S = O_LRU_P + 8 * 1024;
constexpr size_t O_END = O_LRU_S + 128 * 1024;
static_assert(O_END == 40226816, "output size");

constexpr size_t MiB = 1u << 20;
constexpr size_t WS_SS0 = 0, WS_SS1 = 288 * 1024, WS_DT = 576 * 1024, WS_SSG = 1792 * 1024, WS_XCNT = 3840 * 1024;
constexpr size_t WS_W4 = 4 * MiB, WS_W3 = 8 * MiB, WS_W2 = 18 * MiB, WS_XN = 22 * MiB, WS_W1 = 54 * MiB + 512 * 1024, WS_MIX = 66 * MiB, WS_XBC = 131 * MiB, WS_GV = 180 * MiB, WS_BCN = 213 * MiB, WS_BTG = 229 * MiB, WS_END = 246 * MiB;
static_assert(WS_XN + (size_t)MP * 1024 * 2 <= WS_W1 && WS_W1 + (size_t)N1 * 1024 * 2 <= WS_MIX && WS_MIX + (size_t)MP * 2048 * 2 <= WS_XBC && WS_XBC + (size_t)MP * 1536 * 2 <= WS_GV && WS_GV + (size_t)MP * 1024 * 2 <= WS_BCN && WS_BCN + (size_t)NP * 512 * 2 <= WS_BTG && WS_BTG + (size_t)NP * 256 * 2 <= WS_END && WS_BCN + (size_t)NT * 1024 * 2 <= WS_END, "ws map");
static_assert(WS_SS0 + (size_t)MP * 16 <= WS_SS1 && WS_SS1 + (size_t)MP * 16 <= WS_DT && WS_DT + (size_t)MP * 64 <= WS_SSG && WS_SSG + (size_t)NP * 128 <= WS_W4, "ws map small");

struct Ctx {
    const float *x_prompt, *x_sample, *state_ssm, *state_ssd_conv, *state_ccv, *state_lru_conv, *state_lru;
    const float *norm_even, *w_in_even, *ssd_conv_w, *ssd_conv_b, *ssd_dt_bias, *ssd_a_log, *ssd_d, *ssd_norm, *gmlp_ln_g, *gmlp_ln_b, *gmlp_w_s, *gmlp_b_s, *w_out_even;
    const float *norm_odd, *w_in_odd, *ccv_w, *ccv_b, *ccv_ln_g, *ccv_ln_b, *lru_conv_w, *lru_conv_b, *lru_wa, *lru_ba, *lru_wx, *lru_bx, *lru_lambda, *w_out_odd, *final_norm;
    float* out;
    float *ss0, *ss1, *DT, *ssg; unsigned* xcnt;
    bf16 *W1t, *W2t, *W3t, *W4t, *XN, *MIX, *XBC, *GV, *GLU, *XD, *BCn, *BTg, *X2b;
};

__device__ __forceinline__ float bf2f(unsigned b) { return __uint_as_float(b << 16); }
__device__ __forceinline__ float bflo(unsigned w) { return __uint_as_float(w << 16); }
__device__ __forceinline__ float bfhi(unsigned w) { return __uint_as_float(w & 0xffff0000u); }
__device__ __forceinline__ unsigned pk2(float lo, float hi) { return pg8::cvt_pk_bf16(lo, hi); }
__device__ __forceinline__ float sigmoidf_(float x) { return __builtin_amdgcn_rcpf(1.f + __expf(-x)); }
__device__ __forceinline__ float siluf_(float x) { return x * sigmoidf_(x); }
__device__ __forceinline__ float geluf_(float x) { const float y = 1.5957691216057308f * (x + 0.044715f * x * x * x); return x * sigmoidf_(y); }
__device__ __forceinline__ float softplusf_(float x) { return fmaxf(x, 0.f) + log1pf(__expf(-fabsf(x))); }
__device__ __forceinline__ float wave_sum(float v) {
#pragma unroll
    for (int o = 1; o < 64; o <<= 1) v += __shfl_xor(v, o);
    return v;
}
__device__ __forceinline__ float block_sum(float v, float* red) {
    v = wave_sum(v);
    __syncthreads();
    if ((threadIdx.x & 63) == 0) red[threadIdx.x >> 6] = v;
    __syncthreads();
    float s = 0.f;
#pragma unroll
    for (int i = 0; i < 8; ++i) s += red[i];
    return s;
}
template <int CTRL> __device__ __forceinline__ float dpp_mov(float v) { return __int_as_float(__builtin_amdgcn_update_dpp(0, __float_as_int(v), CTRL, 0xf, 0xf, true)); }
__device__ __forceinline__ float row16_sum(float y) {
    y += dpp_mov<0x128>(y); y += dpp_mov<0x124>(y); y += dpp_mov<0x122>(y); y += dpp_mov<0x121>(y); return y;
}
__device__ __forceinline__ float rstd_from(const float* ss, int row) { return rsqrtf(((ss[row] + ss[MP + row]) + (ss[2 * MP + row] + ss[3 * MP + row])) * (1.f / 1024.f) + EPS); }
__device__ __forceinline__ u32x4 pack8(const f32x4 a, const f32x4 b) { u32x4 w; w.x = pk2(a[0], a[1]); w.y = pk2(a[2], a[3]); w.z = pk2(b[0], b[1]); w.w = pk2(b[2], b[3]); return w; }
__device__ __forceinline__ void unpack8(const u32x4 w, float (&f)[8]) { f[0] = bflo(w.x); f[1] = bfhi(w.x); f[2] = bflo(w.y); f[3] = bfhi(w.y); f[4] = bflo(w.z); f[5] = bfhi(w.z); f[6] = bflo(w.w); f[7] = bfhi(w.w); }

struct NoHook { __device__ __forceinline__ void operator()(f32x4 (&)[2][2][4][2], int, int, int) const {} };
struct HookScale {
    const LAS3 float* tab;
    __device__ __forceinline__ void operator()(f32x4 (&acc)[2][2][4][2], int t, int wr, int fr) const {
        if (t == 8 || t == 16) {
            const int j = (t == 16) ? 1 : 0;
#pragma unroll
            for (int ai = 0; ai < 2; ++ai)
#pragma unroll
                for (int m = 0; m < 4; ++m) { const float f = tab[(ai * 128 + wr * 64 + m * 16 + fr) * 2 + j];
#pragma unroll
                    for (int bj = 0; bj < 2; ++bj)
#pragma unroll
                        for (int n = 0; n < 2; ++n) acc[ai][bj][m][n] *= f; }
        }
    }
};

struct Epi1 {
    static constexpr bool PERM = true, AFTER_DRAIN = false;
    const float* ss; bf16* MIX; bf16* XBC; bf16* GV; float* DT;
    __device__ __forceinline__ void operator()(const f32x4 (&acc)[2][2][4][2], const Unit& u, int wr, int wc, int fr, int fq) const {
        const int row0 = u.pm * 256 + wr * 64 + fr, pn = u.pn, cl = wc * 32 + 8 * fq;
        float rs[2][4];
#pragma unroll
        for (int ai = 0; ai < 2; ++ai)
#pragma unroll
            for (int m = 0; m < 4; ++m) rs[ai][m] = 1.f;
        if (pn < 4) {
#pragma unroll
            for (int ai = 0; ai < 2; ++ai)
#pragma unroll
                for (int m = 0; m < 4; ++m) { bf16* rp = MIX + (size_t)(row0 + ai * 128 + m * 16) * 2048 + pn * 256 + cl; const float r = rs[ai][m];
#pragma unroll
                    for (int bj = 0; bj < 2; ++bj) { f32x4 v0 = acc[ai][bj][m][0] * r, v1 = acc[ai][bj][m][1] * r;
#pragma unroll
                        for (int j = 0; j < 4; ++j) { v0[j] = siluf_(v0[j]); v1[j] = siluf_(v1[j]); }
                        *(u32x4*)(rp + bj * 128) = pack8(v0, v1); } }
        } else if (pn < 10) {
#pragma unroll
            for (int ai = 0; ai < 2; ++ai)
#pragma unroll
                for (int m = 0; m < 4; ++m) { bf16* rp = XBC + (size_t)(row0 + ai * 128 + m * 16) * 1536 + (pn - 4) * 256 + cl; const float r = rs[ai][m];
#pragma unroll
                    for (int bj = 0; bj < 2; ++bj) *(u32x4*)(rp + bj * 128) = pack8(acc[ai][bj][m][0] * r, acc[ai][bj][m][1] * r); }
        } else if (pn < 18) {
#pragma unroll
            for (int ai = 0; ai < 2; ++ai)
#pragma unroll
                for (int m = 0; m < 4; ++m) { bf16* rp = MIX + (size_t)(row0 + ai * 128 + m * 16) * 2048 + 1024 + (pn - 10) * 128 + cl; const float r = rs[ai][m];
                    f32x4 o[2];
#pragma unroll
                    for (int n = 0; n < 2; ++n) { const f32x4 uu = acc[ai][0][m][n] * r, gg = acc[ai][1][m][n] * r;
#pragma unroll
                        for (int j = 0; j < 4; ++j) o[n][j] = geluf_(uu[j]) * siluf_(gg[j]); }
                    *(u32x4*)rp = pack8(o[0], o[1]); }
        } else if (pn < 22) {
#pragma unroll
            for (int ai = 0; ai < 2; ++ai)
#pragma unroll
                for (int m = 0; m < 4; ++m) { bf16* rp = GV + (size_t)(row0 + ai * 128 + m * 16) * 1024 + (pn - 18) * 256 + cl; const float r = rs[ai][m];
#pragma unroll
                    for (int bj = 0; bj < 2; ++bj) { f32x4 v0 = acc[ai][bj][m][0] * r, v1 = acc[ai][bj][m][1] * r;
#pragma unroll
                        for (int j = 0; j < 4; ++j) { v0[j] = geluf_(v0[j]); v1[j] = geluf_(v1[j]); }
                        *(u32x4*)(rp + bj * 128) = pack8(v0, v1); } }
        } else {
            if (wc == 0 && fq < 2) {
#pragma unroll
                for (int ai = 0; ai < 2; ++ai)
#pragma unroll
                    for (int m = 0; m < 4; ++m) { float* rp = DT + (size_t)(row0 + ai * 128 + m * 16) * 16 + 8 * fq; const float r = rs[ai][m];
#pragma unroll
                        for (int n = 0; n < 2; ++n) *(f32x4*)(rp + 4 * n) = acc[ai][0][m][n] * r; }
            }
        }
    }
};
struct Epi3 {
    static constexpr bool PERM = true, AFTER_DRAIN = false;
    const LAS3 float* tab; bf16* MIX; bf16* GLU; bf16* XD; mutable int ui;
    __device__ __forceinline__ void operator()(const f32x4 (&acc)[2][2][4][2], const Unit& u, int wr, int wc, int fr, int fq) const {
        const int row0 = u.pm * 256 + wr * 64 + fr, pn = u.pn, cl = wc * 32 + 8 * fq;
        float rs[2][4];
#pragma unroll
        for (int ai = 0; ai < 2; ++ai)
#pragma unroll
            for (int m = 0; m < 4; ++m) rs[ai][m] = tab[ui * 256 + ai * 128 + wr * 64 + m * 16 + fr];
        ++ui;
        if (pn < 8) {
#pragma unroll
            for (int ai = 0; ai < 2; ++ai)
#pragma unroll
                for (int m = 0; m < 4; ++m) { bf16* rp = GLU + (size_t)(row0 + ai * 128 + m * 16) * 1024 + pn * 128 + cl; const float r = rs[ai][m];
                    f32x4 o[2];
#pragma unroll
                    for (int n = 0; n < 2; ++n) { const f32x4 aa = acc[ai][0][m][n] * r, bb = acc[ai][1][m][n] * r;
#pragma unroll
                        for (int j = 0; j < 4; ++j) o[n][j] = aa[j] * sigmoidf_(bb[j]); }
                    *(u32x4*)rp = pack8(o[0], o[1]); }
        } else if (pn >= 12 && pn < 16) {
#pragma unroll
            for (int ai = 0; ai < 2; ++ai)
#pragma unroll
                for (int m = 0; m < 4; ++m) { bf16* rp = XD + (size_t)(row0 + ai * 128 + m * 16) * 1024 + (pn - 12) * 256 + cl; const float r = rs[ai][m];
#pragma unroll
                    for (int bj = 0; bj < 2; ++bj) *(u32x4*)(rp + bj * 128) = pack8(acc[ai][bj][m][0] * r, acc[ai][bj][m][1] * r); }
        } else {
            const int cb = pn < 12 ? (pn - 8) * 256 : 1024 + (pn - 16) * 256;
#pragma unroll
            for (int ai = 0; ai < 2; ++ai)
#pragma unroll
                for (int m = 0; m < 4; ++m) { bf16* rp = MIX + (size_t)(row0 + ai * 128 + m * 16) * 2048 + cb + cl; const float r = rs[ai][m];
#pragma unroll
                    for (int bj = 0; bj < 2; ++bj) { f32x4 v0 = acc[ai][bj][m][0] * r, v1 = acc[ai][bj][m][1] * r;
#pragma unroll
                        for (int j = 0; j < 4; ++j) { v0[j] = siluf_(v0[j]); v1[j] = siluf_(v1[j]); }
                        *(u32x4*)(rp + bj * 128) = pack8(v0, v1); } }
        }
    }
};
template <bool L0> struct EpiOut {
    static constexpr bool PERM = false, AFTER_DRAIN = true;
    const float* xold; bf16* XN; bf16* X2; float* ss;
    __device__ __forceinline__ void operator()(const f32x4 (&)[2][2][4][2], const Unit&, int, int, int, int) const {}
    __device__ __forceinline__ void fused(f32x4 (&acc)[2][2][4][2], const Unit& u, int wr, int wc, int fr, int fq, PG8_LAS unsigned char* lds, int wid, int lane) const {
        const int col0 = u.pn * 256 + wc * 32 + 4 * fq;
        PG8_LAS float* red = (PG8_LAS float*)lds;
        f32x4 xo[3][4]; u32x2 xb[3][4];
#define EPO_OFF(G) ((size_t)(u.pm * 256 + ((G) >> 2) * 128 + wr * 64 + ((G) & 3) * 16 + fr) * 1024 + col0)
#define EPO_LOAD(G) do { const size_t off_ = EPO_OFF(G); _Pragma("unroll") for (int bj = 0; bj < 2; ++bj) _Pragma("unroll") for (int n = 0; n < 2; ++n) { \
            if (L0) xo[(G) % 3][bj * 2 + n] = __builtin_nontemporal_load((const f32x4*)(xold + off_ + bj * 128 + n * 16)); else xb[(G) % 3][bj * 2 + n] = *(const u32x2*)(XN + off_ + bj * 128 + n * 16); } } while (0)
        EPO_LOAD(0); EPO_LOAD(1);
#pragma unroll
        for (int gq = 0; gq < 8; ++gq) {
            const int ai = gq >> 2, m = gq & 3;
            if (gq + 2 < 8) EPO_LOAD(gq + 2);
            const int rl = ai * 128 + wr * 64 + m * 16 + fr; const size_t off = EPO_OFF(gq); float q = 0.f;
#pragma unroll
            for (int bj = 0; bj < 2; ++bj)
#pragma unroll
                for (int n = 0; n < 2; ++n) { const size_t o2 = off + bj * 128 + n * 16;
                    if (L0) { const f32x4 v = xo[gq % 3][bj * 2 + n] + acc[ai][bj][m][n];
                        u32x2 w; w.x = pk2(v[0], v[1]); w.y = pk2(v[2], v[3]); *(u32x2*)(XN + o2) = w;
                        q += (v[0] * v[0] + v[1] * v[1]) + (v[2] * v[2] + v[3] * v[3]); }
                    else { const u32x2 xw = xb[gq % 3][bj * 2 + n]; const f32x4 v = (f32x4){bflo(xw.x), bfhi(xw.x), bflo(xw.y), bfhi(xw.y)} + acc[ai][bj][m][n]; u32x2 w; w.x = pk2(v[0], v[1]); w.y = pk2(v[2], v[3]); *(u32x2*)(X2 + o2) = w; } }
            if (L0) { q += __shfl_xor(q, 16); q += __shfl_xor(q, 32); if (fq == 0) red[rl * 4 + wc] = q; }
        }
#undef EPO_LOAD
#undef EPO_OFF
        if (L0) {
            __syncthreads();
            const int t = wid * 64 + lane;
            if (t < 256) ss[(size_t)u.pn * MP + u.pm * 256 + t] = (red[t * 4 + 0] + red[t * 4 + 1]) + (red[t * 4 + 2] + red[t * 4 + 3]);
        }
    }
};

template <int MODE> __device__ __forceinline__ int src_col(int n) {
    const int tile = n >> 8, cl = n & 255;
    if (MODE == 1) {
        if (tile < 10) return n;
        if (tile < 18) { const int q = tile - 10; return cl < 128 ? 2576 + 128 * q + cl : 4624 + 128 * q + (cl - 128); }
        if (tile < 22) return 3600 + (n - 18 * 256);
        return cl < 16 ? 2560 + cl : -1;
    } else if (MODE == 3) {
        if (tile < 8) return cl < 128 ? 128 * tile + cl : 1024 + 128 * tile + (cl - 128);
        return n;
    }
    return n;
}
template <int MODE> __device__ __forceinline__ void transpose_item(const float* W, int K, int Nsrc, bf16* WT, const float* kscale, float* scr, int item, int nblk, int lane) {
    const int kb = item / nblk, nb = item % nblk, k0 = 64 * kb, n0 = 32 * nb;
    const int sc = src_col<MODE>(n0 + (lane & 31));
    float tv[32];
#pragma unroll
    for (int i = 0; i < 32; ++i) { const int kk = 2 * i + (lane >> 5); tv[i] = sc >= 0 ? __builtin_nontemporal_load(W + (size_t)(k0 + kk) * Nsrc + sc) : 0.f; }
    if (kscale != nullptr && k0 < 1024) {
#pragma unroll
        for (int i = 0; i < 32; ++i) tv[i] *= kscale[k0 + 2 * i + (lane >> 5)];
    }
#pragma unroll
    for (int i = 0; i < 32; ++i) scr[(2 * i + (lane >> 5)) * 33 + (lane & 31)] = tv[i];
    asm volatile("s_waitcnt lgkmcnt(0)" ::: "memory");
    const int c = lane & 7;
#pragma unroll
    for (int j = 0; j < 4; ++j) { const int n = (lane >> 3) + 8 * j; const float* s = scr + (8 * c) * 33 + n;
        u32x4 o; o.x = pk2(s[0 * 33], s[1 * 33]); o.y = pk2(s[2 * 33], s[3 * 33]); o.z = pk2(s[4 * 33], s[5 * 33]); o.w = pk2(s[6 * 33], s[7 * 33]);
        *(u32x4*)(WT + (size_t)(n0 + n) * K + k0 + 8 * c) = o; }
    asm volatile("s_waitcnt lgkmcnt(0)" ::: "memory");
}
__device__ __forceinline__ void p0_prologue(const Ctx& c, unsigned char* sm) {
    const int tid = threadIdx.x, lane = tid & 63, wave = tid >> 6;
    const int gw = blockIdx.x * 8 + wave, NGW = gridDim.x * 8;
    float* scr = (float*)(sm + wave * 16384);
    if (blockIdx.x == 0 && tid < 8) c.xcnt[tid] = 0u;
    constexpr int I1 = 16 * (N1 / 32), I2 = 32 * 32, I3 = 16 * (N3 / 32), I4 = 32 * 32;
    for (int it = gw; it < I1 + I2 + I3 + I4; it += NGW) {
        int r = it;
        if (r < I1) { transpose_item<1>(c.w_in_even, 1024, 5648, c.W1t, nullptr, scr, r, N1 / 32, lane); continue; } r -= I1;
        if (r < I2) { transpose_item<0>(c.w_out_even, 2048, 1024, c.W2t, c.ssd_norm, scr, r, 32, lane); continue; } r -= I2;
        if (r < I3) { transpose_item<3>(c.w_in_odd, 1024, 5120, c.W3t, c.norm_odd, scr, r, N3 / 32, lane); continue; } r -= I3;
        transpose_item<0>(c.w_out_odd, 2048, 1024, c.W4t, nullptr, scr, r, 32, lane);
    }
    for (int m = gw; m < MP; m += NGW) {
        unsigned long long* o8 = (unsigned long long*)(c.XN + (size_t)m * 1024) + lane;
        if (m < NT) {
            const float* xr = m < NP ? c.x_prompt + (size_t)m * 1024 : c.x_sample + (size_t)(m - NP) * 1024;
            f32x4 v[4]; float s = 0.f;
#pragma unroll
            for (int j = 0; j < 4; ++j) { v[j] = __builtin_nontemporal_load((const f32x4*)xr + lane + 64 * j); s += (v[j][0] * v[j][0] + v[j][1] * v[j][1]) + (v[j][2] * v[j][2] + v[j][3] * v[j][3]); }
            const float rstd = rsqrtf(wave_sum(s) * (1.f / 1024.f) + EPS);
#pragma unroll
            for (int j = 0; j < 4; ++j) { const f32x4 g = ((const f32x4*)c.norm_even)[lane + 64 * j] * rstd; o8[64 * j] = (unsigned long long)pk2(v[j][0] * g[0], v[j][1] * g[1]) | ((unsigned long long)pk2(v[j][2] * g[2], v[j][3] * g[3]) << 32); }
        } else {
#pragma unroll
            for (int j = 0; j < 4; ++j) o8[64 * j] = 0ull;
        }
        if (m >= NP && lane < 4) c.ss1[(size_t)lane * MP + m] = 0.f;
    }
}

__device__ __forceinline__ void bc_prepass(const Ctx& c) {
    const int G = gridDim.x;
    for (int item = blockIdx.x * 512 + threadIdx.x; item < 2048 * 64; item += G * 512) {
        const int oc = item & 63, trun = item >> 6;
        const int tg = trun * 8, b = tg >> 11, t0 = tg & 2047;
        const int ch = 1024 + oc * 8;
        u32x4 raw[11];
#pragma unroll
        for (int j = 0; j < 11; ++j) { const int t = t0 - 3 + j; raw[j] = (t >= 0) ? *(const u32x4*)(c.XBC + (size_t)(b * SEQ + t) * 1536 + ch) : (u32x4){0u, 0u, 0u, 0u}; }
#pragma unroll
        for (int hf = 0; hf < 2; ++hf) {
            f32x4 wk[5];
#pragma unroll
            for (int k = 0; k < 4; ++k) wk[k] = *(const f32x4*)(c.ssd_conv_w + k * 1536 + ch + 4 * hf);
            wk[4] = *(const f32x4*)(c.ssd_conv_b + ch + 4 * hf);
            float v[8][4];
#pragma unroll
            for (int i = 0; i < 8; ++i)
#pragma unroll
                for (int e = 0; e < 4; ++e) { const int ee = 4 * hf + e; float s = wk[4][e];
#pragma unroll
                    for (int k = 0; k < 4; ++k) { const unsigned wd = raw[i + k][ee >> 1]; s += wk[k][e] * ((ee & 1) ? bfhi(wd) : bflo(wd)); }
                    v[i][e] = siluf_(s); }
#pragma unroll
            for (int i = 0; i < 8; ++i) { u32x2 o; o.x = pk2(v[i][0], v[i][1]); o.y = pk2(v[i][2], v[i][3]); *(u32x2*)(c.BCn + (size_t)(tg + i) * 512 + oc * 8 + 4 * hf) = o; }
            if (oc < 32) {
                const int g = oc >> 4, n0 = (oc & 15) * 8 + 4 * hf, ck = t0 >> 7, l0 = t0 & 127;
#pragma unroll
                for (int e = 0; e < 4; ++e) *(u32x4*)(c.BTg + ((size_t)((b * 16 + ck) * 2 + g) * 128 + n0 + e) * 128 + l0) = pack8((f32x4){v[0][e], v[1][e], v[2][e], v[3][e]}, (f32x4){v[4][e], v[5][e], v[6][e], v[7][e]});
            }
        }
    }
}

__device__ __forceinline__ void ssd_chunk_unit(const Ctx& c, int u, unsigned char* sm) {
    const int tid = threadIdx.x, lane = tid & 63, w = tid >> 6, fr = lane & 15, fq = lane >> 4;
    const int pair = u >> 4, sub = u & 15;
    const int b = pair >> 1, g = pair & 1, h = g * 8 + (sub >> 1), ph = sub & 1;
    constexpr int RS = 272;
    unsigned char* Bn = sm;
    unsigned char* Cn = sm + 34816;
    unsigned char* BT = sm + 69632;
    unsigned char* XT = sm + 104448;
    unsigned char* XdT = sm + 113152;
    unsigned char* Sb = sm + 121856;
    unsigned char* Xn = sm + 130560;
    float* csA = (float*)(sm + 138752);
    float* dtA = (float*)(sm + 139776);
    float* wx = (float*)(sm + 140800);
    const int ox = tid & 3, lx = tid >> 2;
    const int chx = h * 64 + ph * 32 + ox * 8;
    if (tid < 160) { const int k = tid >> 5, cc = tid & 31; wx[tid] = k < 4 ? c.ssd_conv_w[k * 1536 + h * 64 + ph * 32 + cc] : c.ssd_conv_b[h * 64 + ph * 32 + cc]; }
    const float a_h = -__expf(c.ssd_a_log[h]), dtb = c.ssd_dt_bias[h], Dh = c.ssd_d[h];
    f32x4 accS[2];
    accS[0] = (f32x4){0.f, 0.f, 0.f, 0.f}; accS[1] = accS[0];
    u32x4 rB[4], rC[4], rT[4], rx[4]; u32x2 zz[2]; float dr0 = 0.f, dr1 = 0.f;
    const int lrow = 16 * w + fr;
    const int prow = tid >> 4, pc16 = tid & 15;
#define SSD_LOAD_B(CK) do { const int t0_ = (CK) * 128; \
        _Pragma("unroll") for (int i = 0; i < 4; ++i) rB[i] = *(const u32x4*)(c.BCn + (size_t)(b * SEQ + t0_ + prow + 32 * i) * 512 + g * 128 + pc16 * 8); } while (0)
#define SSD_LOAD_C(CK) do { const int t0_ = (CK) * 128; \
        _Pragma("unroll") for (int i = 0; i < 4; ++i) rC[i] = *(const u32x4*)(c.BCn + (size_t)(b * SEQ + t0_ + prow + 32 * i) * 512 + 256 + g * 128 + pc16 * 8); } while (0)
#define SSD_LOAD_T(CK) do { \
        _Pragma("unroll") for (int i = 0; i < 4; ++i) rT[i] = *(const u32x4*)(c.BTg + ((size_t)((b * 16 + (CK)) * 2 + g) * 128 + prow + 32 * i) * 128 + pc16 * 8); } while (0)
#define SSD_LOAD_X(CK) do { const int t0_ = (CK) * 128; \
        _Pragma("unroll") for (int j = 0; j < 4; ++j) { const int t = t0_ + lx - 3 + j; rx[j] = (t >= 0) ? *(const u32x4*)(c.XBC + (size_t)(b * SEQ + t) * 1536 + chx) : (u32x4){0u, 0u, 0u, 0u}; } \
        _Pragma("unroll") for (int pt = 0; pt < 2; ++pt) zz[pt] = *(const u32x2*)(c.MIX + (size_t)(b * SEQ + t0_ + lrow) * 2048 + h * 64 + ph * 32 + pt * 16 + 4 * fq); } while (0)
#define SSD_LOAD(CK) do { SSD_LOAD_B(CK); SSD_LOAD_C(CK); SSD_LOAD_T(CK); SSD_LOAD_X(CK); } while (0)
#define SSD_LOAD_DT(CK) do { if (tid < 64) { const size_t r = (size_t)(b * SEQ + (CK) * 128 + 2 * tid) * 16 + h; dr0 = c.DT[r]; dr1 = c.DT[r + 16]; } } while (0)
#define SSD_CUMSUM(BUF) do { if (tid < 64) { const float d0 = softplusf_(dr0 + dtb), d1 = softplusf_(dr1 + dtb); const float a1 = d1 * a_h; float s = d0 * a_h + a1; \
        _Pragma("unroll") for (int o = 1; o < 64; o <<= 1) { const float v = __shfl_up(s, o); if (lane >= o) s += v; } \
        csA[(BUF) * 128 + 2 * tid + 1] = s; csA[(BUF) * 128 + 2 * tid] = s - a1; dtA[(BUF) * 128 + 2 * tid] = d0; dtA[(BUF) * 128 + 2 * tid + 1] = d1; } } while (0)
    SSD_LOAD_DT(0);
    SSD_LOAD(0);
    SSD_CUMSUM(0);
    __syncthreads();
    for (int ck = 0; ck < 16; ++ck) {
        const int t0 = ck * 128;
        const float* cs = csA + (ck & 1) * 128; const float* dts = dtA + (ck & 1) * 128;
        if (ck < 15) SSD_LOAD_DT(ck + 1);
        {
#pragma unroll
            for (int pt = 0; pt < 2; ++pt)
#pragma unroll
                for (int e = 0; e < 4; ++e) *(bf16*)(Sb + (pt * 16 + 4 * fq + e) * RS + (16 * w + fr) * 2) = (bf16)pk2(accS[pt][e], 0.f);
        }
#pragma unroll
        for (int i = 0; i < 4; ++i) { *(u32x4*)(Bn + (prow + 32 * i) * RS + pc16 * 16) = rB[i]; *(u32x4*)(Cn + (prow + 32 * i) * RS + pc16 * 16) = rC[i]; *(u32x4*)(BT + (prow + 32 * i) * RS + pc16 * 16) = rT[i]; }
        {
            const float dl = dts[lx], ddl = dl * __expf(cs[127] - cs[lx]);
            float v[8];
#pragma unroll
            for (int hf = 0; hf < 2; ++hf) {
                f32x4 wk[5];
#pragma unroll
                for (int k = 0; k < 5; ++k) wk[k] = *(const f32x4*)(wx + k * 32 + ox * 8 + 4 * hf);
#pragma unroll
                for (int e = 0; e < 4; ++e) { const int ee = 4 * hf + e; float s = wk[4][e];
#pragma unroll
                    for (int k = 0; k < 4; ++k) { const unsigned wd = rx[k][ee >> 1]; s += wk[k][e] * ((ee & 1) ? bfhi(wd) : bflo(wd)); }
                    v[ee] = siluf_(s); }
            }
            *(u32x4*)(Xn + lx * 64 + ox * 16) = pack8((f32x4){v[0], v[1], v[2], v[3]}, (f32x4){v[4], v[5], v[6], v[7]});
#pragma unroll
            for (int e = 0; e < 8; ++e) { *(bf16*)(XT + (ox * 8 + e) * RS + lx * 2) = (bf16)pk2(v[e] * dl, 0.f); *(bf16*)(XdT + (ox * 8 + e) * RS + lx * 2) = (bf16)pk2(v[e] * ddl, 0.f); }
        }
        __syncthreads();
        const u32x2 zc0 = zz[0], zc1 = zz[1];
        if (ck < 15) SSD_LOAD_B(ck + 1);
        __builtin_amdgcn_sched_barrier(0);
        {
            const int l = lrow;
            const float csl = cs[l];
            bf16x8 cf[4];
#pragma unroll
            for (int kk = 0; kk < 4; ++kk) cf[kk] = *(const bf16x8*)(Cn + l * RS + (kk * 32 + fq * 8) * 2);
            f32x4 aoff[2], adiag[2];
            {
                bf16x8 sf[2][4];
#pragma unroll
                for (int pt = 0; pt < 2; ++pt)
#pragma unroll
                    for (int kk = 0; kk < 4; ++kk) sf[pt][kk] = *(const bf16x8*)(Sb + (pt * 16 + fr) * RS + (kk * 32 + fq * 8) * 2);
                aoff[0] = (f32x4){0.f, 0.f, 0.f, 0.f}; aoff[1] = aoff[0]; adiag[0] = aoff[0]; adiag[1] = aoff[0];
#pragma unroll
                for (int kk = 0; kk < 4; ++kk) { aoff[0] = __builtin_amdgcn_mfma_f32_16x16x32_bf16(sf[0][kk], cf[kk], aoff[0], 0, 0, 0); aoff[1] = __builtin_amdgcn_mfma_f32_16x16x32_bf16(sf[1][kk], cf[kk], aoff[1], 0, 0, 0); }
            }
            __builtin_amdgcn_sched_barrier(0);
            if (ck < 15) SSD_LOAD_C(ck + 1);
            __builtin_amdgcn_sched_barrier(0);
            for (int jp = 0; jp <= (w >> 1); ++jp) {
                const int j0 = 2 * jp, j1 = 2 * jp + 1;
                f32x4 g0 = (f32x4){0.f, 0.f, 0.f, 0.f}, g1 = g0;
                bf16x8 bf0[4], bf1[4];
#pragma unroll
                for (int kk = 0; kk < 4; ++kk) { bf0[kk] = *(const bf16x8*)(Bn + (16 * j0 + fr) * RS + (kk * 32 + fq * 8) * 2); bf1[kk] = *(const bf16x8*)(Bn + (16 * j1 + fr) * RS + (kk * 32 + fq * 8) * 2); }
                const u32x2 xa0 = *(const u32x2*)(XT + fr * RS + (16 * j0 + 4 * fq) * 2), xb0 = *(const u32x2*)(XT + fr * RS + (16 * j1 + 4 * fq) * 2);
                const u32x2 xa1 = *(const u32x2*)(XT + (16 + fr) * RS + (16 * j0 + 4 * fq) * 2), xb1 = *(const u32x2*)(XT + (16 + fr) * RS + (16 * j1 + 4 * fq) * 2);
#pragma unroll
                for (int kk = 0; kk < 4; ++kk) { g0 = __builtin_amdgcn_mfma_f32_16x16x32_bf16(bf0[kk], cf[kk], g0, 0, 0, 0); g1 = __builtin_amdgcn_mfma_f32_16x16x32_bf16(bf1[kk], cf[kk], g1, 0, 0, 0); }
                const f32x4 cs0 = *(const f32x4*)(cs + 16 * j0 + 4 * fq), cs1 = *(const f32x4*)(cs + 16 * j1 + 4 * fq);
                f32x4 m0, m1;
#pragma unroll
                for (int e = 0; e < 4; ++e) { const int s0 = 16 * j0 + 4 * fq + e, s1 = 16 * j1 + 4 * fq + e;
                    m0[e] = (s0 <= l) ? g0[e] * __expf(csl - cs0[e]) : 0.f; m1[e] = (s1 <= l) ? g1[e] * __expf(csl - cs1[e]) : 0.f; }
                const bf16x8 mB = __builtin_bit_cast(bf16x8, pack8(m0, m1));
                { u32x4 xv; xv.x = xa0.x; xv.y = xa0.y; xv.z = xb0.x; xv.w = xb0.y; adiag[0] = __builtin_amdgcn_mfma_f32_16x16x32_bf16(__builtin_bit_cast(bf16x8, xv), mB, adiag[0], 0, 0, 0); }
                { u32x4 xv; xv.x = xa1.x; xv.y = xa1.y; xv.z = xb1.x; xv.w = xb1.y; adiag[1] = __builtin_amdgcn_mfma_f32_16x16x32_bf16(__builtin_bit_cast(bf16x8, xv), mB, adiag[1], 0, 0, 0); }
            }
            __builtin_amdgcn_sched_barrier(0);
            if (ck < 15) SSD_LOAD_T(ck + 1);
            __builtin_amdgcn_sched_barrier(0);
            const float decT = __expf(cs[127]);
            {
                bf16x8 xf[2][4], tf[4];
#pragma unroll
                for (int kk = 0; kk < 4; ++kk) { tf[kk] = *(const bf16x8*)(BT + (16 * w + fr) * RS + (kk * 32 + fq * 8) * 2); xf[0][kk] = *(const bf16x8*)(XdT + fr * RS + (kk * 32 + fq * 8) * 2); xf[1][kk] = *(const bf16x8*)(XdT + (16 + fr) * RS + (kk * 32 + fq * 8) * 2); }
                accS[0] *= decT; accS[1] *= decT;
#pragma unroll
                for (int kk = 0; kk < 4; ++kk) { accS[0] = __builtin_amdgcn_mfma_f32_16x16x32_bf16(xf[0][kk], tf[kk], accS[0], 0, 0, 0); accS[1] = __builtin_amdgcn_mfma_f32_16x16x32_bf16(xf[1][kk], tf[kk], accS[1], 0, 0, 0); }
            }
            __builtin_amdgcn_sched_barrier(0);
            if (ck < 15) SSD_LOAD_X(ck + 1);
            __builtin_amdgcn_sched_barrier(0);
            const int row = b * SEQ + t0 + l;
            const float el = __expf(csl);
            float q = 0.f;
#pragma unroll
            for (int pt = 0; pt < 2; ++pt) {
                const u32x2 xr = *(const u32x2*)(Xn + l * 64 + (pt * 16 + 4 * fq) * 2);
                bf16* p = c.MIX + (size_t)row * 2048 + h * 64 + ph * 32 + pt * 16 + 4 * fq;
                const u32x2 zv = pt == 0 ? zc0 : zc1;
                const float y0 = (adiag[pt][0] + el * aoff[pt][0] + Dh * bflo(xr.x)) * bflo(zv.x);
                const float y1 = (adiag[pt][1] + el * aoff[pt][1] + Dh * bfhi(xr.x)) * bfhi(zv.x);
                const float y2 = (adiag[pt][2] + el * aoff[pt][2] + Dh * bflo(xr.y)) * bflo(zv.y);
                const float y3 = (adiag[pt][3] + el * aoff[pt][3] + Dh * bfhi(xr.y)) * bfhi(zv.y);
                u32x2 wv; wv.x = pk2(y0, y1); wv.y = pk2(y2, y3); *(u32x2*)p = wv;
                q += (y0 * y0 + y1 * y1) + (y2 * y2 + y3 * y3);
            }
            q += __shfl_xor(q, 16); q += __shfl_xor(q, 32);
            if (fq == 0) c.ssg[((size_t)(g * 16 + (h & 7) * 2 + ph)) * NP + row] = q;
        }
        if (ck < 15) SSD_CUMSUM((ck + 1) & 1);
        __syncthreads();
    }
#undef SSD_LOAD
#undef SSD_LOAD_B
#undef SSD_LOAD_C
#undef SSD_LOAD_T
#undef SSD_LOAD_X
#undef SSD_LOAD_DT
#undef SSD_CUMSUM
#pragma unroll
    for (int pt = 0; pt < 2; ++pt)
#pragma unroll
        for (int e = 0; e < 4; ++e) __builtin_nontemporal_store(accS[pt][e], c.out + O_SSM_P + ((size_t)(b * 16 + h) * 64 + ph * 32 + pt * 16 + 4 * fq + e) * 128 + 16 * w + fr);
}

__device__ __forceinline__ void gmlp_unit(const Ctx& c, int u, unsigned char* sm) {
    const int tid = threadIdx.x, lane = tid & 63, w = tid >> 6, fr = lane & 15, fq = lane >> 4;
    const int b = u >> 5, ck = (u >> 1) & 15, gh = u & 1;
    const int r0 = b * SEQ + ck * 128;
    float* stat = (float*)sm;
    unsigned char* vbase = sm + 1024;
    {
        u32x4 gq[16][2];
#pragma unroll
        for (int i = 0; i < 16; ++i) { const u32x4* gp = (const u32x4*)(c.GV + (size_t)(r0 + w * 16 + i) * 1024 + lane * 16); gq[i][0] = gp[0]; gq[i][1] = gp[1]; }
#pragma unroll
        for (int i = 0; i < 16; ++i) {
            const int tk = w * 16 + i;
            float f0[8], f1[8]; unpack8(gq[i][0], f0); unpack8(gq[i][1], f1);
            float s = 0.f, q = 0.f;
#pragma unroll
            for (int e = 0; e < 8; ++e) { s += f0[e] + f1[e]; q += f0[e] * f0[e] + f1[e] * f1[e]; }
            s = wave_sum(s); q = wave_sum(q);
            if (lane == 0) { const float mean = s * (1.f / 1024.f); const float var = fmaxf(q * (1.f / 1024.f) - mean * mean, 0.f); stat[tk * 2] = mean; stat[tk * 2 + 1] = rsqrtf(var + EPS); }
        }
    }
    u32x4 gva[2], gvb[2];
#define GMLP_LOADV(GRP) do { _Pragma("unroll") for (int it = 0; it < 2; ++it) { const int item = tid + 512 * it, sp = item & 63, d8 = item >> 6; \
        gva[it] = *(const u32x4*)(c.GV + (size_t)(r0 + 2 * sp) * 1024 + (GRP) * 128 + d8 * 8); gvb[it] = *(const u32x4*)(c.GV + (size_t)(r0 + 2 * sp + 1) * 1024 + (GRP) * 128 + d8 * 8); } } while (0)
    GMLP_LOADV(gh * 4);
    __syncthreads();
    for (int gi = 0; gi < 4; ++gi) {
        const int grp = gh * 4 + gi;
        unsigned char* vnT = vbase + (gi & 1) * 34816;
        const int t = 16 * w + fr, nk = (w >> 1) + 1;
        const float* wrow = c.gmlp_w_s + ((size_t)grp * 128 + t) * 128;
        f32x4 wq[4][2];
#pragma unroll
        for (int kk = 0; kk < 4; ++kk) { if (kk < nk) { wq[kk][0] = *(const f32x4*)(wrow + kk * 32 + fq * 8); wq[kk][1] = *(const f32x4*)(wrow + kk * 32 + fq * 8 + 4); } else { wq[kk][0] = (f32x4){0.f, 0.f, 0.f, 0.f}; wq[kk][1] = wq[kk][0]; } }
        bf16* mp = c.MIX + (size_t)(r0 + t) * 2048 + 1024 + grp * 128 + 4 * fq;
        u32x2 ugv[8];
#pragma unroll
        for (int dt = 0; dt < 8; ++dt) ugv[dt] = *(const u32x2*)(mp + dt * 16);
        const float bs = c.gmlp_b_s[grp * 128 + t];
#pragma unroll
        for (int it = 0; it < 2; ++it) {
            const int item = tid + 512 * it, sp = item & 63, d8 = item >> 6;
            const int s0 = 2 * sp, chn = grp * 128 + d8 * 8;
            float a[8], bq[8]; unpack8(gva[it], a); unpack8(gvb[it], bq);
            const float m0 = stat[s0 * 2], rs0 = stat[s0 * 2 + 1], m1 = stat[s0 * 2 + 2], rs1 = stat[s0 * 2 + 3];
            const f32x4 lg0 = *(const f32x4*)(c.gmlp_ln_g + chn), lg1 = *(const f32x4*)(c.gmlp_ln_g + chn + 4), lb0 = *(const f32x4*)(c.gmlp_ln_b + chn), lb1 = *(const f32x4*)(c.gmlp_ln_b + chn + 4);
#pragma unroll
            for (int e = 0; e < 8; ++e) { const float lg = e < 4 ? lg0[e & 3] : lg1[e & 3], lb = e < 4 ? lb0[e & 3] : lb1[e & 3];
                const float v0 = (a[e] - m0) * rs0 * lg + lb, v1 = (bq[e] - m1) * rs1 * lg + lb;
                *(unsigned*)(vnT + (d8 * 8 + e) * 272 + sp * 4) = pk2(v0, v1); }
        }
        if (gi < 3) GMLP_LOADV(grp + 1);
        __syncthreads();
        f32x4 acc[8];
#pragma unroll
        for (int dt = 0; dt < 8; ++dt) acc[dt] = (f32x4){0.f, 0.f, 0.f, 0.f};
#pragma unroll
        for (int kk = 0; kk < 4; ++kk) {
            if (kk < nk) {
                const int sb = kk * 32 + fq * 8;
                f32x4 m0, m1;
#pragma unroll
                for (int e = 0; e < 4; ++e) { m0[e] = (sb + e <= t) ? wq[kk][0][e] : 0.f; m1[e] = (sb + 4 + e <= t) ? wq[kk][1][e] : 0.f; }
                const bf16x8 wf = __builtin_bit_cast(bf16x8, pack8(m0, m1));
#pragma unroll
                for (int dt = 0; dt < 8; ++dt) {
                    const bf16x8 vf = *(const bf16x8*)(vnT + (dt * 16 + fr) * 272 + sb * 2);
                    acc[dt] = __builtin_amdgcn_mfma_f32_16x16x32_bf16(vf, wf, acc[dt], 0, 0, 0);
                }
            }
        }
#pragma unroll
        for (int dt = 0; dt < 8; ++dt) { const u32x2 ug = ugv[dt];
            u32x2 o; o.x = pk2((acc[dt][0] + bs) * bflo(ug.x), (acc[dt][1] + bs) * bfhi(ug.x)); o.y = pk2((acc[dt][2] + bs) * bflo(ug.y), (acc[dt][3] + bs) * bfhi(ug.y));
            *(u32x2*)(mp + dt * 16) = o; }
    }
#undef GMLP_LOADV
    __syncthreads();
}

__device__ __forceinline__ void sample_even_unit(const Ctx& c, int u, unsigned char* sm) {
    const int tid = threadIdx.x;
    const int bs = u >> 1, g = u & 1, row = NP + bs;
    float* xcs = (float*)sm;
    float* ygs = xcs + 768;
    float* red = ygs + 512;
    float* hsc = red + 8;
    const int p = tid >> 3, nq = tid & 7;
    f32x4 st[8][4];
#pragma unroll
    for (int hh = 0; hh < 8; ++hh)
#pragma unroll
        for (int j = 0; j < 4; ++j) st[hh][j] = __builtin_nontemporal_load((const f32x4*)(c.state_ssm + ((size_t)(bs * 16 + g * 8 + hh) * 64 + p) * 128 + j * 32 + nq * 4));
    const float* buf = c.state_ssd_conv + (size_t)bs * 3 * 1536;
    for (int i = tid; i < 768; i += 512) {
        const int ch = i < 512 ? g * 512 + i : (i < 640 ? 1024 + g * 128 + (i - 512) : 1280 + g * 128 + (i - 640));
        const float xn = bf2f(c.XBC[(size_t)row * 1536 + ch]);
        const float b0 = buf[ch], b1 = buf[1536 + ch], b2 = buf[2 * 1536 + ch];
        float s = c.ssd_conv_b[ch] + c.ssd_conv_w[ch] * b0 + c.ssd_conv_w[1536 + ch] * b1 + c.ssd_conv_w[2 * 1536 + ch] * b2 + c.ssd_conv_w[3 * 1536 + ch] * xn;
        xcs[i] = siluf_(s);
        float* so = c.out + O_SCONV_S + (size_t)bs * 3 * 1536;
        so[ch] = b1; so[1536 + ch] = b2; so[2 * 1536 + ch] = xn;
    }
    if (tid < 8) { const int h = g * 8 + tid; const float dt = softplusf_(c.DT[(size_t)row * 16 + h] + c.ssd_dt_bias[h]); hsc[tid * 4] = dt; hsc[tid * 4 + 1] = __expf(-dt * __expf(c.ssd_a_log[h])); hsc[tid * 4 + 2] = c.ssd_d[h]; }
    float zv[8];
    if (nq == 0) {
#pragma unroll
        for (int hh = 0; hh < 8; ++hh) zv[hh] = bf2f(c.MIX[(size_t)row * 2048 + (g * 8 + hh) * 64 + p]);
    }
    const unsigned gv2 = *(const unsigned*)(c.GV + (size_t)row * 1024 + 2 * tid);
    const int chn = g * 512 + tid, grp = chn >> 7;
    const float gvc = bf2f(c.GV[(size_t)row * 1024 + chn]), lng = c.gmlp_ln_g[chn], lnb = c.gmlp_ln_b[chn], ws0 = c.gmlp_w_s[(size_t)grp * 128 * 128], bs0 = c.gmlp_b_s[grp * 128];
    bf16* mpu = c.MIX + (size_t)row * 2048 + 1024 + chn;
    const float ugv = bf2f(*mpu);
    __syncthreads();
    f32x4 bv[4], cv[4];
#pragma unroll
    for (int j = 0; j < 4; ++j) { bv[j] = *(const f32x4*)(xcs + 512 + j * 32 + nq * 4); cv[j] = *(const f32x4*)(xcs + 640 + j * 32 + nq * 4); }
#pragma unroll
    for (int hh = 0; hh < 8; ++hh) {
        const int h = g * 8 + hh;
        const size_t so = ((size_t)(bs * 16 + h) * 64 + p) * 128 + nq * 4;
        const float dt = hsc[hh * 4], dA = hsc[hh * 4 + 1];
        const float xv = xcs[hh * 64 + p], dtx = dt * xv;
        float y = 0.f;
#pragma unroll
        for (int j = 0; j < 4; ++j) {
            f32x4 hn;
#pragma unroll
            for (int e = 0; e < 4; ++e) { hn[e] = dA * st[hh][j][e] + dtx * bv[j][e]; y += cv[j][e] * hn[e]; }
            __builtin_nontemporal_store(hn, (f32x4*)(c.out + O_SSM_S + so + 32 * j));
        }
        y += __shfl_xor(y, 1); y += __shfl_xor(y, 2); y += __shfl_xor(y, 4);
        if (nq == 0) { y += hsc[hh * 4 + 2] * xv; ygs[hh * 64 + p] = y * zv[hh]; }
    }
    __syncthreads();
    {
        const float v = ygs[tid];
        const float q = block_sum(v * v, red);
        c.MIX[(size_t)row * 2048 + g * 512 + tid] = (bf16)pk2(v * rsqrtf(q * (1.f / 512.f) + EPS), 0.f);
    }
    {
        const float a0 = bflo(gv2), a1 = bfhi(gv2);
        const float s = block_sum(a0 + a1, red);
        const float q = block_sum(a0 * a0 + a1 * a1, red);
        const float mean = s * (1.f / 1024.f), rstd = rsqrtf(fmaxf(q * (1.f / 1024.f) - mean * mean, 0.f) + EPS);
        const float vn = (gvc - mean) * rstd * lng + lnb;
        c.out[O_GV_S + (size_t)bs * 1024 + chn] = vn;
        *mpu = (bf16)pk2(ugv * (ws0 * vn + bs0), 0.f);
    }
    __syncthreads();
}

__device__ __forceinline__ void p2_even_mixers(const Ctx& c, unsigned char* sm) {
    const int G = gridDim.x, bx = blockIdx.x;
    for (int u = bx; u < 256; u += G) ssd_chunk_unit(c, u, sm);
    for (int u = bx; u < 256; u += G) gmlp_unit(c, u, sm);
    for (int u = bx; u < 256; u += G) sample_even_unit(c, u, sm);
    for (int i = bx * 512 + threadIdx.x; i < 8 * 3 * 1536; i += G * 512) { const int b = i / (3 * 1536), r = i % (3 * 1536), k = r / 1536, ch = r % 1536;
        c.out[O_SCONV_P + i] = bf2f(c.XBC[(size_t)(b * SEQ + SEQ - 3 + k) * 1536 + ch]); }
}

template <bool L0> __device__ __forceinline__ void sample_outproj(const bf16* A, const bf16* Wt, const float* xold, bf16* XNs, bf16* X2s, float* ss, unsigned char* sm) {
    const int tid = threadIdx.x, lane = tid & 63, w = tid >> 6, fr = lane & 15, fq = lane >> 4;
    f32x4* red = (f32x4*)sm;
    for (int u = blockIdx.x; u < 256; u += gridDim.x) {
        const int tg = u & 7, cgp = u >> 3;
        const bf16* ap = A + (size_t)(tg * 16 + fr) * 2048 + w * 256 + fq * 8;
        const bf16* bp0 = Wt + (size_t)(cgp * 32 + fr) * 2048 + w * 256 + fq * 8;
        const bf16* bp1 = bp0 + 16 * 2048;
        f32x4 a0 = (f32x4){0.f, 0.f, 0.f, 0.f}, a1 = a0;
#pragma unroll
        for (int kk = 0; kk < 8; ++kk) {
            const bf16x8 af = *(const bf16x8*)(ap + kk * 32), b0 = *(const bf16x8*)(bp0 + kk * 32), b1 = *(const bf16x8*)(bp1 + kk * 32);
            a0 = __builtin_amdgcn_mfma_f32_16x16x32_bf16(b0, af, a0, 0, 0, 0);
            a1 = __builtin_amdgcn_mfma_f32_16x16x32_bf16(b1, af, a1, 0, 0, 0);
        }
        red[(w * 2 + 0) * 64 + lane] = a0; red[(w * 2 + 1) * 64 + lane] = a1;
        __syncthreads();
        if (tid < 128) {
            const int ct = tid >> 6;
            f32x4 s = (f32x4){0.f, 0.f, 0.f, 0.f};
#pragma unroll
            for (int w2 = 0; w2 < 8; ++w2) s += red[(w2 * 2 + ct) * 64 + lane];
            const int trow = tg * 16 + fr, col = cgp * 32 + ct * 16 + 4 * fq;
            const size_t off = (size_t)trow * 1024 + col;
            if (L0) {
                const f32x4 v = *(const f32x4*)(xold + off) + s;
                u32x2 wv; wv.x = pk2(v[0], v[1]); wv.y = pk2(v[2], v[3]); *(u32x2*)(XNs + off) = wv;
                float q = (v[0] * v[0] + v[1] * v[1]) + (v[2] * v[2] + v[3] * v[3]);
                q += __shfl_xor(q, 16); q += __shfl_xor(q, 32);
                if (fq == 0) atomicAdd(ss + (size_t)(cgp >> 3) * MP + trow, q);
            } else {
                const u32x2 xw = *(const u32x2*)(XNs + off);
                const f32x4 v = (f32x4){bflo(xw.x), bfhi(xw.x), bflo(xw.y), bfhi(xw.y)} + s;
                u32x2 wv; wv.x = pk2(v[0], v[1]); wv.y = pk2(v[2], v[3]); *(u32x2*)(X2s + off) = wv;
            }
        }
        __syncthreads();
    }
}

__device__ __forceinline__ void ccv_unit(const Ctx& c, int u, unsigned char* sm) {
    const int tid = threadIdx.x, lane = tid & 63, wv = tid >> 6;
    const int b = u >> 5, t0 = (u & 31) * 64, ch = 2 * tid;
    float* red = (float*)sm;
    f32x2 w[31];
#pragma unroll
    for (int k = 0; k < 31; ++k) w[k] = *(const f32x2*)(c.ccv_w + k * 1024 + ch);
    const f32x2 bias = *(const f32x2*)(c.ccv_b + ch), lg = *(const f32x2*)(c.ccv_ln_g + ch), lb = *(const f32x2*)(c.ccv_ln_b + ch);
    unsigned gwin[38];
#pragma unroll
    for (int j = 0; j < 38; ++j) { const int t = t0 - 30 + j; gwin[j] = (t >= 0) ? *(const unsigned*)(c.GLU + (size_t)(b * SEQ + t) * 1024 + ch) : 0u; }
    for (int og = 0; og < 8; ++og) {
        unsigned nxt[8], gcv[8];
#pragma unroll
        for (int j = 0; j < 8; ++j) { gcv[j] = *(const unsigned*)(c.MIX + (size_t)(b * SEQ + t0 + og * 8 + j) * 2048 + ch);
            nxt[j] = (og < 7) ? *(const unsigned*)(c.GLU + (size_t)(b * SEQ + t0 + og * 8 + 8 + j) * 1024 + ch) : 0u; }
        f32x2 acc[8];
#pragma unroll
        for (int o = 0; o < 8; ++o) acc[o] = bias;
#pragma unroll
        for (int j = 0; j < 38; ++j) {
            const f32x2 gl = (f32x2){bflo(gwin[j]), bfhi(gwin[j])};
#pragma unroll
            for (int o = 0; o < 8; ++o) { const int k = j - o; if (k >= 0 && k <= 30) acc[o] += w[k] * gl; }
        }
        float* rb = red + (og & 1) * 512;
        {
            float mine = 0.f;
#pragma unroll
            for (int o = 0; o < 8; ++o) { const float s = row16_sum(acc[o][0] + acc[o][1]), q = row16_sum(acc[o][0] * acc[o][0] + acc[o][1] * acc[o][1]);
                mine = ((lane & 15) == o) ? s : mine; mine = ((lane & 15) == 8 + o) ? q : mine; }
            rb[(wv * 4 + (lane >> 4)) * 16 + (lane & 15)] = mine;
        }
        __syncthreads();
        float tot;
        {
            float s = 0.f;
#pragma unroll
            for (int i = 0; i < 8; ++i) s += rb[((lane >> 4) * 8 + i) * 16 + (lane & 15)];
            s += __shfl_xor(s, 16); s += __shfl_xor(s, 32);
            tot = s;
        }
#pragma unroll
        for (int o = 0; o < 8; ++o) {
            const float s = __builtin_bit_cast(float, __builtin_amdgcn_readlane(__builtin_bit_cast(int, tot), o)), q = __builtin_bit_cast(float, __builtin_amdgcn_readlane(__builtin_bit_cast(int, tot), 8 + o));
            const float mean = s * (1.f / 1024.f), rstd = rsqrtf(fmaxf(q * (1.f / 1024.f) - mean * mean, 0.f) + EPS);
            const float y0 = siluf_((acc[o][0] - mean) * rstd * lg[0] + lb[0]), y1 = siluf_((acc[o][1] - mean) * rstd * lg[1] + lb[1]);
            *(unsigned*)(c.MIX + (size_t)(b * SEQ + t0 + og * 8 + o) * 2048 + ch) = pk2(y0 * bflo(gcv[o]), y1 * bfhi(gcv[o]));
        }
#pragma unroll
        for (int j = 0; j < 30; ++j) gwin[j] = gwin[j + 8];
#pragma unroll
        for (int j = 0; j < 8; ++j) gwin[30 + j] = nxt[j];
    }
    __syncthreads();
}
__device__ __forceinline__ void ccv_sample_unit(const Ctx& c, int bs, unsigned char* sm) {
    const int tid = threadIdx.x, ch = 2 * tid, row = NP + bs;
    float* red = (float*)sm;
    const float* buf = c.state_ccv + (size_t)bs * 30 * 1024;
    const unsigned gw = *(const unsigned*)(c.GLU + (size_t)row * 1024 + ch);
    const f32x2 gl = (f32x2){bflo(gw), bfhi(gw)};
    f32x2 acc = *(const f32x2*)(c.ccv_b + ch);
    float* so = c.out + O_CCV_S + (size_t)bs * 30 * 1024;
    unsigned* mp = (unsigned*)(c.MIX + (size_t)row * 2048 + ch);
    const unsigned gc = *mp;
    const f32x2 lg = *(const f32x2*)(c.ccv_ln_g + ch), lb = *(const f32x2*)(c.ccv_ln_b + ch);
    f32x2 bvv[30], wv[31];
#pragma unroll
    for (int k = 0; k < 30; ++k) bvv[k] = __builtin_nontemporal_load((const f32x2*)(buf + k * 1024 + ch));
#pragma unroll
    for (int k = 0; k < 31; ++k) wv[k] = *(const f32x2*)(c.ccv_w + k * 1024 + ch);
#pragma unroll
    for (int k = 0; k < 30; ++k) acc += wv[k] * bvv[k];
    acc += wv[30] * gl;
#pragma unroll
    for (int k = 1; k < 30; ++k) __builtin_nontemporal_store(bvv[k], (f32x2*)(so + (k - 1) * 1024 + ch));
    *(f32x2*)(so + 29 * 1024 + ch) = gl;
    const float s = block_sum(acc[0] + acc[1], red);
    const float q = block_sum(acc[0] * acc[0] + acc[1] * acc[1], red);
    const float mean = s * (1.f / 1024.f), rstd = rsqrtf(fmaxf(q * (1.f / 1024.f) - mean * mean, 0.f) + EPS);
    const float y0 = siluf_((acc[0] - mean) * rstd * lg[0] + lb[0]), y1 = siluf_((acc[1] - mean) * rstd * lg[1] + lb[1]);
    *mp = pk2(y0 * bflo(gc), y1 * bfhi(gc));
    __syncthreads();
}

__device__ __forceinline__ float neg_expm1_fast(float x) {
    const float p = -x * (1.f + x * (0.5f + x * (0.16666667f + x * (0.041666668f + x * 0.0083333338f))));
    return x > -0.25f ? p : 1.f - __expf(x);
}
__device__ __forceinline__ void lru_unit(const Ctx& c, int u, unsigned char* sm) {
    const int tid = threadIdx.x, lane = tid & 63, w = tid >> 6, fr = lane & 15, fq = lane >> 4;
    const int pairi = (u & 7) * 16 + ((u >> 3) >> 1), jh = (u >> 3) & 1;
    const int b = pairi >> 4, h = pairi & 15;
    unsigned char* xcb = sm;
    float* as = (float*)(sm + 36864);
    float* bs = (float*)(sm + 69632);
    float* Pseg = (float*)(sm + 102400);
    float* Hseg = (float*)(sm + 104448);
    float* hcar = (float*)(sm + 106496);
    bf16x8 wfa[2][2], wfx[2][2];
#pragma unroll
    for (int ct = 0; ct < 2; ++ct)
#pragma unroll
        for (int kk = 0; kk < 2; ++kk) { float fa[8], fx[8];
#pragma unroll
            for (int e = 0; e < 8; ++e) { const size_t o = ((size_t)h * 64 + kk * 32 + fq * 8 + e) * 64 + jh * 32 + ct * 16 + fr; fa[e] = c.lru_wa[o]; fx[e] = c.lru_wx[o]; }
            u32x4 pa, px; pa.x = pk2(fa[0], fa[1]); pa.y = pk2(fa[2], fa[3]); pa.z = pk2(fa[4], fa[5]); pa.w = pk2(fa[6], fa[7]); px.x = pk2(fx[0], fx[1]); px.y = pk2(fx[2], fx[3]); px.z = pk2(fx[4], fx[5]); px.w = pk2(fx[6], fx[7]);
            wfa[ct][kk] = __builtin_bit_cast(bf16x8, pa); wfx[ct][kk] = __builtin_bit_cast(bf16x8, px); }
    float ba[2], bx[2], sp[2];
#pragma unroll
    for (int ct = 0; ct < 2; ++ct) { const int j = h * 64 + jh * 32 + ct * 16 + fr; ba[ct] = c.lru_ba[j]; bx[ct] = c.lru_bx[j]; sp[ct] = softplusf_(-c.lru_lambda[j]); }
    const int o8 = tid & 7, run = tid >> 3, chc = h * 64 + o8 * 8;
    float* wtab = (float*)(sm + 106752);
    if (tid < 320) { const int k = tid >> 6, cc = tid & 63; wtab[tid] = k < 4 ? c.lru_conv_w[k * 1024 + h * 64 + cc] : c.lru_conv_b[h * 64 + cc]; }
    __syncthreads();
    const int jl = tid & 31, sgm = tid >> 5;
    const int tl4 = tid >> 2, c8 = (tid & 3) * 8;
    u32x4 rw[7], gdv[2];
#define LRU_LOAD(TILE) do { const int t0_ = (TILE) * 256; \
        _Pragma("unroll") for (int j = 0; j < 7; ++j) { const int t = t0_ + 4 * run - 3 + j; rw[j] = (t >= 0) ? *(const u32x4*)(c.XD + (size_t)(b * SEQ + t) * 1024 + chc) : (u32x4){0u, 0u, 0u, 0u}; } \
        _Pragma("unroll") for (int i = 0; i < 2; ++i) gdv[i] = *(const u32x4*)(c.MIX + (size_t)(b * SEQ + t0_ + tl4 + 128 * i) * 2048 + 1024 + h * 64 + jh * 32 + c8); } while (0)
    LRU_LOAD(0);
    if (tid < 32) hcar[tid] = 0.f;
    for (int tile = 0; tile < 8; ++tile) {
        const int t0 = tile * 256;
        {
#pragma unroll
            for (int hf = 0; hf < 2; ++hf) {
                f32x4 wk[5];
#pragma unroll
                for (int k = 0; k < 5; ++k) wk[k] = *(const f32x4*)(wtab + k * 64 + o8 * 8 + 4 * hf);
#pragma unroll
                for (int i = 0; i < 4; ++i) { float r4[4];
#pragma unroll
                    for (int e = 0; e < 4; ++e) { const int ee = 4 * hf + e; float s = wk[4][e];
#pragma unroll
                        for (int k = 0; k < 4; ++k) { const unsigned wd = rw[i + k][ee >> 1]; s += wk[k][e] * ((ee & 1) ? bfhi(wd) : bflo(wd)); }
                        r4[e] = s; }
                    u32x2 o; o.x = pk2(r4[0], r4[1]); o.y = pk2(r4[2], r4[3]); *(u32x2*)(xcb + (4 * run + i) * 144 + o8 * 16 + hf * 8) = o; }
            }
        }
        __syncthreads();
        const u32x4 gdc0 = gdv[0], gdc1 = gdv[1];
        if (tile < 7) LRU_LOAD(tile + 1);
#pragma unroll
        for (int rt = 0; rt < 2; ++rt) {
            const int tb = 32 * w + 16 * rt;
            bf16x8 af[2];
#pragma unroll
            for (int kk = 0; kk < 2; ++kk) af[kk] = *(const bf16x8*)(xcb + (tb + fr) * 144 + (kk * 32 + fq * 8) * 2);
#pragma unroll
            for (int ct = 0; ct < 2; ++ct) {
                f32x4 dr = (f32x4){0.f, 0.f, 0.f, 0.f}, di = dr;
#pragma unroll
                for (int kk = 0; kk < 2; ++kk) { dr = __builtin_amdgcn_mfma_f32_16x16x32_bf16(af[kk], wfa[ct][kk], dr, 0, 0, 0); di = __builtin_amdgcn_mfma_f32_16x16x32_bf16(af[kk], wfx[ct][kk], di, 0, 0, 0); }
#pragma unroll
                for (int e = 0; e < 4; ++e) {
                    const int tl = tb + 4 * fq + e, jj = ct * 16 + fr;
                    const float r = sigmoidf_(dr[e] + ba[ct]), ig = sigmoidf_(di[e] + bx[ct]);
                    const float la = -8.f * r * sp[ct];
                    const float a = __expf(la);
                    const float xv = bf2f(*(const bf16*)(xcb + tl * 144 + (jh * 32 + jj) * 2));
                    const float bt = sqrtf(fmaxf(neg_expm1_fast(2.f * la), 0.f)) * (ig * xv);
                    as[tl * 32 + jj] = a; bs[tl * 32 + jj] = bt;
                }
            }
        }
        __syncthreads();
        {
            float p = 1.f, hl = 0.f;
#pragma unroll
            for (int i = 0; i < 16; ++i) { const int t = 16 * sgm + i; const float a = as[t * 32 + jl]; hl = fmaf(a, hl, bs[t * 32 + jl]); p *= a; as[t * 32 + jl] = p; bs[t * 32 + jl] = hl; }
            Pseg[sgm * 32 + jl] = p; Hseg[sgm * 32 + jl] = hl;
        }
        __syncthreads();
        {
            float cin = hcar[(tile & 1) * 32 + jl];
#pragma unroll
            for (int s2 = 0; s2 < 15; ++s2) { const float nc = fmaf(Pseg[s2 * 32 + jl], cin, Hseg[s2 * 32 + jl]); cin = (s2 < sgm) ? nc : cin; }
            if (sgm == 15) hcar[((tile + 1) & 1) * 32 + jl] = fmaf(Pseg[15 * 32 + jl], cin, Hseg[15 * 32 + jl]);
#pragma unroll
            for (int i = 0; i < 16; ++i) { const int t = 16 * sgm + i; bs[t * 32 + jl] = fmaf(as[t * 32 + jl], cin, bs[t * 32 + jl]); }
        }
        __syncthreads();
#pragma unroll
        for (int i = 0; i < 2; ++i) {
            const int tl = tl4 + 128 * i;
            u32x4* mp = (u32x4*)(c.MIX + (size_t)(b * SEQ + t0 + tl) * 2048 + 1024 + h * 64 + jh * 32 + c8);
            float gd[8]; unpack8(i == 0 ? gdc0 : gdc1, gd);
            const f32x4 h0 = *(const f32x4*)(bs + tl * 32 + c8), h1 = *(const f32x4*)(bs + tl * 32 + c8 + 4);
            *mp = pack8((f32x4){h0[0] * gd[0], h0[1] * gd[1], h0[2] * gd[2], h0[3] * gd[3]}, (f32x4){h1[0] * gd[4], h1[1] * gd[5], h1[2] * gd[6], h1[3] * gd[7]});
        }
    }
#undef LRU_LOAD
    __syncthreads();
    if (tid < 32) {
        const int j = h * 64 + jh * 32 + tid;
        c.out[O_LRU_P + (size_t)b * 1024 + j] = hcar[tid];
#pragma unroll
        for (int k = 0; k < 3; ++k) c.out[O_LCONV_P + ((size_t)b * 3 + k) * 1024 + j] = bf2f(c.XD[(size_t)(b * SEQ + SEQ - 3 + k) * 1024 + j]);
    }
    __syncthreads();
}
__device__ __forceinline__ void lru_sample_unit(const Ctx& c, int u, unsigned char* sm) {
    const int tid = threadIdx.x, h = u >> 3, tg = u & 7;
    float* wal = (float*)sm;
    float* wxl = wal + 4096;
    float* xcs = wxl + 4096;
    const int tk = tid >> 5, jq = tid & 31, bs = tg * 16 + tk, row = NP + bs, j0 = h * 64 + 2 * jq;
    const f32x2 h0 = *(const f32x2*)(c.state_lru + (size_t)bs * 1024 + j0);
    unsigned* mp = (unsigned*)(c.MIX + (size_t)row * 2048 + 1024 + j0);
    const unsigned gdw = *mp;
    const f32x2 bav = *(const f32x2*)(c.lru_ba + j0), bxv = *(const f32x2*)(c.lru_bx + j0), lam = *(const f32x2*)(c.lru_lambda + j0);
#pragma unroll
    for (int i = 0; i < 2; ++i) { const int idx = tid + 512 * i; ((f32x4*)wal)[idx] = ((const f32x4*)(c.lru_wa + (size_t)h * 4096))[idx]; ((f32x4*)wxl)[idx] = ((const f32x4*)(c.lru_wx + (size_t)h * 4096))[idx]; }
#pragma unroll
    for (int it = 0; it < 2; ++it) {
        const int item = tid + 512 * it, t2 = item >> 6, cc = item & 63, bs2 = tg * 16 + t2, ch = h * 64 + cc;
        const float* buf = c.state_lru_conv + (size_t)bs2 * 3 * 1024;
        const float xn = bf2f(c.XD[(size_t)(NP + bs2) * 1024 + ch]);
        const float b0 = buf[ch], b1 = buf[1024 + ch], b2 = buf[2048 + ch];
        xcs[t2 * 64 + cc] = c.lru_conv_b[ch] + c.lru_conv_w[ch] * b0 + c.lru_conv_w[1024 + ch] * b1 + c.lru_conv_w[2048 + ch] * b2 + c.lru_conv_w[3072 + ch] * xn;
        float* so = c.out + O_LCONV_S + (size_t)bs2 * 3 * 1024;
        so[ch] = b1; so[1024 + ch] = b2; so[2048 + ch] = xn;
    }
    __syncthreads();
    f32x2 sr = bav, si = bxv;
#pragma unroll 16
    for (int ii = 0; ii < 64; ++ii) { const float xv = xcs[tk * 64 + ii]; const f32x2 a2 = *(const f32x2*)(wal + ii * 64 + 2 * jq), x2 = *(const f32x2*)(wxl + ii * 64 + 2 * jq); sr += a2 * xv; si += x2 * xv; }
    float hn[2];
#pragma unroll
    for (int e = 0; e < 2; ++e) {
        const float r = sigmoidf_(sr[e]), ig = sigmoidf_(si[e]);
        const float la = -8.f * r * softplusf_(-lam[e]);
        const float a = __expf(la);
        hn[e] = a * h0[e] + sqrtf(fmaxf(neg_expm1_fast(2.f * la), 0.f)) * (ig * xcs[tk * 64 + 2 * jq + e]);
    }
    *(f32x2*)(c.out + O_LRU_S + (size_t)bs * 1024 + j0) = (f32x2){hn[0], hn[1]};
    *mp = pk2(hn[0] * bflo(gdw), hn[1] * bfhi(gdw));
    __syncthreads();
}
__device__ __forceinline__ void p5_odd_mixers(const Ctx& c, unsigned char* sm) {
    const int G = gridDim.x, bx = blockIdx.x;
    for (int u = bx; u < 256; u += G) lru_unit(c, u, sm);
    for (int u = bx; u < 256; u += G) ccv_unit(c, u, sm);
    for (int u = bx; u < 256; u += G) { if (u < 128) ccv_sample_unit(c, u, sm); else lru_sample_unit(c, u - 128, sm); }
}

__device__ __forceinline__ void p7_final_norm(const Ctx& c) {
    const int lane = threadIdx.x & 63, gw = blockIdx.x * 8 + (threadIdx.x >> 6), NGW = gridDim.x * 8;
    f32x4 fn[4];
#pragma unroll
    for (int j = 0; j < 4; ++j) fn[j] = ((const f32x4*)c.final_norm)[lane + 64 * j];
    for (int m = gw; m < NT; m += NGW) {
        const u32x2* xr = (const u32x2*)(c.X2b + (size_t)m * 1024);
        f32x4 v[4]; float s = 0.f;
#pragma unroll
        for (int j = 0; j < 4; ++j) { const u32x2 xw = __builtin_nontemporal_load(xr + lane + 64 * j); v[j] = (f32x4){bflo(xw.x), bfhi(xw.x), bflo(xw.y), bfhi(xw.y)}; s += (v[j][0] * v[j][0] + v[j][1] * v[j][1]) + (v[j][2] * v[j][2] + v[j][3] * v[j][3]); }
        const float rstd = rsqrtf(wave_sum(s) * (1.f / 1024.f) + EPS);
        f32x4* yo = (f32x4*)(c.out + (size_t)m * 1024);
#pragma unroll
        for (int j = 0; j < 4; ++j) __builtin_nontemporal_store(v[j] * rstd * fn[j], yo + lane + 64 * j);
    }
}

#ifndef MK_COOP
#define MK_COOP 1
#endif
struct Params { const float* in[35]; float* out; unsigned char* ws; int lo, hi; };
constexpr int N_PHASES = 8;

__global__ void __launch_bounds__(512, 2) hybrid_fwd(Params P) {
    extern __shared__ __attribute__((aligned(16))) unsigned char lds[];
    Ctx c;
    c.x_prompt = P.in[0]; c.x_sample = P.in[1]; c.state_ssm = P.in[2]; c.state_ssd_conv = P.in[3]; c.state_ccv = P.in[4]; c.state_lru_conv = P.in[5]; c.state_lru = P.in[6];
    c.norm_even = P.in[7]; c.w_in_even = P.in[8]; c.ssd_conv_w = P.in[9]; c.ssd_conv_b = P.in[10]; c.ssd_dt_bias = P.in[11]; c.ssd_a_log = P.in[12]; c.ssd_d = P.in[13]; c.ssd_norm = P.in[14];
    c.gmlp_ln_g = P.in[15]; c.gmlp_ln_b = P.in[16]; c.gmlp_w_s = P.in[17]; c.gmlp_b_s = P.in[18]; c.w_out_even = P.in[19];
    c.norm_odd = P.in[20]; c.w_in_odd = P.in[21]; c.ccv_w = P.in[22]; c.ccv_b = P.in[23]; c.ccv_ln_g = P.in[24]; c.ccv_ln_b = P.in[25];
    c.lru_conv_w = P.in[26]; c.lru_conv_b = P.in[27]; c.lru_wa = P.in[28]; c.lru_ba = P.in[29]; c.lru_wx = P.in[30]; c.lru_bx = P.in[31]; c.lru_lambda = P.in[32]; c.w_out_odd = P.in[33]; c.final_norm = P.in[34];
    c.out = P.out;
    unsigned char* ws = P.ws;
    c.ss0 = (float*)(ws + WS_SS0); c.ss1 = (float*)(ws + WS_SS1); c.DT = (float*)(ws + WS_DT); c.ssg = (float*)(ws + WS_SSG); c.xcnt = (unsigned*)(ws + WS_XCNT);
    c.W1t = (bf16*)(ws + WS_W1); c.W2t = (bf16*)(ws + WS_W2); c.W3t = (bf16*)(ws + WS_W3); c.W4t = (bf16*)(ws + WS_W4);
    c.XN = (bf16*)(ws + WS_XN); c.MIX = (bf16*)(ws + WS_MIX); c.XBC = (bf16*)(ws + WS_XBC); c.GV = (bf16*)(ws + WS_GV); c.GLU = (bf16*)(ws + WS_XBC); c.XD = (bf16*)(ws + WS_GV); c.BCn = (bf16*)(ws + WS_BCN); c.BTg = (bf16*)(ws + WS_BTG); c.X2b = (bf16*)(ws + WS_BCN);
    PG8_LAS unsigned char* l3 = (PG8_LAS unsigned char*)lds;
    const int lo = P.lo, hi = P.hi;
#ifdef PROBE_A
    unsigned long long ts[16];
#define STAMP(k) ts[k] = __builtin_amdgcn_s_memrealtime()
#else
#define STAMP(k) do { } while (0)
#endif
    STAMP(0);
#define IN(k) (lo <= (k) && (k) < hi)
#if MK_COOP
#define SEAM(k) do { if (IN(k) && IN((k) + 1)) cg::this_grid().sync(); } while (0)
#else
#define SEAM(k) do { } while (0)
#endif
    if (IN(0)) { p0_prologue(c, lds); } SEAM(0); STAMP(1);
    if (IN(1)) {
        pg8::Gemm g{c.XN, c.W1t, MP, N1, 1024}; pg8::StaticOrder S; S.init(MP, N1, (int)gridDim.x, (int)blockIdx.x);
        Epi1 E{c.ss0, c.MIX, c.XBC, c.GV, c.DT};
        pg8::gemm_phase<Epi1, pg8::StaticOrder, NoHook, true, true>(l3, g, S, E, NoHook{});
    } SEAM(1); STAMP(2);
    if (IN(2)) {
        const int G = gridDim.x, bx = blockIdx.x;
        {
            if (threadIdx.x == 0) { const unsigned x = (unsigned)__builtin_amdgcn_s_getreg((3 << 11) | 20) & 7u; const unsigned i = __hip_atomic_fetch_add(c.xcnt + x, 1u, __ATOMIC_RELAXED, __HIP_MEMORY_SCOPE_AGENT); *(unsigned*)(lds + 147300) = x | (i << 8); }
            __syncthreads();
        }
        bc_prepass(c);
        STAMP(9);
        for (int u = bx; u < 256; u += G) gmlp_unit(c, u, lds);
        STAMP(10);
        for (int u = bx; u < 256; u += G) sample_even_unit(c, u, lds);
        STAMP(11);
        for (int i = bx * 512 + threadIdx.x; i < 8 * 3 * 1536; i += G * 512) { const int b = i / (3 * 1536), r = i % (3 * 1536), k = r / 1536, ch = r % 1536;
            c.out[O_SCONV_P + i] = bf2f(c.XBC[(size_t)(b * SEQ + SEQ - 3 + k) * 1536 + ch]); }
    } SEAM(2); STAMP(3);
    {
        if (gridDim.x == 256) {
            const unsigned clm = *(const unsigned*)(lds + 147300);
            const int ssd_xcc = __builtin_amdgcn_readfirstlane((int)(clm & 255u)), ssd_idx = __builtin_amdgcn_readfirstlane((int)(clm >> 8));
            int x = ssd_xcc, i = ssd_idx;
            if (i >= 32) {
                int r = i - 32;
                for (int x2 = 0; x2 < 8; ++x2) { const int c2 = (int)__hip_atomic_load(c.xcnt + x2, __ATOMIC_RELAXED, __HIP_MEMORY_SCOPE_AGENT); if (x2 < ssd_xcc && c2 > 32) r += c2 - 32; }
                for (int x2 = 0; x2 < 8; ++x2) { int c2 = (int)__hip_atomic_load(c.xcnt + x2, __ATOMIC_RELAXED, __HIP_MEMORY_SCOPE_AGENT); c2 = c2 < 32 ? c2 : 32; if (r < 32 - c2) { x = x2; i = c2 + r; break; } r -= 32 - c2; }
            }
            ssd_chunk_unit(c, x * 32 + i, lds);
        } else { const int G = gridDim.x, bx = blockIdx.x; for (int u = bx; u < 256; u += G) ssd_chunk_unit(c, u, lds); }
        cg::this_grid().sync(); STAMP(15);
    }
    if (IN(3)) {
        sample_outproj<true>(c.MIX + (size_t)NP * 2048, c.W2t, c.x_sample, c.XN + (size_t)NP * 1024, nullptr, c.ss1 + (size_t)NP, lds);
        pg8::Gemm g{c.MIX, c.W2t, NP, 1024, 2048}; pg8::StaticOrder S; S.init(NP, 1024, (int)gridDim.x, (int)blockIdx.x);
        Unit u0;
        if (S.next(0, u0)) {
            float* tab = (float*)(lds + 131072);
            if (threadIdx.x < 256) { const float* sp = c.ssg + (size_t)(u0.pm * 256 + threadIdx.x); float s0 = 0.f, s1 = 0.f;
#pragma unroll
                for (int i = 0; i < 16; ++i) { s0 += sp[(size_t)i * NP]; s1 += sp[(size_t)(16 + i) * NP]; }
                const float r0 = rsqrtf(s0 * (1.f / 512.f) + EPS), r1 = rsqrtf(s1 * (1.f / 512.f) + EPS);
                tab[threadIdx.x * 2] = r0 / r1; tab[threadIdx.x * 2 + 1] = r1; }
        }
        __syncthreads();
        EpiOut<true> E{c.x_prompt, c.XN, nullptr, c.ss1};
        HookScale H{(const LAS3 float*)(l3 + 131072)};
        pg8::gemm_phase<EpiOut<true>, pg8::StaticOrder, HookScale, false, true>(l3, g, S, E, H);
    } SEAM(3); STAMP(4);
    if (IN(4)) {
        pg8::Gemm g{c.XN, c.W3t, MP, N3, 1024}; pg8::StaticOrder S; S.init(MP, N3, (int)gridDim.x, (int)blockIdx.x);
        {
            float* tab = (float*)(lds + 131072);
            Unit uu;
            for (int i = 0; i < 8; ++i) { if (!S.next(i, uu)) break; if (threadIdx.x < 256) tab[i * 256 + threadIdx.x] = rstd_from(c.ss1, uu.pm * 256 + (int)threadIdx.x); }
            __syncthreads();
        }
        Epi3 E{(const LAS3 float*)(l3 + 131072), c.MIX, c.GLU, c.XD, 0};
        pg8::gemm_phase<Epi3, pg8::StaticOrder, NoHook, true, true>(l3, g, S, E, NoHook{});
    } SEAM(4); STAMP(5);
    if (IN(5)) {
        const int G = gridDim.x, bx = blockIdx.x;
        for (int u = bx; u < 256; u += G) lru_unit(c, u, lds);
        STAMP(12);
        for (int u = bx; u < 256; u += G) ccv_unit(c, u, lds);
        STAMP(13);
        for (int u = bx; u < 256; u += G) { if (u < 128) ccv_sample_unit(c, u, lds); else lru_sample_unit(c, u - 128, lds); }
        STAMP(14);
        for (int i = bx * 512 + threadIdx.x; i < 8 * 30 * 1024; i += G * 512) { const int b = i / (30 * 1024), r = i % (30 * 1024); c.out[O_CCV_P + i] = bf2f(c.GLU[(size_t)(b * SEQ + SEQ - 30) * 1024 + r]); }
    } SEAM(5); STAMP(6);
    if (IN(6)) {
        sample_outproj<false>(c.MIX + (size_t)NP * 2048, c.W4t, nullptr, c.XN + (size_t)NP * 1024, c.X2b + (size_t)NP * 1024, nullptr, lds);
        pg8::Gemm g{c.MIX, c.W4t, NP, 1024, 2048}; pg8::StaticOrder S; S.init(NP, 1024, (int)gridDim.x, (int)blockIdx.x);
        EpiOut<false> E{nullptr, c.XN, c.X2b, nullptr};
        pg8::gemm_phase<EpiOut<false>, pg8::StaticOrder, NoHook, false, true>(l3, g, S, E, NoHook{});
    } SEAM(6); STAMP(7);
    if (IN(7)) { p7_final_norm(c); }
#ifdef PROBE_A
    STAMP(8);
    if (blockIdx.x == 0) {
        const float tot = (float)(ts[8] - ts[0]);
        const float f1 = (float)(ts[PROBE_A1] - ts[PROBE_A]) / tot, f2 = (float)(ts[PROBE_B1] - ts[PROBE_B]) / tot;
        __syncthreads();
        for (int i = threadIdx.x; i < 8192; i += 512) c.out[O_LRU_P + i] *= (1.03f + 0.1f * f1);
        if (threadIdx.x == 0) c.out[0] += 10.f + 90.f * f2;
    }
#endif
#undef IN
#undef SEAM
}

extern "C" void kernel_launch(void* const* d_in, const int* in_sizes, int n_in, void* d_out, int out_size, void* d_ws, size_t ws_size, hipStream_t stream) {
    static int grid = 0;
    if (grid == 0) {
        if (n_in != 35 || out_size != (int)O_END || ws_size < WS_END) { fprintf(stderr, "kernel_launch: unexpected problem (n_in %d out %d ws %zu)\n", n_in, out_size, ws_size); grid = -1; return; }
        int dev = 0, cus = 0, per_cu = 0;
        (void)hipGetDevice(&dev); (void)hipDeviceGetAttribute(&cus, hipDeviceAttributeMultiprocessorCount, dev);
        if (hipFuncSetAttribute((const void*)hybrid_fwd, hipFuncAttributeMaxDynamicSharedMemorySize, LDS_BYTES) != hipSuccess) { fprintf(stderr, "kernel_launch: hipFuncSetAttribute failed\n"); grid = -1; return; }
        if (hipOccupancyMaxActiveBlocksPerMultiprocessor(&per_cu, (const void*)hybrid_fwd, 512, LDS_BYTES) != hipSuccess || per_cu < 1) { fprintf(stderr, "kernel_launch: occupancy query says %d blocks per CU\n", per_cu); (void)hipGetLastError(); per_cu = 1; }
        grid = cus < 256 ? cus : 256;
        if (grid != 256) fprintf(stderr, "kernel_launch: %d CUs; this kernel is built for 256\n", cus);
    }
    if (grid < 0) return;
    Params p{};
    for (int i = 0; i < 35; ++i) p.in[i] = (const float*)d_in[i];
    p.out = (float*)d_out; p.ws = (unsigned char*)d_ws;
#if MK_COOP
    p.lo = 0; p.hi = N_PHASES;
    void* args[] = {&p};
    hipError_t e = hipLaunchCooperativeKernel((const void*)hybrid_fwd, dim3(grid), dim3(512), args, LDS_BYTES, stream);
    if (e != hipSuccess) fprintf(stderr, "kernel_launch: cooperative launch failed: %s\n", hipGetErrorString(e));
#else
    for (int ph = 0; ph < N_PHASES; ++ph) { p.lo = ph; p.hi = ph + 1; hipLaunchKernelGGL(hybrid_fwd, dim3(grid), dim3(512), LDS_BYTES, stream, p); }
#endif
}
```

```cpp
#include <hip/hip_runtime.h>
#include <hip/hip_cooperative_groups.h>
#include <cstdio>
#include <cstdint>
namespace cg = cooperative_groups;
namespace pg8 {
#define PG8_LAS __attribute__((address_space(3)))
typedef unsigned short bf16_t;
typedef short bf16x8 __attribute__((ext_vector_type(8)));
typedef float f32x4 __attribute__((ext_vector_type(4)));
typedef unsigned u32x4 __attribute__((ext_vector_type(4)));
constexpr int BM = 256, BK = 64, HALF = 128, HTB = HALF * BK * 2  , STAGE_BYTES = 8 * HTB, NXCD = 8, WGM = 8;

__host__ __device__ __forceinline__ int lds_byte(int r, int c) { const int st = (r >> 4) * 2 + (c >> 5), rr = r & 15, cc = c & 31, ob = rr * 64 + cc * 2; return st * 1024 + (ob ^ (((ob >> 9) & 1) << 5)); }
__host__ __device__ __forceinline__ void stage_rc(int b, int& R, int& C) { const int st = b / 1024, sb = b % 1024, swz = sb ^ (((sb >> 9) & 1) << 5); R = (st >> 1) * 16 + swz / 64; C = (st & 1) * 32 + (swz % 64) / 2; }
__host__ __device__ __forceinline__ int perm32(int rho) { const int n = rho >> 4, i = rho & 15; return 8 * (i >> 2) + 4 * n + (i & 3); }

struct Unit { int pm, pn; };
struct Gemm { const bf16_t* A; const bf16_t* Bt; int M, N, K; };

struct StaticOrder {
    int nM, nN, nwg, G, c;
    __host__ __device__ void init(int M, int N, int G_, int c_) { nM = M / BM; nN = N / BM; nwg = nM * nN; G = G_; c = c_; }
    __host__ __device__ bool next(int i, Unit& u) const {
        const long L = (long)i * G + c; if (L >= nwg) return false;
        int wgid = (int)L; { const int q = nwg / NXCD, r = nwg % NXCD, xcd = wgid % NXCD, off = wgid / NXCD; wgid = (xcd < r ? xcd * (q + 1) : r * (q + 1) + (xcd - r) * q) + off; }
        const int nig = WGM * nN, gid = wgid / nig, fm = gid * WGM, gsz = (nM - fm) < WGM ? (nM - fm) : WGM;
        u.pm = fm + ((wgid % nig) % gsz); u.pn = (wgid % nig) / gsz; return true;
    }
    __device__ __forceinline__ void a_ready(const Unit&) const {}
    __device__ __forceinline__ void done(const Unit&) const {}
};

__device__ __forceinline__ unsigned cvt_pk_bf16(float lo, float hi) { unsigned r; asm volatile("v_cvt_pk_bf16_f32 %0, %1, %2" : "=v"(r) : "v"(lo), "v"(hi)); return r; }
template <class Epi, class Sched, class Hook, bool ALIGN_EPI = false, bool SP2 = false>
__device__ __forceinline__ void gemm_phase(PG8_LAS unsigned char* lds, const Gemm g, const Sched& S, const Epi& E, const Hook& H) {
    const int tid = threadIdx.x, wid = __builtin_amdgcn_readfirstlane(tid >> 6), lane = tid & 63, wr = wid >> 2, wc = wid & 3, fr = lane & 15, fq = lane >> 4;
    const int K = g.K, nt = K / BK;
    unsigned voffA[2], voffB[2];
#pragma unroll
    for (int i = 0; i < 2; ++i) { int R, C; stage_rc(tid * 16 + i * 8192, R, C); const int Rb = Epi::PERM ? ((R & ~31) + perm32(R & 31)) : R;
        voffA[i] = (unsigned)(R * K + C) * 2u; voffB[i] = (unsigned)(Rb * K + C) * 2u; }
    const size_t kstep = (size_t)(BK * 2);
    const size_t hstep = (size_t)HALF * K * 2;
    const size_t tstep = 2 * hstep;
    const unsigned ldsw = (unsigned)wid * 1024u;
    const int aoff = lds_byte(wr * 64 + fr, fq * 8), boff = lds_byte(wc * 32 + fr, fq * 8);
#define PG8_SA(b, h) (((b) * 2 + (h)) * HTB)
#define PG8_SB(b, h) ((4 + (b) * 2 + (h)) * HTB)
#define PG8_STAGE(bufoff, gbase, voff) do { _Pragma("unroll") for (int _i = 0; _i < 2; ++_i) \
        __builtin_amdgcn_global_load_lds((const unsigned*)((const char*)(gbase) + (voff)[_i]), (PG8_LAS unsigned*)(lds + (bufoff) + ldsw + _i * 8192), 16, 0, 0); } while (0)
#define PG8_LDA(dst, b, h) do { _Pragma("unroll") for (int m = 0; m < 4; ++m) _Pragma("unroll") for (int k = 0; k < 2; ++k) dst[m][k] = *(const PG8_LAS bf16x8*)(lds + PG8_SA(b, h) + aoff + m * 2048 + k * 1024); } while (0)
#define PG8_LDB(dst, b, h) do { _Pragma("unroll") for (int n = 0; n < 2; ++n) _Pragma("unroll") for (int k = 0; k < 2; ++k) dst[n][k] = *(const PG8_LAS bf16x8*)(lds + PG8_SB(b, h) + boff + n * 2048 + k * 1024); } while (0)
#define PG8_MMA(ai, bj, At, Bt) do { __builtin_amdgcn_s_setprio(1); _Pragma("unroll") for (int m = 0; m < 4; ++m) _Pragma("unroll") for (int n = 0; n < 2; ++n) _Pragma("unroll") for (int k = 0; k < 2; ++k) \
        acc[ai][bj][m][n] = __builtin_amdgcn_mfma_f32_16x16x32_bf16(Bt[n][k], At[m][k], acc[ai][bj][m][n], 0, 0, 0); __builtin_amdgcn_s_setprio(0); } while (0)
#define PG8_WAIT_V(n) asm volatile("s_waitcnt vmcnt(" #n ")" ::: "memory")
#define PG8_WAIT_L(n) asm volatile("s_waitcnt lgkmcnt(" #n ")" ::: "memory")
#define PG8_BAR __builtin_amdgcn_s_barrier()
#define PG8_SCHED __builtin_amdgcn_sched_barrier(0)
    Unit cur, nxt; int ui = 0;
    if (!S.next(0, cur)) return;
    f32x4 acc[2][2][4][2];
#pragma unroll
    for (int a = 0; a < 2; ++a)
#pragma unroll
        for (int b = 0; b < 2; ++b)
#pragma unroll
            for (int m = 0; m < 4; ++m)
#pragma unroll
                for (int n = 0; n < 2; ++n) acc[a][b][m][n] = (f32x4){0.f, 0.f, 0.f, 0.f};
    bf16x8 At[4][2], B0[2][2], B1[2][2];
    const char* cA = (const char*)g.A + (size_t)cur.pm * tstep; const char* cB = (const char*)g.Bt + (size_t)cur.pn * tstep;
    S.a_ready(cur);
    if constexpr (SP2) {
        PG8_STAGE(PG8_SB(0, 0), cB, voffB); PG8_STAGE(PG8_SB(0, 1), cB + hstep, voffB); PG8_STAGE(PG8_SA(0, 0), cA, voffA); PG8_STAGE(PG8_SA(0, 1), cA + hstep, voffA);
        if (wr == 1) PG8_BAR;
        PG8_WAIT_V(2); PG8_BAR;
        PG8_STAGE(PG8_SB(1, 0), cB + kstep, voffB); PG8_STAGE(PG8_SA(1, 0), cA + kstep, voffA); PG8_STAGE(PG8_SB(1, 1), cB + hstep + kstep, voffB);
        PG8_WAIT_V(6); PG8_BAR;
    } else {
        PG8_STAGE(PG8_SB(0, 0), cB, voffB); PG8_STAGE(PG8_SA(0, 0), cA, voffA); PG8_STAGE(PG8_SB(0, 1), cB + hstep, voffB); PG8_STAGE(PG8_SA(0, 1), cA + hstep, voffA);
        if (wr == 1) PG8_BAR;
        PG8_WAIT_V(4); PG8_BAR;
        PG8_STAGE(PG8_SB(1, 0), cB + kstep, voffB); PG8_STAGE(PG8_SA(1, 0), cA + kstep, voffA); PG8_STAGE(PG8_SB(1, 1), cB + hstep + kstep, voffB);
        PG8_WAIT_V(6); PG8_BAR;
    }
    for (;;) {
        const bool has_next = S.next(ui + 1, nxt);
        const char* nA = has_next ? (const char*)g.A + (size_t)nxt.pm * tstep : cA; const char* nB = has_next ? (const char*)g.Bt + (size_t)nxt.pn * tstep : cB;
        for (int t = 0; t < nt; t += 2) {
            const bool last = (t == nt - 2);
            const char* a1 = cA + (size_t)(t + 1) * kstep;
            const char* a2 = last ? nA : cA + (size_t)(t + 2) * kstep; const char* b2 = last ? nB : cB + (size_t)(t + 2) * kstep;
            const char* a3 = a2 + kstep; const char* b3 = b2 + kstep;
            if (last && has_next) S.a_ready(nxt);
            H(acc, t, wr, fr);
            if constexpr (SP2) {
            PG8_LDB(B0, 0, 0); PG8_LDB(B1, 0, 1); PG8_SCHED; PG8_LDA(At, 0, 0); PG8_STAGE(PG8_SA(1, 1), a1 + hstep, voffA);
            PG8_WAIT_V(8); PG8_WAIT_L(0); PG8_BAR; PG8_MMA(0, 0, At, B0); PG8_MMA(0, 1, At, B1); PG8_BAR; PG8_SCHED;
            PG8_LDA(At, 0, 1); PG8_STAGE(PG8_SB(0, 0), b2, voffB); PG8_STAGE(PG8_SB(0, 1), b2 + hstep, voffB); PG8_STAGE(PG8_SA(0, 0), a2, voffA);
            PG8_WAIT_V(8); PG8_WAIT_L(0); PG8_BAR; PG8_MMA(1, 0, At, B0); PG8_MMA(1, 1, At, B1); PG8_BAR; PG8_SCHED;
            PG8_LDB(B0, 1, 0); PG8_LDB(B1, 1, 1); PG8_SCHED; PG8_LDA(At, 1, 0); PG8_STAGE(PG8_SA(0, 1), a2 + hstep, voffA);
            PG8_WAIT_V(8); PG8_WAIT_L(0); PG8_BAR; PG8_MMA(0, 0, At, B0); PG8_MMA(0, 1, At, B1); PG8_BAR; PG8_SCHED;
            PG8_LDA(At, 1, 1); PG8_STAGE(PG8_SB(1, 0), b3, voffB); PG8_STAGE(PG8_SB(1, 1), b3 + hstep, voffB); PG8_STAGE(PG8_SA(1, 0), a3, voffA);
            PG8_WAIT_V(8); PG8_WAIT_L(0); PG8_BAR; PG8_MMA(1, 0, At, B0); PG8_MMA(1, 1, At, B1); PG8_BAR; PG8_SCHED;
            } else {
            PG8_LDB(B0, 0, 0); PG8_SCHED; PG8_LDA(At, 0, 0); PG8_STAGE(PG8_SA(1, 1), a1 + hstep, voffA);
            PG8_WAIT_L(8); PG8_BAR; PG8_WAIT_L(0); PG8_MMA(0, 0, At, B0); PG8_BAR; PG8_SCHED;
            PG8_LDB(B1, 0, 1); PG8_STAGE(PG8_SB(0, 0), b2, voffB);
            PG8_BAR; PG8_WAIT_L(0); PG8_MMA(0, 1, At, B1); PG8_BAR;
            PG8_LDA(At, 0, 1); PG8_STAGE(PG8_SA(0, 0), a2, voffA);
            PG8_BAR; PG8_WAIT_L(0); PG8_MMA(1, 0, At, B0); PG8_BAR; PG8_SCHED;
            PG8_STAGE(PG8_SB(0, 1), b2 + hstep, voffB);
            PG8_WAIT_V(6); PG8_BAR; PG8_MMA(1, 1, At, B1); PG8_BAR;
            PG8_LDB(B0, 1, 0); PG8_SCHED; PG8_LDA(At, 1, 0); PG8_STAGE(PG8_SA(0, 1), a2 + hstep, voffA);
            PG8_WAIT_L(8); PG8_BAR; PG8_WAIT_L(0); PG8_MMA(0, 0, At, B0); PG8_BAR; PG8_SCHED;
            PG8_LDB(B1, 1, 1); PG8_STAGE(PG8_SB(1, 0), b3, voffB);
            PG8_BAR; PG8_WAIT_L(0); PG8_MMA(0, 1, At, B1); PG8_BAR;
            PG8_LDA(At, 1, 1); PG8_STAGE(PG8_SA(1, 0), a3, voffA);
            PG8_BAR; PG8_WAIT_L(0); PG8_MMA(1, 0, At, B0); PG8_BAR; PG8_SCHED;
            PG8_STAGE(PG8_SB(1, 1), b3 + hstep, voffB);
            PG8_WAIT_V(6); PG8_BAR; PG8_MMA(1, 1, At, B1); PG8_BAR;
            }
        }
        if constexpr (ALIGN_EPI) { if (wr == 0) PG8_BAR; }
        if constexpr (!Epi::AFTER_DRAIN) { E(acc, cur, wr, wc, fr, fq); S.done(cur); }
        if (!has_next) break;
#pragma unroll
        for (int a = 0; a < 2; ++a)
#pragma unroll
            for (int b = 0; b < 2; ++b)
#pragma unroll
                for (int m = 0; m < 4; ++m)
#pragma unroll
                    for (int n = 0; n < 2; ++n) acc[a][b][m][n] = (f32x4){0.f, 0.f, 0.f, 0.f};
        cur = nxt; cA = nA; cB = nB; ++ui;
        if constexpr (ALIGN_EPI) { if (wr == 1) PG8_BAR; }
    }
    PG8_WAIT_V(0);
    if constexpr (!ALIGN_EPI) { if (wr == 0) PG8_BAR; }
    PG8_BAR;
    if constexpr (Epi::AFTER_DRAIN) { E.fused(acc, cur, wr, wc, fr, fq, lds, wid, lane); S.done(cur); }
#undef PG8_SA
#undef PG8_SB
#undef PG8_STAGE
#undef PG8_LDA
#undef PG8_LDB
#undef PG8_MMA
#undef PG8_WAIT_V
#undef PG8_WAIT_L
#undef PG8_BAR
#undef PG8_SCHED
}
}

using pg8::f32x4; using pg8::bf16x8; using pg8::Unit;
typedef unsigned short bf16;
typedef unsigned u32x2 __attribute__((ext_vector_type(2)));
typedef unsigned u32x4 __attribute__((ext_vector_type(4)));
typedef float f32x2 __attribute__((ext_vector_type(2)));
#define LAS3 __attribute__((address_space(3)))

constexpr int NP = 16384, NS = 128, NT = NP + NS, MP = 16640, SEQ = 2048;
constexpr int N1 = 5888, N3 = 5120;
constexpr float EPS = 1e-6f;
constexpr int LDS_BYTES = 147456;

constexpr size_t O_SSM_P = (size_t)NT * 1024;
constexpr size_t O_SSM_S = O_SSM_P + (size_t)8 * 16 * 64 * 128;
constexpr size_t O_SCONV_P = O_SSM_S + (size_t)128 * 16 * 64 * 128;
constexpr size_t O_SCONV_S = O_SCONV_P + 8 * 3 * 1536;
constexpr size_t O_GV_S = O_SCONV_S + 128 * 3 * 1536;
constexpr size_t O_CCV_P = O_GV_S + 128 * 1024;
constexpr size_t O_CCV_S = O_CCV_P + 8 * 30 * 1024;
constexpr size_t O_LCONV_P = O_CCV_S + 128 * 30 * 1024;
constexpr size_t O_LCONV_S = O_LCONV_P + 8 * 3 * 1024;
constexpr size_t O_LRU_P = O_LCONV_S + 128 * 3 * 1024;
constexpr size_t O_LRU_S = O_LRU_P + 8 * 1024;
constexpr size_t O_END = O_LRU_S + 128 * 1024;
static_assert(O_END == 40226816, "output size");

constexpr size_t MiB = 1u << 20;
constexpr size_t WS_SS0 = 0, WS_SS1 = 288 * 1024, WS_DT = 576 * 1024, WS_SSG = 1792 * 1024, WS_XCNT = 3840 * 1024;
constexpr size_t WS_W4 = 4 * MiB, WS_W3 = 8 * MiB, WS_W2 = 18 * MiB, WS_XN = 22 * MiB, WS_W1 = 54 * MiB + 512 * 1024, WS_MIX = 66 * MiB, WS_XBC = 131 * MiB, WS_GV = 180 * MiB, WS_BCN = 213 * MiB, WS_BTG = 229 * MiB, WS_GG = 237 * MiB, WS_END = 246 * MiB;
static_assert(WS_XN + (size_t)MP * 1024 * 2 <= WS_W1 && WS_W1 + (size_t)N1 * 1024 * 2 <= WS_MIX && WS_MIX + (size_t)MP * 2048 * 2 <= WS_XBC && WS_XBC + (size_t)MP * 1536 * 2 <= WS_GV && WS_GV + (size_t)MP * 1024 * 2 <= WS_BCN && WS_BCN + (size_t)NP * 512 * 2 <= WS_BTG && WS_BTG + (size_t)NP * 256 * 2 <= WS_END && WS_BCN + (size_t)NT * 1024 * 2 <= WS_END, "ws map");
static_assert(WS_SS0 + (size_t)MP * 16 <= WS_SS1 && WS_SS1 + (size_t)MP * 16 <= WS_DT && WS_DT + (size_t)MP * 64 <= WS_SSG && WS_SSG + (size_t)NP * 128 <= WS_W4, "ws map small");

struct Ctx {
    const float *x_prompt, *x_sample, *state_ssm, *state_ssd_conv, *state_ccv, *state_lru_conv, *state_lru;
    const float *norm_even, *w_in_even, *ssd_conv_w, *ssd_conv_b, *ssd_dt_bias, *ssd_a_log, *ssd_d, *ssd_norm, *gmlp_ln_g, *gmlp_ln_b, *gmlp_w_s, *gmlp_b_s, *w_out_even;
    const float *norm_odd, *w_in_odd, *ccv_w, *ccv_b, *ccv_ln_g, *ccv_ln_b, *lru_conv_w, *lru_conv_b, *lru_wa, *lru_ba, *lru_wx, *lru_bx, *lru_lambda, *w_out_odd, *final_norm;
    float* out;
    float *ss0, *ss1, *DT, *ssg; unsigned* xcnt;
    bf16 *W1t, *W2t, *W3t, *W4t, *XN, *MIX, *XBC, *GV, *GLU, *XD, *BCn, *BTg, *Gg, *X2b;
};

__device__ __forceinline__ float bf2f(unsigned b) { return __uint_as_float(b << 16); }
__device__ __forceinline__ float bflo(unsigned w) { return __uint_as_float(w << 16); }
__device__ __forceinline__ float bfhi(unsigned w) { return __uint_as_float(w & 0xffff0000u); }
__device__ __forceinline__ unsigned pk2(float lo, float hi) { return pg8::cvt_pk_bf16(lo, hi); }
__device__ __forceinline__ float sigmoidf_(float x) { return __builtin_amdgcn_rcpf(1.f + __expf(-x)); }
__device__ __forceinline__ float siluf_(float x) { return x * sigmoidf_(x); }
__device__ __forceinline__ float geluf_(float x) { const float y = 1.5957691216057308f * (x + 0.044715f * x * x * x); return x * sigmoidf_(y); }
__device__ __forceinline__ float softplusf_(float x) { return fmaxf(x, 0.f) + log1pf(__expf(-fabsf(x))); }
__device__ __forceinline__ float wave_sum(float v) {
#pragma unroll
    for (int o = 1; o < 64; o <<= 1) v += __shfl_xor(v, o);
    return v;
}
__device__ __forceinline__ float block_sum(float v, float* red) {
    v = wave_sum(v);
    __syncthreads();
    if ((threadIdx.x & 63) == 0) red[threadIdx.x >> 6] = v;
    __syncthreads();
    float s = 0.f;
#pragma unroll
    for (int i = 0; i < 8; ++i) s += red[i];
    return s;
}
template <int CTRL> __device__ __forceinline__ float dpp_mov(float v) { return __int_as_float(__builtin_amdgcn_update_dpp(0, __float_as_int(v), CTRL, 0xf, 0xf, true)); }
__device__ __forceinline__ float row16_sum(float y) {
    y += dpp_mov<0x128>(y); y += dpp_mov<0x124>(y); y += dpp_mov<0x122>(y); y += dpp_mov<0x121>(y); return y;
}
__device__ __forceinline__ float rstd_from(const float* ss, int row) { return rsqrtf(((ss[row] + ss[MP + row]) + (ss[2 * MP + row] + ss[3 * MP + row])) * (1.f / 1024.f) + EPS); }
__device__ __forceinline__ u32x4 pack8(const f32x4 a, const f32x4 b) { u32x4 w; w.x = pk2(a[0], a[1]); w.y = pk2(a[2], a[3]); w.z = pk2(b[0], b[1]); w.w = pk2(b[2], b[3]); return w; }
__device__ __forceinline__ void unpack8(const u32x4 w, float (&f)[8]) { f[0] = bflo(w.x); f[1] = bfhi(w.x); f[2] = bflo(w.y); f[3] = bfhi(w.y); f[4] = bflo(w.z); f[5] = bfhi(w.z); f[6] = bflo(w.w); f[7] = bfhi(w.w); }

struct NoHook { __device__ __forceinline__ void operator()(f32x4 (&)[2][2][4][2], int, int, int) const {} };
struct HookScale {
    const LAS3 float* tab;
    __device__ __forceinline__ void operator()(f32x4 (&acc)[2][2][4][2], int t, int wr, int fr) const {
        if (t == 8 || t == 16) {
            const int j = (t == 16) ? 1 : 0;
#pragma unroll
            for (int ai = 0; ai < 2; ++ai)
#pragma unroll
                for (int m = 0; m < 4; ++m) { const float f = tab[(ai * 128 + wr * 64 + m * 16 + fr) * 2 + j];
#pragma unroll
                    for (int bj = 0; bj < 2; ++bj)
#pragma unroll
                        for (int n = 0; n < 2; ++n) acc[ai][bj][m][n] *= f; }
        }
    }
};

struct Epi1 {
    static constexpr bool PERM = true, AFTER_DRAIN = false;
    const float* ss; bf16* MIX; bf16* XBC; bf16* GV; float* DT;
    __device__ __forceinline__ void operator()(const f32x4 (&acc)[2][2][4][2], const Unit& u, int wr, int wc, int fr, int fq) const {
        const int row0 = u.pm * 256 + wr * 64 + fr, pn = u.pn, cl = wc * 32 + 8 * fq;
        float rs[2][4];
#pragma unroll
        for (int ai = 0; ai < 2; ++ai)
#pragma unroll
            for (int m = 0; m < 4; ++m) rs[ai][m] = 1.f;
        if (pn < 4) {
#pragma unroll
            for (int ai = 0; ai < 2; ++ai)
#pragma unroll
                for (int m = 0; m < 4; ++m) { bf16* rp = MIX + (size_t)(row0 + ai * 128 + m * 16) * 2048 + pn * 256 + cl; const float r = rs[ai][m];
#pragma unroll
                    for (int bj = 0; bj < 2; ++bj) { f32x4 v0 = acc[ai][bj][m][0] * r, v1 = acc[ai][bj][m][1] * r;
#pragma unroll
                        for (int j = 0; j < 4; ++j) { v0[j] = siluf_(v0[j]); v1[j] = siluf_(v1[j]); }
                        *(u32x4*)(rp + bj * 128) = pack8(v0, v1); } }
        } else if (pn < 10) {
#pragma unroll
            for (int ai = 0; ai < 2; ++ai)
#pragma unroll
                for (int m = 0; m < 4; ++m) { bf16* rp = XBC + (size_t)(row0 + ai * 128 + m * 16) * 1536 + (pn - 4) * 256 + cl; const float r = rs[ai][m];
#pragma unroll
                    for (int bj = 0; bj < 2; ++bj) *(u32x4*)(rp + bj * 128) = pack8(acc[ai][bj][m][0] * r, acc[ai][bj][m][1] * r); }
        } else if (pn < 18) {
#pragma unroll
            for (int ai = 0; ai < 2; ++ai)
#pragma unroll
                for (int m = 0; m < 4; ++m) { bf16* rp = MIX + (size_t)(row0 + ai * 128 + m * 16) * 2048 + 1024 + (pn - 10) * 128 + cl; const float r = rs[ai][m];
                    f32x4 o[2];
#pragma unroll
                    for (int n = 0; n < 2; ++n) { const f32x4 uu = acc[ai][0][m][n] * r, gg = acc[ai][1][m][n] * r;
#pragma unroll
                        for (int j = 0; j < 4; ++j) o[n][j] = geluf_(uu[j]) * siluf_(gg[j]); }
                    *(u32x4*)rp = pack8(o[0], o[1]); }
        } else if (pn < 22) {
#pragma unroll
            for (int ai = 0; ai < 2; ++ai)
#pragma unroll
                for (int m = 0; m < 4; ++m) { bf16* rp = GV + (size_t)(row0 + ai * 128 + m * 16) * 1024 + (pn - 18) * 256 + cl; const float r = rs[ai][m];
#pragma unroll
                    for (int bj = 0; bj < 2; ++bj) { f32x4 v0 = acc[ai][bj][m][0] * r, v1 = acc[ai][bj][m][1] * r;
#pragma unroll
                        for (int j = 0; j < 4; ++j) { v0[j] = geluf_(v0[j]); v1[j] = geluf_(v1[j]); }
                        *(u32x4*)(rp + bj * 128) = pack8(v0, v1); } }
        } else {
            if (wc == 0 && fq < 2) {
#pragma unroll
                for (int ai = 0; ai < 2; ++ai)
#pragma unroll
                    for (int m = 0; m < 4; ++m) { float* rp = DT + (size_t)(row0 + ai * 128 + m * 16) * 16 + 8 * fq; const float r = rs[ai][m];
#pragma unroll
                        for (int n = 0; n < 2; ++n) *(f32x4*)(rp + 4 * n) = acc[ai][0][m][n] * r; }
            }
        }
    }
};
struct Epi3 {
    static constexpr bool PERM = true, AFTER_DRAIN = false;
    const LAS3 float* tab; bf16* MIX; bf16* GLU; bf16* XD; mutable int ui;
    __device__ __forceinline__ void operator()(const f32x4 (&acc)[2][2][4][2], const Unit& u, int wr, int wc, int fr, int fq) const {
        const int row0 = u.pm * 256 + wr * 64 + fr, pn = u.pn, cl = wc * 32 + 8 * fq;
        float rs[2][4];
#pragma unroll
        for (int ai = 0; ai < 2; ++ai)
#pragma unroll
            for (int m = 0; m < 4; ++m) rs[ai][m] = tab[ui * 256 + ai * 128 + wr * 64 + m * 16 + fr];
        ++ui;
        if (pn < 8) {
#pragma unroll
            for (int ai = 0; ai < 2; ++ai)
#pragma unroll
                for (int m = 0; m < 4; ++m) { bf16* rp = GLU + (size_t)(row0 + ai * 128 + m * 16) * 1024 + pn * 128 + cl; const float r = rs[ai][m];
                    f32x4 o[2];
#pragma unroll
                    for (int n = 0; n < 2; ++n) { const f32x4 aa = acc[ai][0][m][n] * r, bb = acc[ai][1][m][n] * r;
#pragma unroll
                        for (int j = 0; j < 4; ++j) o[n][j] = aa[j] * sigmoidf_(bb[j]); }
                    *(u32x4*)rp = pack8(o[0], o[1]); }
        } else if (pn >= 12 && pn < 16) {
#pragma unroll
            for (int ai = 0; ai < 2; ++ai)
#pragma unroll
                for (int m = 0; m < 4; ++m) { bf16* rp = XD + (size_t)(row0 + ai * 128 + m * 16) * 1024 + (pn - 12) * 256 + cl; const float r = rs[ai][m];
#pragma unroll
                    for (int bj = 0; bj < 2; ++bj) *(u32x4*)(rp + bj * 128) = pack8(acc[ai][bj][m][0] * r, acc[ai][bj][m][1] * r); }
        } else {
            const int cb = pn < 12 ? (pn - 8) * 256 : 1024 + (pn - 16) * 256;
#pragma unroll
            for (int ai = 0; ai < 2; ++ai)
#pragma unroll
                for (int m = 0; m < 4; ++m) { bf16* rp = MIX + (size_t)(row0 + ai * 128 + m * 16) * 2048 + cb + cl; const float r = rs[ai][m];
#pragma unroll
                    for (int bj = 0; bj < 2; ++bj) { f32x4 v0 = acc[ai][bj][m][0] * r, v1 = acc[ai][bj][m][1] * r;
#pragma unroll
                        for (int j = 0; j < 4; ++j) { v0[j] = siluf_(v0[j]); v1[j] = siluf_(v1[j]); }
                        *(u32x4*)(rp + bj * 128) = pack8(v0, v1); } }
        }
    }
};
template <bool L0> struct EpiOut {
    static constexpr bool PERM = false, AFTER_DRAIN = true;
    const float* xold; bf16* XN; bf16* X2; float* ss;
    __device__ __forceinline__ void operator()(const f32x4 (&)[2][2][4][2], const Unit&, int, int, int, int) const {}
    __device__ __forceinline__ void fused(f32x4 (&acc)[2][2][4][2], const Unit& u, int wr, int wc, int fr, int fq, PG8_LAS unsigned char* lds, int wid, int lane) const {
        const int col0 = u.pn * 256 + wc * 32 + 4 * fq;
        PG8_LAS float* red = (PG8_LAS float*)lds;
        f32x4 xo[3][4]; u32x2 xb[3][4];
#define EPO_OFF(G) ((size_t)(u.pm * 256 + ((G) >> 2) * 128 + wr * 64 + ((G) & 3) * 16 + fr) * 1024 + col0)
#define EPO_LOAD(G) do { const size_t off_ = EPO_OFF(G); _Pragma("unroll") for (int bj = 0; bj < 2; ++bj) _Pragma("unroll") for (int n = 0; n < 2; ++n) { \
            if (L0) xo[(G) % 3][bj * 2 + n] = __builtin_nontemporal_load((const f32x4*)(xold + off_ + bj * 128 + n * 16)); else xb[(G) % 3][bj * 2 + n] = *(const u32x2*)(XN + off_ + bj * 128 + n * 16); } } while (0)
        EPO_LOAD(0); EPO_LOAD(1);
#pragma unroll
        for (int gq = 0; gq < 8; ++gq) {
            const int ai = gq >> 2, m = gq & 3;
            if (gq + 2 < 8) EPO_LOAD(gq + 2);
            const int rl = ai * 128 + wr * 64 + m * 16 + fr; const size_t off = EPO_OFF(gq); float q = 0.f;
#pragma unroll
            for (int bj = 0; bj < 2; ++bj)
#pragma unroll
                for (int n = 0; n < 2; ++n) { const size_t o2 = off + bj * 128 + n * 16;
                    if (L0) { const f32x4 v = xo[gq % 3][bj * 2 + n] + acc[ai][bj][m][n];
                        u32x2 w; w.x = pk2(v[0], v[1]); w.y = pk2(v[2], v[3]); *(u32x2*)(XN + o2) = w;
                        q += (v[0] * v[0] + v[1] * v[1]) + (v[2] * v[2] + v[3] * v[3]); }
                    else { const u32x2 xw = xb[gq % 3][bj * 2 + n]; const f32x4 v = (f32x4){bflo(xw.x), bfhi(xw.x), bflo(xw.y), bfhi(xw.y)} + acc[ai][bj][m][n]; u32x2 w; w.x = pk2(v[0], v[1]); w.y = pk2(v[2], v[3]); *(u32x2*)(X2 + o2) = w; } }
            if (L0) { q += __shfl_xor(q, 16); q += __shfl_xor(q, 32); if (fq == 0) red[rl * 4 + wc] = q; }
        }
#undef EPO_LOAD
#undef EPO_OFF
        if (L0) {
            __syncthreads();
            const int t = wid * 64 + lane;
            if (t < 256) ss[(size_t)u.pn * MP + u.pm * 256 + t] = (red[t * 4 + 0] + red[t * 4 + 1]) + (red[t * 4 + 2] + red[t * 4 + 3]);
        }
    }
};

template <int MODE> __device__ __forceinline__ int src_col(int n) {
    const int tile = n >> 8, cl = n & 255;
    if (MODE == 1) {
        if (tile < 10) return n;
        if (tile < 18) { const int q = tile - 10; return cl < 128 ? 2576 + 128 * q + cl : 4624 + 128 * q + (cl - 128); }
        if (tile < 22) return 3600 + (n - 18 * 256);
        return cl < 16 ? 2560 + cl : -1;
    } else if (MODE == 3) {
        if (tile < 8) return cl < 128 ? 128 * tile + cl : 1024 + 128 * tile + (cl - 128);
        return n;
    }
    return n;
}
template <int MODE> __device__ __forceinline__ void transpose_item(const float* W, int K, int Nsrc, bf16* WT, const float* kscale, float* scr, int item, int nblk, int lane) {
    const int kb = item / nblk, nb = item % nblk, k0 = 64 * kb, n0 = 32 * nb;
    const int sc = src_col<MODE>(n0 + (lane & 31));
    float tv[32];
#pragma unroll
    for (int i = 0; i < 32; ++i) { const int kk = 2 * i + (lane >> 5); tv[i] = sc >= 0 ? __builtin_nontemporal_load(W + (size_t)(k0 + kk) * Nsrc + sc) : 0.f; }
    if (kscale != nullptr && k0 < 1024) {
#pragma unroll
        for (int i = 0; i < 32; ++i) tv[i] *= kscale[k0 + 2 * i + (lane >> 5)];
    }
#pragma unroll
    for (int i = 0; i < 32; ++i) scr[(2 * i + (lane >> 5)) * 33 + (lane & 31)] = tv[i];
    asm volatile("s_waitcnt lgkmcnt(0)" ::: "memory");
    const int c = lane & 7;
#pragma unroll
    for (int j = 0; j < 4; ++j) { const int n = (lane >> 3) + 8 * j; const float* s = scr + (8 * c) * 33 + n;
        u32x4 o; o.x = pk2(s[0 * 33], s[1 * 33]); o.y = pk2(s[2 * 33], s[3 * 33]); o.z = pk2(s[4 * 33], s[5 * 33]); o.w = pk2(s[6 * 33], s[7 * 33]);
        *(u32x4*)(WT + (size_t)(n0 + n) * K + k0 + 8 * c) = o; }
    asm volatile("s_waitcnt lgkmcnt(0)" ::: "memory");
}
__device__ __forceinline__ void p0_prologue(const Ctx& c, unsigned char* sm) {
    const int tid = threadIdx.x, lane = tid & 63, wave = tid >> 6;
    const int gw = blockIdx.x * 8 + wave, NGW = gridDim.x * 8;
    float* scr = (float*)(sm + wave * 16384);
    if (blockIdx.x == 0 && tid < 8) c.xcnt[tid] = 0u;
    constexpr int I1 = 16 * (N1 / 32), I2 = 32 * 32, I3 = 16 * (N3 / 32), I4 = 32 * 32;
    for (int it = gw; it < I1 + I2 + I3 + I4; it += NGW) {
        int r = it;
        if (r < I1) { transpose_item<1>(c.w_in_even, 1024, 5648, c.W1t, nullptr, scr, r, N1 / 32, lane); continue; } r -= I1;
        if (r < I2) { transpose_item<0>(c.w_out_even, 2048, 1024, c.W2t, c.ssd_norm, scr, r, 32, lane); continue; } r -= I2;
        if (r < I3) { transpose_item<3>(c.w_in_odd, 1024, 5120, c.W3t, c.norm_odd, scr, r, N3 / 32, lane); continue; } r -= I3;
        transpose_item<0>(c.w_out_odd, 2048, 1024, c.W4t, nullptr, scr, r, 32, lane);
    }
    for (int m = gw; m < MP; m += NGW) {
        unsigned long long* o8 = (unsigned long long*)(c.XN + (size_t)m * 1024) + lane;
        if (m < NT) {
            const float* xr = m < NP ? c.x_prompt + (size_t)m * 1024 : c.x_sample + (size_t)(m - NP) * 1024;
            f32x4 v[4]; float s = 0.f;
#pragma unroll
            for (int j = 0; j < 4; ++j) { v[j] = __builtin_nontemporal_load((const f32x4*)xr + lane + 64 * j); s += (v[j][0] * v[j][0] + v[j][1] * v[j][1]) + (v[j][2] * v[j][2] + v[j][3] * v[j][3]); }
            const float rstd = rsqrtf(wave_sum(s) * (1.f / 1024.f) + EPS);
#pragma unroll
            for (int j = 0; j < 4; ++j) { const f32x4 g = ((const f32x4*)c.norm_even)[lane + 64 * j] * rstd; o8[64 * j] = (unsigned long long)pk2(v[j][0] * g[0], v[j][1] * g[1]) | ((unsigned long long)pk2(v[j][2] * g[2], v[j][3] * g[3]) << 32); }
        } else {
#pragma unroll
            for (int j = 0; j < 4; ++j) o8[64 * j] = 0ull;
        }
        if (m >= NP && lane < 4) c.ss1[(size_t)lane * MP + m] = 0.f;
    }
}

__device__ __forceinline__ void bc_prepass_unit(const Ctx& c, int u, unsigned char* sm) {
    const int tid = threadIdx.x, lane = tid & 63, w = tid >> 6, fr = lane & 15, fq = lane >> 4;
    const int b = u >> 5, ck = (u >> 1) & 15, g = u & 1, t0 = ck * 128;
    constexpr int RS = 272;
    unsigned char* Bn = sm; unsigned char* Cn = sm + 34816;
    const int oc = tid & 31, run = tid >> 5;
    const int ch = oc < 16 ? 1024 + g * 128 + oc * 8 : 1280 + g * 128 + (oc - 16) * 8;
    u32x4 raw[11];
#pragma unroll
    for (int j = 0; j < 11; ++j) { const int t = t0 + run * 8 - 3 + j; raw[j] = (t >= 0) ? *(const u32x4*)(c.XBC + (size_t)(b * SEQ + t) * 1536 + ch) : (u32x4){0u, 0u, 0u, 0u}; }
    unsigned char* nat = (oc < 16 ? Bn : Cn) + (oc & 15) * 16;
#pragma unroll
    for (int hf = 0; hf < 2; ++hf) {
        f32x4 wk[5];
#pragma unroll
        for (int k = 0; k < 4; ++k) wk[k] = *(const f32x4*)(c.ssd_conv_w + k * 1536 + ch + 4 * hf);
        wk[4] = *(const f32x4*)(c.ssd_conv_b + ch + 4 * hf);
        float v[8][4];
#pragma unroll
        for (int i = 0; i < 8; ++i)
#pragma unroll
            for (int e = 0; e < 4; ++e) { const int ee = 4 * hf + e; float s = wk[4][e];
#pragma unroll
                for (int k = 0; k < 4; ++k) { const unsigned wd = raw[i + k][ee >> 1]; s += wk[k][e] * ((ee & 1) ? bfhi(wd) : bflo(wd)); }
                v[i][e] = siluf_(s); }
#pragma unroll
        for (int i = 0; i < 8; ++i) { u32x2 o; o.x = pk2(v[i][0], v[i][1]); o.y = pk2(v[i][2], v[i][3]); *(u32x2*)(nat + (8 * run + i) * RS + hf * 8) = o;
            if (oc >= 16) *(u32x2*)(c.BCn + (size_t)(b * SEQ + t0 + 8 * run + i) * 512 + 256 + g * 128 + (oc - 16) * 8 + 4 * hf) = o; }
        if (oc < 16) {
#pragma unroll
            for (int e = 0; e < 4; ++e) *(u32x4*)(c.BTg + ((size_t)((b * 16 + ck) * 2 + g) * 128 + oc * 8 + 4 * hf + e) * 128 + run * 8) = pack8((f32x4){v[0][e], v[1][e], v[2][e], v[3][e]}, (f32x4){v[4][e], v[5][e], v[6][e], v[7][e]});
        }
    }
    __syncthreads();
    {
        bf16x8 cf[4];
#pragma unroll
        for (int kk = 0; kk < 4; ++kk) cf[kk] = *(const bf16x8*)(Cn + (16 * w + fr) * RS + (kk * 32 + fq * 8) * 2);
        for (int j = 0; j <= w; ++j) {
            bf16x8 bf[4];
#pragma unroll
            for (int kk = 0; kk < 4; ++kk) bf[kk] = *(const bf16x8*)(Bn + (16 * j + fr) * RS + (kk * 32 + fq * 8) * 2);
            f32x4 gt = (f32x4){0.f, 0.f, 0.f, 0.f};
#pragma unroll
            for (int kk = 0; kk < 4; ++kk) gt = __builtin_amdgcn_mfma_f32_16x16x32_bf16(bf[kk], cf[kk], gt, 0, 0, 0);
            unsigned r_[4];
#pragma unroll
            for (int e = 0; e < 4; ++e) { const unsigned ub = __float_as_uint(gt[e]); r_[e] = (ub + 0x7fffu + ((ub >> 16) & 1u)) >> 16; }
            u32x2 o; o.x = r_[0] | (r_[1] << 16); o.y = r_[2] | (r_[3] << 16);
            *(u32x2*)(c.Gg + ((size_t)((u * 8 + w) * 8 + j) * 64 + lane) * 4) = o;
        }
    }
    __syncthreads();
}

__device__ __forceinline__ void ssd_chunk_unit(const Ctx& c, int u, unsigned char* sm) {
    const int tid = threadIdx.x, lane = tid & 63, w = tid >> 6, fr = lane & 15, fq = lane >> 4;
    const int pair = u >> 4, sub = u & 15;
    const int b = pair >> 1, g = pair & 1, h = g * 8 + (sub >> 1), ph = sub & 1;
    constexpr int RS = 272;
    unsigned char* Cn = sm + 34816;
    unsigned char* BT = sm + 69632;
    unsigned char* XT = sm + 104448;
    unsigned char* XdT = sm + 113152;
    unsigned char* Sb = sm + 121856;
    unsigned char* Xn = sm + 130560;
    float* csA = (float*)(sm + 138752);
    float* dtA = (float*)(sm + 139776);
    float* wx = (float*)(sm + 140800);
    const int ox = tid & 3, lx = tid >> 2;
    const int chx = h * 64 + ph * 32 + ox * 8;
    if (tid < 160) { const int k = tid >> 5, cc = tid & 31; wx[tid] = k < 4 ? c.ssd_conv_w[k * 1536 + h * 64 + ph * 32 + cc] : c.ssd_conv_b[h * 64 + ph * 32 + cc]; }
    const float a_h = -__expf(c.ssd_a_log[h]), dtb = c.ssd_dt_bias[h], Dh = c.ssd_d[h];
    f32x4 accS[2];
    accS[0] = (f32x4){0.f, 0.f, 0.f, 0.f}; accS[1] = accS[0];
    u32x4 rC[4], rT[4], rx[4]; u32x2 zz[2], gG[8]; float dr0 = 0.f, dr1 = 0.f;
#pragma unroll
    for (int j = 0; j < 8; ++j) gG[j] = (u32x2){0u, 0u};
    const int lrow = 16 * w + fr;
    const int prow = tid >> 4, pc16 = tid & 15;
#define SSD_LOAD_B(CK) do { const size_t gu_ = (size_t)(((b * 16 + (CK)) * 2 + g) * 8 + w) * 8; \
        _Pragma("unroll") for (int j = 0; j < 8; ++j) { if (j <= w) gG[j] = *(const u32x2*)(c.Gg + ((gu_ + j) * 64 + lane) * 4); } } while (0)
#define SSD_LOAD_C(CK) do { const int t0_ = (CK) * 128; \
        _Pragma("unroll") for (int i = 0; i < 4; ++i) rC[i] = *(const u32x4*)(c.BCn + (size_t)(b * SEQ + t0_ + prow + 32 * i) * 512 + 256 + g * 128 + pc16 * 8); } while (0)
#define SSD_LOAD_T(CK) do { \
        _Pragma("unroll") for (int i = 0; i < 4; ++i) rT[i] = *(const u32x4*)(c.BTg + ((size_t)((b * 16 + (CK)) * 2 + g) * 128 + prow + 32 * i) * 128 + pc16 * 8); } while (0)
#define SSD_LOAD_X(CK) do { const int t0_ = (CK) * 128; \
        _Pragma("unroll") for (int j = 0; j < 4; ++j) { const int t = t0_ + lx - 3 + j; rx[j] = (t >= 0) ? *(const u32x4*)(c.XBC + (size_t)(b * SEQ + t) * 1536 + chx) : (u32x4){0u, 0u, 0u, 0u}; } \
        _Pragma("unroll") for (int pt = 0; pt < 2; ++pt) zz[pt] = *(const u32x2*)(c.MIX + (size_t)(b * SEQ + t0_ + lrow) * 2048 + h * 64 + ph * 32 + pt * 16 + 4 * fq); } while (0)
#define SSD_LOAD(CK) do { SSD_LOAD_B(CK); SSD_LOAD_C(CK); SSD_LOAD_T(CK); SSD_LOAD_X(CK); } while (0)
#define SSD_LOAD_DT(CK) do { if (tid < 64) { const size_t r = (size_t)(b * SEQ + (CK) * 128 + 2 * tid) * 16 + h; dr0 = c.DT[r]; dr1 = c.DT[r + 16]; } } while (0)
#define SSD_CUMSUM(BUF) do { if (tid < 64) { const float d0 = softplusf_(dr0 + dtb), d1 = softplusf_(dr1 + dtb); const float a1 = d1 * a_h; float s = d0 * a_h + a1; \
        _Pragma("unroll") for (int o = 1; o < 64; o <<= 1) { const float v = __shfl_up(s, o); if (lane >= o) s += v; } \
        csA[(BUF) * 128 + 2 * tid + 1] = s; csA[(BUF) * 128 + 2 * tid] = s - a1; dtA[(BUF) * 128 + 2 * tid] = d0; dtA[(BUF) * 128 + 2 * tid + 1] = d1; } } while (0)
    SSD_LOAD_DT(0);
    SSD_LOAD(0);
    SSD_CUMSUM(0);
    __syncthreads();
    for (int ck = 0; ck < 16; ++ck) {
        const int t0 = ck * 128;
        const float* cs = csA + (ck & 1) * 128; const float* dts = dtA + (ck & 1) * 128;
        if (ck < 15) SSD_LOAD_DT(ck + 1);
        {
#pragma unroll
            for (int pt = 0; pt < 2; ++pt)
#pragma unroll
                for (int e = 0; e < 4; ++e) *(bf16*)(Sb + (pt * 16 + 4 * fq + e) * RS + (16 * w + fr) * 2) = (bf16)pk2(accS[pt][e], 0.f);
        }
#pragma unroll
        for (int i = 0; i < 4; ++i) { *(u32x4*)(Cn + (prow + 32 * i) * RS + pc16 * 16) = rC[i]; *(u32x4*)(BT + (prow + 32 * i) * RS + pc16 * 16) = rT[i]; }
        {
            const float dl = dts[lx], ddl = dl * __expf(cs[127] - cs[lx]);
            float v[8];
#pragma unroll
            for (int hf = 0; hf < 2; ++hf) {
                f32x4 wk[5];
#pragma unroll
                for (int k = 0; k < 5; ++k) wk[k] = *(const f32x4*)(wx + k * 32 + ox * 8 + 4 * hf);
#pragma unroll
                for (int e = 0; e < 4; ++e) { const int ee = 4 * hf + e; float s = wk[4][e];
#pragma unroll
                    for (int k = 0; k < 4; ++k) { const unsigned wd = rx[k][ee >> 1]; s += wk[k][e] * ((ee & 1) ? bfhi(wd) : bflo(wd)); }
                    v[ee] = siluf_(s); }
            }
            *(u32x4*)(Xn + lx * 64 + ox * 16) = pack8((f32x4){v[0], v[1], v[2], v[3]}, (f32x4){v[4], v[5], v[6], v[7]});
#pragma unroll
            for (int e = 0; e < 8; ++e) { *(bf16*)(XT + (ox * 8 + e) * RS + lx * 2) = (bf16)pk2(v[e] * dl, 0.f); *(bf16*)(XdT + (ox * 8 + e) * RS + lx * 2) = (bf16)pk2(v[e] * ddl, 0.f); }
        }
        __syncthreads();
        const u32x2 zc0 = zz[0], zc1 = zz[1];
        u32x2 gC[8];
#pragma unroll
        for (int j = 0; j < 8; ++j) gC[j] = gG[j];
        if (ck < 15) SSD_LOAD_B(ck + 1);
        __builtin_amdgcn_sched_barrier(0);
        {
            const int l = lrow;
            const float csl = cs[l];
            bf16x8 cf[4];
#pragma unroll
            for (int kk = 0; kk < 4; ++kk) cf[kk] = *(const bf16x8*)(Cn + l * RS + (kk * 32 + fq * 8) * 2);
            f32x4 aoff[2], adiag[2];
            {
                bf16x8 sf[2][4];
#pragma unroll
                for (int pt = 0; pt < 2; ++pt)
#pragma unroll
                    for (int kk = 0; kk < 4; ++kk) sf[pt][kk] = *(const bf16x8*)(Sb + (pt * 16 + fr) * RS + (kk * 32 + fq * 8) * 2);
                aoff[0] = (f32x4){0.f, 0.f, 0.f, 0.f}; aoff[1] = aoff[0]; adiag[0] = aoff[0]; adiag[1] = aoff[0];
#pragma unroll
                for (int kk = 0; kk < 4; ++kk) { aoff[0] = __builtin_amdgcn_mfma_f32_16x16x32_bf16(sf[0][kk], cf[kk], aoff[0], 0, 0, 0); aoff[1] = __builtin_amdgcn_mfma_f32_16x16x32_bf16(sf[1][kk], cf[kk], aoff[1], 0, 0, 0); }
            }
            __builtin_amdgcn_sched_barrier(0);
            if (ck < 15) SSD_LOAD_C(ck + 1);
            __builtin_amdgcn_sched_barrier(0);
#pragma unroll
            for (int jp = 0; jp < 4; ++jp) if (jp <= (w >> 1)) {
                const int j0 = 2 * jp, j1 = 2 * jp + 1;
                const u32x2 ga = gC[2 * jp], gb = gC[2 * jp + 1];
                const f32x4 g0 = (f32x4){bflo(ga.x), bfhi(ga.x), bflo(ga.y), bfhi(ga.y)}, g1 = (f32x4){bflo(gb.x), bfhi(gb.x), bflo(gb.y), bfhi(gb.y)};
                const u32x2 xa0 = *(const u32x2*)(XT + fr * RS + (16 * j0 + 4 * fq) * 2), xb0 = *(const u32x2*)(XT + fr * RS + (16 * j1 + 4 * fq) * 2);
                const u32x2 xa1 = *(const u32x2*)(XT + (16 + fr) * RS + (16 * j0 + 4 * fq) * 2), xb1 = *(const u32x2*)(XT + (16 + fr) * RS + (16 * j1 + 4 * fq) * 2);
                const f32x4 cs0 = *(const f32x4*)(cs + 16 * j0 + 4 * fq), cs1 = *(const f32x4*)(cs + 16 * j1 + 4 * fq);
                f32x4 m0, m1;
#pragma unroll
                for (int e = 0; e < 4; ++e) { const int s0 = 16 * j0 + 4 * fq + e, s1 = 16 * j1 + 4 * fq + e;
                    m0[e] = (s0 <= l) ? g0[e] * __expf(csl - cs0[e]) : 0.f; m1[e] = (s1 <= l) ? g1[e] * __expf(csl - cs1[e]) : 0.f; }
                const bf16x8 mB = __builtin_bit_cast(bf16x8, pack8(m0, m1));
                { u32x4 xv; xv.x = xa0.x; xv.y = xa0.y; xv.z = xb0.x; xv.w = xb0.y; adiag[0] = __builtin_amdgcn_mfma_f32_16x16x32_bf16(__builtin_bit_cast(bf16x8, xv), mB, adiag[0], 0, 0, 0); }
                { u32x4 xv; xv.x = xa1.x; xv.y = xa1.y; xv.z = xb1.x; xv.w = xb1.y; adiag[1] = __builtin_amdgcn_mfma_f32_16x16x32_bf16(__builtin_bit_cast(bf16x8, xv), mB, adiag[1], 0, 0, 0); }
            }
            __builtin_amdgcn_sched_barrier(0);
            if (ck < 15) SSD_LOAD_T(ck + 1);
            __builtin_amdgcn_sched_barrier(0);
            const float decT = __expf(cs[127]);
            {
                bf16x8 xf[2][4], tf[4];
#pragma unroll
                for (int kk = 0; kk < 4; ++kk) { tf[kk] = *(const bf16x8*)(BT + (16 * w + fr) * RS + (kk * 32 + fq * 8) * 2); xf[0][kk] = *(const bf16x8*)(XdT + fr * RS + (kk * 32 + fq * 8) * 2); xf[1][kk] = *(const bf16x8*)(XdT + (16 + fr) * RS + (kk * 32 + fq * 8) * 2); }
                accS[0] *= decT; accS[1] *= decT;
#pragma unroll
                for (int kk = 0; kk < 4; ++kk) { accS[0] = __builtin_amdgcn_mfma_f32_16x16x32_bf16(xf[0][kk], tf[kk], accS[0], 0, 0, 0); accS[1] = __builtin_amdgcn_mfma_f32_16x16x32_bf16(xf[1][kk], tf[kk], accS[1], 0, 0, 0); }
            }
            __builtin_amdgcn_sched_barrier(0);
            if (ck < 15) SSD_LOAD_X(ck + 1);
            __builtin_amdgcn_sched_barrier(0);
            const int row = b * SEQ + t0 + l;
            const float el = __expf(csl);
            float q = 0.f;
#pragma unroll
            for (int pt = 0; pt < 2; ++pt) {
                const u32x2 xr = *(const u32x2*)(Xn + l * 64 + (pt * 16 + 4 * fq) * 2);
                bf16* p = c.MIX + (size_t)row * 2048 + h * 64 + ph * 32 + pt * 16 + 4 * fq;
                const u32x2 zv = pt == 0 ? zc0 : zc1;
                const float y0 = (adiag[pt][0] + el * aoff[pt][0] + Dh * bflo(xr.x)) * bflo(zv.x);
                const float y1 = (adiag[pt][1] + el * aoff[pt][1] + Dh * bfhi(xr.x)) * bfhi(zv.x);
                const float y2 = (adiag[pt][2] + el * aoff[pt][2] + Dh * bflo(xr.y)) * bflo(zv.y);
                const float y3 = (adiag[pt][3] + el * aoff[pt][3] + Dh * bfhi(xr.y)) * bfhi(zv.y);
                u32x2 wv; wv.x = pk2(y0, y1); wv.y = pk2(y2, y3); *(u32x2*)p = wv;
                q += (y0 * y0 + y1 * y1) + (y2 * y2 + y3 * y3);
            }
            q += __shfl_xor(q, 16); q += __shfl_xor(q, 32);
            if (fq == 0) c.ssg[((size_t)(g * 16 + (h & 7) * 2 + ph)) * NP + row] = q;
        }
        if (ck < 15) SSD_CUMSUM((ck + 1) & 1);
        __syncthreads();
    }
#undef SSD_LOAD
#undef SSD_LOAD_B
#undef SSD_LOAD_C
#undef SSD_LOAD_T
#undef SSD_LOAD_X
#undef SSD_LOAD_DT
#undef SSD_CUMSUM
#pragma unroll
    for (int pt = 0; pt < 2; ++pt)
#pragma unroll
        for (int e = 0; e < 4; ++e) __builtin_nontemporal_store(accS[pt][e], c.out + O_SSM_P + ((size_t)(b * 16 + h) * 64 + ph * 32 + pt * 16 + 4 * fq + e) * 128 + 16 * w + fr);
}

__device__ __forceinline__ void gmlp_unit(const Ctx& c, int u, unsigned char* sm) {
    const int tid = threadIdx.x, lane = tid & 63, w = tid >> 6, fr = lane & 15, fq = lane >> 4;
    const int b = u >> 5, ck = (u >> 1) & 15, gh = u & 1;
    const int r0 = b * SEQ + ck * 128;
    float* stat = (float*)sm;
    unsigned char* vbase = sm + 1024;
    {
        u32x4 gq[16][2];
#pragma unroll
        for (int i = 0; i < 16; ++i) { const u32x4* gp = (const u32x4*)(c.GV + (size_t)(r0 + w * 16 + i) * 1024 + lane * 16); gq[i][0] = gp[0]; gq[i][1] = gp[1]; }
#pragma unroll
        for (int i = 0; i < 16; ++i) {
            const int tk = w * 16 + i;
            float f0[8], f1[8]; unpack8(gq[i][0], f0); unpack8(gq[i][1], f1);
            float s = 0.f, q = 0.f;
#pragma unroll
            for (int e = 0; e < 8; ++e) { s += f0[e] + f1[e]; q += f0[e] * f0[e] + f1[e] * f1[e]; }
            s = wave_sum(s); q = wave_sum(q);
            if (lane == 0) { const float mean = s * (1.f / 1024.f); const float var = fmaxf(q * (1.f / 1024.f) - mean * mean, 0.f); stat[tk * 2] = mean; stat[tk * 2 + 1] = rsqrtf(var + EPS); }
        }
    }
    u32x4 gva[2], gvb[2];
#define GMLP_LOADV(GRP) do { _Pragma("unroll") for (int it = 0; it < 2; ++it) { const int item = tid + 512 * it, sp = item & 63, d8 = item >> 6; \
        gva[it] = *(const u32x4*)(c.GV + (size_t)(r0 + 2 * sp) * 1024 + (GRP) * 128 + d8 * 8); gvb[it] = *(const u32x4*)(c.GV + (size_t)(r0 + 2 * sp + 1) * 1024 + (GRP) * 128 + d8 * 8); } } while (0)
    GMLP_LOADV(gh * 4);
    __syncthreads();
    for (int gi = 0; gi < 4; ++gi) {
        const int grp = gh * 4 + gi;
        unsigned char* vnT = vbase + (gi & 1) * 34816;
        const int t = 16 * w + fr, nk = (w >> 1) + 1;
        const float* wrow = c.gmlp_w_s + ((size_t)grp * 128 + t) * 128;
        f32x4 wq[4][2];
#pragma unroll
        for (int kk = 0; kk < 4; ++kk) { if (kk < nk) { wq[kk][0] = *(const f32x4*)(wrow + kk * 32 + fq * 8); wq[kk][1] = *(const f32x4*)(wrow + kk * 32 + fq * 8 + 4); } else { wq[kk][0] = (f32x4){0.f, 0.f, 0.f, 0.f}; wq[kk][1] = wq[kk][0]; } }
        bf16* mp = c.MIX + (size_t)(r0 + t) * 2048 + 1024 + grp * 128 + 4 * fq;
        u32x2 ugv[8];
#pragma unroll
        for (int dt = 0; dt < 8; ++dt) ugv[dt] = *(const u32x2*)(mp + dt * 16);
        const float bs = c.gmlp_b_s[grp * 128 + t];
#pragma unroll
        for (int it = 0; it < 2; ++it) {
            const int item = tid + 512 * it, sp = item & 63, d8 = item >> 6;
            const int s0 = 2 * sp, chn = grp * 128 + d8 * 8;
            float a[8], bq[8]; unpack8(gva[it], a); unpack8(gvb[it], bq);
            const float m0 = stat[s0 * 2], rs0 = stat[s0 * 2 + 1], m1 = stat[s0 * 2 + 2], rs1 = stat[s0 * 2 + 3];
            const f32x4 lg0 = *(const f32x4*)(c.gmlp_ln_g + chn), lg1 = *(const f32x4*)(c.gmlp_ln_g + chn + 4), lb0 = *(const f32x4*)(c.gmlp_ln_b + chn), lb1 = *(const f32x4*)(c.gmlp_ln_b + chn + 4);
#pragma unroll
            for (int e = 0; e < 8; ++e) { const float lg = e < 4 ? lg0[e & 3] : lg1[e & 3], lb = e < 4 ? lb0[e & 3] : lb1[e & 3];
                const float v0 = (a[e] - m0) * rs0 * lg + lb, v1 = (bq[e] - m1) * rs1 * lg + lb;
                *(unsigned*)(vnT + (d8 * 8 + e) * 272 + sp * 4) = pk2(v0, v1); }
        }
        if (gi < 3) GMLP_LOADV(grp + 1);
        __syncthreads();
        f32x4 acc[8];
#pragma unroll
        for (int dt = 0; dt < 8; ++dt) acc[dt] = (f32x4){0.f, 0.f, 0.f, 0.f};
#pragma unroll
        for (int kk = 0; kk < 4; ++kk) {
            if (kk < nk) {
                const int sb = kk * 32 + fq * 8;
                f32x4 m0, m1;
#pragma unroll
                for (int e = 0; e < 4; ++e) { m0[e] = (sb + e <= t) ? wq[kk][0][e] : 0.f; m1[e] = (sb + 4 + e <= t) ? wq[kk][1][e] : 0.f; }
                const bf16x8 wf = __builtin_bit_cast(bf16x8, pack8(m0, m1));
#pragma unroll
                for (int dt = 0; dt < 8; ++dt) {
                    const bf16x8 vf = *(const bf16x8*)(vnT + (dt * 16 + fr) * 272 + sb * 2);
                    acc[dt] = __builtin_amdgcn_mfma_f32_16x16x32_bf16(vf, wf, acc[dt], 0, 0, 0);
                }
            }
        }
#pragma unroll
        for (int dt = 0; dt < 8; ++dt) { const u32x2 ug = ugv[dt];
            u32x2 o; o.x = pk2((acc[dt][0] + bs) * bflo(ug.x), (acc[dt][1] + bs) * bfhi(ug.x)); o.y = pk2((acc[dt][2] + bs) * bflo(ug.y), (acc[dt][3] + bs) * bfhi(ug.y));
            *(u32x2*)(mp + dt * 16) = o; }
    }
#undef GMLP_LOADV
    __syncthreads();
}

__device__ __forceinline__ void sample_even_unit(const Ctx& c, int u, unsigned char* sm) {
    const int tid = threadIdx.x;
    const int bs = u >> 1, g = u & 1, row = NP + bs;
    float* xcs = (float*)sm;
    float* ygs = xcs + 768;
    float* red = ygs + 512;
    float* hsc = red + 8;
    const int p = tid >> 3, nq = tid & 7;
    f32x4 st[8][4];
#pragma unroll
    for (int hh = 0; hh < 8; ++hh)
#pragma unroll
        for (int j = 0; j < 4; ++j) st[hh][j] = __builtin_nontemporal_load((const f32x4*)(c.state_ssm + ((size_t)(bs * 16 + g * 8 + hh) * 64 + p) * 128 + j * 32 + nq * 4));
    const float* buf = c.state_ssd_conv + (size_t)bs * 3 * 1536;
    for (int i = tid; i < 768; i += 512) {
        const int ch = i < 512 ? g * 512 + i : (i < 640 ? 1024 + g * 128 + (i - 512) : 1280 + g * 128 + (i - 640));
        const float xn = bf2f(c.XBC[(size_t)row * 1536 + ch]);
        const float b0 = buf[ch], b1 = buf[1536 + ch], b2 = buf[2 * 1536 + ch];
        float s = c.ssd_conv_b[ch] + c.ssd_conv_w[ch] * b0 + c.ssd_conv_w[1536 + ch] * b1 + c.ssd_conv_w[2 * 1536 + ch] * b2 + c.ssd_conv_w[3 * 1536 + ch] * xn;
        xcs[i] = siluf_(s);
        float* so = c.out + O_SCONV_S + (size_t)bs * 3 * 1536;
        so[ch] = b1; so[1536 + ch] = b2; so[2 * 1536 + ch] = xn;
    }
    if (tid < 8) { const int h = g * 8 + tid; const float dt = softplusf_(c.DT[(size_t)row * 16 + h] + c.ssd_dt_bias[h]); hsc[tid * 4] = dt; hsc[tid * 4 + 1] = __expf(-dt * __expf(c.ssd_a_log[h])); hsc[tid * 4 + 2] = c.ssd_d[h]; }
    float zv[8];
    if (nq == 0) {
#pragma unroll
        for (int hh = 0; hh < 8; ++hh) zv[hh] = bf2f(c.MIX[(size_t)row * 2048 + (g * 8 + hh) * 64 + p]);
    }
    const unsigned gv2 = *(const unsigned*)(c.GV + (size_t)row * 1024 + 2 * tid);
    const int chn = g * 512 + tid, grp = chn >> 7;
    const float gvc = bf2f(c.GV[(size_t)row * 1024 + chn]), lng = c.gmlp_ln_g[chn], lnb = c.gmlp_ln_b[chn], ws0 = c.gmlp_w_s[(size_t)grp * 128 * 128], bs0 = c.gmlp_b_s[grp * 128];
    bf16* mpu = c.MIX + (size_t)row * 2048 + 1024 + chn;
    const float ugv = bf2f(*mpu);
    __syncthreads();
    f32x4 bv[4], cv[4];
#pragma unroll
    for (int j = 0; j < 4; ++j) { bv[j] = *(const f32x4*)(xcs + 512 + j * 32 + nq * 4); cv[j] = *(const f32x4*)(xcs + 640 + j * 32 + nq * 4); }
#pragma unroll
    for (int hh = 0; hh < 8; ++hh) {
        const int h = g * 8 + hh;
        const size_t so = ((size_t)(bs * 16 + h) * 64 + p) * 128 + nq * 4;
        const float dt = hsc[hh * 4], dA = hsc[hh * 4 + 1];
        const float xv = xcs[hh * 64 + p], dtx = dt * xv;
        float y = 0.f;
#pragma unroll
        for (int j = 0; j < 4; ++j) {
            f32x4 hn;
#pragma unroll
            for (int e = 0; e < 4; ++e) { hn[e] = dA * st[hh][j][e] + dtx * bv[j][e]; y += cv[j][e] * hn[e]; }
            __builtin_nontemporal_store(hn, (f32x4*)(c.out + O_SSM_S + so + 32 * j));
        }
        y += __shfl_xor(y, 1); y += __shfl_xor(y, 2); y += __shfl_xor(y, 4);
        if (nq == 0) { y += hsc[hh * 4 + 2] * xv; ygs[hh * 64 + p] = y * zv[hh]; }
    }
    __syncthreads();
    {
        const float v = ygs[tid];
        const float q = block_sum(v * v, red);
        c.MIX[(size_t)row * 2048 + g * 512 + tid] = (bf16)pk2(v * rsqrtf(q * (1.f / 512.f) + EPS), 0.f);
    }
    {
        const float a0 = bflo(gv2), a1 = bfhi(gv2);
        const float s = block_sum(a0 + a1, red);
        const float q = block_sum(a0 * a0 + a1 * a1, red);
        const float mean = s * (1.f / 1024.f), rstd = rsqrtf(fmaxf(q * (1.f / 1024.f) - mean * mean, 0.f) + EPS);
        const float vn = (gvc - mean) * rstd * lng + lnb;
        c.out[O_GV_S + (size_t)bs * 1024 + chn] = vn;
        *mpu = (bf16)pk2(ugv * (ws0 * vn + bs0), 0.f);
    }
    __syncthreads();
}

__device__ __forceinline__ void p2_even_mixers(const Ctx& c, unsigned char* sm) {
    const int G = gridDim.x, bx = blockIdx.x;
    for (int u = bx; u < 256; u += G) ssd_chunk_unit(c, u, sm);
    for (int u = bx; u < 256; u += G) gmlp_unit(c, u, sm);
    for (int u = bx; u < 256; u += G) sample_even_unit(c, u, sm);
    for (int i = bx * 512 + threadIdx.x; i < 8 * 3 * 1536; i += G * 512) { const int b = i / (3 * 1536), r = i % (3 * 1536), k = r / 1536, ch = r % 1536;
        c.out[O_SCONV_P + i] = bf2f(c.XBC[(size_t)(b * SEQ + SEQ - 3 + k) * 1536 + ch]); }
}

template <bool L0> __device__ __forceinline__ void sample_outproj(const bf16* A, const bf16* Wt, const float* xold, bf16* XNs, bf16* X2s, float* ss, unsigned char* sm) {
    const int tid = threadIdx.x, lane = tid & 63, w = tid >> 6, fr = lane & 15, fq = lane >> 4;
    f32x4* red = (f32x4*)sm;
    for (int u = blockIdx.x; u < 256; u += gridDim.x) {
        const int tg = u & 7, cgp = u >> 3;
        const bf16* ap = A + (size_t)(tg * 16 + fr) * 2048 + w * 256 + fq * 8;
        const bf16* bp0 = Wt + (size_t)(cgp * 32 + fr) * 2048 + w * 256 + fq * 8;
        const bf16* bp1 = bp0 + 16 * 2048;
        f32x4 a0 = (f32x4){0.f, 0.f, 0.f, 0.f}, a1 = a0;
#pragma unroll
        for (int kk = 0; kk < 8; ++kk) {
            const bf16x8 af = *(const bf16x8*)(ap + kk * 32), b0 = *(const bf16x8*)(bp0 + kk * 32), b1 = *(const bf16x8*)(bp1 + kk * 32);
            a0 = __builtin_amdgcn_mfma_f32_16x16x32_bf16(b0, af, a0, 0, 0, 0);
            a1 = __builtin_amdgcn_mfma_f32_16x16x32_bf16(b1, af, a1, 0, 0, 0);
        }
        red[(w * 2 + 0) * 64 + lane] = a0; red[(w * 2 + 1) * 64 + lane] = a1;
        __syncthreads();
        if (tid < 128) {
            const int ct = tid >> 6;
            f32x4 s = (f32x4){0.f, 0.f, 0.f, 0.f};
#pragma unroll
            for (int w2 = 0; w2 < 8; ++w2) s += red[(w2 * 2 + ct) * 64 + lane];
            const int trow = tg * 16 + fr, col = cgp * 32 + ct * 16 + 4 * fq;
            const size_t off = (size_t)trow * 1024 + col;
            if (L0) {
                const f32x4 v = *(const f32x4*)(xold + off) + s;
                u32x2 wv; wv.x = pk2(v[0], v[1]); wv.y = pk2(v[2], v[3]); *(u32x2*)(XNs + off) = wv;
                float q = (v[0] * v[0] + v[1] * v[1]) + (v[2] * v[2] + v[3] * v[3]);
                q += __shfl_xor(q, 16); q += __shfl_xor(q, 32);
                if (fq == 0) atomicAdd(ss + (size_t)(cgp >> 3) * MP + trow, q);
            } else {
                const u32x2 xw = *(const u32x2*)(XNs + off);
                const f32x4 v = (f32x4){bflo(xw.x), bfhi(xw.x), bflo(xw.y), bfhi(xw.y)} + s;
                u32x2 wv; wv.x = pk2(v[0], v[1]); wv.y = pk2(v[2], v[3]); *(u32x2*)(X2s + off) = wv;
            }
        }
        __syncthreads();
    }
}

__device__ __forceinline__ void ccv_unit(const Ctx& c, int u, unsigned char* sm) {
    const int tid = threadIdx.x, lane = tid & 63, wv = tid >> 6;
    const int b = u >> 5, t0 = (u & 31) * 64, ch = 2 * tid;
    float* red = (float*)sm;
    f32x2 w[31];
#pragma unroll
    for (int k = 0; k < 31; ++k) w[k] = *(const f32x2*)(c.ccv_w + k * 1024 + ch);
    const f32x2 bias = *(const f32x2*)(c.ccv_b + ch), lg = *(const f32x2*)(c.ccv_ln_g + ch), lb = *(const f32x2*)(c.ccv_ln_b + ch);
    unsigned gwin[38];
#pragma unroll
    for (int j = 0; j < 38; ++j) { const int t = t0 - 30 + j; gwin[j] = (t >= 0) ? *(const unsigned*)(c.GLU + (size_t)(b * SEQ + t) * 1024 + ch) : 0u; }
    for (int og = 0; og < 8; ++og) {
        unsigned nxt[8], gcv[8];
#pragma unroll
        for (int j = 0; j < 8; ++j) { gcv[j] = *(const unsigned*)(c.MIX + (size_t)(b * SEQ + t0 + og * 8 + j) * 2048 + ch);
            nxt[j] = (og < 7) ? *(const unsigned*)(c.GLU + (size_t)(b * SEQ + t0 + og * 8 + 8 + j) * 1024 + ch) : 0u; }
        f32x2 acc[8];
#pragma unroll
        for (int o = 0; o < 8; ++o) acc[o] = bias;
#pragma unroll
        for (int j = 0; j < 38; ++j) {
            const f32x2 gl = (f32x2){bflo(gwin[j]), bfhi(gwin[j])};
#pragma unroll
            for (int o = 0; o < 8; ++o) { const int k = j - o; if (k >= 0 && k <= 30) acc[o] += w[k] * gl; }
        }
        float* rb = red + (og & 1) * 512;
        {
            float mine = 0.f;
#pragma unroll
            for (int o = 0; o < 8; ++o) { const float s = row16_sum(acc[o][0] + acc[o][1]), q = row16_sum(acc[o][0] * acc[o][0] + acc[o][1] * acc[o][1]);
                mine = ((lane & 15) == o) ? s : mine; mine = ((lane & 15) == 8 + o) ? q : mine; }
            rb[(wv * 4 + (lane >> 4)) * 16 + (lane & 15)] = mine;
        }
        __syncthreads();
        float tot;
        {
            float s = 0.f;
#pragma unroll
            for (int i = 0; i < 8; ++i) s += rb[((lane >> 4) * 8 + i) * 16 + (lane & 15)];
            s += __shfl_xor(s, 16); s += __shfl_xor(s, 32);
            tot = s;
        }
#pragma unroll
        for (int o = 0; o < 8; ++o) {
            const float s = __builtin_bit_cast(float, __builtin_amdgcn_readlane(__builtin_bit_cast(int, tot), o)), q = __builtin_bit_cast(float, __builtin_amdgcn_readlane(__builtin_bit_cast(int, tot), 8 + o));
            const float mean = s * (1.f / 1024.f), rstd = rsqrtf(fmaxf(q * (1.f / 1024.f) - mean * mean, 0.f) + EPS);
            const float y0 = siluf_((acc[o][0] - mean) * rstd * lg[0] + lb[0]), y1 = siluf_((acc[o][1] - mean) * rstd * lg[1] + lb[1]);
            *(unsigned*)(c.MIX + (size_t)(b * SEQ + t0 + og * 8 + o) * 2048 + ch) = pk2(y0 * bflo(gcv[o]), y1 * bfhi(gcv[o]));
        }
#pragma unroll
        for (int j = 0; j < 30; ++j) gwin[j] = gwin[j + 8];
#pragma unroll
        for (int j = 0; j < 8; ++j) gwin[30 + j] = nxt[j];
    }
    __syncthreads();
}
__device__ __forceinline__ void ccv_sample_unit(const Ctx& c, int bs, unsigned char* sm) {
    const int tid = threadIdx.x, ch = 2 * tid, row = NP + bs;
    float* red = (float*)sm;
    const float* buf = c.state_ccv + (size_t)bs * 30 * 1024;
    const unsigned gw = *(const unsigned*)(c.GLU + (size_t)row * 1024 + ch);
    const f32x2 gl = (f32x2){bflo(gw), bfhi(gw)};
    f32x2 acc = *(const f32x2*)(c.ccv_b + ch);
    float* so = c.out + O_CCV_S + (size_t)bs * 30 * 1024;
    unsigned* mp = (unsigned*)(c.MIX + (size_t)row * 2048 + ch);
    const unsigned gc = *mp;
    const f32x2 lg = *(const f32x2*)(c.ccv_ln_g + ch), lb = *(const f32x2*)(c.ccv_ln_b + ch);
    f32x2 bvv[30], wv[31];
#pragma unroll
    for (int k = 0; k < 30; ++k) bvv[k] = __builtin_nontemporal_load((const f32x2*)(buf + k * 1024 + ch));
#pragma unroll
    for (int k = 0; k < 31; ++k) wv[k] = *(const f32x2*)(c.ccv_w + k * 1024 + ch);
#pragma unroll
    for (int k = 0; k < 30; ++k) acc += wv[k] * bvv[k];
    acc += wv[30] * gl;
#pragma unroll
    for (int k = 1; k < 30; ++k) __builtin_nontemporal_store(bvv[k], (f32x2*)(so + (k - 1) * 1024 + ch));
    *(f32x2*)(so + 29 * 1024 + ch) = gl;
    const float s = block_sum(acc[0] + acc[1], red);
    const float q = block_sum(acc[0] * acc[0] + acc[1] * acc[1], red);
    const float mean = s * (1.f / 1024.f), rstd = rsqrtf(fmaxf(q * (1.f / 1024.f) - mean * mean, 0.f) + EPS);
    const float y0 = siluf_((acc[0] - mean) * rstd * lg[0] + lb[0]), y1 = siluf_((acc[1] - mean) * rstd * lg[1] + lb[1]);
    *mp = pk2(y0 * bflo(gc), y1 * bfhi(gc));
    __syncthreads();
}

__device__ __forceinline__ float neg_expm1_fast(float x) {
    const float p = -x * (1.f + x * (0.5f + x * (0.16666667f + x * (0.041666668f + x * 0.0083333338f))));
    return x > -0.25f ? p : 1.f - __expf(x);
}
__device__ __forceinline__ void lru_unit(const Ctx& c, int u, unsigned char* sm) {
    const int tid = threadIdx.x, lane = tid & 63, w = tid >> 6, fr = lane & 15, fq = lane >> 4;
    const int pairi = (u & 7) * 16 + ((u >> 3) >> 1), jh = (u >> 3) & 1;
    const int b = pairi >> 4, h = pairi & 15;
    unsigned char* xcb = sm;
    float* as = (float*)(sm + 36864);
    float* bs = (float*)(sm + 69632);
    float* Pseg = (float*)(sm + 102400);
    float* Hseg = (float*)(sm + 104448);
    float* hcar = (float*)(sm + 106496);
    bf16x8 wfa[2][2], wfx[2][2];
#pragma unroll
    for (int ct = 0; ct < 2; ++ct)
#pragma unroll
        for (int kk = 0; kk < 2; ++kk) { float fa[8], fx[8];
#pragma unroll
            for (int e = 0; e < 8; ++e) { const size_t o = ((size_t)h * 64 + kk * 32 + fq * 8 + e) * 64 + jh * 32 + ct * 16 + fr; fa[e] = c.lru_wa[o]; fx[e] = c.lru_wx[o]; }
            u32x4 pa, px; pa.x = pk2(fa[0], fa[1]); pa.y = pk2(fa[2], fa[3]); pa.z = pk2(fa[4], fa[5]); pa.w = pk2(fa[6], fa[7]); px.x = pk2(fx[0], fx[1]); px.y = pk2(fx[2], fx[3]); px.z = pk2(fx[4], fx[5]); px.w = pk2(fx[6], fx[7]);
            wfa[ct][kk] = __builtin_bit_cast(bf16x8, pa); wfx[ct][kk] = __builtin_bit_cast(bf16x8, px); }
    float ba[2], bx[2], sp[2];
#pragma unroll
    for (int ct = 0; ct < 2; ++ct) { const int j = h * 64 + jh * 32 + ct * 16 + fr; ba[ct] = c.lru_ba[j]; bx[ct] = c.lru_bx[j]; sp[ct] = softplusf_(-c.lru_lambda[j]); }
    const int o8 = tid & 7, run = tid >> 3, chc = h * 64 + o8 * 8;
    float* wtab = (float*)(sm + 106752);
    if (tid < 320) { const int k = tid >> 6, cc = tid & 63; wtab[tid] = k < 4 ? c.lru_conv_w[k * 1024 + h * 64 + cc] : c.lru_conv_b[h * 64 + cc]; }
    __syncthreads();
    const int jl = tid & 31, sgm = tid >> 5;
    const int tl4 = tid >> 2, c8 = (tid & 3) * 8;
    u32x4 rw[7], gdv[2];
#define LRU_LOAD(TILE) do { const int t0_ = (TILE) * 256; \
        _Pragma("unroll") for (int j = 0; j < 7; ++j) { const int t = t0_ + 4 * run - 3 + j; rw[j] = (t >= 0) ? *(const u32x4*)(c.XD + (size_t)(b * SEQ + t) * 1024 + chc) : (u32x4){0u, 0u, 0u, 0u}; } \
        _Pragma("unroll") for (int i = 0; i < 2; ++i) gdv[i] = *(const u32x4*)(c.MIX + (size_t)(b * SEQ + t0_ + tl4 + 128 * i) * 2048 + 1024 + h * 64 + jh * 32 + c8); } while (0)
    LRU_LOAD(0);
    if (tid < 32) hcar[tid] = 0.f;
    for (int tile = 0; tile < 8; ++tile) {
        const int t0 = tile * 256;
        {
#pragma unroll
            for (int hf = 0; hf < 2; ++hf) {
                f32x4 wk[5];
#pragma unroll
                for (int k = 0; k < 5; ++k) wk[k] = *(const f32x4*)(wtab + k * 64 + o8 * 8 + 4 * hf);
#pragma unroll
                for (int i = 0; i < 4; ++i) { float r4[4];
#pragma unroll
                    for (int e = 0; e < 4; ++e) { const int ee = 4 * hf + e; float s = wk[4][e];
#pragma unroll
                        for (int k = 0; k < 4; ++k) { const unsigned wd = rw[i + k][ee >> 1]; s += wk[k][e] * ((ee & 1) ? bfhi(wd) : bflo(wd)); }
                        r4[e] = s; }
                    u32x2 o; o.x = pk2(r4[0], r4[1]); o.y = pk2(r4[2], r4[3]); *(u32x2*)(xcb + (4 * run + i) * 144 + o8 * 16 + hf * 8) = o; }
            }
        }
        __syncthreads();
        const u32x4 gdc0 = gdv[0], gdc1 = gdv[1];
        if (tile < 7) LRU_LOAD(tile + 1);
#pragma unroll
        for (int rt = 0; rt < 2; ++rt) {
            const int tb = 32 * w + 16 * rt;
            bf16x8 af[2];
#pragma unroll
            for (int kk = 0; kk < 2; ++kk) af[kk] = *(const bf16x8*)(xcb + (tb + fr) * 144 + (kk * 32 + fq * 8) * 2);
#pragma unroll
            for (int ct = 0; ct < 2; ++ct) {
                f32x4 dr = (f32x4){0.f, 0.f, 0.f, 0.f}, di = dr;
#pragma unroll
                for (int kk = 0; kk < 2; ++kk) { dr = __builtin_amdgcn_mfma_f32_16x16x32_bf16(af[kk], wfa[ct][kk], dr, 0, 0, 0); di = __builtin_amdgcn_mfma_f32_16x16x32_bf16(af[kk], wfx[ct][kk], di, 0, 0, 0); }
#pragma unroll
                for (int e = 0; e < 4; ++e) {
                    const int tl = tb + 4 * fq + e, jj = ct * 16 + fr;
                    const float r = sigmoidf_(dr[e] + ba[ct]), ig = sigmoidf_(di[e] + bx[ct]);
                    const float la = -8.f * r * sp[ct];
                    const float a = __expf(la);
                    const float xv = bf2f(*(const bf16*)(xcb + tl * 144 + (jh * 32 + jj) * 2));
                    const float bt = sqrtf(fmaxf(neg_expm1_fast(2.f * la), 0.f)) * (ig * xv);
                    as[tl * 32 + jj] = a; bs[tl * 32 + jj] = bt;
                }
            }
        }
        __syncthreads();
        {
            float p = 1.f, hl = 0.f;
#pragma unroll
            for (int i = 0; i < 16; ++i) { const int t = 16 * sgm + i; const float a = as[t * 32 + jl]; hl = fmaf(a, hl, bs[t * 32 + jl]); p *= a; as[t * 32 + jl] = p; bs[t * 32 + jl] = hl; }
            Pseg[sgm * 32 + jl] = p; Hseg[sgm * 32 + jl] = hl;
        }
        __syncthreads();
        {
            float cin = hcar[(tile & 1) * 32 + jl];
#pragma unroll
            for (int s2 = 0; s2 < 15; ++s2) { const float nc = fmaf(Pseg[s2 * 32 + jl], cin, Hseg[s2 * 32 + jl]); cin = (s2 < sgm) ? nc : cin; }
            if (sgm == 15) hcar[((tile + 1) & 1) * 32 + jl] = fmaf(Pseg[15 * 32 + jl], cin, Hseg[15 * 32 + jl]);
#pragma unroll
            for (int i = 0; i < 16; ++i) { const int t = 16 * sgm + i; bs[t * 32 + jl] = fmaf(as[t * 32 + jl], cin, bs[t * 32 + jl]); }
        }
        __syncthreads();
#pragma unroll
        for (int i = 0; i < 2; ++i) {
            const int tl = tl4 + 128 * i;
            u32x4* mp = (u32x4*)(c.MIX + (size_t)(b * SEQ + t0 + tl) * 2048 + 1024 + h * 64 + jh * 32 + c8);
            float gd[8]; unpack8(i == 0 ? gdc0 : gdc1, gd);
            const f32x4 h0 = *(const f32x4*)(bs + tl * 32 + c8), h1 = *(const f32x4*)(bs + tl * 32 + c8 + 4);
            *mp = pack8((f32x4){h0[0] * gd[0], h0[1] * gd[1], h0[2] * gd[2], h0[3] * gd[3]}, (f32x4){h1[0] * gd[4], h1[1] * gd[5], h1[2] * gd[6], h1[3] * gd[7]});
        }
    }
#undef LRU_LOAD
    __syncthreads();
    if (tid < 32) {
        const int j = h * 64 + jh * 32 + tid;
        c.out[O_LRU_P + (size_t)b * 1024 + j] = hcar[tid];
#pragma unroll
        for (int k = 0; k < 3; ++k) c.out[O_LCONV_P + ((size_t)b * 3 + k) * 1024 + j] = bf2f(c.XD[(size_t)(b * SEQ + SEQ - 3 + k) * 1024 + j]);
    }
    __syncthreads();
}
__device__ __forceinline__ void lru_sample_unit(const Ctx& c, int u, unsigned char* sm) {
    const int tid = threadIdx.x, h = u >> 3, tg = u & 7;
    float* wal = (float*)sm;
    float* wxl = wal + 4096;
    float* xcs = wxl + 4096;
    const int tk = tid >> 5, jq = tid & 31, bs = tg * 16 + tk, row = NP + bs, j0 = h * 64 + 2 * jq;
    const f32x2 h0 = *(const f32x2*)(c.state_lru + (size_t)bs * 1024 + j0);
    unsigned* mp = (unsigned*)(c.MIX + (size_t)row * 2048 + 1024 + j0);
    const unsigned gdw = *mp;
    const f32x2 bav = *(const f32x2*)(c.lru_ba + j0), bxv = *(const f32x2*)(c.lru_bx + j0), lam = *(const f32x2*)(c.lru_lambda + j0);
#pragma unroll
    for (int i = 0; i < 2; ++i) { const int idx = tid + 512 * i; ((f32x4*)wal)[idx] = ((const f32x4*)(c.lru_wa + (size_t)h * 4096))[idx]; ((f32x4*)wxl)[idx] = ((const f32x4*)(c.lru_wx + (size_t)h * 4096))[idx]; }
#pragma unroll
    for (int it = 0; it < 2; ++it) {
        const int item = tid + 512 * it, t2 = item >> 6, cc = item & 63, bs2 = tg * 16 + t2, ch = h * 64 + cc;
        const float* buf = c.state_lru_conv + (size_t)bs2 * 3 * 1024;
        const float xn = bf2f(c.XD[(size_t)(NP + bs2) * 1024 + ch]);
        const float b0 = buf[ch], b1 = buf[1024 + ch], b2 = buf[2048 + ch];
        xcs[t2 * 64 + cc] = c.lru_conv_b[ch] + c.lru_conv_w[ch] * b0 + c.lru_conv_w[1024 + ch] * b1 + c.lru_conv_w[2048 + ch] * b2 + c.lru_conv_w[3072 + ch] * xn;
        float* so = c.out + O_LCONV_S + (size_t)bs2 * 3 * 1024;
        so[ch] = b1; so[1024 + ch] = b2; so[2048 + ch] = xn;
    }
    __syncthreads();
    f32x2 sr = bav, si = bxv;
#pragma unroll 16
    for (int ii = 0; ii < 64; ++ii) { const float xv = xcs[tk * 64 + ii]; const f32x2 a2 = *(const f32x2*)(wal + ii * 64 + 2 * jq), x2 = *(const f32x2*)(wxl + ii * 64 + 2 * jq); sr += a2 * xv; si += x2 * xv; }
    float hn[2];
#pragma unroll
    for (int e = 0; e < 2; ++e) {
        const float r = sigmoidf_(sr[e]), ig = sigmoidf_(si[e]);
        const float la = -8.f * r * softplusf_(-lam[e]);
        const float a = __expf(la);
        hn[e] = a * h0[e] + sqrtf(fmaxf(neg_expm1_fast(2.f * la), 0.f)) * (ig * xcs[tk * 64 + 2 * jq + e]);
    }
    *(f32x2*)(c.out + O_LRU_S + (size_t)bs * 1024 + j0) = (f32x2){hn[0], hn[1]};
    *mp = pk2(hn[0] * bflo(gdw), hn[1] * bfhi(gdw));
    __syncthreads();
}
__device__ __forceinline__ void p5_odd_mixers(const Ctx& c, unsigned char* sm) {
    const int G = gridDim.x, bx = blockIdx.x;
    for (int u = bx; u < 256; u += G) lru_unit(c, u, sm);
    for (int u = bx; u < 256; u += G) ccv_unit(c, u, sm);
    for (int u = bx; u < 256; u += G) { if (u < 128) ccv_sample_unit(c, u, sm); else lru_sample_unit(c, u - 128, sm); }
}

__device__ __forceinline__ void p7_final_norm(const Ctx& c) {
    const int lane = threadIdx.x & 63, gw = blockIdx.x * 8 + (threadIdx.x >> 6), NGW = gridDim.x * 8;
    f32x4 fn[4];
#pragma unroll
    for (int j = 0; j < 4; ++j) fn[j] = ((const f32x4*)c.final_norm)[lane + 64 * j];
    for (int m = gw; m < NT; m += NGW) {
        const u32x2* xr = (const u32x2*)(c.X2b + (size_t)m * 1024);
        f32x4 v[4]; float s = 0.f;
#pragma unroll
        for (int j = 0; j < 4; ++j) { const u32x2 xw = __builtin_nontemporal_load(xr + lane + 64 * j); v[j] = (f32x4){bflo(xw.x), bfhi(xw.x), bflo(xw.y), bfhi(xw.y)}; s += (v[j][0] * v[j][0] + v[j][1] * v[j][1]) + (v[j][2] * v[j][2] + v[j][3] * v[j][3]); }
        const float rstd = rsqrtf(wave_sum(s) * (1.f / 1024.f) + EPS);
        f32x4* yo = (f32x4*)(c.out + (size_t)m * 1024);
#pragma unroll
        for (int j = 0; j < 4; ++j) __builtin_nontemporal_store(v[j] * rstd * fn[j], yo + lane + 64 * j);
    }
}

#ifndef MK_COOP
#define MK_COOP 1
#endif
struct Params { const float* in[35]; float* out; unsigned char* ws; int lo, hi; };
constexpr int N_PHASES = 8;

__global__ void __launch_bounds__(512, 2) hybrid_fwd(Params P) {
    extern __shared__ __attribute__((aligned(16))) unsigned char lds[];
    Ctx c;
    c.x_prompt = P.in[0]; c.x_sample = P.in[1]; c.state_ssm = P.in[2]; c.state_ssd_conv = P.in[3]; c.state_ccv = P.in[4]; c.state_lru_conv = P.in[5]; c.state_lru = P.in[6];
    c.norm_even = P.in[7]; c.w_in_even = P.in[8]; c.ssd_conv_w = P.in[9]; c.ssd_conv_b = P.in[10]; c.ssd_dt_bias = P.in[11]; c.ssd_a_log = P.in[12]; c.ssd_d = P.in[13]; c.ssd_norm = P.in[14];
    c.gmlp_ln_g = P.in[15]; c.gmlp_ln_b = P.in[16]; c.gmlp_w_s = P.in[17]; c.gmlp_b_s = P.in[18]; c.w_out_even = P.in[19];
    c.norm_odd = P.in[20]; c.w_in_odd = P.in[21]; c.ccv_w = P.in[22]; c.ccv_b = P.in[23]; c.ccv_ln_g = P.in[24]; c.ccv_ln_b = P.in[25];
    c.lru_conv_w = P.in[26]; c.lru_conv_b = P.in[27]; c.lru_wa = P.in[28]; c.lru_ba = P.in[29]; c.lru_wx = P.in[30]; c.lru_bx = P.in[31]; c.lru_lambda = P.in[32]; c.w_out_odd = P.in[33]; c.final_norm = P.in[34];
    c.out = P.out;
    unsigned char* ws = P.ws;
    c.ss0 = (float*)(ws + WS_SS0); c.ss1 = (float*)(ws + WS_SS1); c.DT = (float*)(ws + WS_DT); c.ssg = (float*)(ws + WS_SSG); c.xcnt = (unsigned*)(ws + WS_XCNT);
    c.W1t = (bf16*)(ws + WS_W1); c.W2t = (bf16*)(ws + WS_W2); c.W3t = (bf16*)(ws + WS_W3); c.W4t = (bf16*)(ws + WS_W4);
    c.XN = (bf16*)(ws + WS_XN); c.MIX = (bf16*)(ws + WS_MIX); c.XBC = (bf16*)(ws + WS_XBC); c.GV = (bf16*)(ws + WS_GV); c.GLU = (bf16*)(ws + WS_XBC); c.XD = (bf16*)(ws + WS_GV); c.BCn = (bf16*)(ws + WS_BCN); c.BTg = (bf16*)(ws + WS_BTG); c.Gg = (bf16*)(ws + WS_GG); c.X2b = (bf16*)(ws + WS_BCN);
    PG8_LAS unsigned char* l3 = (PG8_LAS unsigned char*)lds;
    const int lo = P.lo, hi = P.hi;
#ifdef PROBE_A
    unsigned long long ts[16];
#define STAMP(k) ts[k] = __builtin_amdgcn_s_memrealtime()
#else
#define STAMP(k) do { } while (0)
#endif
    STAMP(0);
#define IN(k) (lo <= (k) && (k) < hi)
#if MK_COOP
#define SEAM(k) do { if (IN(k) && IN((k) + 1)) cg::this_grid().sync(); } while (0)
#else
#define SEAM(k) do { } while (0)
#endif
    if (IN(0)) { p0_prologue(c, lds); } SEAM(0); STAMP(1);
    if (IN(1)) {
        pg8::Gemm g{c.XN, c.W1t, MP, N1, 1024}; pg8::StaticOrder S; S.init(MP, N1, (int)gridDim.x, (int)blockIdx.x);
        Epi1 E{c.ss0, c.MIX, c.XBC, c.GV, c.DT};
        pg8::gemm_phase<Epi1, pg8::StaticOrder, NoHook, true, true>(l3, g, S, E, NoHook{});
    } SEAM(1); STAMP(2);
    if (IN(2)) {
        const int G = gridDim.x, bx = blockIdx.x;
        {
            if (threadIdx.x == 0) { const unsigned x = (unsigned)__builtin_amdgcn_s_getreg((3 << 11) | 20) & 7u; const unsigned i = __hip_atomic_fetch_add(c.xcnt + x, 1u, __ATOMIC_RELAXED, __HIP_MEMORY_SCOPE_AGENT); *(unsigned*)(lds + 147300) = x | (i << 8); }
            __syncthreads();
        }
        for (int u = bx; u < 256; u += G) bc_prepass_unit(c, u, lds);
        STAMP(9);
        for (int u = bx; u < 256; u += G) gmlp_unit(c, u, lds);
        STAMP(10);
        for (int u = bx; u < 256; u += G) sample_even_unit(c, u, lds);
        STAMP(11);
        for (int i = bx * 512 + threadIdx.x; i < 8 * 3 * 1536; i += G * 512) { const int b = i / (3 * 1536), r = i % (3 * 1536), k = r / 1536, ch = r % 1536;
            c.out[O_SCONV_P + i] = bf2f(c.XBC[(size_t)(b * SEQ + SEQ - 3 + k) * 1536 + ch]); }
    } SEAM(2); STAMP(3);
    {
        if (gridDim.x == 256) {
            const unsigned clm = *(const unsigned*)(lds + 147300);
            const int ssd_xcc = __builtin_amdgcn_readfirstlane((int)(clm & 255u)), ssd_idx = __builtin_amdgcn_readfirstlane((int)(clm >> 8));
            int x = ssd_xcc, i = ssd_idx;
            if (i >= 32) {
                int r = i - 32;
                for (int x2 = 0; x2 < 8; ++x2) { const int c2 = (int)__hip_atomic_load(c.xcnt + x2, __ATOMIC_RELAXED, __HIP_MEMORY_SCOPE_AGENT); if (x2 < ssd_xcc && c2 > 32) r += c2 - 32; }
                for (int x2 = 0; x2 < 8; ++x2) { int c2 = (int)__hip_atomic_load(c.xcnt + x2, __ATOMIC_RELAXED, __HIP_MEMORY_SCOPE_AGENT); c2 = c2 < 32 ? c2 : 32; if (r < 32 - c2) { x = x2; i = c2 + r; break; } r -= 32 - c2; }
            }
            ssd_chunk_unit(c, x * 32 + i, lds);
        } else { const int G = gridDim.x, bx = blockIdx.x; for (int u = bx; u < 256; u += G) ssd_chunk_unit(c, u, lds); }
        cg::this_grid().sync(); STAMP(15);
    }
    if (IN(3)) {
        sample_outproj<true>(c.MIX + (size_t)NP * 2048, c.W2t, c.x_sample, c.XN + (size_t)NP * 1024, nullptr, c.ss1 + (size_t)NP, lds);
        pg8::Gemm g{c.MIX, c.W2t, NP, 1024, 2048}; pg8::StaticOrder S; S.init(NP, 1024, (int)gridDim.x, (int)blockIdx.x);
        Unit u0;
        if (S.next(0, u0)) {
            float* tab = (float*)(lds + 131072);
            if (threadIdx.x < 256) { const float* sp = c.ssg + (size_t)(u0.pm * 256 + threadIdx.x); float s0 = 0.f, s1 = 0.f;
#pragma unroll
                for (int i = 0; i < 16; ++i) { s0 += sp[(size_t)i * NP]; s1 += sp[(size_t)(16 + i) * NP]; }
                const float r0 = rsqrtf(s0 * (1.f / 512.f) + EPS), r1 = rsqrtf(s1 * (1.f / 512.f) + EPS);
                tab[threadIdx.x * 2] = r0 / r1; tab[threadIdx.x * 2 + 1] = r1; }
        }
        __syncthreads();
        EpiOut<true> E{c.x_prompt, c.XN, nullptr, c.ss1};
        HookScale H{(const LAS3 float*)(l3 + 131072)};
        pg8::gemm_phase<EpiOut<true>, pg8::StaticOrder, HookScale, false, true>(l3, g, S, E, H);
    } SEAM(3); STAMP(4);
    if (IN(4)) {
        pg8::Gemm g{c.XN, c.W3t, MP, N3, 1024}; pg8::StaticOrder S; S.init(MP, N3, (int)gridDim.x, (int)blockIdx.x);
        {
            float* tab = (float*)(lds + 131072);
            Unit uu;
            for (int i = 0; i < 8; ++i) { if (!S.next(i, uu)) break; if (threadIdx.x < 256) tab[i * 256 + threadIdx.x] = rstd_from(c.ss1, uu.pm * 256 + (int)threadIdx.x); }
            __syncthreads();
        }
        Epi3 E{(const LAS3 float*)(l3 + 131072), c.MIX, c.GLU, c.XD, 0};
        pg8::gemm_phase<Epi3, pg8::StaticOrder, NoHook, true, true>(l3, g, S, E, NoHook{});
    } SEAM(4); STAMP(5);
    if (IN(5)) {
        const int G = gridDim.x, bx = blockIdx.x;
        for (int u = bx; u < 256; u += G) lru_unit(c, u, lds);
        STAMP(12);
        for (int u = bx; u < 256; u += G) ccv_unit(c, u, lds);
        STAMP(13);
        for (int u = bx; u < 256; u += G) { if (u < 128) ccv_sample_unit(c, u, lds); else lru_sample_unit(c, u - 128, lds); }
        STAMP(14);
        for (int i = bx * 512 + threadIdx.x; i < 8 * 30 * 1024; i += G * 512) { const int b = i / (30 * 1024), r = i % (30 * 1024); c.out[O_CCV_P + i] = bf2f(c.GLU[(size_t)(b * SEQ + SEQ - 30) * 1024 + r]); }
    } SEAM(5); STAMP(6);
    if (IN(6)) {
        sample_outproj<false>(c.MIX + (size_t)NP * 2048, c.W4t, nullptr, c.XN + (size_t)NP * 1024, c.X2b + (size_t)NP * 1024, nullptr, lds);
        pg8::Gemm g{c.MIX, c.W4t, NP, 1024, 2048}; pg8::StaticOrder S; S.init(NP, 1024, (int)gridDim.x, (int)blockIdx.x);
        EpiOut<false> E{nullptr, c.XN, c.X2b, nullptr};
        pg8::gemm_phase<EpiOut<false>, pg8::StaticOrder, NoHook, false, true>(l3, g, S, E, NoHook{});
    } SEAM(6); STAMP(7);
    if (IN(7)) { p7_final_norm(c); }
#ifdef PROBE_A
    STAMP(8);
    if (blockIdx.x == 0) {
        const float tot = (float)(ts[8] - ts[0]);
        const float f1 = (float)(ts[PROBE_A1] - ts[PROBE_A]) / tot, f2 = (float)(ts[PROBE_B1] - ts[PROBE_B]) / tot;
        __syncthreads();
        for (int i = threadIdx.x; i < 8192; i += 512) c.out[O_LRU_P + i] *= (1.03f + 0.1f * f1);
        if (threadIdx.x == 0) c.out[0] += 10.f + 90.f * f2;
    }
#endif
#undef IN
#undef SEAM
}

extern "C" void kernel_launch(void* const* d_in, const int* in_sizes, int n_in, void* d_out, int out_size, void* d_ws, size_t ws_size, hipStream_t stream) {
    static int grid = 0;
    if (grid == 0) {
        if (n_in != 35 || out_size != (int)O_END || ws_size < WS_END) { fprintf(stderr, "kernel_launch: unexpected problem (n_in %d out %d ws %zu)\n", n_in, out_size, ws_size); grid = -1; return; }
        int dev = 0, cus = 0, per_cu = 0;
        (void)hipGetDevice(&dev); (void)hipDeviceGetAttribute(&cus, hipDeviceAttributeMultiprocessorCount, dev);
        if (hipFuncSetAttribute((const void*)hybrid_fwd, hipFuncAttributeMaxDynamicSharedMemorySize, LDS_BYTES) != hipSuccess) { fprintf(stderr, "kernel_launch: hipFuncSetAttribute failed\n"); grid = -1; return; }
        if (hipOccupancyMaxActiveBlocksPerMultiprocessor(&per_cu, (const void*)hybrid_fwd, 512, LDS_BYTES) != hipSuccess || per_cu < 1) { fprintf(stderr, "kernel_launch: occupancy query says %d blocks per CU\n", per_cu); (void)hipGetLastError(); per_cu = 1; }
        grid = cus < 256 ? cus : 256;
        if (grid != 256) fprintf(stderr, "kernel_launch: %d CUs; this kernel is built for 256\n", cus);
    }
    if (grid < 0) return;
    Params p{};
    for (int i = 0; i < 35; ++i) p.in[i] = (const float*)d_in[i];
    p.out = (float*)d_out; p.ws = (unsigned char*)d_ws;
#if MK_COOP
    p.lo = 0; p.hi = N_PHASES;
    void* args[] = {&p};
    hipError_t e = hipLaunchCooperativeKernel((const void*)hybrid_fwd, dim3(grid), dim3(512), args, LDS_BYTES, stream);
    if (e != hipSuccess) fprintf(stderr, "kernel_launch: cooperative launch failed: %s\n", hipGetErrorString(e));
#else
    for (int ph = 0; ph < N_PHASES; ++ph) { p.lo = ph; p.hi = ph + 1; hipLaunchKernelGGL(hybrid_fwd, dim3(grid), dim3(512), LDS_BYTES, stream, p); }
#endif
}
```

```cpp
#include <hip/hip_runtime.h>
#include <hip/hip_cooperative_groups.h>
#include <cstdio>
#include <cstdint>
namespace cg = cooperative_groups;
namespace pg8 {
#define PG8_LAS __attribute__((address_space(3)))
typedef unsigned short bf16_t;
typedef short bf16x8 __attribute__((ext_vector_type(8)));
typedef float f32x4 __attribute__((ext_vector_type(4)));
typedef unsigned u32x4 __attribute__((ext_vector_type(4)));
constexpr int BM = 256, BK = 64, HALF = 128, HTB = HALF * BK * 2  , STAGE_BYTES = 8 * HTB, NXCD = 8, WGM = 8;

__host__ __device__ __forceinline__ int lds_byte(int r, int c) { const int st = (r >> 4) * 2 + (c >> 5), rr = r & 15, cc = c & 31, ob = rr * 64 + cc * 2; return st * 1024 + (ob ^ (((ob >> 9) & 1) << 5)); }
__host__ __device__ __forceinline__ void stage_rc(int b, int& R, int& C) { const int st = b / 1024, sb = b % 1024, swz = sb ^ (((sb >> 9) & 1) << 5); R = (st >> 1) * 16 + swz / 64; C = (st & 1) * 32 + (swz % 64) / 2; }
__host__ __device__ __forceinline__ int perm32(int rho) { const int n = rho >> 4, i = rho & 15; return 8 * (i >> 2) + 4 * n + (i & 3); }

struct Unit { int pm, pn; };
struct Gemm { const bf16_t* A; const bf16_t* Bt; int M, N, K; };

struct StaticOrder {
    int nM, nN, nwg, G, c;
    __host__ __device__ void init(int M, int N, int G_, int c_) { nM = M / BM; nN = N / BM; nwg = nM * nN; G = G_; c = c_; }
    __host__ __device__ bool next(int i, Unit& u) const {
        const long L = (long)i * G + c; if (L >= nwg) return false;
        int wgid = (int)L; { const int q = nwg / NXCD, r = nwg % NXCD, xcd = wgid % NXCD, off = wgid / NXCD; wgid = (xcd < r ? xcd * (q + 1) : r * (q + 1) + (xcd - r) * q) + off; }
        const int nig = WGM * nN, gid = wgid / nig, fm = gid * WGM, gsz = (nM - fm) < WGM ? (nM - fm) : WGM;
        u.pm = fm + ((wgid % nig) % gsz); u.pn = (wgid % nig) / gsz; return true;
    }
    __device__ __forceinline__ void a_ready(const Unit&) const {}
    __device__ __forceinline__ void done(const Unit&) const {}
};

__device__ __forceinline__ unsigned cvt_pk_bf16(float lo, float hi) { unsigned r; asm volatile("v_cvt_pk_bf16_f32 %0, %1, %2" : "=v"(r) : "v"(lo), "v"(hi)); return r; }
template <class Epi, class Sched, class Hook, bool ALIGN_EPI = false, bool SP2 = false>
__device__ __forceinline__ void gemm_phase(PG8_LAS unsigned char* lds, const Gemm g, const Sched& S, const Epi& E, const Hook& H) {
    const int tid = threadIdx.x, wid = __builtin_amdgcn_readfirstlane(tid >> 6), lane = tid & 63, wr = wid >> 2, wc = wid & 3, fr = lane & 15, fq = lane >> 4;
    const int K = g.K, nt = K / BK;
    unsigned voffA[2], voffB[2];
#pragma unroll
    for (int i = 0; i < 2; ++i) { int R, C; stage_rc(tid * 16 + i * 8192, R, C); const int Rb = Epi::PERM ? ((R & ~31) + perm32(R & 31)) : R;
        voffA[i] = (unsigned)(R * K + C) * 2u; voffB[i] = (unsigned)(Rb * K + C) * 2u; }
    const size_t kstep = (size_t)(BK * 2);
    const size_t hstep = (size_t)HALF * K * 2;
    const size_t tstep = 2 * hstep;
    const unsigned ldsw = (unsigned)wid * 1024u;
    const int aoff = lds_byte(wr * 64 + fr, fq * 8), boff = lds_byte(wc * 32 + fr, fq * 8);
#define PG8_SA(b, h) (((b) * 2 + (h)) * HTB)
#define PG8_SB(b, h) ((4 + (b) * 2 + (h)) * HTB)
#define PG8_STAGE(bufoff, gbase, voff) do { _Pragma("unroll") for (int _i = 0; _i < 2; ++_i) \
        __builtin_amdgcn_global_load_lds((const unsigned*)((const char*)(gbase) + (voff)[_i]), (PG8_LAS unsigned*)(lds + (bufoff) + ldsw + _i * 8192), 16, 0, 0); } while (0)
#define PG8_LDA(dst, b, h) do { _Pragma("unroll") for (int m = 0; m < 4; ++m) _Pragma("unroll") for (int k = 0; k < 2; ++k) dst[m][k] = *(const PG8_LAS bf16x8*)(lds + PG8_SA(b, h) + aoff + m * 2048 + k * 1024); } while (0)
#define PG8_LDB(dst, b, h) do { _Pragma("unroll") for (int n = 0; n < 2; ++n) _Pragma("unroll") for (int k = 0; k < 2; ++k) dst[n][k] = *(const PG8_LAS bf16x8*)(lds + PG8_SB(b, h) + boff + n * 2048 + k * 1024); } while (0)
#define PG8_MMA(ai, bj, At, Bt) do { __builtin_amdgcn_s_setprio(1); _Pragma("unroll") for (int m = 0; m < 4; ++m) _Pragma("unroll") for (int n = 0; n < 2; ++n) _Pragma("unroll") for (int k = 0; k < 2; ++k) \
        acc[ai][bj][m][n] = __builtin_amdgcn_mfma_f32_16x16x32_bf16(Bt[n][k], At[m][k], acc[ai][bj][m][n], 0, 0, 0); __builtin_amdgcn_s_setprio(0); } while (0)
#define PG8_WAIT_V(n) asm volatile("s_waitcnt vmcnt(" #n ")" ::: "memory")
#define PG8_WAIT_L(n) asm volatile("s_waitcnt lgkmcnt(" #n ")" ::: "memory")
#define PG8_BAR __builtin_amdgcn_s_barrier()
#define PG8_SCHED __builtin_amdgcn_sched_barrier(0)
    Unit cur, nxt; int ui = 0;
    if (!S.next(0, cur)) return;
    f32x4 acc[2][2][4][2];
#pragma unroll
    for (int a = 0; a < 2; ++a)
#pragma unroll
        for (int b = 0; b < 2; ++b)
#pragma unroll
            for (int m = 0; m < 4; ++m)
#pragma unroll
                for (int n = 0; n < 2; ++n) acc[a][b][m][n] = (f32x4){0.f, 0.f, 0.f, 0.f};
    bf16x8 At[4][2], B0[2][2], B1[2][2];
    const char* cA = (const char*)g.A + (size_t)cur.pm * tstep; const char* cB = (const char*)g.Bt + (size_t)cur.pn * tstep;
    S.a_ready(cur);
    if constexpr (SP2) {
        PG8_STAGE(PG8_SB(0, 0), cB, voffB); PG8_STAGE(PG8_SB(0, 1), cB + hstep, voffB); PG8_STAGE(PG8_SA(0, 0), cA, voffA); PG8_STAGE(PG8_SA(0, 1), cA + hstep, voffA);
        if (wr == 1) PG8_BAR;
        PG8_WAIT_V(2); PG8_BAR;
        PG8_STAGE(PG8_SB(1, 0), cB + kstep, voffB); PG8_STAGE(PG8_SA(1, 0), cA + kstep, voffA); PG8_STAGE(PG8_SB(1, 1), cB + hstep + kstep, voffB);
        PG8_WAIT_V(6); PG8_BAR;
    } else {
        PG8_STAGE(PG8_SB(0, 0), cB, voffB); PG8_STAGE(PG8_SA(0, 0), cA, voffA); PG8_STAGE(PG8_SB(0, 1), cB + hstep, voffB); PG8_STAGE(PG8_SA(0, 1), cA + hstep, voffA);
        if (wr == 1) PG8_BAR;
        PG8_WAIT_V(4); PG8_BAR;
        PG8_STAGE(PG8_SB(1, 0), cB + kstep, voffB); PG8_STAGE(PG8_SA(1, 0), cA + kstep, voffA); PG8_STAGE(PG8_SB(1, 1), cB + hstep + kstep, voffB);
        PG8_WAIT_V(6); PG8_BAR;
    }
    for (;;) {
        const bool has_next = S.next(ui + 1, nxt);
        const char* nA = has_next ? (const char*)g.A + (size_t)nxt.pm * tstep : cA; const char* nB = has_next ? (const char*)g.Bt + (size_t)nxt.pn * tstep : cB;
        for (int t = 0; t < nt; t += 2) {
            const bool last = (t == nt - 2);
            const char* a1 = cA + (size_t)(t + 1) * kstep;
            const char* a2 = last ? nA : cA + (size_t)(t + 2) * kstep; const char* b2 = last ? nB : cB + (size_t)(t + 2) * kstep;
            const char* a3 = a2 + kstep; const char* b3 = b2 + kstep;
            if (last && has_next) S.a_ready(nxt);
            H(acc, t, wr, fr);
            if constexpr (SP2) {
            PG8_LDB(B0, 0, 0); PG8_LDB(B1, 0, 1); PG8_SCHED; PG8_LDA(At, 0, 0); PG8_STAGE(PG8_SA(1, 1), a1 + hstep, voffA);
            PG8_WAIT_V(8); PG8_WAIT_L(0); PG8_BAR; PG8_MMA(0, 0, At, B0); PG8_MMA(0, 1, At, B1); PG8_BAR; PG8_SCHED;
            PG8_LDA(At, 0, 1); PG8_STAGE(PG8_SB(0, 0), b2, voffB); PG8_STAGE(PG8_SB(0, 1), b2 + hstep, voffB); PG8_STAGE(PG8_SA(0, 0), a2, voffA);
            PG8_WAIT_V(8); PG8_WAIT_L(0); PG8_BAR; PG8_MMA(1, 0, At, B0); PG8_MMA(1, 1, At, B1); PG8_BAR; PG8_SCHED;
            PG8_LDB(B0, 1, 0); PG8_LDB(B1, 1, 1); PG8_SCHED; PG8_LDA(At, 1, 0); PG8_STAGE(PG8_SA(0, 1), a2 + hstep, voffA);
            PG8_WAIT_V(8); PG8_WAIT_L(0); PG8_BAR; PG8_MMA(0, 0, At, B0); PG8_MMA(0, 1, At, B1); PG8_BAR; PG8_SCHED;
            PG8_LDA(At, 1, 1); PG8_STAGE(PG8_SB(1, 0), b3, voffB); PG8_STAGE(PG8_SB(1, 1), b3 + hstep, voffB); PG8_STAGE(PG8_SA(1, 0), a3, voffA);
            PG8_WAIT_V(8); PG8_WAIT_L(0); PG8_BAR; PG8_MMA(1, 0, At, B0); PG8_MMA(1, 1, At, B1); PG8_BAR; PG8_SCHED;
            } else {
            PG8_LDB(B0, 0, 0); PG8_SCHED; PG8_LDA(At, 0, 0); PG8_STAGE(PG8_SA(1, 1), a1 + hstep, voffA);
            PG8_WAIT_L(8); PG8_BAR; PG8_WAIT_L(0); PG8_MMA(0, 0, At, B0); PG8_BAR; PG8_SCHED;
            PG8_LDB(B1, 0, 1); PG8_STAGE(PG8_SB(0, 0), b2, voffB);
            PG8_BAR; PG8_WAIT_L(0); PG8_MMA(0, 1, At, B1); PG8_BAR;
            PG8_LDA(At, 0, 1); PG8_STAGE(PG8_SA(0, 0), a2, voffA);
            PG8_BAR; PG8_WAIT_L(0); PG8_MMA(1, 0, At, B0); PG8_BAR; PG8_SCHED;
            PG8_STAGE(PG8_SB(0, 1), b2 + hstep, voffB);
            PG8_WAIT_V(6); PG8_BAR; PG8_MMA(1, 1, At, B1); PG8_BAR;
            PG8_LDB(B0, 1, 0); PG8_SCHED; PG8_LDA(At, 1, 0); PG8_STAGE(PG8_SA(0, 1), a2 + hstep, voffA);
            PG8_WAIT_L(8); PG8_BAR; PG8_WAIT_L(0); PG8_MMA(0, 0, At, B0); PG8_BAR; PG8_SCHED;
            PG8_LDB(B1, 1, 1); PG8_STAGE(PG8_SB(1, 0), b3, voffB);
            PG8_BAR; PG8_WAIT_L(0); PG8_MMA(0, 1, At, B1); PG8_BAR;
            PG8_LDA(At, 1, 1); PG8_STAGE(PG8_SA(1, 0), a3, voffA);
            PG8_BAR; PG8_WAIT_L(0); PG8_MMA(1, 0, At, B0); PG8_BAR; PG8_SCHED;
            PG8_STAGE(PG8_SB(1, 1), b3 + hstep, voffB);
            PG8_WAIT_V(6); PG8_BAR; PG8_MMA(1, 1, At, B1); PG8_BAR;
            }
        }
        if constexpr (ALIGN_EPI) { if (wr == 0) PG8_BAR; }
        if constexpr (!Epi::AFTER_DRAIN) { E(acc, cur, wr, wc, fr, fq); S.done(cur); }
        if (!has_next) break;
#pragma unroll
        for (int a = 0; a < 2; ++a)
#pragma unroll
            for (int b = 0; b < 2; ++b)
#pragma unroll
                for (int m = 0; m < 4; ++m)
#pragma unroll
                    for (int n = 0; n < 2; ++n) acc[a][b][m][n] = (f32x4){0.f, 0.f, 0.f, 0.f};
        cur = nxt; cA = nA; cB = nB; ++ui;
        if constexpr (ALIGN_EPI) { if (wr == 1) PG8_BAR; }
    }
    PG8_WAIT_V(0);
    if constexpr (!ALIGN_EPI) { if (wr == 0) PG8_BAR; }
    PG8_BAR;
    if constexpr (Epi::AFTER_DRAIN) { E.fused(acc, cur, wr, wc, fr, fq, lds, wid, lane); S.done(cur); }
#undef PG8_SA
#undef PG8_SB
#undef PG8_STAGE
#undef PG8_LDA
#undef PG8_LDB
#undef PG8_MMA
#undef PG8_WAIT_V
#undef PG8_WAIT_L
#undef PG8_BAR
#undef PG8_SCHED
}
}

using pg8::f32x4; using pg8::bf16x8; using pg8::Unit;
typedef unsigned short bf16;
typedef unsigned u32x2 __attribute__((ext_vector_type(2)));
typedef unsigned u32x4 __attribute__((ext_vector_type(4)));
typedef float f32x2 __attribute__((ext_vector_type(2)));
#define LAS3 __attribute__((address_space(3)))

constexpr int NP = 16384, NS = 128, NT = NP + NS, MP = 16640, SEQ = 2048;
constexpr int N1 = 5888, N3 = 5120;
constexpr float EPS = 1e-6f;
constexpr int LDS_BYTES = 147456;

constexpr size_t O_SSM_P = (size_t)NT * 1024;
constexpr size_t O_SSM_S = O_SSM_P + (size_t)8 * 16 * 64 * 128;
constexpr size_t O_SCONV_P = O_SSM_S + (size_t)128 * 16 * 64 * 128;
constexpr size_t O_SCONV_S = O_SCONV_P + 8 * 3 * 1536;
constexpr size_t O_GV_S = O_SCONV_S + 128 * 3 * 1536;
constexpr size_t O_CCV_P = O_GV_S + 128 * 1024;
constexpr size_t O_CCV_S = O_CCV_P + 8 * 30 * 1024;
constexpr size_t O_LCONV_P = O_CCV_S + 128 * 30 * 1024;
constexpr size_t O_LCONV_S = O_LCONV_P + 8 * 3 * 1024;
constexpr size_t O_LRU_P = O_LCONV_S + 128 * 3 * 1024;
constexpr size_t O_LRU_S = O_LRU_P + 8 * 1024;
constexpr size_t O_END = O_LRU_S + 128 * 1024;
static_assert(O_END == 40226816, "output size");

constexpr size_t MiB = 1u << 20;
constexpr size_t WS_SS0 = 0, WS_SS1 = 288 * 1024, WS_DT = 576 * 1024, WS_SSG = 1792 * 1024, WS_XCNT = 3840 * 1024;
constexpr size_t WS_W4 = 4 * MiB, WS_W3 = 8 * MiB, WS_W2 = 18 * MiB, WS_XN = 22 * MiB, WS_W1 = 54 * MiB + 512 * 1024, WS_MIX = 66 * MiB, WS_XBC = 131 * MiB, WS_GV = 180 * MiB, WS_BCN = 213 * MiB, WS_BTG = 229 * MiB, WS_GG = 237 * MiB, WS_END = 246 * MiB;
static_assert(WS_XN + (size_t)MP * 1024 * 2 <= WS_W1 && WS_W1 + (size_t)N1 * 1024 * 2 <= WS_MIX && WS_MIX + (size_t)MP * 2048 * 2 <= WS_XBC && WS_XBC + (size_t)MP * 1536 * 2 <= WS_GV && WS_GV + (size_t)MP * 1024 * 2 <= WS_BCN && WS_BCN + (size_t)NP * 512 * 2 <= WS_BTG && WS_BTG + (size_t)NP * 256 * 2 <= WS_END && WS_BCN + (size_t)NT * 1024 * 2 <= WS_END, "ws map");
static_assert(WS_SS0 + (size_t)MP * 16 <= WS_SS1 && WS_SS1 + (size_t)MP * 16 <= WS_DT && WS_DT + (size_t)MP * 64 <= WS_SSG && WS_SSG + (size_t)NP * 128 <= WS_W4, "ws map small");

struct Ctx {
    const float *x_prompt, *x_sample, *state_ssm, *state_ssd_conv, *state_ccv, *state_lru_conv, *state_lru;
    const float *norm_even, *w_in_even, *ssd_conv_w, *ssd_conv_b, *ssd_dt_bias, *ssd_a_log, *ssd_d, *ssd_norm, *gmlp_ln_g, *gmlp_ln_b, *gmlp_w_s, *gmlp_b_s, *w_out_even;
    const float *norm_odd, *w_in_odd, *ccv_w, *ccv_b, *ccv_ln_g, *ccv_ln_b, *lru_conv_w, *lru_conv_b, *lru_wa, *lru_ba, *lru_wx, *lru_bx, *lru_lambda, *w_out_odd, *final_norm;
    float* out;
    float *ss0, *ss1, *DT, *ssg; unsigned* xcnt;
    bf16 *W1t, *W2t, *W3t, *W4t, *XN, *MIX, *XBC, *GV, *GLU, *XD, *BCn, *BTg, *Gg, *X2b;
};

__device__ __forceinline__ float bf2f(unsigned b) { return __uint_as_float(b << 16); }
__device__ __forceinline__ float bflo(unsigned w) { return __uint_as_float(w << 16); }
__device__ __forceinline__ float bfhi(unsigned w) { return __uint_as_float(w & 0xffff0000u); }
__device__ __forceinline__ unsigned pk2(float lo, float hi) { return pg8::cvt_pk_bf16(lo, hi); }
__device__ __forceinline__ float sigmoidf_(float x) { return __builtin_amdgcn_rcpf(1.f + __expf(-x)); }
__device__ __forceinline__ float siluf_(float x) { return x * sigmoidf_(x); }
__device__ __forceinline__ float geluf_(float x) { const float y = 1.5957691216057308f * (x + 0.044715f * x * x * x); return x * sigmoidf_(y); }
__device__ __forceinline__ float softplusf_(float x) { return fmaxf(x, 0.f) + log1pf(__expf(-fabsf(x))); }
__device__ __forceinline__ float wave_sum(float v) {
#pragma unroll
    for (int o = 1; o < 64; o <<= 1) v += __shfl_xor(v, o);
    return v;
}
__device__ __forceinline__ float block_sum(float v, float* red) {
    v = wave_sum(v);
    __syncthreads();
    if ((threadIdx.x & 63) == 0) red[threadIdx.x >> 6] = v;
    __syncthreads();
    float s = 0.f;
#pragma unroll
    for (int i = 0; i < 8; ++i) s += red[i];
    return s;
}
template <int CTRL> __device__ __forceinline__ float dpp_mov(float v) { return __int_as_float(__builtin_amdgcn_update_dpp(0, __float_as_int(v), CTRL, 0xf, 0xf, true)); }
__device__ __forceinline__ float row16_sum(float y) {
    y += dpp_mov<0x128>(y); y += dpp_mov<0x124>(y); y += dpp_mov<0x122>(y); y += dpp_mov<0x121>(y); return y;
}
__device__ __forceinline__ float rstd_from(const float* ss, int row) { return rsqrtf(((ss[row] + ss[MP + row]) + (ss[2 * MP + row] + ss[3 * MP + row])) * (1.f / 1024.f) + EPS); }
__device__ __forceinline__ u32x4 pack8(const f32x4 a, const f32x4 b) { u32x4 w; w.x = pk2(a[0], a[1]); w.y = pk2(a[2], a[3]); w.z = pk2(b[0], b[1]); w.w = pk2(b[2], b[3]); return w; }
__device__ __forceinline__ void unpack8(const u32x4 w, float (&f)[8]) { f[0] = bflo(w.x); f[1] = bfhi(w.x); f[2] = bflo(w.y); f[3] = bfhi(w.y); f[4] = bflo(w.z); f[5] = bfhi(w.z); f[6] = bflo(w.w); f[7] = bfhi(w.w); }

struct NoHook { __device__ __forceinline__ void operator()(f32x4 (&)[2][2][4][2], int, int, int) const {} };
struct HookScale {
    const LAS3 float* tab;
    __device__ __forceinline__ void operator()(f32x4 (&acc)[2][2][4][2], int t, int wr, int fr) const {
        if (t == 8 || t == 16) {
            const int j = (t == 16) ? 1 : 0;
#pragma unroll
            for (int ai = 0; ai < 2; ++ai)
#pragma unroll
                for (int m = 0; m < 4; ++m) { const float f = tab[(ai * 128 + wr * 64 + m * 16 + fr) * 2 + j];
#pragma unroll
                    for (int bj = 0; bj < 2; ++bj)
#pragma unroll
                        for (int n = 0; n < 2; ++n) acc[ai][bj][m][n] *= f; }
        }
    }
};

struct Epi1 {
    static constexpr bool PERM = true, AFTER_DRAIN = false;
    const float* ss; bf16* MIX; bf16* XBC; bf16* GV; float* DT;
    __device__ __forceinline__ void operator()(const f32x4 (&acc)[2][2][4][2], const Unit& u, int wr, int wc, int fr, int fq) const {
        const int row0 = u.pm * 256 + wr * 64 + fr, pn = u.pn, cl = wc * 32 + 8 * fq;
        float rs[2][4];
#pragma unroll
        for (int ai = 0; ai < 2; ++ai)
#pragma unroll
            for (int m = 0; m < 4; ++m) rs[ai][m] = 1.f;
        if (pn < 4) {
#pragma unroll
            for (int ai = 0; ai < 2; ++ai)
#pragma unroll
                for (int m = 0; m < 4; ++m) { bf16* rp = MIX + (size_t)(row0 + ai * 128 + m * 16) * 2048 + pn * 256 + cl; const float r = rs[ai][m];
#pragma unroll
                    for (int bj = 0; bj < 2; ++bj) { f32x4 v0 = acc[ai][bj][m][0] * r, v1 = acc[ai][bj][m][1] * r;
#pragma unroll
                        for (int j = 0; j < 4; ++j) { v0[j] = siluf_(v0[j]); v1[j] = siluf_(v1[j]); }
                        *(u32x4*)(rp + bj * 128) = pack8(v0, v1); } }
        } else if (pn < 10) {
#pragma unroll
            for (int ai = 0; ai < 2; ++ai)
#pragma unroll
                for (int m = 0; m < 4; ++m) { bf16* rp = XBC + (size_t)(row0 + ai * 128 + m * 16) * 1536 + (pn - 4) * 256 + cl; const float r = rs[ai][m];
#pragma unroll
                    for (int bj = 0; bj < 2; ++bj) *(u32x4*)(rp + bj * 128) = pack8(acc[ai][bj][m][0] * r, acc[ai][bj][m][1] * r); }
        } else if (pn < 18) {
#pragma unroll
            for (int ai = 0; ai < 2; ++ai)
#pragma unroll
                for (int m = 0; m < 4; ++m) { bf16* rp = MIX + (size_t)(row0 + ai * 128 + m * 16) * 2048 + 1024 + (pn - 10) * 128 + cl; const float r = rs[ai][m];
                    f32x4 o[2];
#pragma unroll
                    for (int n = 0; n < 2; ++n) { const f32x4 uu = acc[ai][0][m][n] * r, gg = acc[ai][1][m][n] * r;
#pragma unroll
                        for (int j = 0; j < 4; ++j) o[n][j] = geluf_(uu[j]) * siluf_(gg[j]); }
                    *(u32x4*)rp = pack8(o[0], o[1]); }
        } else if (pn < 22) {
#pragma unroll
            for (int ai = 0; ai < 2; ++ai)
#pragma unroll
                for (int m = 0; m < 4; ++m) { bf16* rp = GV + (size_t)(row0 + ai * 128 + m * 16) * 1024 + (pn - 18) * 256 + cl; const float r = rs[ai][m];
#pragma unroll
                    for (int bj = 0; bj < 2; ++bj) { f32x4 v0 = acc[ai][bj][m][0] * r, v1 = acc[ai][bj][m][1] * r;
#pragma unroll
                        for (int j = 0; j < 4; ++j) { v0[j] = geluf_(v0[j]); v1[j] = geluf_(v1[j]); }
                        *(u32x4*)(rp + bj * 128) = pack8(v0, v1); } }
        } else {
            if (wc == 0 && fq < 2) {
#pragma unroll
                for (int ai = 0; ai < 2; ++ai)
#pragma unroll
                    for (int m = 0; m < 4; ++m) { float* rp = DT + (size_t)(row0 + ai * 128 + m * 16) * 16 + 8 * fq; const float r = rs[ai][m];
#pragma unroll
                        for (int n = 0; n < 2; ++n) *(f32x4*)(rp + 4 * n) = acc[ai][0][m][n] * r; }
            }
        }
    }
};
struct Epi3 {
    static constexpr bool PERM = true, AFTER_DRAIN = false;
    const LAS3 float* tab; bf16* MIX; bf16* GLU; bf16* XD; mutable int ui;
    __device__ __forceinline__ void operator()(const f32x4 (&acc)[2][2][4][2], const Unit& u, int wr, int wc, int fr, int fq) const {
        const int row0 = u.pm * 256 + wr * 64 + fr, pn = u.pn, cl = wc * 32 + 8 * fq;
        float rs[2][4];
#pragma unroll
        for (int ai = 0; ai < 2; ++ai)
#pragma unroll
            for (int m = 0; m < 4; ++m) rs[ai][m] = tab[ui * 256 + ai * 128 + wr * 64 + m * 16 + fr];
        ++ui;
        if (pn < 8) {
#pragma unroll
            for (int ai = 0; ai < 2; ++ai)
#pragma unroll
                for (int m = 0; m < 4; ++m) { bf16* rp = GLU + (size_t)(row0 + ai * 128 + m * 16) * 1024 + pn * 128 + cl; const float r = rs[ai][m];
                    f32x4 o[2];
#pragma unroll
                    for (int n = 0; n < 2; ++n) { const f32x4 aa = acc[ai][0][m][n] * r, bb = acc[ai][1][m][n] * r;
#pragma unroll
                        for (int j = 0; j < 4; ++j) o[n][j] = aa[j] * sigmoidf_(bb[j]); }
                    *(u32x4*)rp = pack8(o[0], o[1]); }
        } else if (pn >= 12 && pn < 16) {
#pragma unroll
            for (int ai = 0; ai < 2; ++ai)
#pragma unroll
                for (int m = 0; m < 4; ++m) { bf16* rp = XD + (size_t)(row0 + ai * 128 + m * 16) * 1024 + (pn - 12) * 256 + cl; const float r = rs[ai][m];
#pragma unroll
                    for (int bj = 0; bj < 2; ++bj) *(u32x4*)(rp + bj * 128) = pack8(acc[ai][bj][m][0] * r, acc[ai][bj][m][1] * r); }
        } else {
            const int cb = pn < 12 ? (pn - 8) * 256 : 1024 + (pn - 16) * 256;
#pragma unroll
            for (int ai = 0; ai < 2; ++ai)
#pragma unroll
                for (int m = 0; m < 4; ++m) { bf16* rp = MIX + (size_t)(row0 + ai * 128 + m * 16) * 2048 + cb + cl; const float r = rs[ai][m];
#pragma unroll
                    for (int bj = 0; bj < 2; ++bj) { f32x4 v0 = acc[ai][bj][m][0] * r, v1 = acc[ai][bj][m][1] * r;
#pragma unroll
                        for (int j = 0; j < 4; ++j) { v0[j] = siluf_(v0[j]); v1[j] = siluf_(v1[j]); }
                        *(u32x4*)(rp + bj * 128) = pack8(v0, v1); } }
        }
    }
};
template <bool L0> struct EpiOut {
    static constexpr bool PERM = false, AFTER_DRAIN = true;
    const float* xold; bf16* XN; bf16* X2; float* ss;
    __device__ __forceinline__ void operator()(const f32x4 (&)[2][2][4][2], const Unit&, int, int, int, int) const {}
    __device__ __forceinline__ void fused(f32x4 (&acc)[2][2][4][2], const Unit& u, int wr, int wc, int fr, int fq, PG8_LAS unsigned char* lds, int wid, int lane) const {
        const int col0 = u.pn * 256 + wc * 32 + 4 * fq;
        PG8_LAS float* red = (PG8_LAS float*)lds;
        f32x4 xo[3][4]; u32x2 xb[3][4];
#define EPO_OFF(G) ((size_t)(u.pm * 256 + ((G) >> 2) * 128 + wr * 64 + ((G) & 3) * 16 + fr) * 1024 + col0)
#define EPO_LOAD(G) do { const size_t off_ = EPO_OFF(G); _Pragma("unroll") for (int bj = 0; bj < 2; ++bj) _Pragma("unroll") for (int n = 0; n < 2; ++n) { \
            if (L0) xo[(G) % 3][bj * 2 + n] = __builtin_nontemporal_load((const f32x4*)(xold + off_ + bj * 128 + n * 16)); else xb[(G) % 3][bj * 2 + n] = *(const u32x2*)(XN + off_ + bj * 128 + n * 16); } } while (0)
        EPO_LOAD(0); EPO_LOAD(1);
#pragma unroll
        for (int gq = 0; gq < 8; ++gq) {
            const int ai = gq >> 2, m = gq & 3;
            if (gq + 2 < 8) EPO_LOAD(gq + 2);
            const int rl = ai * 128 + wr * 64 + m * 16 + fr; const size_t off = EPO_OFF(gq); float q = 0.f;
#pragma unroll
            for (int bj = 0; bj < 2; ++bj)
#pragma unroll
                for (int n = 0; n < 2; ++n) { const size_t o2 = off + bj * 128 + n * 16;
                    if (L0) { const f32x4 v = xo[gq % 3][bj * 2 + n] + acc[ai][bj][m][n];
                        u32x2 w; w.x = pk2(v[0], v[1]); w.y = pk2(v[2], v[3]); *(u32x2*)(XN + o2) = w;
                        q += (v[0] * v[0] + v[1] * v[1]) + (v[2] * v[2] + v[3] * v[3]); }
                    else { const u32x2 xw = xb[gq % 3][bj * 2 + n]; const f32x4 v = (f32x4){bflo(xw.x), bfhi(xw.x), bflo(xw.y), bfhi(xw.y)} + acc[ai][bj][m][n]; u32x2 w; w.x = pk2(v[0], v[1]); w.y = pk2(v[2], v[3]); *(u32x2*)(X2 + o2) = w; } }
            if (L0) { q += __shfl_xor(q, 16); q += __shfl_xor(q, 32); if (fq == 0) red[rl * 4 + wc] = q; }
        }
#undef EPO_LOAD
#undef EPO_OFF
        if (L0) {
            __syncthreads();
            const int t = wid * 64 + lane;
            if (t < 256) ss[(size_t)u.pn * MP + u.pm * 256 + t] = (red[t * 4 + 0] + red[t * 4 + 1]) + (red[t * 4 + 2] + red[t * 4 + 3]);
        }
    }
};

template <int MODE> __device__ __forceinline__ int src_col(int n) {
    const int tile = n >> 8, cl = n & 255;
    if (MODE == 1) {
        if (tile < 10) return n;
        if (tile < 18) { const int q = tile - 10; return cl < 128 ? 2576 + 128 * q + cl : 4624 + 128 * q + (cl - 128); }
        if (tile < 22) return 3600 + (n - 18 * 256);
        return cl < 16 ? 2560 + cl : -1;
    } else if (MODE == 3) {
        if (tile < 8) return cl < 128 ? 128 * tile + cl : 1024 + 128 * tile + (cl - 128);
        return n;
    }
    return n;
}
template <int MODE> __device__ __forceinline__ void transpose_item(const float* W, int K, int Nsrc, bf16* WT, const float* kscale, float* scr, int item, int nblk, int lane) {
    const int kb = item / nblk, nb = item % nblk, k0 = 64 * kb, n0 = 32 * nb;
    const int sc = src_col<MODE>(n0 + (lane & 31));
    float tv[32];
#pragma unroll
    for (int i = 0; i < 32; ++i) { const int kk = 2 * i + (lane >> 5); tv[i] = sc >= 0 ? __builtin_nontemporal_load(W + (size_t)(k0 + kk) * Nsrc + sc) : 0.f; }
    if (kscale != nullptr && k0 < 1024) {
#pragma unroll
        for (int i = 0; i < 32; ++i) tv[i] *= kscale[k0 + 2 * i + (lane >> 5)];
    }
#pragma unroll
    for (int i = 0; i < 32; ++i) scr[(2 * i + (lane >> 5)) * 33 + (lane & 31)] = tv[i];
    asm volatile("s_waitcnt lgkmcnt(0)" ::: "memory");
    const int c = lane & 7;
#pragma unroll
    for (int j = 0; j < 4; ++j) { const int n = (lane >> 3) + 8 * j; const float* s = scr + (8 * c) * 33 + n;
        u32x4 o; o.x = pk2(s[0 * 33], s[1 * 33]); o.y = pk2(s[2 * 33], s[3 * 33]); o.z = pk2(s[4 * 33], s[5 * 33]); o.w = pk2(s[6 * 33], s[7 * 33]);
        *(u32x4*)(WT + (size_t)(n0 + n) * K + k0 + 8 * c) = o; }
    asm volatile("s_waitcnt lgkmcnt(0)" ::: "memory");
}
__device__ __forceinline__ void p0_prologue(const Ctx& c, unsigned char* sm) {
    const int tid = threadIdx.x, lane = tid & 63, wave = tid >> 6;
    const int gw = blockIdx.x * 8 + wave, NGW = gridDim.x * 8;
    float* scr = (float*)(sm + wave * 16384);
    if (blockIdx.x == 0 && tid < 8) c.xcnt[tid] = 0u;
    constexpr int I1 = 16 * (N1 / 32), I2 = 32 * 32, I3 = 16 * (N3 / 32), I4 = 32 * 32;
    for (int it = gw; it < I1 + I2 + I3 + I4; it += NGW) {
        int r = it;
        if (r < I1) { transpose_item<1>(c.w_in_even, 1024, 5648, c.W1t, nullptr, scr, r, N1 / 32, lane); continue; } r -= I1;
        if (r < I2) { transpose_item<0>(c.w_out_even, 2048, 1024, c.W2t, c.ssd_norm, scr, r, 32, lane); continue; } r -= I2;
        if (r < I3) { transpose_item<3>(c.w_in_odd, 1024, 5120, c.W3t, c.norm_odd, scr, r, N3 / 32, lane); continue; } r -= I3;
        transpose_item<0>(c.w_out_odd, 2048, 1024, c.W4t, nullptr, scr, r, 32, lane);
    }
    {
        f32x4 gq[4];
#pragma unroll
        for (int j = 0; j < 4; ++j) gq[j] = ((const f32x4*)c.norm_even)[lane + 64 * j];
        for (int m0 = gw; m0 < MP; m0 += 4 * NGW) {
            f32x4 v[4][4];
#pragma unroll
            for (int r = 0; r < 4; ++r) { const int m = m0 + r * NGW;
                if (m < NT) { const float* xr = m < NP ? c.x_prompt + (size_t)m * 1024 : c.x_sample + (size_t)(m - NP) * 1024;
#pragma unroll
                    for (int j = 0; j < 4; ++j) v[r][j] = __builtin_nontemporal_load((const f32x4*)xr + lane + 64 * j); } }
#pragma unroll
            for (int r = 0; r < 4; ++r) { const int m = m0 + r * NGW;
                if (m < MP) {
                    unsigned long long* o8 = (unsigned long long*)(c.XN + (size_t)m * 1024) + lane;
                    if (m < NT) {
                        float s = 0.f;
#pragma unroll
                        for (int j = 0; j < 4; ++j) s += (v[r][j][0] * v[r][j][0] + v[r][j][1] * v[r][j][1]) + (v[r][j][2] * v[r][j][2] + v[r][j][3] * v[r][j][3]);
                        const float rstd = rsqrtf(wave_sum(s) * (1.f / 1024.f) + EPS);
#pragma unroll
                        for (int j = 0; j < 4; ++j) { const f32x4 g = gq[j] * rstd; o8[64 * j] = (unsigned long long)pk2(v[r][j][0] * g[0], v[r][j][1] * g[1]) | ((unsigned long long)pk2(v[r][j][2] * g[2], v[r][j][3] * g[3]) << 32); }
                    } else {
#pragma unroll
                        for (int j = 0; j < 4; ++j) o8[64 * j] = 0ull;
                    }
                    if (m >= NP && lane < 4) c.ss1[(size_t)lane * MP + m] = 0.f;
                } }
        }
    }
}

__device__ __forceinline__ void bc_prepass_unit(const Ctx& c, int u, unsigned char* sm) {
    const int tid = threadIdx.x, lane = tid & 63, w = tid >> 6, fr = lane & 15, fq = lane >> 4;
    const int b = u >> 5, ck = (u >> 1) & 15, g = u & 1, t0 = ck * 128;
    constexpr int RS = 272;
    unsigned char* Bn = sm; unsigned char* Cn = sm + 34816;
    const int oc = tid & 31, run = tid >> 5;
    const int ch = oc < 16 ? 1024 + g * 128 + oc * 8 : 1280 + g * 128 + (oc - 16) * 8;
    u32x4 raw[11];
#pragma unroll
    for (int j = 0; j < 11; ++j) { const int t = t0 + run * 8 - 3 + j; raw[j] = (t >= 0) ? *(const u32x4*)(c.XBC + (size_t)(b * SEQ + t) * 1536 + ch) : (u32x4){0u, 0u, 0u, 0u}; }
    unsigned char* nat = (oc < 16 ? Bn : Cn) + (oc & 15) * 16;
#pragma unroll
    for (int hf = 0; hf < 2; ++hf) {
        f32x4 wk[5];
#pragma unroll
        for (int k = 0; k < 4; ++k) wk[k] = *(const f32x4*)(c.ssd_conv_w + k * 1536 + ch + 4 * hf);
        wk[4] = *(const f32x4*)(c.ssd_conv_b + ch + 4 * hf);
        float v[8][4];
#pragma unroll
        for (int i = 0; i < 8; ++i)
#pragma unroll
            for (int e = 0; e < 4; ++e) { const int ee = 4 * hf + e; float s = wk[4][e];
#pragma unroll
                for (int k = 0; k < 4; ++k) { const unsigned wd = raw[i + k][ee >> 1]; s += wk[k][e] * ((ee & 1) ? bfhi(wd) : bflo(wd)); }
                v[i][e] = siluf_(s); }
#pragma unroll
        for (int i = 0; i < 8; ++i) { u32x2 o; o.x = pk2(v[i][0], v[i][1]); o.y = pk2(v[i][2], v[i][3]); *(u32x2*)(nat + (8 * run + i) * RS + hf * 8) = o;
            if (oc >= 16) *(u32x2*)(c.BCn + (size_t)(b * SEQ + t0 + 8 * run + i) * 512 + 256 + g * 128 + (oc - 16) * 8 + 4 * hf) = o; }
        if (oc < 16) {
#pragma unroll
            for (int e = 0; e < 4; ++e) *(u32x4*)(c.BTg + ((size_t)((b * 16 + ck) * 2 + g) * 128 + oc * 8 + 4 * hf + e) * 128 + run * 8) = pack8((f32x4){v[0][e], v[1][e], v[2][e], v[3][e]}, (f32x4){v[4][e], v[5][e], v[6][e], v[7][e]});
        }
    }
    __syncthreads();
    {
        bf16x8 cf[4];
#pragma unroll
        for (int kk = 0; kk < 4; ++kk) cf[kk] = *(const bf16x8*)(Cn + (16 * w + fr) * RS + (kk * 32 + fq * 8) * 2);
        for (int j = 0; j <= w; ++j) {
            bf16x8 bf[4];
#pragma unroll
            for (int kk = 0; kk < 4; ++kk) bf[kk] = *(const bf16x8*)(Bn + (16 * j + fr) * RS + (kk * 32 + fq * 8) * 2);
            f32x4 gt = (f32x4){0.f, 0.f, 0.f, 0.f};
#pragma unroll
            for (int kk = 0; kk < 4; ++kk) gt = __builtin_amdgcn_mfma_f32_16x16x32_bf16(bf[kk], cf[kk], gt, 0, 0, 0);
            unsigned r_[4];
#pragma unroll
            for (int e = 0; e < 4; ++e) { const unsigned ub = __float_as_uint(gt[e]); r_[e] = (ub + 0x7fffu + ((ub >> 16) & 1u)) >> 16; }
            u32x2 o; o.x = r_[0] | (r_[1] << 16); o.y = r_[2] | (r_[3] << 16);
            *(u32x2*)(c.Gg + ((size_t)((u * 8 + w) * 8 + j) * 64 + lane) * 4) = o;
        }
    }
    __syncthreads();
}

__device__ __forceinline__ void ssd_chunk_unit(const Ctx& c, int u, unsigned char* sm) {
    const int tid = threadIdx.x, lane = tid & 63, w = tid >> 6, fr = lane & 15, fq = lane >> 4;
    const int pair = u >> 4, sub = u & 15;
    const int b = pair >> 1, g = pair & 1, h = g * 8 + (sub >> 1), ph = sub & 1;
    constexpr int RS = 272;
    unsigned char* Cn = sm + 34816;
    unsigned char* BT = sm + 69632;
    unsigned char* XT = sm + 104448;
    unsigned char* XdT = sm + 113152;
    unsigned char* Sb = sm + 121856;
    unsigned char* Xn = sm + 130560;
    float* csA = (float*)(sm + 138752);
    float* dtA = (float*)(sm + 139776);
    float* wx = (float*)(sm + 140800);
    const int ox = tid & 3, lx = tid >> 2;
    const int chx = h * 64 + ph * 32 + ox * 8;
    if (tid < 160) { const int k = tid >> 5, cc = tid & 31; wx[tid] = k < 4 ? c.ssd_conv_w[k * 1536 + h * 64 + ph * 32 + cc] : c.ssd_conv_b[h * 64 + ph * 32 + cc]; }
    const float a_h = -__expf(c.ssd_a_log[h]), dtb = c.ssd_dt_bias[h], Dh = c.ssd_d[h];
    f32x4 accS[2];
    accS[0] = (f32x4){0.f, 0.f, 0.f, 0.f}; accS[1] = accS[0];
    u32x4 rC[4], rT[4], rx[4]; u32x2 zz[2], gG[8]; float dr0 = 0.f, dr1 = 0.f;
#pragma unroll
    for (int j = 0; j < 8; ++j) gG[j] = (u32x2){0u, 0u};
    const int lrow = 16 * w + fr;
    const int prow = tid >> 4, pc16 = tid & 15;
#define SSD_LOAD_B(CK) do { const size_t gu_ = (size_t)(((b * 16 + (CK)) * 2 + g) * 8 + w) * 8; \
        _Pragma("unroll") for (int j = 0; j < 8; ++j) { if (j <= w) gG[j] = *(const u32x2*)(c.Gg + ((gu_ + j) * 64 + lane) * 4); } } while (0)
#define SSD_LOAD_C(CK) do { const int t0_ = (CK) * 128; \
        _Pragma("unroll") for (int i = 0; i < 4; ++i) rC[i] = *(const u32x4*)(c.BCn + (size_t)(b * SEQ + t0_ + prow + 32 * i) * 512 + 256 + g * 128 + pc16 * 8); } while (0)
#define SSD_LOAD_T(CK) do { \
        _Pragma("unroll") for (int i = 0; i < 4; ++i) rT[i] = *(const u32x4*)(c.BTg + ((size_t)((b * 16 + (CK)) * 2 + g) * 128 + prow + 32 * i) * 128 + pc16 * 8); } while (0)
#define SSD_LOAD_X(CK) do { const int t0_ = (CK) * 128; \
        _Pragma("unroll") for (int j = 0; j < 4; ++j) { const int t = t0_ + lx - 3 + j; rx[j] = (t >= 0) ? *(const u32x4*)(c.XBC + (size_t)(b * SEQ + t) * 1536 + chx) : (u32x4){0u, 0u, 0u, 0u}; } \
        _Pragma("unroll") for (int pt = 0; pt < 2; ++pt) zz[pt] = *(const u32x2*)(c.MIX + (size_t)(b * SEQ + t0_ + lrow) * 2048 + h * 64 + ph * 32 + pt * 16 + 4 * fq); } while (0)
#define SSD_LOAD(CK) do { SSD_LOAD_B(CK); SSD_LOAD_C(CK); SSD_LOAD_T(CK); SSD_LOAD_X(CK); } while (0)
#define SSD_LOAD_DT(CK) do { if (tid < 64) { const size_t r = (size_t)(b * SEQ + (CK) * 128 + 2 * tid) * 16 + h; dr0 = c.DT[r]; dr1 = c.DT[r + 16]; } } while (0)
#define SSD_CUMSUM(BUF) do { if (tid < 64) { const float d0 = softplusf_(dr0 + dtb), d1 = softplusf_(dr1 + dtb); const float a1 = d1 * a_h; float s = d0 * a_h + a1; \
        _Pragma("unroll") for (int o = 1; o < 64; o <<= 1) { const float v = __shfl_up(s, o); if (lane >= o) s += v; } \
        csA[(BUF) * 128 + 2 * tid + 1] = s; csA[(BUF) * 128 + 2 * tid] = s - a1; dtA[(BUF) * 128 + 2 * tid] = d0; dtA[(BUF) * 128 + 2 * tid + 1] = d1; } } while (0)
    SSD_LOAD_DT(0);
    SSD_LOAD(0);
    SSD_CUMSUM(0);
    __syncthreads();
    for (int ck = 0; ck < 16; ++ck) {
        const int t0 = ck * 128;
        const float* cs = csA + (ck & 1) * 128; const float* dts = dtA + (ck & 1) * 128;
        if (ck < 15) SSD_LOAD_DT(ck + 1);
        {
#pragma unroll
            for (int pt = 0; pt < 2; ++pt)
#pragma unroll
                for (int e = 0; e < 4; ++e) *(bf16*)(Sb + (pt * 16 + 4 * fq + e) * RS + (16 * w + fr) * 2) = (bf16)pk2(accS[pt][e], 0.f);
        }
#pragma unroll
        for (int i = 0; i < 4; ++i) { *(u32x4*)(Cn + (prow + 32 * i) * RS + pc16 * 16) = rC[i]; *(u32x4*)(BT + (prow + 32 * i) * RS + pc16 * 16) = rT[i]; }
        {
            const float dl = dts[lx], ddl = dl * __expf(cs[127] - cs[lx]);
            float v[8];
#pragma unroll
            for (int hf = 0; hf < 2; ++hf) {
                f32x4 wk[5];
#pragma unroll
                for (int k = 0; k < 5; ++k) wk[k] = *(const f32x4*)(wx + k * 32 + ox * 8 + 4 * hf);
#pragma unroll
                for (int e = 0; e < 4; ++e) { const int ee = 4 * hf + e; float s = wk[4][e];
#pragma unroll
                    for (int k = 0; k < 4; ++k) { const unsigned wd = rx[k][ee >> 1]; s += wk[k][e] * ((ee & 1) ? bfhi(wd) : bflo(wd)); }
                    v[ee] = siluf_(s); }
            }
            *(u32x4*)(Xn + lx * 64 + ox * 16) = pack8((f32x4){v[0], v[1], v[2], v[3]}, (f32x4){v[4], v[5], v[6], v[7]});
#pragma unroll
            for (int e = 0; e < 8; ++e) { *(bf16*)(XT + (ox * 8 + e) * RS + lx * 2) = (bf16)pk2(v[e] * dl, 0.f); *(bf16*)(XdT + (ox * 8 + e) * RS + lx * 2) = (bf16)pk2(v[e] * ddl, 0.f); }
        }
        __syncthreads();
        const u32x2 zc0 = zz[0], zc1 = zz[1];
        u32x2 gC[8];
#pragma unroll
        for (int j = 0; j < 8; ++j) gC[j] = gG[j];
        if (ck < 15) SSD_LOAD_B(ck + 1);
        __builtin_amdgcn_sched_barrier(0);
        {
            const int l = lrow;
            const float csl = cs[l];
            bf16x8 cf[4];
#pragma unroll
            for (int kk = 0; kk < 4; ++kk) cf[kk] = *(const bf16x8*)(Cn + l * RS + (kk * 32 + fq * 8) * 2);
            f32x4 aoff[2], adiag[2];
            {
                bf16x8 sf[2][4];
#pragma unroll
                for (int pt = 0; pt < 2; ++pt)
#pragma unroll
                    for (int kk = 0; kk < 4; ++kk) sf[pt][kk] = *(const bf16x8*)(Sb + (pt * 16 + fr) * RS + (kk * 32 + fq * 8) * 2);
                aoff[0] = (f32x4){0.f, 0.f, 0.f, 0.f}; aoff[1] = aoff[0]; adiag[0] = aoff[0]; adiag[1] = aoff[0];
#pragma unroll
                for (int kk = 0; kk < 4; ++kk) { aoff[0] = __builtin_amdgcn_mfma_f32_16x16x32_bf16(sf[0][kk], cf[kk], aoff[0], 0, 0, 0); aoff[1] = __builtin_amdgcn_mfma_f32_16x16x32_bf16(sf[1][kk], cf[kk], aoff[1], 0, 0, 0); }
            }
            __builtin_amdgcn_sched_barrier(0);
            if (ck < 15) SSD_LOAD_C(ck + 1);
            __builtin_amdgcn_sched_barrier(0);
#pragma unroll
            for (int jp = 0; jp < 4; ++jp) if (jp <= (w >> 1)) {
                const int j0 = 2 * jp, j1 = 2 * jp + 1;
                const u32x2 ga = gC[2 * jp], gb = gC[2 * jp + 1];
                const f32x4 g0 = (f32x4){bflo(ga.x), bfhi(ga.x), bflo(ga.y), bfhi(ga.y)}, g1 = (f32x4){bflo(gb.x), bfhi(gb.x), bflo(gb.y), bfhi(gb.y)};
                const u32x2 xa0 = *(const u32x2*)(XT + fr * RS + (16 * j0 + 4 * fq) * 2), xb0 = *(const u32x2*)(XT + fr * RS + (16 * j1 + 4 * fq) * 2);
                const u32x2 xa1 = *(const u32x2*)(XT + (16 + fr) * RS + (16 * j0 + 4 * fq) * 2), xb1 = *(const u32x2*)(XT + (16 + fr) * RS + (16 * j1 + 4 * fq) * 2);
                const f32x4 cs0 = *(const f32x4*)(cs + 16 * j0 + 4 * fq), cs1 = *(const f32x4*)(cs + 16 * j1 + 4 * fq);
                f32x4 m0, m1;
#pragma unroll
                for (int e = 0; e < 4; ++e) { const int s0 = 16 * j0 + 4 * fq + e, s1 = 16 * j1 + 4 * fq + e;
                    m0[e] = (s0 <= l) ? g0[e] * __expf(csl - cs0[e]) : 0.f; m1[e] = (s1 <= l) ? g1[e] * __expf(csl - cs1[e]) : 0.f; }
                const bf16x8 mB = __builtin_bit_cast(bf16x8, pack8(m0, m1));
                { u32x4 xv; xv.x = xa0.x; xv.y = xa0.y; xv.z = xb0.x; xv.w = xb0.y; adiag[0] = __builtin_amdgcn_mfma_f32_16x16x32_bf16(__builtin_bit_cast(bf16x8, xv), mB, adiag[0], 0, 0, 0); }
                { u32x4 xv; xv.x = xa1.x; xv.y = xa1.y; xv.z = xb1.x; xv.w = xb1.y; adiag[1] = __builtin_amdgcn_mfma_f32_16x16x32_bf16(__builtin_bit_cast(bf16x8, xv), mB, adiag[1], 0, 0, 0); }
            }
            __builtin_amdgcn_sched_barrier(0);
            if (ck < 15) SSD_LOAD_T(ck + 1);
            __builtin_amdgcn_sched_barrier(0);
            const float decT = __expf(cs[127]);
            {
                bf16x8 xf[2][4], tf[4];
#pragma unroll
                for (int kk = 0; kk < 4; ++kk) { tf[kk] = *(const bf16x8*)(BT + (16 * w + fr) * RS + (kk * 32 + fq * 8) * 2); xf[0][kk] = *(const bf16x8*)(XdT + fr * RS + (kk * 32 + fq * 8) * 2); xf[1][kk] = *(const bf16x8*)(XdT + (16 + fr) * RS + (kk * 32 + fq * 8) * 2); }
                accS[0] *= decT; accS[1] *= decT;
#pragma unroll
                for (int kk = 0; kk < 4; ++kk) { accS[0] = __builtin_amdgcn_mfma_f32_16x16x32_bf16(xf[0][kk], tf[kk], accS[0], 0, 0, 0); accS[1] = __builtin_amdgcn_mfma_f32_16x16x32_bf16(xf[1][kk], tf[kk], accS[1], 0, 0, 0); }
            }
            __builtin_amdgcn_sched_barrier(0);
            if (ck < 15) SSD_LOAD_X(ck + 1);
            __builtin_amdgcn_sched_barrier(0);
            const int row = b * SEQ + t0 + l;
            const float el = __expf(csl);
            float q = 0.f;
#pragma unroll
            for (int pt = 0; pt < 2; ++pt) {
                const u32x2 xr = *(const u32x2*)(Xn + l * 64 + (pt * 16 + 4 * fq) * 2);
                bf16* p = c.MIX + (size_t)row * 2048 + h * 64 + ph * 32 + pt * 16 + 4 * fq;
                const u32x2 zv = pt == 0 ? zc0 : zc1;
                const float y0 = (adiag[pt][0] + el * aoff[pt][0] + Dh * bflo(xr.x)) * bflo(zv.x);
                const float y1 = (adiag[pt][1] + el * aoff[pt][1] + Dh * bfhi(xr.x)) * bfhi(zv.x);
                const float y2 = (adiag[pt][2] + el * aoff[pt][2] + Dh * bflo(xr.y)) * bflo(zv.y);
                const float y3 = (adiag[pt][3] + el * aoff[pt][3] + Dh * bfhi(xr.y)) * bfhi(zv.y);
                u32x2 wv; wv.x = pk2(y0, y1); wv.y = pk2(y2, y3); *(u32x2*)p = wv;
                q += (y0 * y0 + y1 * y1) + (y2 * y2 + y3 * y3);
            }
            q += __shfl_xor(q, 16); q += __shfl_xor(q, 32);
            if (fq == 0) c.ssg[((size_t)(g * 16 + (h & 7) * 2 + ph)) * NP + row] = q;
        }
        if (ck < 15) SSD_CUMSUM((ck + 1) & 1);
        __syncthreads();
    }
#undef SSD_LOAD
#undef SSD_LOAD_B
#undef SSD_LOAD_C
#undef SSD_LOAD_T
#undef SSD_LOAD_X
#undef SSD_LOAD_DT
#undef SSD_CUMSUM
#pragma unroll
    for (int pt = 0; pt < 2; ++pt)
#pragma unroll
        for (int e = 0; e < 4; ++e) __builtin_nontemporal_store(accS[pt][e], c.out + O_SSM_P + ((size_t)(b * 16 + h) * 64 + ph * 32 + pt * 16 + 4 * fq + e) * 128 + 16 * w + fr);
}

__device__ __forceinline__ void gmlp_unit(const Ctx& c, int u, unsigned char* sm) {
    const int tid = threadIdx.x, lane = tid & 63, w = tid >> 6, fr = lane & 15, fq = lane >> 4;
    const int b = u >> 5, ck = (u >> 1) & 15, gh = u & 1;
    const int r0 = b * SEQ + ck * 128;
    float* stat = (float*)sm;
    unsigned char* vbase = sm + 1024;
    {
        u32x4 gq[16][2];
#pragma unroll
        for (int i = 0; i < 16; ++i) { const u32x4* gp = (const u32x4*)(c.GV + (size_t)(r0 + w * 16 + i) * 1024 + lane * 16); gq[i][0] = gp[0]; gq[i][1] = gp[1]; }
#pragma unroll
        for (int i = 0; i < 16; ++i) {
            const int tk = w * 16 + i;
            float f0[8], f1[8]; unpack8(gq[i][0], f0); unpack8(gq[i][1], f1);
            float s = 0.f, q = 0.f;
#pragma unroll
            for (int e = 0; e < 8; ++e) { s += f0[e] + f1[e]; q += f0[e] * f0[e] + f1[e] * f1[e]; }
            s = wave_sum(s); q = wave_sum(q);
            if (lane == 0) { const float mean = s * (1.f / 1024.f); const float var = fmaxf(q * (1.f / 1024.f) - mean * mean, 0.f); stat[tk * 2] = mean; stat[tk * 2 + 1] = rsqrtf(var + EPS); }
        }
    }
    u32x4 gva[2], gvb[2];
#define GMLP_LOADV(GRP) do { _Pragma("unroll") for (int it = 0; it < 2; ++it) { const int item = tid + 512 * it, sp = item & 63, d8 = item >> 6; \
        gva[it] = *(const u32x4*)(c.GV + (size_t)(r0 + 2 * sp) * 1024 + (GRP) * 128 + d8 * 8); gvb[it] = *(const u32x4*)(c.GV + (size_t)(r0 + 2 * sp + 1) * 1024 + (GRP) * 128 + d8 * 8); } } while (0)
    GMLP_LOADV(gh * 4);
    __syncthreads();
    for (int gi = 0; gi < 4; ++gi) {
        const int grp = gh * 4 + gi;
        unsigned char* vnT = vbase + (gi & 1) * 34816;
        const int t = 16 * w + fr, nk = (w >> 1) + 1;
        const float* wrow = c.gmlp_w_s + ((size_t)grp * 128 + t) * 128;
        f32x4 wq[4][2];
#pragma unroll
        for (int kk = 0; kk < 4; ++kk) { if (kk < nk) { wq[kk][0] = *(const f32x4*)(wrow + kk * 32 + fq * 8); wq[kk][1] = *(const f32x4*)(wrow + kk * 32 + fq * 8 + 4); } else { wq[kk][0] = (f32x4){0.f, 0.f, 0.f, 0.f}; wq[kk][1] = wq[kk][0]; } }
        bf16* mp = c.MIX + (size_t)(r0 + t) * 2048 + 1024 + grp * 128 + 4 * fq;
        u32x2 ugv[8];
#pragma unroll
        for (int dt = 0; dt < 8; ++dt) ugv[dt] = *(const u32x2*)(mp + dt * 16);
        const float bs = c.gmlp_b_s[grp * 128 + t];
#pragma unroll
        for (int it = 0; it < 2; ++it) {
            const int item = tid + 512 * it, sp = item & 63, d8 = item >> 6;
            const int s0 = 2 * sp, chn = grp * 128 + d8 * 8;
            float a[8], bq[8]; unpack8(gva[it], a); unpack8(gvb[it], bq);
            const float m0 = stat[s0 * 2], rs0 = stat[s0 * 2 + 1], m1 = stat[s0 * 2 + 2], rs1 = stat[s0 * 2 + 3];
            const f32x4 lg0 = *(const f32x4*)(c.gmlp_ln_g + chn), lg1 = *(const f32x4*)(c.gmlp_ln_g + chn + 4), lb0 = *(const f32x4*)(c.gmlp_ln_b + chn), lb1 = *(const f32x4*)(c.gmlp_ln_b + chn + 4);
#pragma unroll
            for (int e = 0; e < 8; ++e) { const float lg = e < 4 ? lg0[e & 3] : lg1[e & 3], lb = e < 4 ? lb0[e & 3] : lb1[e & 3];
                const float v0 = (a[e] - m0) * rs0 * lg + lb, v1 = (bq[e] - m1) * rs1 * lg + lb;
                *(unsigned*)(vnT + (d8 * 8 + e) * 272 + sp * 4) = pk2(v0, v1); }
        }
        if (gi < 3) GMLP_LOADV(grp + 1);
        __syncthreads();
        f32x4 acc[8];
#pragma unroll
        for (int dt = 0; dt < 8; ++dt) acc[dt] = (f32x4){0.f, 0.f, 0.f, 0.f};
#pragma unroll
        for (int kk = 0; kk < 4; ++kk) {
            if (kk < nk) {
                const int sb = kk * 32 + fq * 8;
                f32x4 m0, m1;
#pragma unroll
                for (int e = 0; e < 4; ++e) { m0[e] = (sb + e <= t) ? wq[kk][0][e] : 0.f; m1[e] = (sb + 4 + e <= t) ? wq[kk][1][e] : 0.f; }
                const bf16x8 wf = __builtin_bit_cast(bf16x8, pack8(m0, m1));
#pragma unroll
                for (int dt = 0; dt < 8; ++dt) {
                    const bf16x8 vf = *(const bf16x8*)(vnT + (dt * 16 + fr) * 272 + sb * 2);
                    acc[dt] = __builtin_amdgcn_mfma_f32_16x16x32_bf16(vf, wf, acc[dt], 0, 0, 0);
                }
            }
        }
#pragma unroll
        for (int dt = 0; dt < 8; ++dt) { const u32x2 ug = ugv[dt];
            u32x2 o; o.x = pk2((acc[dt][0] + bs) * bflo(ug.x), (acc[dt][1] + bs) * bfhi(ug.x)); o.y = pk2((acc[dt][2] + bs) * bflo(ug.y), (acc[dt][3] + bs) * bfhi(ug.y));
            *(u32x2*)(mp + dt * 16) = o; }
    }
#undef GMLP_LOADV
    __syncthreads();
}

__device__ __forceinline__ void sample_even_unit(const Ctx& c, int u, unsigned char* sm) {
    const int tid = threadIdx.x;
    const int bs = u >> 1, g = u & 1, row = NP + bs;
    float* xcs = (float*)sm;
    float* ygs = xcs + 768;
    float* red = ygs + 512;
    float* hsc = red + 8;
    const int p = tid >> 3, nq = tid & 7;
    f32x4 st[8][4];
#pragma unroll
    for (int hh = 0; hh < 8; ++hh)
#pragma unroll
        for (int j = 0; j < 4; ++j) st[hh][j] = __builtin_nontemporal_load((const f32x4*)(c.state_ssm + ((size_t)(bs * 16 + g * 8 + hh) * 64 + p) * 128 + j * 32 + nq * 4));
    const float* buf = c.state_ssd_conv + (size_t)bs * 3 * 1536;
    for (int i = tid; i < 768; i += 512) {
        const int ch = i < 512 ? g * 512 + i : (i < 640 ? 1024 + g * 128 + (i - 512) : 1280 + g * 128 + (i - 640));
        const float xn = bf2f(c.XBC[(size_t)row * 1536 + ch]);
        const float b0 = buf[ch], b1 = buf[1536 + ch], b2 = buf[2 * 1536 + ch];
        float s = c.ssd_conv_b[ch] + c.ssd_conv_w[ch] * b0 + c.ssd_conv_w[1536 + ch] * b1 + c.ssd_conv_w[2 * 1536 + ch] * b2 + c.ssd_conv_w[3 * 1536 + ch] * xn;
        xcs[i] = siluf_(s);
        float* so = c.out + O_SCONV_S + (size_t)bs * 3 * 1536;
        so[ch] = b1; so[1536 + ch] = b2; so[2 * 1536 + ch] = xn;
    }
    if (tid < 8) { const int h = g * 8 + tid; const float dt = softplusf_(c.DT[(size_t)row * 16 + h] + c.ssd_dt_bias[h]); hsc[tid * 4] = dt; hsc[tid * 4 + 1] = __expf(-dt * __expf(c.ssd_a_log[h])); hsc[tid * 4 + 2] = c.ssd_d[h]; }
    float zv[8];
    if (nq == 0) {
#pragma unroll
        for (int hh = 0; hh < 8; ++hh) zv[hh] = bf2f(c.MIX[(size_t)row * 2048 + (g * 8 + hh) * 64 + p]);
    }
    const unsigned gv2 = *(const unsigned*)(c.GV + (size_t)row * 1024 + 2 * tid);
    const int chn = g * 512 + tid, grp = chn >> 7;
    const float gvc = bf2f(c.GV[(size_t)row * 1024 + chn]), lng = c.gmlp_ln_g[chn], lnb = c.gmlp_ln_b[chn], ws0 = c.gmlp_w_s[(size_t)grp * 128 * 128], bs0 = c.gmlp_b_s[grp * 128];
    bf16* mpu = c.MIX + (size_t)row * 2048 + 1024 + chn;
    const float ugv = bf2f(*mpu);
    __syncthreads();
    f32x4 bv[4], cv[4];
#pragma unroll
    for (int j = 0; j < 4; ++j) { bv[j] = *(const f32x4*)(xcs + 512 + j * 32 + nq * 4); cv[j] = *(const f32x4*)(xcs + 640 + j * 32 + nq * 4); }
#pragma unroll
    for (int hh = 0; hh < 8; ++hh) {
        const int h = g * 8 + hh;
        const size_t so = ((size_t)(bs * 16 + h) * 64 + p) * 128 + nq * 4;
        const float dt = hsc[hh * 4], dA = hsc[hh * 4 + 1];
        const float xv = xcs[hh * 64 + p], dtx = dt * xv;
        float y = 0.f;
#pragma unroll
        for (int j = 0; j < 4; ++j) {
            f32x4 hn;
#pragma unroll
            for (int e = 0; e < 4; ++e) { hn[e] = dA * st[hh][j][e] + dtx * bv[j][e]; y += cv[j][e] * hn[e]; }
            __builtin_nontemporal_store(hn, (f32x4*)(c.out + O_SSM_S + so + 32 * j));
        }
        y += __shfl_xor(y, 1); y += __shfl_xor(y, 2); y += __shfl_xor(y, 4);
        if (nq == 0) { y += hsc[hh * 4 + 2] * xv; ygs[hh * 64 + p] = y * zv[hh]; }
    }
    __syncthreads();
    {
        const float v = ygs[tid];
        const float q = block_sum(v * v, red);
        c.MIX[(size_t)row * 2048 + g * 512 + tid] = (bf16)pk2(v * rsqrtf(q * (1.f / 512.f) + EPS), 0.f);
    }
    {
        const float a0 = bflo(gv2), a1 = bfhi(gv2);
        const float s = block_sum(a0 + a1, red);
        const float q = block_sum(a0 * a0 + a1 * a1, red);
        const float mean = s * (1.f / 1024.f), rstd = rsqrtf(fmaxf(q * (1.f / 1024.f) - mean * mean, 0.f) + EPS);
        const float vn = (gvc - mean) * rstd * lng + lnb;
        c.out[O_GV_S + (size_t)bs * 1024 + chn] = vn;
        *mpu = (bf16)pk2(ugv * (ws0 * vn + bs0), 0.f);
    }
    __syncthreads();
}

__device__ __forceinline__ void p2_even_mixers(const Ctx& c, unsigned char* sm) {
    const int G = gridDim.x, bx = blockIdx.x;
    for (int u = bx; u < 256; u += G) ssd_chunk_unit(c, u, sm);
    for (int u = bx; u < 256; u += G) gmlp_unit(c, u, sm);
    for (int u = bx; u < 256; u += G) sample_even_unit(c, u, sm);
    for (int i = bx * 512 + threadIdx.x; i < 8 * 3 * 1536; i += G * 512) { const int b = i / (3 * 1536), r = i % (3 * 1536), k = r / 1536, ch = r % 1536;
        c.out[O_SCONV_P + i] = bf2f(c.XBC[(size_t)(b * SEQ + SEQ - 3 + k) * 1536 + ch]); }
}

template <bool L0> __device__ __forceinline__ void sample_outproj(const bf16* A, const bf16* Wt, const float* xold, bf16* XNs, bf16* X2s, float* ss, unsigned char* sm) {
    const int tid = threadIdx.x, lane = tid & 63, w = tid >> 6, fr = lane & 15, fq = lane >> 4;
    f32x4* red = (f32x4*)sm;
    for (int u = blockIdx.x; u < 256; u += gridDim.x) {
        const int tg = u & 7, cgp = u >> 3;
        const bf16* ap = A + (size_t)(tg * 16 + fr) * 2048 + w * 256 + fq * 8;
        const bf16* bp0 = Wt + (size_t)(cgp * 32 + fr) * 2048 + w * 256 + fq * 8;
        const bf16* bp1 = bp0 + 16 * 2048;
        f32x4 a0 = (f32x4){0.f, 0.f, 0.f, 0.f}, a1 = a0;
#pragma unroll
        for (int kk = 0; kk < 8; ++kk) {
            const bf16x8 af = *(const bf16x8*)(ap + kk * 32), b0 = *(const bf16x8*)(bp0 + kk * 32), b1 = *(const bf16x8*)(bp1 + kk * 32);
            a0 = __builtin_amdgcn_mfma_f32_16x16x32_bf16(b0, af, a0, 0, 0, 0);
            a1 = __builtin_amdgcn_mfma_f32_16x16x32_bf16(b1, af, a1, 0, 0, 0);
        }
        red[(w * 2 + 0) * 64 + lane] = a0; red[(w * 2 + 1) * 64 + lane] = a1;
        __syncthreads();
        if (tid < 128) {
            const int ct = tid >> 6;
            f32x4 s = (f32x4){0.f, 0.f, 0.f, 0.f};
#pragma unroll
            for (int w2 = 0; w2 < 8; ++w2) s += red[(w2 * 2 + ct) * 64 + lane];
            const int trow = tg * 16 + fr, col = cgp * 32 + ct * 16 + 4 * fq;
            const size_t off = (size_t)trow * 1024 + col;
            if (L0) {
                const f32x4 v = *(const f32x4*)(xold + off) + s;
                u32x2 wv; wv.x = pk2(v[0], v[1]); wv.y = pk2(v[2], v[3]); *(u32x2*)(XNs + off) = wv;
                float q = (v[0] * v[0] + v[1] * v[1]) + (v[2] * v[2] + v[3] * v[3]);
                q += __shfl_xor(q, 16); q += __shfl_xor(q, 32);
                if (fq == 0) atomicAdd(ss + (size_t)(cgp >> 3) * MP + trow, q);
            } else {
                const u32x2 xw = *(const u32x2*)(XNs + off);
                const f32x4 v = (f32x4){bflo(xw.x), bfhi(xw.x), bflo(xw.y), bfhi(xw.y)} + s;
                u32x2 wv; wv.x = pk2(v[0], v[1]); wv.y = pk2(v[2], v[3]); *(u32x2*)(X2s + off) = wv;
            }
        }
        __syncthreads();
    }
}

__device__ __forceinline__ void ccv_unit(const Ctx& c, int u, unsigned char* sm) {
    const int tid = threadIdx.x, lane = tid & 63, wv = tid >> 6;
    const int b = u >> 5, t0 = (u & 31) * 64, ch = 2 * tid;
    float* red = (float*)sm;
    f32x2 w[31];
#pragma unroll
    for (int k = 0; k < 31; ++k) w[k] = *(const f32x2*)(c.ccv_w + k * 1024 + ch);
    const f32x2 bias = *(const f32x2*)(c.ccv_b + ch), lg = *(const f32x2*)(c.ccv_ln_g + ch), lb = *(const f32x2*)(c.ccv_ln_b + ch);
    unsigned gwin[38];
#pragma unroll
    for (int j = 0; j < 38; ++j) { const int t = t0 - 30 + j; gwin[j] = (t >= 0) ? *(const unsigned*)(c.GLU + (size_t)(b * SEQ + t) * 1024 + ch) : 0u; }
    for (int og = 0; og < 8; ++og) {
        unsigned nxt[8], gcv[8];
#pragma unroll
        for (int j = 0; j < 8; ++j) { gcv[j] = *(const unsigned*)(c.MIX + (size_t)(b * SEQ + t0 + og * 8 + j) * 2048 + ch);
            nxt[j] = (og < 7) ? *(const unsigned*)(c.GLU + (size_t)(b * SEQ + t0 + og * 8 + 8 + j) * 1024 + ch) : 0u; }
        f32x2 acc[8];
#pragma unroll
        for (int o = 0; o < 8; ++o) acc[o] = bias;
#pragma unroll
        for (int j = 0; j < 38; ++j) {
            const f32x2 gl = (f32x2){bflo(gwin[j]), bfhi(gwin[j])};
#pragma unroll
            for (int o = 0; o < 8; ++o) { const int k = j - o; if (k >= 0 && k <= 30) acc[o] += w[k] * gl; }
        }
        float* rb = red + (og & 1) * 512;
        {
            float mine = 0.f;
#pragma unroll
            for (int o = 0; o < 8; ++o) { const float s = row16_sum(acc[o][0] + acc[o][1]), q = row16_sum(acc[o][0] * acc[o][0] + acc[o][1] * acc[o][1]);
                mine = ((lane & 15) == o) ? s : mine; mine = ((lane & 15) == 8 + o) ? q : mine; }
            rb[(wv * 4 + (lane >> 4)) * 16 + (lane & 15)] = mine;
        }
        __syncthreads();
        float tot;
        {
            float s = 0.f;
#pragma unroll
            for (int i = 0; i < 8; ++i) s += rb[((lane >> 4) * 8 + i) * 16 + (lane & 15)];
            s += __shfl_xor(s, 16); s += __shfl_xor(s, 32);
            tot = s;
        }
#pragma unroll
        for (int o = 0; o < 8; ++o) {
            const float s = __builtin_bit_cast(float, __builtin_amdgcn_readlane(__builtin_bit_cast(int, tot), o)), q = __builtin_bit_cast(float, __builtin_amdgcn_readlane(__builtin_bit_cast(int, tot), 8 + o));
            const float mean = s * (1.f / 1024.f), rstd = rsqrtf(fmaxf(q * (1.f / 1024.f) - mean * mean, 0.f) + EPS);
            const float y0 = siluf_((acc[o][0] - mean) * rstd * lg[0] + lb[0]), y1 = siluf_((acc[o][1] - mean) * rstd * lg[1] + lb[1]);
            *(unsigned*)(c.MIX + (size_t)(b * SEQ + t0 + og * 8 + o) * 2048 + ch) = pk2(y0 * bflo(gcv[o]), y1 * bfhi(gcv[o]));
        }
#pragma unroll
        for (int j = 0; j < 30; ++j) gwin[j] = gwin[j + 8];
#pragma unroll
        for (int j = 0; j < 8; ++j) gwin[30 + j] = nxt[j];
    }
    __syncthreads();
}
__device__ __forceinline__ void ccv_sample_unit(const Ctx& c, int bs, unsigned char* sm) {
    const int tid = threadIdx.x, ch = 2 * tid, row = NP + bs;
    float* red = (float*)sm;
    const float* buf = c.state_ccv + (size_t)bs * 30 * 1024;
    const unsigned gw = *(const unsigned*)(c.GLU + (size_t)row * 1024 + ch);
    const f32x2 gl = (f32x2){bflo(gw), bfhi(gw)};
    f32x2 acc = *(const f32x2*)(c.ccv_b + ch);
    float* so = c.out + O_CCV_S + (size_t)bs * 30 * 1024;
    unsigned* mp = (unsigned*)(c.MIX + (size_t)row * 2048 + ch);
    const unsigned gc = *mp;
    const f32x2 lg = *(const f32x2*)(c.ccv_ln_g + ch), lb = *(const f32x2*)(c.ccv_ln_b + ch);
    f32x2 bvv[30], wv[31];
#pragma unroll
    for (int k = 0; k < 30; ++k) bvv[k] = __builtin_nontemporal_load((const f32x2*)(buf + k * 1024 + ch));
#pragma unroll
    for (int k = 0; k < 31; ++k) wv[k] = *(const f32x2*)(c.ccv_w + k * 1024 + ch);
#pragma unroll
    for (int k = 0; k < 30; ++k) acc += wv[k] * bvv[k];
    acc += wv[30] * gl;
#pragma unroll
    for (int k = 1; k < 30; ++k) __builtin_nontemporal_store(bvv[k], (f32x2*)(so + (k - 1) * 1024 + ch));
    *(f32x2*)(so + 29 * 1024 + ch) = gl;
    const float s = block_sum(acc[0] + acc[1], red);
    const float q = block_sum(acc[0] * acc[0] + acc[1] * acc[1], red);
    const float mean = s * (1.f / 1024.f), rstd = rsqrtf(fmaxf(q * (1.f / 1024.f) - mean * mean, 0.f) + EPS);
    const float y0 = siluf_((acc[0] - mean) * rstd * lg[0] + lb[0]), y1 = siluf_((acc[1] - mean) * rstd * lg[1] + lb[1]);
    *mp = pk2(y0 * bflo(gc), y1 * bfhi(gc));
    __syncthreads();
}

__device__ __forceinline__ float neg_expm1_fast(float x) {
    const float p = -x * (1.f + x * (0.5f + x * (0.16666667f + x * (0.041666668f + x * 0.0083333338f))));
    return x > -0.25f ? p : 1.f - __expf(x);
}
__device__ __forceinline__ void lru_unit(const Ctx& c, int u, unsigned char* sm) {
    const int tid = threadIdx.x, lane = tid & 63, w = tid >> 6, fr = lane & 15, fq = lane >> 4;
    const int pairi = (u & 7) * 16 + ((u >> 3) >> 1), jh = (u >> 3) & 1;
    const int b = pairi >> 4, h = pairi & 15;
    unsigned char* xcb = sm;
    float* as = (float*)(sm + 36864);
    float* bs = (float*)(sm + 69632);
    float* Pseg = (float*)(sm + 102400);
    float* Hseg = (float*)(sm + 104448);
    float* hcar = (float*)(sm + 106496);
    bf16x8 wfa[2][2], wfx[2][2];
#pragma unroll
    for (int ct = 0; ct < 2; ++ct)
#pragma unroll
        for (int kk = 0; kk < 2; ++kk) { float fa[8], fx[8];
#pragma unroll
            for (int e = 0; e < 8; ++e) { const size_t o = ((size_t)h * 64 + kk * 32 + fq * 8 + e) * 64 + jh * 32 + ct * 16 + fr; fa[e] = c.lru_wa[o]; fx[e] = c.lru_wx[o]; }
            u32x4 pa, px; pa.x = pk2(fa[0], fa[1]); pa.y = pk2(fa[2], fa[3]); pa.z = pk2(fa[4], fa[5]); pa.w = pk2(fa[6], fa[7]); px.x = pk2(fx[0], fx[1]); px.y = pk2(fx[2], fx[3]); px.z = pk2(fx[4], fx[5]); px.w = pk2(fx[6], fx[7]);
            wfa[ct][kk] = __builtin_bit_cast(bf16x8, pa); wfx[ct][kk] = __builtin_bit_cast(bf16x8, px); }
    float ba[2], bx[2], sp[2];
#pragma unroll
    for (int ct = 0; ct < 2; ++ct) { const int j = h * 64 + jh * 32 + ct * 16 + fr; ba[ct] = c.lru_ba[j]; bx[ct] = c.lru_bx[j]; sp[ct] = softplusf_(-c.lru_lambda[j]); }
    const int o8 = tid & 7, run = tid >> 3, chc = h * 64 + o8 * 8;
    float* wtab = (float*)(sm + 106752);
    if (tid < 320) { const int k = tid >> 6, cc = tid & 63; wtab[tid] = k < 4 ? c.lru_conv_w[k * 1024 + h * 64 + cc] : c.lru_conv_b[h * 64 + cc]; }
    __syncthreads();
    const int jl = tid & 31, sgm = tid >> 5;
    const int tl4 = tid >> 2, c8 = (tid & 3) * 8;
    u32x4 rw[7], gdv[2];
#define LRU_LOAD(TILE) do { const int t0_ = (TILE) * 256; \
        _Pragma("unroll") for (int j = 0; j < 7; ++j) { const int t = t0_ + 4 * run - 3 + j; rw[j] = (t >= 0) ? *(const u32x4*)(c.XD + (size_t)(b * SEQ + t) * 1024 + chc) : (u32x4){0u, 0u, 0u, 0u}; } \
        _Pragma("unroll") for (int i = 0; i < 2; ++i) gdv[i] = *(const u32x4*)(c.MIX + (size_t)(b * SEQ + t0_ + tl4 + 128 * i) * 2048 + 1024 + h * 64 + jh * 32 + c8); } while (0)
    LRU_LOAD(0);
    if (tid < 32) hcar[tid] = 0.f;
    for (int tile = 0; tile < 8; ++tile) {
        const int t0 = tile * 256;
        {
#pragma unroll
            for (int hf = 0; hf < 2; ++hf) {
                f32x4 wk[5];
#pragma unroll
                for (int k = 0; k < 5; ++k) wk[k] = *(const f32x4*)(wtab + k * 64 + o8 * 8 + 4 * hf);
#pragma unroll
                for (int i = 0; i < 4; ++i) { float r4[4];
#pragma unroll
                    for (int e = 0; e < 4; ++e) { const int ee = 4 * hf + e; float s = wk[4][e];
#pragma unroll
                        for (int k = 0; k < 4; ++k) { const unsigned wd = rw[i + k][ee >> 1]; s += wk[k][e] * ((ee & 1) ? bfhi(wd) : bflo(wd)); }
                        r4[e] = s; }
                    u32x2 o; o.x = pk2(r4[0], r4[1]); o.y = pk2(r4[2], r4[3]); *(u32x2*)(xcb + (4 * run + i) * 144 + o8 * 16 + hf * 8) = o; }
            }
        }
        __syncthreads();
        const u32x4 gdc0 = gdv[0], gdc1 = gdv[1];
        if (tile < 7) LRU_LOAD(tile + 1);
#pragma unroll
        for (int rt = 0; rt < 2; ++rt) {
            const int tb = 32 * w + 16 * rt;
            bf16x8 af[2];
#pragma unroll
            for (int kk = 0; kk < 2; ++kk) af[kk] = *(const bf16x8*)(xcb + (tb + fr) * 144 + (kk * 32 + fq * 8) * 2);
#pragma unroll
            for (int ct = 0; ct < 2; ++ct) {
                f32x4 dr = (f32x4){0.f, 0.f, 0.f, 0.f}, di = dr;
#pragma unroll
                for (int kk = 0; kk < 2; ++kk) { dr = __builtin_amdgcn_mfma_f32_16x16x32_bf16(af[kk], wfa[ct][kk], dr, 0, 0, 0); di = __builtin_amdgcn_mfma_f32_16x16x32_bf16(af[kk], wfx[ct][kk], di, 0, 0, 0); }
#pragma unroll
                for (int e = 0; e < 4; ++e) {
                    const int tl = tb + 4 * fq + e, jj = ct * 16 + fr;
                    const float r = sigmoidf_(dr[e] + ba[ct]), ig = sigmoidf_(di[e] + bx[ct]);
                    const float la = -8.f * r * sp[ct];
                    const float a = __expf(la);
                    const float xv = bf2f(*(const bf16*)(xcb + tl * 144 + (jh * 32 + jj) * 2));
                    const float bt = sqrtf(fmaxf(neg_expm1_fast(2.f * la), 0.f)) * (ig * xv);
                    as[tl * 32 + jj] = a; bs[tl * 32 + jj] = bt;
                }
            }
        }
        __syncthreads();
        {
            float p = 1.f, hl = 0.f;
#pragma unroll
            for (int i = 0; i < 16; ++i) { const int t = 16 * sgm + i; const float a = as[t * 32 + jl]; hl = fmaf(a, hl, bs[t * 32 + jl]); p *= a; as[t * 32 + jl] = p; bs[t * 32 + jl] = hl; }
            Pseg[sgm * 32 + jl] = p; Hseg[sgm * 32 + jl] = hl;
        }
        __syncthreads();
        {
            float cin = hcar[(tile & 1) * 32 + jl];
#pragma unroll
            for (int s2 = 0; s2 < 15; ++s2) { const float nc = fmaf(Pseg[s2 * 32 + jl], cin, Hseg[s2 * 32 + jl]); cin = (s2 < sgm) ? nc : cin; }
            if (sgm == 15) hcar[((tile + 1) & 1) * 32 + jl] = fmaf(Pseg[15 * 32 + jl], cin, Hseg[15 * 32 + jl]);
#pragma unroll
            for (int i = 0; i < 16; ++i) { const int t = 16 * sgm + i; bs[t * 32 + jl] = fmaf(as[t * 32 + jl], cin, bs[t * 32 + jl]); }
        }
        __syncthreads();
#pragma unroll
        for (int i = 0; i < 2; ++i) {
            const int tl = tl4 + 128 * i;
            u32x4* mp = (u32x4*)(c.MIX + (size_t)(b * SEQ + t0 + tl) * 2048 + 1024 + h * 64 + jh * 32 + c8);
            float gd[8]; unpack8(i == 0 ? gdc0 : gdc1, gd);
            const f32x4 h0 = *(const f32x4*)(bs + tl * 32 + c8), h1 = *(const f32x4*)(bs + tl * 32 + c8 + 4);
            *mp = pack8((f32x4){h0[0] * gd[0], h0[1] * gd[1], h0[2] * gd[2], h0[3] * gd[3]}, (f32x4){h1[0] * gd[4], h1[1] * gd[5], h1[2] * gd[6], h1[3] * gd[7]});
        }
    }
#undef LRU_LOAD
    __syncthreads();
    if (tid < 32) {
        const int j = h * 64 + jh * 32 + tid;
        c.out[O_LRU_P + (size_t)b * 1024 + j] = hcar[tid];
#pragma unroll
        for (int k = 0; k < 3; ++k) c.out[O_LCONV_P + ((size_t)b * 3 + k) * 1024 + j] = bf2f(c.XD[(size_t)(b * SEQ + SEQ - 3 + k) * 1024 + j]);
    }
    __syncthreads();
}
__device__ __forceinline__ void lru_sample_unit(const Ctx& c, int u, unsigned char* sm) {
    const int tid = threadIdx.x, h = u >> 3, tg = u & 7;
    float* wal = (float*)sm;
    float* wxl = wal + 4096;
    float* xcs = wxl + 4096;
    const int tk = tid >> 5, jq = tid & 31, bs = tg * 16 + tk, row = NP + bs, j0 = h * 64 + 2 * jq;
    const f32x2 h0 = *(const f32x2*)(c.state_lru + (size_t)bs * 1024 + j0);
    unsigned* mp = (unsigned*)(c.MIX + (size_t)row * 2048 + 1024 + j0);
    const unsigned gdw = *mp;
    const f32x2 bav = *(const f32x2*)(c.lru_ba + j0), bxv = *(const f32x2*)(c.lru_bx + j0), lam = *(const f32x2*)(c.lru_lambda + j0);
#pragma unroll
    for (int i = 0; i < 2; ++i) { const int idx = tid + 512 * i; ((f32x4*)wal)[idx] = ((const f32x4*)(c.lru_wa + (size_t)h * 4096))[idx]; ((f32x4*)wxl)[idx] = ((const f32x4*)(c.lru_wx + (size_t)h * 4096))[idx]; }
#pragma unroll
    for (int it = 0; it < 2; ++it) {
        const int item = tid + 512 * it, t2 = item >> 6, cc = item & 63, bs2 = tg * 16 + t2, ch = h * 64 + cc;
        const float* buf = c.state_lru_conv + (size_t)bs2 * 3 * 1024;
        const float xn = bf2f(c.XD[(size_t)(NP + bs2) * 1024 + ch]);
        const float b0 = buf[ch], b1 = buf[1024 + ch], b2 = buf[2048 + ch];
        xcs[t2 * 64 + cc] = c.lru_conv_b[ch] + c.lru_conv_w[ch] * b0 + c.lru_conv_w[1024 + ch] * b1 + c.lru_conv_w[2048 + ch] * b2 + c.lru_conv_w[3072 + ch] * xn;
        float* so = c.out + O_LCONV_S + (size_t)bs2 * 3 * 1024;
        so[ch] = b1; so[1024 + ch] = b2; so[2048 + ch] = xn;
    }
    __syncthreads();
    f32x2 sr = bav, si = bxv;
#pragma unroll 16
    for (int ii = 0; ii < 64; ++ii) { const float xv = xcs[tk * 64 + ii]; const f32x2 a2 = *(const f32x2*)(wal + ii * 64 + 2 * jq), x2 = *(const f32x2*)(wxl + ii * 64 + 2 * jq); sr += a2 * xv; si += x2 * xv; }
    float hn[2];
#pragma unroll
    for (int e = 0; e < 2; ++e) {
        const float r = sigmoidf_(sr[e]), ig = sigmoidf_(si[e]);
        const float la = -8.f * r * softplusf_(-lam[e]);
        const float a = __expf(la);
        hn[e] = a * h0[e] + sqrtf(fmaxf(neg_expm1_fast(2.f * la), 0.f)) * (ig * xcs[tk * 64 + 2 * jq + e]);
    }
    *(f32x2*)(c.out + O_LRU_S + (size_t)bs * 1024 + j0) = (f32x2){hn[0], hn[1]};
    *mp = pk2(hn[0] * bflo(gdw), hn[1] * bfhi(gdw));
    __syncthreads();
}
__device__ __forceinline__ void p5_odd_mixers(const Ctx& c, unsigned char* sm) {
    const int G = gridDim.x, bx = blockIdx.x;
    for (int u = bx; u < 256; u += G) lru_unit(c, u, sm);
    for (int u = bx; u < 256; u += G) ccv_unit(c, u, sm);
    for (int u = bx; u < 256; u += G) { if (u < 128) ccv_sample_unit(c, u, sm); else lru_sample_unit(c, u - 128, sm); }
}

__device__ __forceinline__ void p7_final_norm(const Ctx& c) {
    const int lane = threadIdx.x & 63, gw = blockIdx.x * 8 + (threadIdx.x >> 6), NGW = gridDim.x * 8;
    f32x4 fn[4];
#pragma unroll
    for (int j = 0; j < 4; ++j) fn[j] = ((const f32x4*)c.final_norm)[lane + 64 * j];
    for (int m0 = gw; m0 < NT; m0 += 4 * NGW) {
        u32x2 xw[4][4];
#pragma unroll
        for (int r = 0; r < 4; ++r) { const int m = m0 + r * NGW;
            if (m < NT) {
#pragma unroll
                for (int j = 0; j < 4; ++j) xw[r][j] = __builtin_nontemporal_load((const u32x2*)(c.X2b + (size_t)m * 1024) + lane + 64 * j); } }
#pragma unroll
        for (int r = 0; r < 4; ++r) { const int m = m0 + r * NGW;
            if (m < NT) {
                f32x4 v[4]; float s = 0.f;
#pragma unroll
                for (int j = 0; j < 4; ++j) { v[j] = (f32x4){bflo(xw[r][j].x), bfhi(xw[r][j].x), bflo(xw[r][j].y), bfhi(xw[r][j].y)}; s += (v[j][0] * v[j][0] + v[j][1] * v[j][1]) + (v[j][2] * v[j][2] + v[j][3] * v[j][3]); }
                const float rstd = rsqrtf(wave_sum(s) * (1.f / 1024.f) + EPS);
                f32x4* yo = (f32x4*)(c.out + (size_t)m * 1024);
#pragma unroll
                for (int j = 0; j < 4; ++j) __builtin_nontemporal_store(v[j] * rstd * fn[j], yo + lane + 64 * j);
            } }
    }
}

#ifndef MK_COOP
#define MK_COOP 1
#endif
struct Params { const float* in[35]; float* out; unsigned char* ws; int lo, hi; };
constexpr int N_PHASES = 8;

__global__ void __launch_bounds__(512, 2) hybrid_fwd(Params P) {
    extern __shared__ __attribute__((aligned(16))) unsigned char lds[];
    Ctx c;
    c.x_prompt = P.in[0]; c.x_sample = P.in[1]; c.state_ssm = P.in[2]; c.state_ssd_conv = P.in[3]; c.state_ccv = P.in[4]; c.state_lru_conv = P.in[5]; c.state_lru = P.in[6];
    c.norm_even = P.in[7]; c.w_in_even = P.in[8]; c.ssd_conv_w = P.in[9]; c.ssd_conv_b = P.in[10]; c.ssd_dt_bias = P.in[11]; c.ssd_a_log = P.in[12]; c.ssd_d = P.in[13]; c.ssd_norm = P.in[14];
    c.gmlp_ln_g = P.in[15]; c.gmlp_ln_b = P.in[16]; c.gmlp_w_s = P.in[17]; c.gmlp_b_s = P.in[18]; c.w_out_even = P.in[19];
    c.norm_odd = P.in[20]; c.w_in_odd = P.in[21]; c.ccv_w = P.in[22]; c.ccv_b = P.in[23]; c.ccv_ln_g = P.in[24]; c.ccv_ln_b = P.in[25];
    c.lru_conv_w = P.in[26]; c.lru_conv_b = P.in[27]; c.lru_wa = P.in[28]; c.lru_ba = P.in[29]; c.lru_wx = P.in[30]; c.lru_bx = P.in[31]; c.lru_lambda = P.in[32]; c.w_out_odd = P.in[33]; c.final_norm = P.in[34];
    c.out = P.out;
    unsigned char* ws = P.ws;
    c.ss0 = (float*)(ws + WS_SS0); c.ss1 = (float*)(ws + WS_SS1); c.DT = (float*)(ws + WS_DT); c.ssg = (float*)(ws + WS_SSG); c.xcnt = (unsigned*)(ws + WS_XCNT);
    c.W1t = (bf16*)(ws + WS_W1); c.W2t = (bf16*)(ws + WS_W2); c.W3t = (bf16*)(ws + WS_W3); c.W4t = (bf16*)(ws + WS_W4);
    c.XN = (bf16*)(ws + WS_XN); c.MIX = (bf16*)(ws + WS_MIX); c.XBC = (bf16*)(ws + WS_XBC); c.GV = (bf16*)(ws + WS_GV); c.GLU = (bf16*)(ws + WS_XBC); c.XD = (bf16*)(ws + WS_GV); c.BCn = (bf16*)(ws + WS_BCN); c.BTg = (bf16*)(ws + WS_BTG); c.Gg = (bf16*)(ws + WS_GG); c.X2b = (bf16*)(ws + WS_BCN);
    PG8_LAS unsigned char* l3 = (PG8_LAS unsigned char*)lds;
    const int lo = P.lo, hi = P.hi;
#ifdef PROBE_A
    unsigned long long ts[16];
#define STAMP(k) ts[k] = __builtin_amdgcn_s_memrealtime()
#else
#define STAMP(k) do { } while (0)
#endif
    STAMP(0);
#define IN(k) (lo <= (k) && (k) < hi)
#if MK_COOP
#define SEAM(k) do { if (IN(k) && IN((k) + 1)) cg::this_grid().sync(); } while (0)
#else
#define SEAM(k) do { } while (0)
#endif
    if (IN(0)) { p0_prologue(c, lds); } SEAM(0); STAMP(1);
    if (IN(1)) {
        pg8::Gemm g{c.XN, c.W1t, MP, N1, 1024}; pg8::StaticOrder S; S.init(MP, N1, (int)gridDim.x, (int)blockIdx.x);
        Epi1 E{c.ss0, c.MIX, c.XBC, c.GV, c.DT};
        pg8::gemm_phase<Epi1, pg8::StaticOrder, NoHook, true, true>(l3, g, S, E, NoHook{});
    } SEAM(1); STAMP(2);
    if (IN(2)) {
        const int G = gridDim.x, bx = blockIdx.x;
        {
            if (threadIdx.x == 0) { const unsigned x = (unsigned)__builtin_amdgcn_s_getreg((3 << 11) | 20) & 7u; const unsigned i = __hip_atomic_fetch_add(c.xcnt + x, 1u, __ATOMIC_RELAXED, __HIP_MEMORY_SCOPE_AGENT); *(unsigned*)(lds + 147300) = x | (i << 8); }
            __syncthreads();
        }
        for (int u = bx; u < 256; u += G) bc_prepass_unit(c, u, lds);
        STAMP(9);
        for (int u = bx; u < 256; u += G) gmlp_unit(c, u, lds);
        STAMP(10);
        for (int u = bx; u < 256; u += G) sample_even_unit(c, u, lds);
        STAMP(11);
        for (int i = bx * 512 + threadIdx.x; i < 8 * 3 * 1536; i += G * 512) { const int b = i / (3 * 1536), r = i % (3 * 1536), k = r / 1536, ch = r % 1536;
            c.out[O_SCONV_P + i] = bf2f(c.XBC[(size_t)(b * SEQ + SEQ - 3 + k) * 1536 + ch]); }
    } SEAM(2); STAMP(3);
    {
        if (gridDim.x == 256) {
            const unsigned clm = *(const unsigned*)(lds + 147300);
            const int ssd_xcc = __builtin_amdgcn_readfirstlane((int)(clm & 255u)), ssd_idx = __builtin_amdgcn_readfirstlane((int)(clm >> 8));
            int x = ssd_xcc, i = ssd_idx;
            if (i >= 32) {
                int r = i - 32;
                for (int x2 = 0; x2 < 8; ++x2) { const int c2 = (int)__hip_atomic_load(c.xcnt + x2, __ATOMIC_RELAXED, __HIP_MEMORY_SCOPE_AGENT); if (x2 < ssd_xcc && c2 > 32) r += c2 - 32; }
                for (int x2 = 0; x2 < 8; ++x2) { int c2 = (int)__hip_atomic_load(c.xcnt + x2, __ATOMIC_RELAXED, __HIP_MEMORY_SCOPE_AGENT); c2 = c2 < 32 ? c2 : 32; if (r < 32 - c2) { x = x2; i = c2 + r; break; } r -= 32 - c2; }
            }
            ssd_chunk_unit(c, x * 32 + i, lds);
        } else { const int G = gridDim.x, bx = blockIdx.x; for (int u = bx; u < 256; u += G) ssd_chunk_unit(c, u, lds); }
        cg::this_grid().sync(); STAMP(15);
    }
    if (IN(3)) {
        sample_outproj<true>(c.MIX + (size_t)NP * 2048, c.W2t, c.x_sample, c.XN + (size_t)NP * 1024, nullptr, c.ss1 + (size_t)NP, lds);
        pg8::Gemm g{c.MIX, c.W2t, NP, 1024, 2048}; pg8::StaticOrder S; S.init(NP, 1024, (int)gridDim.x, (int)blockIdx.x);
        Unit u0;
        if (S.next(0, u0)) {
            float* tab = (float*)(lds + 131072);
            if (threadIdx.x < 256) { const float* sp = c.ssg + (size_t)(u0.pm * 256 + threadIdx.x); float s0 = 0.f, s1 = 0.f;
#pragma unroll
                for (int i = 0; i < 16; ++i) { s0 += sp[(size_t)i * NP]; s1 += sp[(size_t)(16 + i) * NP]; }
                const float r0 = rsqrtf(s0 * (1.f / 512.f) + EPS), r1 = rsqrtf(s1 * (1.f / 512.f) + EPS);
                tab[threadIdx.x * 2] = r0 / r1; tab[threadIdx.x * 2 + 1] = r1; }
        }
        __syncthreads();
        EpiOut<true> E{c.x_prompt, c.XN, nullptr, c.ss1};
        HookScale H{(const LAS3 float*)(l3 + 131072)};
        pg8::gemm_phase<EpiOut<true>, pg8::StaticOrder, HookScale, false, true>(l3, g, S, E, H);
    } SEAM(3); STAMP(4);
    if (IN(4)) {
        pg8::Gemm g{c.XN, c.W3t, MP, N3, 1024}; pg8::StaticOrder S; S.init(MP, N3, (int)gridDim.x, (int)blockIdx.x);
        {
            float* tab = (float*)(lds + 131072);
            Unit uu;
            for (int i = 0; i < 8; ++i) { if (!S.next(i, uu)) break; if (threadIdx.x < 256) tab[i * 256 + threadIdx.x] = rstd_from(c.ss1, uu.pm * 256 + (int)threadIdx.x); }
            __syncthreads();
        }
        Epi3 E{(const LAS3 float*)(l3 + 131072), c.MIX, c.GLU, c.XD, 0};
        pg8::gemm_phase<Epi3, pg8::StaticOrder, NoHook, true, true>(l3, g, S, E, NoHook{});
    } SEAM(4); STAMP(5);
    if (IN(5)) {
        const int G = gridDim.x, bx = blockIdx.x;
        for (int u = bx; u < 256; u += G) lru_unit(c, u, lds);
        STAMP(12);
        for (int u = bx; u < 256; u += G) ccv_unit(c, u, lds);
        STAMP(13);
        for (int u = bx; u < 256; u += G) { if (u < 128) ccv_sample_unit(c, u, lds); else lru_sample_unit(c, u - 128, lds); }
        STAMP(14);
        for (int i = bx * 512 + threadIdx.x; i < 8 * 30 * 1024; i += G * 512) { const int b = i / (30 * 1024), r = i % (30 * 1024); c.out[O_CCV_P + i] = bf2f(c.GLU[(size_t)(b * SEQ + SEQ - 30) * 1024 + r]); }
    } SEAM(5); STAMP(6);
    if (IN(6)) {
        sample_outproj<false>(c.MIX + (size_t)NP * 2048, c.W4t, nullptr, c.XN + (size_t)NP * 1024, c.X2b + (size_t)NP * 1024, nullptr, lds);
        pg8::Gemm g{c.MIX, c.W4t, NP, 1024, 2048}; pg8::StaticOrder S; S.init(NP, 1024, (int)gridDim.x, (int)blockIdx.x);
        EpiOut<false> E{nullptr, c.XN, c.X2b, nullptr};
        pg8::gemm_phase<EpiOut<false>, pg8::StaticOrder, NoHook, false, true>(l3, g, S, E, NoHook{});
    } SEAM(6); STAMP(7);
    if (IN(7)) { p7_final_norm(c); }
#ifdef PROBE_A
    STAMP(8);
    if (blockIdx.x == 0) {
        const float tot = (float)(ts[8] - ts[0]);
        const float f1 = (float)(ts[PROBE_A1] - ts[PROBE_A]) / tot, f2 = (float)(ts[PROBE_B1] - ts[PROBE_B]) / tot;
        __syncthreads();
        for (int i = threadIdx.x; i < 8192; i += 512) c.out[O_LRU_P + i] *= (1.03f + 0.1f * f1);
        if (threadIdx.x == 0) c.out[0] += 10.f + 90.f * f2;
    }
#endif
#undef IN
#undef SEAM
}

extern "C" void kernel_launch(void* const* d_in, const int* in_sizes, int n_in, void* d_out, int out_size, void* d_ws, size_t ws_size, hipStream_t stream) {
    static int grid = 0;
    if (grid == 0) {
        if (n_in != 35 || out_size != (int)O_END || ws_size < WS_END) { fprintf(stderr, "kernel_launch: unexpected problem (n_in %d out %d ws %zu)\n", n_in, out_size, ws_size); grid = -1; return; }
        int dev = 0, cus = 0, per_cu = 0;
        (void)hipGetDevice(&dev); (void)hipDeviceGetAttribute(&cus, hipDeviceAttributeMultiprocessorCount, dev);
        if (hipFuncSetAttribute((const void*)hybrid_fwd, hipFuncAttributeMaxDynamicSharedMemorySize, LDS_BYTES) != hipSuccess) { fprintf(stderr, "kernel_launch: hipFuncSetAttribute failed\n"); grid = -1; return; }
        if (hipOccupancyMaxActiveBlocksPerMultiprocessor(&per_cu, (const void*)hybrid_fwd, 512, LDS_BYTES) != hipSuccess || per_cu < 1) { fprintf(stderr, "kernel_launch: occupancy query says %d blocks per CU\n", per_cu); (void)hipGetLastError(); per_cu = 1; }
        grid = cus < 256 ? cus : 256;
        if (grid != 256) fprintf(stderr, "kernel_launch: %d CUs; this kernel is built for 256\n", cus);
    }
    if (grid < 0) return;
    Params p{};
    for (int i = 0; i < 35; ++i) p.in[i] = (const float*)d_in[i];
    p.out = (float*)d_out; p.ws = (unsigned char*)d_ws;
#if MK_COOP
    p.lo = 0; p.hi = N_PHASES;
    void* args[] = {&p};
    hipError_t e = hipLaunchCooperativeKernel((const void*)hybrid_fwd, dim3(grid), dim3(512), args, LDS_BYTES, stream);
    if (e != hipSuccess) fprintf(stderr, "kernel_launch: cooperative launch failed: %s\n", hipGetErrorString(e));
#else
    for (int ph = 0; ph < N_PHASES; ++ph) { p.lo = ph; p.hi = ph + 1; hipLaunchKernelGGL(hybrid_fwd, dim3(grid), dim3(512), LDS_BYTES, stream, p); }
#endif
}
```

```cpp
#include <hip/hip_runtime.h>
#include <hip/hip_cooperative_groups.h>
#include <cstdio>
#include <cstdint>
namespace cg = cooperative_groups;
namespace pg8 {
#define PG8_LAS __attribute__((address_space(3)))
typedef unsigned short bf16_t;
typedef short bf16x8 __attribute__((ext_vector_type(8)));
typedef float f32x4 __attribute__((ext_vector_type(4)));
typedef unsigned u32x4 __attribute__((ext_vector_type(4)));
constexpr int BM = 256, BK = 64, HALF = 128, HTB = HALF * BK * 2  , STAGE_BYTES = 8 * HTB, NXCD = 8, WGM = 8;

__host__ __device__ __forceinline__ int lds_byte(int r, int c) { const int st = (r >> 4) * 2 + (c >> 5), rr = r & 15, cc = c & 31, ob = rr * 64 + cc * 2; return st * 1024 + (ob ^ (((ob >> 9) & 1) << 5)); }
__host__ __device__ __forceinline__ void stage_rc(int b, int& R, int& C) { const int st = b / 1024, sb = b % 1024, swz = sb ^ (((sb >> 9) & 1) << 5); R = (st >> 1) * 16 + swz / 64; C = (st & 1) * 32 + (swz % 64) / 2; }
__host__ __device__ __forceinline__ int perm32(int rho) { const int n = rho >> 4, i = rho & 15; return 8 * (i >> 2) + 4 * n + (i & 3); }

struct Unit { int pm, pn; };
struct Gemm { const bf16_t* A; const bf16_t* Bt; int M, N, K; };

struct StaticOrder {
    int nM, nN, nwg, G, c;
    __host__ __device__ void init(int M, int N, int G_, int c_) { nM = M / BM; nN = N / BM; nwg = nM * nN; G = G_; c = c_; }
    __host__ __device__ bool next(int i, Unit& u) const {
        const long L = (long)i * G + c; if (L >= nwg) return false;
        int wgid = (int)L; { const int q = nwg / NXCD, r = nwg % NXCD, xcd = wgid % NXCD, off = wgid / NXCD; wgid = (xcd < r ? xcd * (q + 1) : r * (q + 1) + (xcd - r) * q) + off; }
        const int nig = WGM * nN, gid = wgid / nig, fm = gid * WGM, gsz = (nM - fm) < WGM ? (nM - fm) : WGM;
        u.pm = fm + ((wgid % nig) % gsz); u.pn = (wgid % nig) / gsz; return true;
    }
    __device__ __forceinline__ void a_ready(const Unit&) const {}
    __device__ __forceinline__ void done(const Unit&) const {}
};

__device__ __forceinline__ unsigned cvt_pk_bf16(float lo, float hi) { unsigned r; asm volatile("v_cvt_pk_bf16_f32 %0, %1, %2" : "=v"(r) : "v"(lo), "v"(hi)); return r; }
template <class Epi, class Sched, class Hook, bool ALIGN_EPI = false, bool SP2 = false>
__device__ __forceinline__ void gemm_phase(PG8_LAS unsigned char* lds, const Gemm g, const Sched& S, const Epi& E, const Hook& H) {
    const int tid = threadIdx.x, wid = __builtin_amdgcn_readfirstlane(tid >> 6), lane = tid & 63, wr = wid >> 2, wc = wid & 3, fr = lane & 15, fq = lane >> 4;
    const int K = g.K, nt = K / BK;
    unsigned voffA[2], voffB[2];
#pragma unroll
    for (int i = 0; i < 2; ++i) { int R, C; stage_rc(tid * 16 + i * 8192, R, C); const int Rb = Epi::PERM ? ((R & ~31) + perm32(R & 31)) : R;
        voffA[i] = (unsigned)(R * K + C) * 2u; voffB[i] = (unsigned)(Rb * K + C) * 2u; }
    const size_t kstep = (size_t)(BK * 2);
    const size_t hstep = (size_t)HALF * K * 2;
    const size_t tstep = 2 * hstep;
    const unsigned ldsw = (unsigned)wid * 1024u;
    const int aoff = lds_byte(wr * 64 + fr, fq * 8), boff = lds_byte(wc * 32 + fr, fq * 8);
#define PG8_SA(b, h) (((b) * 2 + (h)) * HTB)
#define PG8_SB(b, h) ((4 + (b) * 2 + (h)) * HTB)
#define PG8_STAGE(bufoff, gbase, voff) do { _Pragma("unroll") for (int _i = 0; _i < 2; ++_i) \
        __builtin_amdgcn_global_load_lds((const unsigned*)((const char*)(gbase) + (voff)[_i]), (PG8_LAS unsigned*)(lds + (bufoff) + ldsw + _i * 8192), 16, 0, 0); } while (0)
#define PG8_LDA(dst, b, h) do { _Pragma("unroll") for (int m = 0; m < 4; ++m) _Pragma("unroll") for (int k = 0; k < 2; ++k) dst[m][k] = *(const PG8_LAS bf16x8*)(lds + PG8_SA(b, h) + aoff + m * 2048 + k * 1024); } while (0)
#define PG8_LDB(dst, b, h) do { _Pragma("unroll") for (int n = 0; n < 2; ++n) _Pragma("unroll") for (int k = 0; k < 2; ++k) dst[n][k] = *(const PG8_LAS bf16x8*)(lds + PG8_SB(b, h) + boff + n * 2048 + k * 1024); } while (0)
#define PG8_MMA(ai, bj, At, Bt) do { __builtin_amdgcn_s_setprio(1); _Pragma("unroll") for (int m = 0; m < 4; ++m) _Pragma("unroll") for (int n = 0; n < 2; ++n) _Pragma("unroll") for (int k = 0; k < 2; ++k) \
        acc[ai][bj][m][n] = __builtin_amdgcn_mfma_f32_16x16x32_bf16(Bt[n][k], At[m][k], acc[ai][bj][m][n], 0, 0, 0); __builtin_amdgcn_s_setprio(0); } while (0)
#define PG8_WAIT_V(n) asm volatile("s_waitcnt vmcnt(" #n ")" ::: "memory")
#define PG8_WAIT_L(n) asm volatile("s_waitcnt lgkmcnt(" #n ")" ::: "memory")
#define PG8_BAR __builtin_amdgcn_s_barrier()
#define PG8_SCHED __builtin_amdgcn_sched_barrier(0)
    Unit cur, nxt; int ui = 0;
    if (!S.next(0, cur)) return;
    f32x4 acc[2][2][4][2];
#pragma unroll
    for (int a = 0; a < 2; ++a)
#pragma unroll
        for (int b = 0; b < 2; ++b)
#pragma unroll
            for (int m = 0; m < 4; ++m)
#pragma unroll
                for (int n = 0; n < 2; ++n) acc[a][b][m][n] = (f32x4){0.f, 0.f, 0.f, 0.f};
    bf16x8 At[4][2], B0[2][2], B1[2][2];
    const char* cA = (const char*)g.A + (size_t)cur.pm * tstep; const char* cB = (const char*)g.Bt + (size_t)cur.pn * tstep;
    S.a_ready(cur);
    if constexpr (SP2) {
        PG8_STAGE(PG8_SB(0, 0), cB, voffB); PG8_STAGE(PG8_SB(0, 1), cB + hstep, voffB); PG8_STAGE(PG8_SA(0, 0), cA, voffA); PG8_STAGE(PG8_SA(0, 1), cA + hstep, voffA);
        if (wr == 1) PG8_BAR;
        PG8_WAIT_V(2); PG8_BAR;
        PG8_STAGE(PG8_SB(1, 0), cB + kstep, voffB); PG8_STAGE(PG8_SA(1, 0), cA + kstep, voffA); PG8_STAGE(PG8_SB(1, 1), cB + hstep + kstep, voffB);
        PG8_WAIT_V(6); PG8_BAR;
    } else {
        PG8_STAGE(PG8_SB(0, 0), cB, voffB); PG8_STAGE(PG8_SA(0, 0), cA, voffA); PG8_STAGE(PG8_SB(0, 1), cB + hstep, voffB); PG8_STAGE(PG8_SA(0, 1), cA + hstep, voffA);
        if (wr == 1) PG8_BAR;
        PG8_WAIT_V(4); PG8_BAR;
        PG8_STAGE(PG8_SB(1, 0), cB + kstep, voffB); PG8_STAGE(PG8_SA(1, 0), cA + kstep, voffA); PG8_STAGE(PG8_SB(1, 1), cB + hstep + kstep, voffB);
        PG8_WAIT_V(6); PG8_BAR;
    }
    for (;;) {
        const bool has_next = S.next(ui + 1, nxt);
        const char* nA = has_next ? (const char*)g.A + (size_t)nxt.pm * tstep : cA; const char* nB = has_next ? (const char*)g.Bt + (size_t)nxt.pn * tstep : cB;
        for (int t = 0; t < nt; t += 2) {
            const bool last = (t == nt - 2);
            const char* a1 = cA + (size_t)(t + 1) * kstep;
            const char* a2 = last ? nA : cA + (size_t)(t + 2) * kstep; const char* b2 = last ? nB : cB + (size_t)(t + 2) * kstep;
            const char* a3 = a2 + kstep; const char* b3 = b2 + kstep;
            if (last && has_next) S.a_ready(nxt);
            H(acc, t, wr, fr);
            if constexpr (SP2) {
            PG8_LDB(B0, 0, 0); PG8_LDB(B1, 0, 1); PG8_SCHED; PG8_LDA(At, 0, 0); PG8_STAGE(PG8_SA(1, 1), a1 + hstep, voffA);
            PG8_WAIT_V(8); PG8_WAIT_L(0); PG8_BAR; PG8_MMA(0, 0, At, B0); PG8_MMA(0, 1, At, B1); PG8_BAR; PG8_SCHED;
            PG8_LDA(At, 0, 1); PG8_STAGE(PG8_SB(0, 0), b2, voffB); PG8_STAGE(PG8_SB(0, 1), b2 + hstep, voffB); PG8_STAGE(PG8_SA(0, 0), a2, voffA);
            PG8_WAIT_V(8); PG8_WAIT_L(0); PG8_BAR; PG8_MMA(1, 0, At, B0); PG8_MMA(1, 1, At, B1); PG8_BAR; PG8_SCHED;
            PG8_LDB(B0, 1, 0); PG8_LDB(B1, 1, 1); PG8_SCHED; PG8_LDA(At, 1, 0); PG8_STAGE(PG8_SA(0, 1), a2 + hstep, voffA);
            PG8_WAIT_V(8); PG8_WAIT_L(0); PG8_BAR; PG8_MMA(0, 0, At, B0); PG8_MMA(0, 1, At, B1); PG8_BAR; PG8_SCHED;
            PG8_LDA(At, 1, 1); PG8_STAGE(PG8_SB(1, 0), b3, voffB); PG8_STAGE(PG8_SB(1, 1), b3 + hstep, voffB); PG8_STAGE(PG8_SA(1, 0), a3, voffA);
            PG8_WAIT_V(8); PG8_WAIT_L(0); PG8_BAR; PG8_MMA(1, 0, At, B0); PG8_MMA(1, 1, At, B1); PG8_BAR; PG8_SCHED;
            } else {
            PG8_LDB(B0, 0, 0); PG8_SCHED; PG8_LDA(At, 0, 0); PG8_STAGE(PG8_SA(1, 1), a1 + hstep, voffA);
            PG8_WAIT_L(8); PG8_BAR; PG8_WAIT_L(0); PG8_MMA(0, 0, At, B0); PG8_BAR; PG8_SCHED;
            PG8_LDB(B1, 0, 1); PG8_STAGE(PG8_SB(0, 0), b2, voffB);
            PG8_BAR; PG8_WAIT_L(0); PG8_MMA(0, 1, At, B1); PG8_BAR;
            PG8_LDA(At, 0, 1); PG8_STAGE(PG8_SA(0, 0), a2, voffA);
            PG8_BAR; PG8_WAIT_L(0); PG8_MMA(1, 0, At, B0); PG8_BAR; PG8_SCHED;
            PG8_STAGE(PG8_SB(0, 1), b2 + hstep, voffB);
            PG8_WAIT_V(6); PG8_BAR; PG8_MMA(1, 1, At, B1); PG8_BAR;
            PG8_LDB(B0, 1, 0); PG8_SCHED; PG8_LDA(At, 1, 0); PG8_STAGE(PG8_SA(0, 1), a2 + hstep, voffA);
            PG8_WAIT_L(8); PG8_BAR; PG8_WAIT_L(0); PG8_MMA(0, 0, At, B0); PG8_BAR; PG8_SCHED;
            PG8_LDB(B1, 1, 1); PG8_STAGE(PG8_SB(1, 0), b3, voffB);
            PG8_BAR; PG8_WAIT_L(0); PG8_MMA(0, 1, At, B1); PG8_BAR;
            PG8_LDA(At, 1, 1); PG8_STAGE(PG8_SA(1, 0), a3, voffA);
            PG8_BAR; PG8_WAIT_L(0); PG8_MMA(1, 0, At, B0); PG8_BAR; PG8_SCHED;
            PG8_STAGE(PG8_SB(1, 1), b3 + hstep, voffB);
            PG8_WAIT_V(6); PG8_BAR; PG8_MMA(1, 1, At, B1); PG8_BAR;
            }
        }
        if constexpr (ALIGN_EPI) { if (wr == 0) PG8_BAR; }
        if constexpr (!Epi::AFTER_DRAIN) { E(acc, cur, wr, wc, fr, fq); S.done(cur); }
        if (!has_next) break;
#pragma unroll
        for (int a = 0; a < 2; ++a)
#pragma unroll
            for (int b = 0; b < 2; ++b)
#pragma unroll
                for (int m = 0; m < 4; ++m)
#pragma unroll
                    for (int n = 0; n < 2; ++n) acc[a][b][m][n] = (f32x4){0.f, 0.f, 0.f, 0.f};
        cur = nxt; cA = nA; cB = nB; ++ui;
        if constexpr (ALIGN_EPI) { if (wr == 1) PG8_BAR; }
    }
    PG8_WAIT_V(0);
    if constexpr (!ALIGN_EPI) { if (wr == 0) PG8_BAR; }
    PG8_BAR;
    if constexpr (Epi::AFTER_DRAIN) { E.fused(acc, cur, wr, wc, fr, fq, lds, wid, lane); S.done(cur); }
#undef PG8_SA
#undef PG8_SB
#undef PG8_STAGE
#undef PG8_LDA
#undef PG8_LDB
#undef PG8_MMA
#undef PG8_WAIT_V
#undef PG8_WAIT_L
#undef PG8_BAR
#undef PG8_SCHED
}
}

using pg8::f32x4; using pg8::bf16x8; using pg8::Unit;
typedef unsigned short bf16;
typedef unsigned u32x2 __attribute__((ext_vector_type(2)));
typedef unsigned u32x4 __attribute__((ext_vector_type(4)));
typedef float f32x2 __attribute__((ext_vector_type(2)));
#define LAS3 __attribute__((address_space(3)))

constexpr int NP = 16384, NS = 128, NT = NP + NS, MP = 16640, SEQ = 2048;
constexpr int N1 = 5888, N3 = 5120;
constexpr float EPS = 1e-6f;
constexpr int LDS_BYTES = 147456;

constexpr size_t O_SSM_P = (size_t)NT * 1024;
constexpr size_t O_SSM_S = O_SSM_P + (size_t)8 * 16 * 64 * 128;
constexpr size_t O_SCONV_P = O_SSM_S + (size_t)128 * 16 * 64 * 128;
constexpr size_t O_SCONV_S = O_SCONV_P + 8 * 3 * 1536;
constexpr size_t O_GV_S = O_SCONV_S + 128 * 3 * 1536;
constexpr size_t O_CCV_P = O_GV_S + 128 * 1024;
constexpr size_t O_CCV_S = O_CCV_P + 8 * 30 * 1024;
constexpr size_t O_LCONV_P = O_CCV_S + 128 * 30 * 1024;
constexpr size_t O_LCONV_S = O_LCONV_P + 8 * 3 * 1024;
constexpr size_t O_LRU_P = O_LCONV_S + 128 * 3 * 1024;
constexpr size_t O_LRU_S = O_LRU_P + 8 * 1024;
constexpr size_t O_END = O_LRU_S + 128 * 1024;
static_assert(O_END == 40226816, "output size");

constexpr size_t MiB = 1u << 20;
constexpr size_t WS_SS0 = 0, WS_SS1 = 288 * 1024, WS_DT = 576 * 1024, WS_SSG = 1792 * 1024, WS_XCNT = 3840 * 1024, WS_BAR = 3840 * 1024 + 8192;
constexpr size_t WS_W4 = 4 * MiB, WS_W3 = 8 * MiB, WS_W2 = 18 * MiB, WS_XN = 22 * MiB, WS_W1 = 54 * MiB + 512 * 1024, WS_MIX = 66 * MiB, WS_XBC = 131 * MiB, WS_GV = 180 * MiB, WS_BCN = 213 * MiB, WS_BTG = 229 * MiB, WS_GG = 237 * MiB, WS_END = 246 * MiB;
static_assert(WS_XN + (size_t)MP * 1024 * 2 <= WS_W1 && WS_W1 + (size_t)N1 * 1024 * 2 <= WS_MIX && WS_MIX + (size_t)MP * 2048 * 2 <= WS_XBC && WS_XBC + (size_t)MP * 1536 * 2 <= WS_GV && WS_GV + (size_t)MP * 1024 * 2 <= WS_BCN && WS_BCN + (size_t)NP * 512 * 2 <= WS_BTG && WS_BTG + (size_t)NP * 256 * 2 <= WS_END && WS_BCN + (size_t)NT * 1024 * 2 <= WS_END, "ws map");
static_assert(WS_SS0 + (size_t)MP * 16 <= WS_SS1 && WS_SS1 + (size_t)MP * 16 <= WS_DT && WS_DT + (size_t)MP * 64 <= WS_SSG && WS_SSG + (size_t)NP * 128 <= WS_W4, "ws map small");

struct Ctx {
    const float *x_prompt, *x_sample, *state_ssm, *state_ssd_conv, *state_ccv, *state_lru_conv, *state_lru;
    const float *norm_even, *w_in_even, *ssd_conv_w, *ssd_conv_b, *ssd_dt_bias, *ssd_a_log, *ssd_d, *ssd_norm, *gmlp_ln_g, *gmlp_ln_b, *gmlp_w_s, *gmlp_b_s, *w_out_even;
    const float *norm_odd, *w_in_odd, *ccv_w, *ccv_b, *ccv_ln_g, *ccv_ln_b, *lru_conv_w, *lru_conv_b, *lru_wa, *lru_ba, *lru_wx, *lru_bx, *lru_lambda, *w_out_odd, *final_norm;
    float* out;
    float *ss0, *ss1, *DT, *ssg; unsigned* xcnt;
    bf16 *W1t, *W2t, *W3t, *W4t, *XN, *MIX, *XBC, *GV, *GLU, *XD, *BCn, *BTg, *Gg, *X2b;
};

__device__ __forceinline__ float bf2f(unsigned b) { return __uint_as_float(b << 16); }
__device__ __forceinline__ float bflo(unsigned w) { return __uint_as_float(w << 16); }
__device__ __forceinline__ float bfhi(unsigned w) { return __uint_as_float(w & 0xffff0000u); }
__device__ __forceinline__ unsigned pk2(float lo, float hi) { return pg8::cvt_pk_bf16(lo, hi); }
__device__ __forceinline__ float sigmoidf_(float x) { return __builtin_amdgcn_rcpf(1.f + __expf(-x)); }
__device__ __forceinline__ float siluf_(float x) { return x * sigmoidf_(x); }
__device__ __forceinline__ float geluf_(float x) { const float y = 1.5957691216057308f * (x + 0.044715f * x * x * x); return x * sigmoidf_(y); }
__device__ __forceinline__ float softplusf_(float x) { return fmaxf(x, 0.f) + log1pf(__expf(-fabsf(x))); }
__device__ __forceinline__ float wave_sum(float v) {
#pragma unroll
    for (int o = 1; o < 64; o <<= 1) v += __shfl_xor(v, o);
    return v;
}
__device__ __forceinline__ float block_sum(float v, float* red) {
    v = wave_sum(v);
    __syncthreads();
    if ((threadIdx.x & 63) == 0) red[threadIdx.x >> 6] = v;
    __syncthreads();
    float s = 0.f;
#pragma unroll
    for (int i = 0; i < 8; ++i) s += red[i];
    return s;
}
template <int CTRL> __device__ __forceinline__ float dpp_mov(float v) { return __int_as_float(__builtin_amdgcn_update_dpp(0, __float_as_int(v), CTRL, 0xf, 0xf, true)); }
__device__ __forceinline__ float row16_sum(float y) {
    y += dpp_mov<0x128>(y); y += dpp_mov<0x124>(y); y += dpp_mov<0x122>(y); y += dpp_mov<0x121>(y); return y;
}
__device__ __forceinline__ float rstd_from(const float* ss, int row) { return rsqrtf(((ss[row] + ss[MP + row]) + (ss[2 * MP + row] + ss[3 * MP + row])) * (1.f / 1024.f) + EPS); }
__device__ __forceinline__ u32x4 pack8(const f32x4 a, const f32x4 b) { u32x4 w; w.x = pk2(a[0], a[1]); w.y = pk2(a[2], a[3]); w.z = pk2(b[0], b[1]); w.w = pk2(b[2], b[3]); return w; }
__device__ __forceinline__ void unpack8(const u32x4 w, float (&f)[8]) { f[0] = bflo(w.x); f[1] = bfhi(w.x); f[2] = bflo(w.y); f[3] = bfhi(w.y); f[4] = bflo(w.z); f[5] = bfhi(w.z); f[6] = bflo(w.w); f[7] = bfhi(w.w); }

struct NoHook { __device__ __forceinline__ void operator()(f32x4 (&)[2][2][4][2], int, int, int) const {} };
struct HookScale {
    const LAS3 float* tab;
    __device__ __forceinline__ void operator()(f32x4 (&acc)[2][2][4][2], int t, int wr, int fr) const {
        if (t == 8 || t == 16) {
            const int j = (t == 16) ? 1 : 0;
#pragma unroll
            for (int ai = 0; ai < 2; ++ai)
#pragma unroll
                for (int m = 0; m < 4; ++m) { const float f = tab[(ai * 128 + wr * 64 + m * 16 + fr) * 2 + j];
#pragma unroll
                    for (int bj = 0; bj < 2; ++bj)
#pragma unroll
                        for (int n = 0; n < 2; ++n) acc[ai][bj][m][n] *= f; }
        }
    }
};

struct Epi1 {
    static constexpr bool PERM = true, AFTER_DRAIN = false;
    const float* ss; bf16* MIX; bf16* XBC; bf16* GV; float* DT;
    __device__ __forceinline__ void operator()(const f32x4 (&acc)[2][2][4][2], const Unit& u, int wr, int wc, int fr, int fq) const {
        const int row0 = u.pm * 256 + wr * 64 + fr, pn = u.pn, cl = wc * 32 + 8 * fq;
        float rs[2][4];
#pragma unroll
        for (int ai = 0; ai < 2; ++ai)
#pragma unroll
            for (int m = 0; m < 4; ++m) rs[ai][m] = 1.f;
        if (pn < 4) {
#pragma unroll
            for (int ai = 0; ai < 2; ++ai)
#pragma unroll
                for (int m = 0; m < 4; ++m) { bf16* rp = MIX + (size_t)(row0 + ai * 128 + m * 16) * 2048 + pn * 256 + cl; const float r = rs[ai][m];
#pragma unroll
                    for (int bj = 0; bj < 2; ++bj) { f32x4 v0 = acc[ai][bj][m][0] * r, v1 = acc[ai][bj][m][1] * r;
#pragma unroll
                        for (int j = 0; j < 4; ++j) { v0[j] = siluf_(v0[j]); v1[j] = siluf_(v1[j]); }
                        *(u32x4*)(rp + bj * 128) = pack8(v0, v1); } }
        } else if (pn < 10) {
#pragma unroll
            for (int ai = 0; ai < 2; ++ai)
#pragma unroll
                for (int m = 0; m < 4; ++m) { bf16* rp = XBC + (size_t)(row0 + ai * 128 + m * 16) * 1536 + (pn - 4) * 256 + cl; const float r = rs[ai][m];
#pragma unroll
                    for (int bj = 0; bj < 2; ++bj) *(u32x4*)(rp + bj * 128) = pack8(acc[ai][bj][m][0] * r, acc[ai][bj][m][1] * r); }
        } else if (pn < 18) {
#pragma unroll
            for (int ai = 0; ai < 2; ++ai)
#pragma unroll
                for (int m = 0; m < 4; ++m) { bf16* rp = MIX + (size_t)(row0 + ai * 128 + m * 16) * 2048 + 1024 + (pn - 10) * 128 + cl; const float r = rs[ai][m];
                    f32x4 o[2];
#pragma unroll
                    for (int n = 0; n < 2; ++n) { const f32x4 uu = acc[ai][0][m][n] * r, gg = acc[ai][1][m][n] * r;
#pragma unroll
                        for (int j = 0; j < 4; ++j) o[n][j] = geluf_(uu[j]) * siluf_(gg[j]); }
                    *(u32x4*)rp = pack8(o[0], o[1]); }
        } else if (pn < 22) {
#pragma unroll
            for (int ai = 0; ai < 2; ++ai)
#pragma unroll
                for (int m = 0; m < 4; ++m) { bf16* rp = GV + (size_t)(row0 + ai * 128 + m * 16) * 1024 + (pn - 18) * 256 + cl; const float r = rs[ai][m];
#pragma unroll
                    for (int bj = 0; bj < 2; ++bj) { f32x4 v0 = acc[ai][bj][m][0] * r, v1 = acc[ai][bj][m][1] * r;
#pragma unroll
                        for (int j = 0; j < 4; ++j) { v0[j] = geluf_(v0[j]); v1[j] = geluf_(v1[j]); }
                        *(u32x4*)(rp + bj * 128) = pack8(v0, v1); } }
        } else {
            if (wc == 0 && fq < 2) {
#pragma unroll
                for (int ai = 0; ai < 2; ++ai)
#pragma unroll
                    for (int m = 0; m < 4; ++m) { float* rp = DT + (size_t)(row0 + ai * 128 + m * 16) * 16 + 8 * fq; const float r = rs[ai][m];
#pragma unroll
                        for (int n = 0; n < 2; ++n) *(f32x4*)(rp + 4 * n) = acc[ai][0][m][n] * r; }
            }
        }
    }
};
struct Epi3 {
    static constexpr bool PERM = true, AFTER_DRAIN = false;
    const LAS3 float* tab; bf16* MIX; bf16* GLU; bf16* XD; mutable int ui;
    __device__ __forceinline__ void operator()(const f32x4 (&acc)[2][2][4][2], const Unit& u, int wr, int wc, int fr, int fq) const {
        const int row0 = u.pm * 256 + wr * 64 + fr, pn = u.pn, cl = wc * 32 + 8 * fq;
        float rs[2][4];
#pragma unroll
        for (int ai = 0; ai < 2; ++ai)
#pragma unroll
            for (int m = 0; m < 4; ++m) rs[ai][m] = tab[ui * 256 + ai * 128 + wr * 64 + m * 16 + fr];
        ++ui;
        if (pn < 8) {
#pragma unroll
            for (int ai = 0; ai < 2; ++ai)
#pragma unroll
                for (int m = 0; m < 4; ++m) { bf16* rp = GLU + (size_t)(row0 + ai * 128 + m * 16) * 1024 + pn * 128 + cl; const float r = rs[ai][m];
                    f32x4 o[2];
#pragma unroll
                    for (int n = 0; n < 2; ++n) { const f32x4 aa = acc[ai][0][m][n] * r, bb = acc[ai][1][m][n] * r;
#pragma unroll
                        for (int j = 0; j < 4; ++j) o[n][j] = aa[j] * sigmoidf_(bb[j]); }
                    *(u32x4*)rp = pack8(o[0], o[1]); }
        } else if (pn >= 12 && pn < 16) {
#pragma unroll
            for (int ai = 0; ai < 2; ++ai)
#pragma unroll
                for (int m = 0; m < 4; ++m) { bf16* rp = XD + (size_t)(row0 + ai * 128 + m * 16) * 1024 + (pn - 12) * 256 + cl; const float r = rs[ai][m];
#pragma unroll
                    for (int bj = 0; bj < 2; ++bj) *(u32x4*)(rp + bj * 128) = pack8(acc[ai][bj][m][0] * r, acc[ai][bj][m][1] * r); }
        } else {
            const int cb = pn < 12 ? (pn - 8) * 256 : 1024 + (pn - 16) * 256;
#pragma unroll
            for (int ai = 0; ai < 2; ++ai)
#pragma unroll
                for (int m = 0; m < 4; ++m) { bf16* rp = MIX + (size_t)(row0 + ai * 128 + m * 16) * 2048 + cb + cl; const float r = rs[ai][m];
#pragma unroll
                    for (int bj = 0; bj < 2; ++bj) { f32x4 v0 = acc[ai][bj][m][0] * r, v1 = acc[ai][bj][m][1] * r;
#pragma unroll
                        for (int j = 0; j < 4; ++j) { v0[j] = siluf_(v0[j]); v1[j] = siluf_(v1[j]); }
                        *(u32x4*)(rp + bj * 128) = pack8(v0, v1); } }
        }
    }
};
template <bool L0> struct EpiOut {
    static constexpr bool PERM = false, AFTER_DRAIN = true;
    const float* xold; bf16* XN; bf16* X2; float* ss;
    __device__ __forceinline__ void operator()(const f32x4 (&)[2][2][4][2], const Unit&, int, int, int, int) const {}
    __device__ __forceinline__ void fused(f32x4 (&acc)[2][2][4][2], const Unit& u, int wr, int wc, int fr, int fq, PG8_LAS unsigned char* lds, int wid, int lane) const {
        const int col0 = u.pn * 256 + wc * 32 + 4 * fq;
        PG8_LAS float* red = (PG8_LAS float*)lds;
        f32x4 xo[3][4]; u32x2 xb[3][4];
#define EPO_OFF(G) ((size_t)(u.pm * 256 + ((G) >> 2) * 128 + wr * 64 + ((G) & 3) * 16 + fr) * 1024 + col0)
#define EPO_LOAD(G) do { const size_t off_ = EPO_OFF(G); _Pragma("unroll") for (int bj = 0; bj < 2; ++bj) _Pragma("unroll") for (int n = 0; n < 2; ++n) { \
            if (L0) xo[(G) % 3][bj * 2 + n] = __builtin_nontemporal_load((const f32x4*)(xold + off_ + bj * 128 + n * 16)); else xb[(G) % 3][bj * 2 + n] = *(const u32x2*)(XN + off_ + bj * 128 + n * 16); } } while (0)
        EPO_LOAD(0); EPO_LOAD(1);
#pragma unroll
        for (int gq = 0; gq < 8; ++gq) {
            const int ai = gq >> 2, m = gq & 3;
            if (gq + 2 < 8) EPO_LOAD(gq + 2);
            const int rl = ai * 128 + wr * 64 + m * 16 + fr; const size_t off = EPO_OFF(gq); float q = 0.f;
#pragma unroll
            for (int bj = 0; bj < 2; ++bj)
#pragma unroll
                for (int n = 0; n < 2; ++n) { const size_t o2 = off + bj * 128 + n * 16;
                    if (L0) { const f32x4 v = xo[gq % 3][bj * 2 + n] + acc[ai][bj][m][n];
                        u32x2 w; w.x = pk2(v[0], v[1]); w.y = pk2(v[2], v[3]); *(u32x2*)(XN + o2) = w;
                        q += (v[0] * v[0] + v[1] * v[1]) + (v[2] * v[2] + v[3] * v[3]); }
                    else { const u32x2 xw = xb[gq % 3][bj * 2 + n]; const f32x4 v = (f32x4){bflo(xw.x), bfhi(xw.x), bflo(xw.y), bfhi(xw.y)} + acc[ai][bj][m][n]; u32x2 w; w.x = pk2(v[0], v[1]); w.y = pk2(v[2], v[3]); *(u32x2*)(X2 + o2) = w; } }
            if (L0) { q += __shfl_xor(q, 16); q += __shfl_xor(q, 32); if (fq == 0) red[rl * 4 + wc] = q; }
        }
#undef EPO_LOAD
#undef EPO_OFF
        if (L0) {
            __syncthreads();
            const int t = wid * 64 + lane;
            if (t < 256) ss[(size_t)u.pn * MP + u.pm * 256 + t] = (red[t * 4 + 0] + red[t * 4 + 1]) + (red[t * 4 + 2] + red[t * 4 + 3]);
        }
    }
};

template <int MODE> __device__ __forceinline__ int src_col(int n) {
    const int tile = n >> 8, cl = n & 255;
    if (MODE == 1) {
        if (tile < 10) return n;
        if (tile < 18) { const int q = tile - 10; return cl < 128 ? 2576 + 128 * q + cl : 4624 + 128 * q + (cl - 128); }
        if (tile < 22) return 3600 + (n - 18 * 256);
        return cl < 16 ? 2560 + cl : -1;
    } else if (MODE == 3) {
        if (tile < 8) return cl < 128 ? 128 * tile + cl : 1024 + 128 * tile + (cl - 128);
        return n;
    }
    return n;
}
template <int MODE> __device__ __forceinline__ void transpose_item(const float* W, int K, int Nsrc, bf16* WT, const float* kscale, float* scr, int item, int nblk, int lane) {
    const int kb = item / nblk, nb = item % nblk, k0 = 64 * kb, n0 = 32 * nb;
    const int sc = src_col<MODE>(n0 + (lane & 31));
    float tv[32];
#pragma unroll
    for (int i = 0; i < 32; ++i) { const int kk = 2 * i + (lane >> 5); tv[i] = sc >= 0 ? __builtin_nontemporal_load(W + (size_t)(k0 + kk) * Nsrc + sc) : 0.f; }
    if (kscale != nullptr && k0 < 1024) {
#pragma unroll
        for (int i = 0; i < 32; ++i) tv[i] *= kscale[k0 + 2 * i + (lane >> 5)];
    }
#pragma unroll
    for (int i = 0; i < 32; ++i) scr[(2 * i + (lane >> 5)) * 33 + (lane & 31)] = tv[i];
    asm volatile("s_waitcnt lgkmcnt(0)" ::: "memory");
    const int c = lane & 7;
#pragma unroll
    for (int j = 0; j < 4; ++j) { const int n = (lane >> 3) + 8 * j; const float* s = scr + (8 * c) * 33 + n;
        u32x4 o; o.x = pk2(s[0 * 33], s[1 * 33]); o.y = pk2(s[2 * 33], s[3 * 33]); o.z = pk2(s[4 * 33], s[5 * 33]); o.w = pk2(s[6 * 33], s[7 * 33]);
        *(u32x4*)(WT + (size_t)(n0 + n) * K + k0 + 8 * c) = o; }
    asm volatile("s_waitcnt lgkmcnt(0)" ::: "memory");
}
__device__ __forceinline__ void p0_prologue(const Ctx& c, unsigned char* sm) {
    const int tid = threadIdx.x, lane = tid & 63, wave = tid >> 6;
    const int gw = blockIdx.x * 8 + wave, NGW = gridDim.x * 8;
    float* scr = (float*)(sm + wave * 16384);
    if (blockIdx.x == 0 && tid < 8) c.xcnt[tid] = 0u;
    constexpr int I1 = 16 * (N1 / 32), I2 = 32 * 32, I3 = 16 * (N3 / 32), I4 = 32 * 32;
    for (int it = gw; it < I1 + I2 + I3 + I4; it += NGW) {
        int r = it;
        if (r < I1) { transpose_item<1>(c.w_in_even, 1024, 5648, c.W1t, nullptr, scr, r, N1 / 32, lane); continue; } r -= I1;
        if (r < I2) { transpose_item<0>(c.w_out_even, 2048, 1024, c.W2t, c.ssd_norm, scr, r, 32, lane); continue; } r -= I2;
        if (r < I3) { transpose_item<3>(c.w_in_odd, 1024, 5120, c.W3t, c.norm_odd, scr, r, N3 / 32, lane); continue; } r -= I3;
        transpose_item<0>(c.w_out_odd, 2048, 1024, c.W4t, nullptr, scr, r, 32, lane);
    }
    {
        f32x4 gq[4];
#pragma unroll
        for (int j = 0; j < 4; ++j) gq[j] = ((const f32x4*)c.norm_even)[lane + 64 * j];
        for (int m0 = gw; m0 < MP; m0 += 4 * NGW) {
            f32x4 v[4][4];
#pragma unroll
            for (int r = 0; r < 4; ++r) { const int m = m0 + r * NGW;
                if (m < NT) { const float* xr = m < NP ? c.x_prompt + (size_t)m * 1024 : c.x_sample + (size_t)(m - NP) * 1024;
#pragma unroll
                    for (int j = 0; j < 4; ++j) v[r][j] = __builtin_nontemporal_load((const f32x4*)xr + lane + 64 * j); } }
#pragma unroll
            for (int r = 0; r < 4; ++r) { const int m = m0 + r * NGW;
                if (m < MP) {
                    unsigned long long* o8 = (unsigned long long*)(c.XN + (size_t)m * 1024) + lane;
                    if (m < NT) {
                        float s = 0.f;
#pragma unroll
                        for (int j = 0; j < 4; ++j) s += (v[r][j][0] * v[r][j][0] + v[r][j][1] * v[r][j][1]) + (v[r][j][2] * v[r][j][2] + v[r][j][3] * v[r][j][3]);
                        const float rstd = rsqrtf(wave_sum(s) * (1.f / 1024.f) + EPS);
#pragma unroll
                        for (int j = 0; j < 4; ++j) { const f32x4 g = gq[j] * rstd; o8[64 * j] = (unsigned long long)pk2(v[r][j][0] * g[0], v[r][j][1] * g[1]) | ((unsigned long long)pk2(v[r][j][2] * g[2], v[r][j][3] * g[3]) << 32); }
                    } else {
#pragma unroll
                        for (int j = 0; j < 4; ++j) o8[64 * j] = 0ull;
                    }
                    if (m >= NP && lane < 4) c.ss1[(size_t)lane * MP + m] = 0.f;
                } }
        }
    }
}

__device__ __forceinline__ void bc_prepass_unit(const Ctx& c, int u, unsigned char* sm) {
    const int tid = threadIdx.x, lane = tid & 63, w = tid >> 6, fr = lane & 15, fq = lane >> 4;
    const int b = u >> 5, ck = (u >> 1) & 15, g = u & 1, t0 = ck * 128;
    constexpr int RS = 272;
    unsigned char* Bn = sm; unsigned char* Cn = sm + 34816;
    const int oc = tid & 31, run = tid >> 5;
    const int ch = oc < 16 ? 1024 + g * 128 + oc * 8 : 1280 + g * 128 + (oc - 16) * 8;
    u32x4 raw[11];
#pragma unroll
    for (int j = 0; j < 11; ++j) { const int t = t0 + run * 8 - 3 + j; raw[j] = (t >= 0) ? *(const u32x4*)(c.XBC + (size_t)(b * SEQ + t) * 1536 + ch) : (u32x4){0u, 0u, 0u, 0u}; }
    unsigned char* nat = (oc < 16 ? Bn : Cn) + (oc & 15) * 16;
#pragma unroll
    for (int hf = 0; hf < 2; ++hf) {
        f32x4 wk[5];
#pragma unroll
        for (int k = 0; k < 4; ++k) wk[k] = *(const f32x4*)(c.ssd_conv_w + k * 1536 + ch + 4 * hf);
        wk[4] = *(const f32x4*)(c.ssd_conv_b + ch + 4 * hf);
        float v[8][4];
#pragma unroll
        for (int i = 0; i < 8; ++i)
#pragma unroll
            for (int e = 0; e < 4; ++e) { const int ee = 4 * hf + e; float s = wk[4][e];
#pragma unroll
                for (int k = 0; k < 4; ++k) { const unsigned wd = raw[i + k][ee >> 1]; s += wk[k][e] * ((ee & 1) ? bfhi(wd) : bflo(wd)); }
                v[i][e] = siluf_(s); }
#pragma unroll
        for (int i = 0; i < 8; ++i) { u32x2 o; o.x = pk2(v[i][0], v[i][1]); o.y = pk2(v[i][2], v[i][3]); *(u32x2*)(nat + (8 * run + i) * RS + hf * 8) = o;
            if (oc >= 16) *(u32x2*)(c.BCn + (size_t)(b * SEQ + t0 + 8 * run + i) * 512 + 256 + g * 128 + (oc - 16) * 8 + 4 * hf) = o; }
        if (oc < 16) {
#pragma unroll
            for (int e = 0; e < 4; ++e) *(u32x4*)(c.BTg + ((size_t)((b * 16 + ck) * 2 + g) * 128 + oc * 8 + 4 * hf + e) * 128 + run * 8) = pack8((f32x4){v[0][e], v[1][e], v[2][e], v[3][e]}, (f32x4){v[4][e], v[5][e], v[6][e], v[7][e]});
        }
    }
    __syncthreads();
    {
        bf16x8 cf[4];
#pragma unroll
        for (int kk = 0; kk < 4; ++kk) cf[kk] = *(const bf16x8*)(Cn + (16 * w + fr) * RS + (kk * 32 + fq * 8) * 2);
        for (int j = 0; j <= w; ++j) {
            bf16x8 bf[4];
#pragma unroll
            for (int kk = 0; kk < 4; ++kk) bf[kk] = *(const bf16x8*)(Bn + (16 * j + fr) * RS + (kk * 32 + fq * 8) * 2);
            f32x4 gt = (f32x4){0.f, 0.f, 0.f, 0.f};
#pragma unroll
            for (int kk = 0; kk < 4; ++kk) gt = __builtin_amdgcn_mfma_f32_16x16x32_bf16(bf[kk], cf[kk], gt, 0, 0, 0);
            unsigned r_[4];
#pragma unroll
            for (int e = 0; e < 4; ++e) { const unsigned ub = __float_as_uint(gt[e]); r_[e] = (ub + 0x7fffu + ((ub >> 16) & 1u)) >> 16; }
            u32x2 o; o.x = r_[0] | (r_[1] << 16); o.y = r_[2] | (r_[3] << 16);
            *(u32x2*)(c.Gg + ((size_t)((u * 8 + w) * 8 + j) * 64 + lane) * 4) = o;
        }
    }
    __syncthreads();
}

__device__ __forceinline__ void ssd_chunk_unit(const Ctx& c, int u, unsigned char* sm) {
    const int tid = threadIdx.x, lane = tid & 63, w = tid >> 6, fr = lane & 15, fq = lane >> 4;
    const int pair = u >> 4, sub = u & 15;
    const int b = pair >> 1, g = pair & 1, h = g * 8 + (sub >> 1), ph = sub & 1;
    constexpr int RS = 272;
    unsigned char* Cn = sm + 34816;
    unsigned char* BT = sm + 69632;
    unsigned char* XT = sm + 104448;
    unsigned char* XdT = sm + 113152;
    unsigned char* Sb = sm + 121856;
    unsigned char* Xn = sm + 130560;
    float* csA = (float*)(sm + 138752);
    float* dtA = (float*)(sm + 139776);
    float* wx = (float*)(sm + 140800);
    const int ox = tid & 3, lx = tid >> 2;
    const int chx = h * 64 + ph * 32 + ox * 8;
    if (tid < 160) { const int k = tid >> 5, cc = tid & 31; wx[tid] = k < 4 ? c.ssd_conv_w[k * 1536 + h * 64 + ph * 32 + cc] : c.ssd_conv_b[h * 64 + ph * 32 + cc]; }
    const float a_h = -__expf(c.ssd_a_log[h]), dtb = c.ssd_dt_bias[h], Dh = c.ssd_d[h];
    f32x4 accS[2];
    accS[0] = (f32x4){0.f, 0.f, 0.f, 0.f}; accS[1] = accS[0];
    u32x4 rC[4], rT[4], rx[4]; u32x2 zz[2], gG[8]; float dr0 = 0.f, dr1 = 0.f;
#pragma unroll
    for (int j = 0; j < 8; ++j) gG[j] = (u32x2){0u, 0u};
    const int lrow = 16 * w + fr;
    const int prow = tid >> 4, pc16 = tid & 15;
#define SSD_LOAD_B(CK) do { const size_t gu_ = (size_t)(((b * 16 + (CK)) * 2 + g) * 8 + w) * 8; \
        _Pragma("unroll") for (int j = 0; j < 8; ++j) { if (j <= w) gG[j] = *(const u32x2*)(c.Gg + ((gu_ + j) * 64 + lane) * 4); } } while (0)
#define SSD_LOAD_C(CK) do { const int t0_ = (CK) * 128; \
        _Pragma("unroll") for (int i = 0; i < 4; ++i) rC[i] = *(const u32x4*)(c.BCn + (size_t)(b * SEQ + t0_ + prow + 32 * i) * 512 + 256 + g * 128 + pc16 * 8); } while (0)
#define SSD_LOAD_T(CK) do { \
        _Pragma("unroll") for (int i = 0; i < 4; ++i) rT[i] = *(const u32x4*)(c.BTg + ((size_t)((b * 16 + (CK)) * 2 + g) * 128 + prow + 32 * i) * 128 + pc16 * 8); } while (0)
#define SSD_LOAD_X(CK) do { const int t0_ = (CK) * 128; \
        _Pragma("unroll") for (int j = 0; j < 4; ++j) { const int t = t0_ + lx - 3 + j; rx[j] = (t >= 0) ? *(const u32x4*)(c.XBC + (size_t)(b * SEQ + t) * 1536 + chx) : (u32x4){0u, 0u, 0u, 0u}; } \
        _Pragma("unroll") for (int pt = 0; pt < 2; ++pt) zz[pt] = *(const u32x2*)(c.MIX + (size_t)(b * SEQ + t0_ + lrow) * 2048 + h * 64 + ph * 32 + pt * 16 + 4 * fq); } while (0)
#define SSD_LOAD(CK) do { SSD_LOAD_B(CK); SSD_LOAD_C(CK); SSD_LOAD_T(CK); SSD_LOAD_X(CK); } while (0)
#define SSD_LOAD_DT(CK) do { if (tid < 64) { const size_t r = (size_t)(b * SEQ + (CK) * 128 + 2 * tid) * 16 + h; dr0 = c.DT[r]; dr1 = c.DT[r + 16]; } } while (0)
#define SSD_CUMSUM(BUF) do { if (tid < 64) { const float d0 = softplusf_(dr0 + dtb), d1 = softplusf_(dr1 + dtb); const float a1 = d1 * a_h; float s = d0 * a_h + a1; \
        _Pragma("unroll") for (int o = 1; o < 64; o <<= 1) { const float v = __shfl_up(s, o); if (lane >= o) s += v; } \
        csA[(BUF) * 128 + 2 * tid + 1] = s; csA[(BUF) * 128 + 2 * tid] = s - a1; dtA[(BUF) * 128 + 2 * tid] = d0; dtA[(BUF) * 128 + 2 * tid + 1] = d1; } } while (0)
    SSD_LOAD_DT(0);
    SSD_LOAD(0);
    SSD_CUMSUM(0);
    __syncthreads();
    for (int ck = 0; ck < 16; ++ck) {
        const int t0 = ck * 128;
        const float* cs = csA + (ck & 1) * 128; const float* dts = dtA + (ck & 1) * 128;
        if (ck < 15) SSD_LOAD_DT(ck + 1);
        {
#pragma unroll
            for (int pt = 0; pt < 2; ++pt)
#pragma unroll
                for (int e = 0; e < 4; ++e) *(bf16*)(Sb + (pt * 16 + 4 * fq + e) * RS + (16 * w + fr) * 2) = (bf16)pk2(accS[pt][e], 0.f);
        }
#pragma unroll
        for (int i = 0; i < 4; ++i) { *(u32x4*)(Cn + (prow + 32 * i) * RS + pc16 * 16) = rC[i]; *(u32x4*)(BT + (prow + 32 * i) * RS + pc16 * 16) = rT[i]; }
        {
            const float dl = dts[lx], ddl = dl * __expf(cs[127] - cs[lx]);
            float v[8];
#pragma unroll
            for (int hf = 0; hf < 2; ++hf) {
                f32x4 wk[5];
#pragma unroll
                for (int k = 0; k < 5; ++k) wk[k] = *(const f32x4*)(wx + k * 32 + ox * 8 + 4 * hf);
#pragma unroll
                for (int e = 0; e < 4; ++e) { const int ee = 4 * hf + e; float s = wk[4][e];
#pragma unroll
                    for (int k = 0; k < 4; ++k) { const unsigned wd = rx[k][ee >> 1]; s += wk[k][e] * ((ee & 1) ? bfhi(wd) : bflo(wd)); }
                    v[ee] = siluf_(s); }
            }
            *(u32x4*)(Xn + lx * 64 + ox * 16) = pack8((f32x4){v[0], v[1], v[2], v[3]}, (f32x4){v[4], v[5], v[6], v[7]});
#pragma unroll
            for (int e = 0; e < 8; ++e) { *(bf16*)(XT + (ox * 8 + e) * RS + lx * 2) = (bf16)pk2(v[e] * dl, 0.f); *(bf16*)(XdT + (ox * 8 + e) * RS + lx * 2) = (bf16)pk2(v[e] * ddl, 0.f); }
        }
        __syncthreads();
        const u32x2 zc0 = zz[0], zc1 = zz[1];
        u32x2 gC[8];
#pragma unroll
        for (int j = 0; j < 8; ++j) gC[j] = gG[j];
        if (ck < 15) SSD_LOAD_B(ck + 1);
        __builtin_amdgcn_sched_barrier(0);
        {
            const int l = lrow;
            const float csl = cs[l];
            bf16x8 cf[4];
#pragma unroll
            for (int kk = 0; kk < 4; ++kk) cf[kk] = *(const bf16x8*)(Cn + l * RS + (kk * 32 + fq * 8) * 2);
            f32x4 aoff[2], adiag[2];
            {
                bf16x8 sf[2][4];
#pragma unroll
                for (int pt = 0; pt < 2; ++pt)
#pragma unroll
                    for (int kk = 0; kk < 4; ++kk) sf[pt][kk] = *(const bf16x8*)(Sb + (pt * 16 + fr) * RS + (kk * 32 + fq * 8) * 2);
                aoff[0] = (f32x4){0.f, 0.f, 0.f, 0.f}; aoff[1] = aoff[0]; adiag[0] = aoff[0]; adiag[1] = aoff[0];
#pragma unroll
                for (int kk = 0; kk < 4; ++kk) { aoff[0] = __builtin_amdgcn_mfma_f32_16x16x32_bf16(sf[0][kk], cf[kk], aoff[0], 0, 0, 0); aoff[1] = __builtin_amdgcn_mfma_f32_16x16x32_bf16(sf[1][kk], cf[kk], aoff[1], 0, 0, 0); }
            }
            __builtin_amdgcn_sched_barrier(0);
            if (ck < 15) SSD_LOAD_C(ck + 1);
            __builtin_amdgcn_sched_barrier(0);
#pragma unroll
            for (int jp = 0; jp < 4; ++jp) if (jp <= (w >> 1)) {
                const int j0 = 2 * jp, j1 = 2 * jp + 1;
                const u32x2 ga = gC[2 * jp], gb = gC[2 * jp + 1];
                const f32x4 g0 = (f32x4){bflo(ga.x), bfhi(ga.x), bflo(ga.y), bfhi(ga.y)}, g1 = (f32x4){bflo(gb.x), bfhi(gb.x), bflo(gb.y), bfhi(gb.y)};
                const u32x2 xa0 = *(const u32x2*)(XT + fr * RS + (16 * j0 + 4 * fq) * 2), xb0 = *(const u32x2*)(XT + fr * RS + (16 * j1 + 4 * fq) * 2);
                const u32x2 xa1 = *(const u32x2*)(XT + (16 + fr) * RS + (16 * j0 + 4 * fq) * 2), xb1 = *(const u32x2*)(XT + (16 + fr) * RS + (16 * j1 + 4 * fq) * 2);
                const f32x4 cs0 = *(const f32x4*)(cs + 16 * j0 + 4 * fq), cs1 = *(const f32x4*)(cs + 16 * j1 + 4 * fq);
                f32x4 m0, m1;
#pragma unroll
                for (int e = 0; e < 4; ++e) { const int s0 = 16 * j0 + 4 * fq + e, s1 = 16 * j1 + 4 * fq + e;
                    m0[e] = (s0 <= l) ? g0[e] * __expf(csl - cs0[e]) : 0.f; m1[e] = (s1 <= l) ? g1[e] * __expf(csl - cs1[e]) : 0.f; }
                const bf16x8 mB = __builtin_bit_cast(bf16x8, pack8(m0, m1));
                { u32x4 xv; xv.x = xa0.x; xv.y = xa0.y; xv.z = xb0.x; xv.w = xb0.y; adiag[0] = __builtin_amdgcn_mfma_f32_16x16x32_bf16(__builtin_bit_cast(bf16x8, xv), mB, adiag[0], 0, 0, 0); }
                { u32x4 xv; xv.x = xa1.x; xv.y = xa1.y; xv.z = xb1.x; xv.w = xb1.y; adiag[1] = __builtin_amdgcn_mfma_f32_16x16x32_bf16(__builtin_bit_cast(bf16x8, xv), mB, adiag[1], 0, 0, 0); }
            }
            __builtin_amdgcn_sched_barrier(0);
            if (ck < 15) SSD_LOAD_T(ck + 1);
            __builtin_amdgcn_sched_barrier(0);
            const float decT = __expf(cs[127]);
            {
                bf16x8 xf[2][4], tf[4];
#pragma unroll
                for (int kk = 0; kk < 4; ++kk) { tf[kk] = *(const bf16x8*)(BT + (16 * w + fr) * RS + (kk * 32 + fq * 8) * 2); xf[0][kk] = *(const bf16x8*)(XdT + fr * RS + (kk * 32 + fq * 8) * 2); xf[1][kk] = *(const bf16x8*)(XdT + (16 + fr) * RS + (kk * 32 + fq * 8) * 2); }
                accS[0] *= decT; accS[1] *= decT;
#pragma unroll
                for (int kk = 0; kk < 4; ++kk) { accS[0] = __builtin_amdgcn_mfma_f32_16x16x32_bf16(xf[0][kk], tf[kk], accS[0], 0, 0, 0); accS[1] = __builtin_amdgcn_mfma_f32_16x16x32_bf16(xf[1][kk], tf[kk], accS[1], 0, 0, 0); }
            }
            __builtin_amdgcn_sched_barrier(0);
            if (ck < 15) SSD_LOAD_X(ck + 1);
            __builtin_amdgcn_sched_barrier(0);
            const int row = b * SEQ + t0 + l;
            const float el = __expf(csl);
            float q = 0.f;
#pragma unroll
            for (int pt = 0; pt < 2; ++pt) {
                const u32x2 xr = *(const u32x2*)(Xn + l * 64 + (pt * 16 + 4 * fq) * 2);
                bf16* p = c.MIX + (size_t)row * 2048 + h * 64 + ph * 32 + pt * 16 + 4 * fq;
                const u32x2 zv = pt == 0 ? zc0 : zc1;
                const float y0 = (adiag[pt][0] + el * aoff[pt][0] + Dh * bflo(xr.x)) * bflo(zv.x);
                const float y1 = (adiag[pt][1] + el * aoff[pt][1] + Dh * bfhi(xr.x)) * bfhi(zv.x);
                const float y2 = (adiag[pt][2] + el * aoff[pt][2] + Dh * bflo(xr.y)) * bflo(zv.y);
                const float y3 = (adiag[pt][3] + el * aoff[pt][3] + Dh * bfhi(xr.y)) * bfhi(zv.y);
                u32x2 wv; wv.x = pk2(y0, y1); wv.y = pk2(y2, y3); *(u32x2*)p = wv;
                q += (y0 * y0 + y1 * y1) + (y2 * y2 + y3 * y3);
            }
            q += __shfl_xor(q, 16); q += __shfl_xor(q, 32);
            if (fq == 0) c.ssg[((size_t)(g * 16 + (h & 7) * 2 + ph)) * NP + row] = q;
        }
        if (ck < 15) SSD_CUMSUM((ck + 1) & 1);
        __syncthreads();
    }
#undef SSD_LOAD
#undef SSD_LOAD_B
#undef SSD_LOAD_C
#undef SSD_LOAD_T
#undef SSD_LOAD_X
#undef SSD_LOAD_DT
#undef SSD_CUMSUM
#pragma unroll
    for (int pt = 0; pt < 2; ++pt)
#pragma unroll
        for (int e = 0; e < 4; ++e) __builtin_nontemporal_store(accS[pt][e], c.out + O_SSM_P + ((size_t)(b * 16 + h) * 64 + ph * 32 + pt * 16 + 4 * fq + e) * 128 + 16 * w + fr);
}

__device__ __forceinline__ void gmlp_unit(const Ctx& c, int u, unsigned char* sm) {
    const int tid = threadIdx.x, lane = tid & 63, w = tid >> 6, fr = lane & 15, fq = lane >> 4;
    const int b = u >> 5, ck = (u >> 1) & 15, gh = u & 1;
    const int r0 = b * SEQ + ck * 128;
    float* stat = (float*)sm;
    unsigned char* vbase = sm + 1024;
    {
        u32x4 gq[16][2];
#pragma unroll
        for (int i = 0; i < 16; ++i) { const u32x4* gp = (const u32x4*)(c.GV + (size_t)(r0 + w * 16 + i) * 1024 + lane * 16); gq[i][0] = gp[0]; gq[i][1] = gp[1]; }
#pragma unroll
        for (int i = 0; i < 16; ++i) {
            const int tk = w * 16 + i;
            float f0[8], f1[8]; unpack8(gq[i][0], f0); unpack8(gq[i][1], f1);
            float s = 0.f, q = 0.f;
#pragma unroll
            for (int e = 0; e < 8; ++e) { s += f0[e] + f1[e]; q += f0[e] * f0[e] + f1[e] * f1[e]; }
            s = wave_sum(s); q = wave_sum(q);
            if (lane == 0) { const float mean = s * (1.f / 1024.f); const float var = fmaxf(q * (1.f / 1024.f) - mean * mean, 0.f); stat[tk * 2] = mean; stat[tk * 2 + 1] = rsqrtf(var + EPS); }
        }
    }
    u32x4 gva[2], gvb[2];
#define GMLP_LOADV(GRP) do { _Pragma("unroll") for (int it = 0; it < 2; ++it) { const int item = tid + 512 * it, sp = item & 63, d8 = item >> 6; \
        gva[it] = *(const u32x4*)(c.GV + (size_t)(r0 + 2 * sp) * 1024 + (GRP) * 128 + d8 * 8); gvb[it] = *(const u32x4*)(c.GV + (size_t)(r0 + 2 * sp + 1) * 1024 + (GRP) * 128 + d8 * 8); } } while (0)
    GMLP_LOADV(gh * 4);
    __syncthreads();
    for (int gi = 0; gi < 4; ++gi) {
        const int grp = gh * 4 + gi;
        unsigned char* vnT = vbase + (gi & 1) * 34816;
        const int t = 16 * w + fr, nk = (w >> 1) + 1;
        const float* wrow = c.gmlp_w_s + ((size_t)grp * 128 + t) * 128;
        f32x4 wq[4][2];
#pragma unroll
        for (int kk = 0; kk < 4; ++kk) { if (kk < nk) { wq[kk][0] = *(const f32x4*)(wrow + kk * 32 + fq * 8); wq[kk][1] = *(const f32x4*)(wrow + kk * 32 + fq * 8 + 4); } else { wq[kk][0] = (f32x4){0.f, 0.f, 0.f, 0.f}; wq[kk][1] = wq[kk][0]; } }
        bf16* mp = c.MIX + (size_t)(r0 + t) * 2048 + 1024 + grp * 128 + 4 * fq;
        u32x2 ugv[8];
#pragma unroll
        for (int dt = 0; dt < 8; ++dt) ugv[dt] = *(const u32x2*)(mp + dt * 16);
        const float bs = c.gmlp_b_s[grp * 128 + t];
#pragma unroll
        for (int it = 0; it < 2; ++it) {
            const int item = tid + 512 * it, sp = item & 63, d8 = item >> 6;
            const int s0 = 2 * sp, chn = grp * 128 + d8 * 8;
            float a[8], bq[8]; unpack8(gva[it], a); unpack8(gvb[it], bq);
            const float m0 = stat[s0 * 2], rs0 = stat[s0 * 2 + 1], m1 = stat[s0 * 2 + 2], rs1 = stat[s0 * 2 + 3];
            const f32x4 lg0 = *(const f32x4*)(c.gmlp_ln_g + chn), lg1 = *(const f32x4*)(c.gmlp_ln_g + chn + 4), lb0 = *(const f32x4*)(c.gmlp_ln_b + chn), lb1 = *(const f32x4*)(c.gmlp_ln_b + chn + 4);
#pragma unroll
            for (int e = 0; e < 8; ++e) { const float lg = e < 4 ? lg0[e & 3] : lg1[e & 3], lb = e < 4 ? lb0[e & 3] : lb1[e & 3];
                const float v0 = (a[e] - m0) * rs0 * lg + lb, v1 = (bq[e] - m1) * rs1 * lg + lb;
                *(unsigned*)(vnT + (d8 * 8 + e) * 272 + sp * 4) = pk2(v0, v1); }
        }
        if (gi < 3) GMLP_LOADV(grp + 1);
        __syncthreads();
        f32x4 acc[8];
#pragma unroll
        for (int dt = 0; dt < 8; ++dt) acc[dt] = (f32x4){0.f, 0.f, 0.f, 0.f};
#pragma unroll
        for (int kk = 0; kk < 4; ++kk) {
            if (kk < nk) {
                const int sb = kk * 32 + fq * 8;
                f32x4 m0, m1;
#pragma unroll
                for (int e = 0; e < 4; ++e) { m0[e] = (sb + e <= t) ? wq[kk][0][e] : 0.f; m1[e] = (sb + 4 + e <= t) ? wq[kk][1][e] : 0.f; }
                const bf16x8 wf = __builtin_bit_cast(bf16x8, pack8(m0, m1));
#pragma unroll
                for (int dt = 0; dt < 8; ++dt) {
                    const bf16x8 vf = *(const bf16x8*)(vnT + (dt * 16 + fr) * 272 + sb * 2);
                    acc[dt] = __builtin_amdgcn_mfma_f32_16x16x32_bf16(vf, wf, acc[dt], 0, 0, 0);
                }
            }
        }
#pragma unroll
        for (int dt = 0; dt < 8; ++dt) { const u32x2 ug = ugv[dt];
            u32x2 o; o.x = pk2((acc[dt][0] + bs) * bflo(ug.x), (acc[dt][1] + bs) * bfhi(ug.x)); o.y = pk2((acc[dt][2] + bs) * bflo(ug.y), (acc[dt][3] + bs) * bfhi(ug.y));
            *(u32x2*)(mp + dt * 16) = o; }
    }
#undef GMLP_LOADV
    __syncthreads();
}

__device__ __forceinline__ void sample_even_unit(const Ctx& c, int u, unsigned char* sm) {
    const int tid = threadIdx.x;
    const int bs = u >> 1, g = u & 1, row = NP + bs;
    float* xcs = (float*)sm;
    float* ygs = xcs + 768;
    float* red = ygs + 512;
    float* hsc = red + 8;
    const int p = tid >> 3, nq = tid & 7;
    f32x4 st[8][4];
#pragma unroll
    for (int hh = 0; hh < 8; ++hh)
#pragma unroll
        for (int j = 0; j < 4; ++j) st[hh][j] = __builtin_nontemporal_load((const f32x4*)(c.state_ssm + ((size_t)(bs * 16 + g * 8 + hh) * 64 + p) * 128 + j * 32 + nq * 4));
    const float* buf = c.state_ssd_conv + (size_t)bs * 3 * 1536;
    for (int i = tid; i < 768; i += 512) {
        const int ch = i < 512 ? g * 512 + i : (i < 640 ? 1024 + g * 128 + (i - 512) : 1280 + g * 128 + (i - 640));
        const float xn = bf2f(c.XBC[(size_t)row * 1536 + ch]);
        const float b0 = buf[ch], b1 = buf[1536 + ch], b2 = buf[2 * 1536 + ch];
        float s = c.ssd_conv_b[ch] + c.ssd_conv_w[ch] * b0 + c.ssd_conv_w[1536 + ch] * b1 + c.ssd_conv_w[2 * 1536 + ch] * b2 + c.ssd_conv_w[3 * 1536 + ch] * xn;
        xcs[i] = siluf_(s);
        float* so = c.out + O_SCONV_S + (size_t)bs * 3 * 1536;
        so[ch] = b1; so[1536 + ch] = b2; so[2 * 1536 + ch] = xn;
    }
    if (tid < 8) { const int h = g * 8 + tid; const float dt = softplusf_(c.DT[(size_t)row * 16 + h] + c.ssd_dt_bias[h]); hsc[tid * 4] = dt; hsc[tid * 4 + 1] = __expf(-dt * __expf(c.ssd_a_log[h])); hsc[tid * 4 + 2] = c.ssd_d[h]; }
    float zv[8];
    if (nq == 0) {
#pragma unroll
        for (int hh = 0; hh < 8; ++hh) zv[hh] = bf2f(c.MIX[(size_t)row * 2048 + (g * 8 + hh) * 64 + p]);
    }
    const unsigned gv2 = *(const unsigned*)(c.GV + (size_t)row * 1024 + 2 * tid);
    const int chn = g * 512 + tid, grp = chn >> 7;
    const float gvc = bf2f(c.GV[(size_t)row * 1024 + chn]), lng = c.gmlp_ln_g[chn], lnb = c.gmlp_ln_b[chn], ws0 = c.gmlp_w_s[(size_t)grp * 128 * 128], bs0 = c.gmlp_b_s[grp * 128];
    bf16* mpu = c.MIX + (size_t)row * 2048 + 1024 + chn;
    const float ugv = bf2f(*mpu);
    __syncthreads();
    f32x4 bv[4], cv[4];
#pragma unroll
    for (int j = 0; j < 4; ++j) { bv[j] = *(const f32x4*)(xcs + 512 + j * 32 + nq * 4); cv[j] = *(const f32x4*)(xcs + 640 + j * 32 + nq * 4); }
#pragma unroll
    for (int hh = 0; hh < 8; ++hh) {
        const int h = g * 8 + hh;
        const size_t so = ((size_t)(bs * 16 + h) * 64 + p) * 128 + nq * 4;
        const float dt = hsc[hh * 4], dA = hsc[hh * 4 + 1];
        const float xv = xcs[hh * 64 + p], dtx = dt * xv;
        float y = 0.f;
#pragma unroll
        for (int j = 0; j < 4; ++j) {
            f32x4 hn;
#pragma unroll
            for (int e = 0; e < 4; ++e) { hn[e] = dA * st[hh][j][e] + dtx * bv[j][e]; y += cv[j][e] * hn[e]; }
            __builtin_nontemporal_store(hn, (f32x4*)(c.out + O_SSM_S + so + 32 * j));
        }
        y += __shfl_xor(y, 1); y += __shfl_xor(y, 2); y += __shfl_xor(y, 4);
        if (nq == 0) { y += hsc[hh * 4 + 2] * xv; ygs[hh * 64 + p] = y * zv[hh]; }
    }
    __syncthreads();
    {
        const float v = ygs[tid];
        const float q = block_sum(v * v, red);
        c.MIX[(size_t)row * 2048 + g * 512 + tid] = (bf16)pk2(v * rsqrtf(q * (1.f / 512.f) + EPS), 0.f);
    }
    {
        const float a0 = bflo(gv2), a1 = bfhi(gv2);
        const float s = block_sum(a0 + a1, red);
        const float q = block_sum(a0 * a0 + a1 * a1, red);
        const float mean = s * (1.f / 1024.f), rstd = rsqrtf(fmaxf(q * (1.f / 1024.f) - mean * mean, 0.f) + EPS);
        const float vn = (gvc - mean) * rstd * lng + lnb;
        c.out[O_GV_S + (size_t)bs * 1024 + chn] = vn;
        *mpu = (bf16)pk2(ugv * (ws0 * vn + bs0), 0.f);
    }
    __syncthreads();
}

__device__ __forceinline__ void p2_even_mixers(const Ctx& c, unsigned char* sm) {
    const int G = gridDim.x, bx = blockIdx.x;
    for (int u = bx; u < 256; u += G) ssd_chunk_unit(c, u, sm);
    for (int u = bx; u < 256; u += G) gmlp_unit(c, u, sm);
    for (int u = bx; u < 256; u += G) sample_even_unit(c, u, sm);
    for (int i = bx * 512 + threadIdx.x; i < 8 * 3 * 1536; i += G * 512) { const int b = i / (3 * 1536), r = i % (3 * 1536), k = r / 1536, ch = r % 1536;
        c.out[O_SCONV_P + i] = bf2f(c.XBC[(size_t)(b * SEQ + SEQ - 3 + k) * 1536 + ch]); }
}

template <bool L0> __device__ __forceinline__ void sample_outproj(const bf16* A, const bf16* Wt, const float* xold, bf16* XNs, bf16* X2s, float* ss, unsigned char* sm) {
    const int tid = threadIdx.x, lane = tid & 63, w = tid >> 6, fr = lane & 15, fq = lane >> 4;
    f32x4* red = (f32x4*)sm;
    for (int u = blockIdx.x; u < 256; u += gridDim.x) {
        const int tg = u & 7, cgp = u >> 3;
        const bf16* ap = A + (size_t)(tg * 16 + fr) * 2048 + w * 256 + fq * 8;
        const bf16* bp0 = Wt + (size_t)(cgp * 32 + fr) * 2048 + w * 256 + fq * 8;
        const bf16* bp1 = bp0 + 16 * 2048;
        f32x4 a0 = (f32x4){0.f, 0.f, 0.f, 0.f}, a1 = a0;
#pragma unroll
        for (int kk = 0; kk < 8; ++kk) {
            const bf16x8 af = *(const bf16x8*)(ap + kk * 32), b0 = *(const bf16x8*)(bp0 + kk * 32), b1 = *(const bf16x8*)(bp1 + kk * 32);
            a0 = __builtin_amdgcn_mfma_f32_16x16x32_bf16(b0, af, a0, 0, 0, 0);
            a1 = __builtin_amdgcn_mfma_f32_16x16x32_bf16(b1, af, a1, 0, 0, 0);
        }
        red[(w * 2 + 0) * 64 + lane] = a0; red[(w * 2 + 1) * 64 + lane] = a1;
        __syncthreads();
        if (tid < 128) {
            const int ct = tid >> 6;
            f32x4 s = (f32x4){0.f, 0.f, 0.f, 0.f};
#pragma unroll
            for (int w2 = 0; w2 < 8; ++w2) s += red[(w2 * 2 + ct) * 64 + lane];
            const int trow = tg * 16 + fr, col = cgp * 32 + ct * 16 + 4 * fq;
            const size_t off = (size_t)trow * 1024 + col;
            if (L0) {
                const f32x4 v = *(const f32x4*)(xold + off) + s;
                u32x2 wv; wv.x = pk2(v[0], v[1]); wv.y = pk2(v[2], v[3]); *(u32x2*)(XNs + off) = wv;
                float q = (v[0] * v[0] + v[1] * v[1]) + (v[2] * v[2] + v[3] * v[3]);
                q += __shfl_xor(q, 16); q += __shfl_xor(q, 32);
                if (fq == 0) atomicAdd(ss + (size_t)(cgp >> 3) * MP + trow, q);
            } else {
                const u32x2 xw = *(const u32x2*)(XNs + off);
                const f32x4 v = (f32x4){bflo(xw.x), bfhi(xw.x), bflo(xw.y), bfhi(xw.y)} + s;
                u32x2 wv; wv.x = pk2(v[0], v[1]); wv.y = pk2(v[2], v[3]); *(u32x2*)(X2s + off) = wv;
            }
        }
        __syncthreads();
    }
}

__device__ __forceinline__ void ccv_unit(const Ctx& c, int u, unsigned char* sm) {
    const int tid = threadIdx.x, lane = tid & 63, wv = tid >> 6;
    const int b = u >> 5, t0 = (u & 31) * 64, ch = 2 * tid;
    float* red = (float*)sm;
    f32x2 w[31];
#pragma unroll
    for (int k = 0; k < 31; ++k) w[k] = *(const f32x2*)(c.ccv_w + k * 1024 + ch);
    const f32x2 bias = *(const f32x2*)(c.ccv_b + ch), lg = *(const f32x2*)(c.ccv_ln_g + ch), lb = *(const f32x2*)(c.ccv_ln_b + ch);
    unsigned gwin[38];
#pragma unroll
    for (int j = 0; j < 38; ++j) { const int t = t0 - 30 + j; gwin[j] = (t >= 0) ? *(const unsigned*)(c.GLU + (size_t)(b * SEQ + t) * 1024 + ch) : 0u; }
    for (int og = 0; og < 8; ++og) {
        unsigned nxt[8], gcv[8];
#pragma unroll
        for (int j = 0; j < 8; ++j) { gcv[j] = *(const unsigned*)(c.MIX + (size_t)(b * SEQ + t0 + og * 8 + j) * 2048 + ch);
            nxt[j] = (og < 7) ? *(const unsigned*)(c.GLU + (size_t)(b * SEQ + t0 + og * 8 + 8 + j) * 1024 + ch) : 0u; }
        f32x2 acc[8];
#pragma unroll
        for (int o = 0; o < 8; ++o) acc[o] = bias;
#pragma unroll
        for (int j = 0; j < 38; ++j) {
            const f32x2 gl = (f32x2){bflo(gwin[j]), bfhi(gwin[j])};
#pragma unroll
            for (int o = 0; o < 8; ++o) { const int k = j - o; if (k >= 0 && k <= 30) acc[o] += w[k] * gl; }
        }
        float* rb = red + (og & 1) * 512;
        {
            float mine = 0.f;
#pragma unroll
            for (int o = 0; o < 8; ++o) { const float s = row16_sum(acc[o][0] + acc[o][1]), q = row16_sum(acc[o][0] * acc[o][0] + acc[o][1] * acc[o][1]);
                mine = ((lane & 15) == o) ? s : mine; mine = ((lane & 15) == 8 + o) ? q : mine; }
            rb[(wv * 4 + (lane >> 4)) * 16 + (lane & 15)] = mine;
        }
        __syncthreads();
        float tot;
        {
            float s = 0.f;
#pragma unroll
            for (int i = 0; i < 8; ++i) s += rb[((lane >> 4) * 8 + i) * 16 + (lane & 15)];
            s += __shfl_xor(s, 16); s += __shfl_xor(s, 32);
            tot = s;
        }
#pragma unroll
        for (int o = 0; o < 8; ++o) {
            const float s = __builtin_bit_cast(float, __builtin_amdgcn_readlane(__builtin_bit_cast(int, tot), o)), q = __builtin_bit_cast(float, __builtin_amdgcn_readlane(__builtin_bit_cast(int, tot), 8 + o));
            const float mean = s * (1.f / 1024.f), rstd = rsqrtf(fmaxf(q * (1.f / 1024.f) - mean * mean, 0.f) + EPS);
            const float y0 = siluf_((acc[o][0] - mean) * rstd * lg[0] + lb[0]), y1 = siluf_((acc[o][1] - mean) * rstd * lg[1] + lb[1]);
            *(unsigned*)(c.MIX + (size_t)(b * SEQ + t0 + og * 8 + o) * 2048 + ch) = pk2(y0 * bflo(gcv[o]), y1 * bfhi(gcv[o]));
        }
#pragma unroll
        for (int j = 0; j < 30; ++j) gwin[j] = gwin[j + 8];
#pragma unroll
        for (int j = 0; j < 8; ++j) gwin[30 + j] = nxt[j];
    }
    __syncthreads();
}
__device__ __forceinline__ void ccv_sample_unit(const Ctx& c, int bs, unsigned char* sm) {
    const int tid = threadIdx.x, ch = 2 * tid, row = NP + bs;
    float* red = (float*)sm;
    const float* buf = c.state_ccv + (size_t)bs * 30 * 1024;
    const unsigned gw = *(const unsigned*)(c.GLU + (size_t)row * 1024 + ch);
    const f32x2 gl = (f32x2){bflo(gw), bfhi(gw)};
    f32x2 acc = *(const f32x2*)(c.ccv_b + ch);
    float* so = c.out + O_CCV_S + (size_t)bs * 30 * 1024;
    unsigned* mp = (unsigned*)(c.MIX + (size_t)row * 2048 + ch);
    const unsigned gc = *mp;
    const f32x2 lg = *(const f32x2*)(c.ccv_ln_g + ch), lb = *(const f32x2*)(c.ccv_ln_b + ch);
    f32x2 bvv[30], wv[31];
#pragma unroll
    for (int k = 0; k < 30; ++k) bvv[k] = __builtin_nontemporal_load((const f32x2*)(buf + k * 1024 + ch));
#pragma unroll
    for (int k = 0; k < 31; ++k) wv[k] = *(const f32x2*)(c.ccv_w + k * 1024 + ch);
#pragma unroll
    for (int k = 0; k < 30; ++k) acc += wv[k] * bvv[k];
    acc += wv[30] * gl;
#pragma unroll
    for (int k = 1; k < 30; ++k) __builtin_nontemporal_store(bvv[k], (f32x2*)(so + (k - 1) * 1024 + ch));
    *(f32x2*)(so + 29 * 1024 + ch) = gl;
    const float s = block_sum(acc[0] + acc[1], red);
    const float q = block_sum(acc[0] * acc[0] + acc[1] * acc[1], red);
    const float mean = s * (1.f / 1024.f), rstd = rsqrtf(fmaxf(q * (1.f / 1024.f) - mean * mean, 0.f) + EPS);
    const float y0 = siluf_((acc[0] - mean) * rstd * lg[0] + lb[0]), y1 = siluf_((acc[1] - mean) * rstd * lg[1] + lb[1]);
    *mp = pk2(y0 * bflo(gc), y1 * bfhi(gc));
    __syncthreads();
}

__device__ __forceinline__ float neg_expm1_fast(float x) {
    const float p = -x * (1.f + x * (0.5f + x * (0.16666667f + x * (0.041666668f + x * 0.0083333338f))));
    return x > -0.25f ? p : 1.f - __expf(x);
}
__device__ __forceinline__ void lru_unit(const Ctx& c, int u, unsigned char* sm) {
    const int tid = threadIdx.x, lane = tid & 63, w = tid >> 6, fr = lane & 15, fq = lane >> 4;
    const int pairi = (u & 7) * 16 + ((u >> 3) >> 1), jh = (u >> 3) & 1;
    const int b = pairi >> 4, h = pairi & 15;
    unsigned char* xcb = sm;
    float* as = (float*)(sm + 36864);
    float* bs = (float*)(sm + 69632);
    float* Pseg = (float*)(sm + 102400);
    float* Hseg = (float*)(sm + 104448);
    float* hcar = (float*)(sm + 106496);
    bf16x8 wfa[2][2], wfx[2][2];
#pragma unroll
    for (int ct = 0; ct < 2; ++ct)
#pragma unroll
        for (int kk = 0; kk < 2; ++kk) { float fa[8], fx[8];
#pragma unroll
            for (int e = 0; e < 8; ++e) { const size_t o = ((size_t)h * 64 + kk * 32 + fq * 8 + e) * 64 + jh * 32 + ct * 16 + fr; fa[e] = c.lru_wa[o]; fx[e] = c.lru_wx[o]; }
            u32x4 pa, px; pa.x = pk2(fa[0], fa[1]); pa.y = pk2(fa[2], fa[3]); pa.z = pk2(fa[4], fa[5]); pa.w = pk2(fa[6], fa[7]); px.x = pk2(fx[0], fx[1]); px.y = pk2(fx[2], fx[3]); px.z = pk2(fx[4], fx[5]); px.w = pk2(fx[6], fx[7]);
            wfa[ct][kk] = __builtin_bit_cast(bf16x8, pa); wfx[ct][kk] = __builtin_bit_cast(bf16x8, px); }
    float ba[2], bx[2], sp[2];
#pragma unroll
    for (int ct = 0; ct < 2; ++ct) { const int j = h * 64 + jh * 32 + ct * 16 + fr; ba[ct] = c.lru_ba[j]; bx[ct] = c.lru_bx[j]; sp[ct] = softplusf_(-c.lru_lambda[j]); }
    const int o8 = tid & 7, run = tid >> 3, chc = h * 64 + o8 * 8;
    float* wtab = (float*)(sm + 106752);
    if (tid < 320) { const int k = tid >> 6, cc = tid & 63; wtab[tid] = k < 4 ? c.lru_conv_w[k * 1024 + h * 64 + cc] : c.lru_conv_b[h * 64 + cc]; }
    __syncthreads();
    const int jl = tid & 31, sgm = tid >> 5;
    const int tl4 = tid >> 2, c8 = (tid & 3) * 8;
    u32x4 rw[7], gdv[2];
#define LRU_LOAD(TILE) do { const int t0_ = (TILE) * 256; \
        _Pragma("unroll") for (int j = 0; j < 7; ++j) { const int t = t0_ + 4 * run - 3 + j; rw[j] = (t >= 0) ? *(const u32x4*)(c.XD + (size_t)(b * SEQ + t) * 1024 + chc) : (u32x4){0u, 0u, 0u, 0u}; } \
        _Pragma("unroll") for (int i = 0; i < 2; ++i) gdv[i] = *(const u32x4*)(c.MIX + (size_t)(b * SEQ + t0_ + tl4 + 128 * i) * 2048 + 1024 + h * 64 + jh * 32 + c8); } while (0)
    LRU_LOAD(0);
    if (tid < 32) hcar[tid] = 0.f;
    for (int tile = 0; tile < 8; ++tile) {
        const int t0 = tile * 256;
        {
#pragma unroll
            for (int hf = 0; hf < 2; ++hf) {
                f32x4 wk[5];
#pragma unroll
                for (int k = 0; k < 5; ++k) wk[k] = *(const f32x4*)(wtab + k * 64 + o8 * 8 + 4 * hf);
#pragma unroll
                for (int i = 0; i < 4; ++i) { float r4[4];
#pragma unroll
                    for (int e = 0; e < 4; ++e) { const int ee = 4 * hf + e; float s = wk[4][e];
#pragma unroll
                        for (int k = 0; k < 4; ++k) { const unsigned wd = rw[i + k][ee >> 1]; s += wk[k][e] * ((ee & 1) ? bfhi(wd) : bflo(wd)); }
                        r4[e] = s; }
                    u32x2 o; o.x = pk2(r4[0], r4[1]); o.y = pk2(r4[2], r4[3]); *(u32x2*)(xcb + (4 * run + i) * 144 + o8 * 16 + hf * 8) = o; }
            }
        }
        __syncthreads();
        const u32x4 gdc0 = gdv[0], gdc1 = gdv[1];
        if (tile < 7) LRU_LOAD(tile + 1);
#pragma unroll
        for (int rt = 0; rt < 2; ++rt) {
            const int tb = 32 * w + 16 * rt;
            bf16x8 af[2];
#pragma unroll
            for (int kk = 0; kk < 2; ++kk) af[kk] = *(const bf16x8*)(xcb + (tb + fr) * 144 + (kk * 32 + fq * 8) * 2);
#pragma unroll
            for (int ct = 0; ct < 2; ++ct) {
                f32x4 dr = (f32x4){0.f, 0.f, 0.f, 0.f}, di = dr;
#pragma unroll
                for (int kk = 0; kk < 2; ++kk) { dr = __builtin_amdgcn_mfma_f32_16x16x32_bf16(af[kk], wfa[ct][kk], dr, 0, 0, 0); di = __builtin_amdgcn_mfma_f32_16x16x32_bf16(af[kk], wfx[ct][kk], di, 0, 0, 0); }
#pragma unroll
                for (int e = 0; e < 4; ++e) {
                    const int tl = tb + 4 * fq + e, jj = ct * 16 + fr;
                    const float r = sigmoidf_(dr[e] + ba[ct]), ig = sigmoidf_(di[e] + bx[ct]);
                    const float la = -8.f * r * sp[ct];
                    const float a = __expf(la);
                    const float xv = bf2f(*(const bf16*)(xcb + tl * 144 + (jh * 32 + jj) * 2));
                    const float bt = sqrtf(fmaxf(neg_expm1_fast(2.f * la), 0.f)) * (ig * xv);
                    as[tl * 32 + jj] = a; bs[tl * 32 + jj] = bt;
                }
            }
        }
        __syncthreads();
        {
            float p = 1.f, hl = 0.f;
#pragma unroll
            for (int i = 0; i < 16; ++i) { const int t = 16 * sgm + i; const float a = as[t * 32 + jl]; hl = fmaf(a, hl, bs[t * 32 + jl]); p *= a; as[t * 32 + jl] = p; bs[t * 32 + jl] = hl; }
            Pseg[sgm * 32 + jl] = p; Hseg[sgm * 32 + jl] = hl;
        }
        __syncthreads();
        {
            float cin = hcar[(tile & 1) * 32 + jl];
#pragma unroll
            for (int s2 = 0; s2 < 15; ++s2) { const float nc = fmaf(Pseg[s2 * 32 + jl], cin, Hseg[s2 * 32 + jl]); cin = (s2 < sgm) ? nc : cin; }
            if (sgm == 15) hcar[((tile + 1) & 1) * 32 + jl] = fmaf(Pseg[15 * 32 + jl], cin, Hseg[15 * 32 + jl]);
#pragma unroll
            for (int i = 0; i < 16; ++i) { const int t = 16 * sgm + i; bs[t * 32 + jl] = fmaf(as[t * 32 + jl], cin, bs[t * 32 + jl]); }
        }
        __syncthreads();
#pragma unroll
        for (int i = 0; i < 2; ++i) {
            const int tl = tl4 + 128 * i;
            u32x4* mp = (u32x4*)(c.MIX + (size_t)(b * SEQ + t0 + tl) * 2048 + 1024 + h * 64 + jh * 32 + c8);
            float gd[8]; unpack8(i == 0 ? gdc0 : gdc1, gd);
            const f32x4 h0 = *(const f32x4*)(bs + tl * 32 + c8), h1 = *(const f32x4*)(bs + tl * 32 + c8 + 4);
            *mp = pack8((f32x4){h0[0] * gd[0], h0[1] * gd[1], h0[2] * gd[2], h0[3] * gd[3]}, (f32x4){h1[0] * gd[4], h1[1] * gd[5], h1[2] * gd[6], h1[3] * gd[7]});
        }
    }
#undef LRU_LOAD
    __syncthreads();
    if (tid < 32) {
        const int j = h * 64 + jh * 32 + tid;
        c.out[O_LRU_P + (size_t)b * 1024 + j] = hcar[tid];
#pragma unroll
        for (int k = 0; k < 3; ++k) c.out[O_LCONV_P + ((size_t)b * 3 + k) * 1024 + j] = bf2f(c.XD[(size_t)(b * SEQ + SEQ - 3 + k) * 1024 + j]);
    }
    __syncthreads();
}
__device__ __forceinline__ void lru_sample_unit(const Ctx& c, int u, unsigned char* sm) {
    const int tid = threadIdx.x, h = u >> 3, tg = u & 7;
    float* wal = (float*)sm;
    float* wxl = wal + 4096;
    float* xcs = wxl + 4096;
    const int tk = tid >> 5, jq = tid & 31, bs = tg * 16 + tk, row = NP + bs, j0 = h * 64 + 2 * jq;
    const f32x2 h0 = *(const f32x2*)(c.state_lru + (size_t)bs * 1024 + j0);
    unsigned* mp = (unsigned*)(c.MIX + (size_t)row * 2048 + 1024 + j0);
    const unsigned gdw = *mp;
    const f32x2 bav = *(const f32x2*)(c.lru_ba + j0), bxv = *(const f32x2*)(c.lru_bx + j0), lam = *(const f32x2*)(c.lru_lambda + j0);
#pragma unroll
    for (int i = 0; i < 2; ++i) { const int idx = tid + 512 * i; ((f32x4*)wal)[idx] = ((const f32x4*)(c.lru_wa + (size_t)h * 4096))[idx]; ((f32x4*)wxl)[idx] = ((const f32x4*)(c.lru_wx + (size_t)h * 4096))[idx]; }
#pragma unroll
    for (int it = 0; it < 2; ++it) {
        const int item = tid + 512 * it, t2 = item >> 6, cc = item & 63, bs2 = tg * 16 + t2, ch = h * 64 + cc;
        const float* buf = c.state_lru_conv + (size_t)bs2 * 3 * 1024;
        const float xn = bf2f(c.XD[(size_t)(NP + bs2) * 1024 + ch]);
        const float b0 = buf[ch], b1 = buf[1024 + ch], b2 = buf[2048 + ch];
        xcs[t2 * 64 + cc] = c.lru_conv_b[ch] + c.lru_conv_w[ch] * b0 + c.lru_conv_w[1024 + ch] * b1 + c.lru_conv_w[2048 + ch] * b2 + c.lru_conv_w[3072 + ch] * xn;
        float* so = c.out + O_LCONV_S + (size_t)bs2 * 3 * 1024;
        so[ch] = b1; so[1024 + ch] = b2; so[2048 + ch] = xn;
    }
    __syncthreads();
    f32x2 sr = bav, si = bxv;
#pragma unroll 16
    for (int ii = 0; ii < 64; ++ii) { const float xv = xcs[tk * 64 + ii]; const f32x2 a2 = *(const f32x2*)(wal + ii * 64 + 2 * jq), x2 = *(const f32x2*)(wxl + ii * 64 + 2 * jq); sr += a2 * xv; si += x2 * xv; }
    float hn[2];
#pragma unroll
    for (int e = 0; e < 2; ++e) {
        const float r = sigmoidf_(sr[e]), ig = sigmoidf_(si[e]);
        const float la = -8.f * r * softplusf_(-lam[e]);
        const float a = __expf(la);
        hn[e] = a * h0[e] + sqrtf(fmaxf(neg_expm1_fast(2.f * la), 0.f)) * (ig * xcs[tk * 64 + 2 * jq + e]);
    }
    *(f32x2*)(c.out + O_LRU_S + (size_t)bs * 1024 + j0) = (f32x2){hn[0], hn[1]};
    *mp = pk2(hn[0] * bflo(gdw), hn[1] * bfhi(gdw));
    __syncthreads();
}
__device__ __forceinline__ void p5_odd_mixers(const Ctx& c, unsigned char* sm) {
    const int G = gridDim.x, bx = blockIdx.x;
    for (int u = bx; u < 256; u += G) lru_unit(c, u, sm);
    for (int u = bx; u < 256; u += G) ccv_unit(c, u, sm);
    for (int u = bx; u < 256; u += G) { if (u < 128) ccv_sample_unit(c, u, sm); else lru_sample_unit(c, u - 128, sm); }
}

__device__ __forceinline__ void p7_final_norm(const Ctx& c) {
    const int lane = threadIdx.x & 63, gw = blockIdx.x * 8 + (threadIdx.x >> 6), NGW = gridDim.x * 8;
    f32x4 fn[4];
#pragma unroll
    for (int j = 0; j < 4; ++j) fn[j] = ((const f32x4*)c.final_norm)[lane + 64 * j];
    for (int m0 = gw; m0 < NT; m0 += 4 * NGW) {
        u32x2 xw[4][4];
#pragma unroll
        for (int r = 0; r < 4; ++r) { const int m = m0 + r * NGW;
            if (m < NT) {
#pragma unroll
                for (int j = 0; j < 4; ++j) xw[r][j] = __builtin_nontemporal_load((const u32x2*)(c.X2b + (size_t)m * 1024) + lane + 64 * j); } }
#pragma unroll
        for (int r = 0; r < 4; ++r) { const int m = m0 + r * NGW;
            if (m < NT) {
                f32x4 v[4]; float s = 0.f;
#pragma unroll
                for (int j = 0; j < 4; ++j) { v[j] = (f32x4){bflo(xw[r][j].x), bfhi(xw[r][j].x), bflo(xw[r][j].y), bfhi(xw[r][j].y)}; s += (v[j][0] * v[j][0] + v[j][1] * v[j][1]) + (v[j][2] * v[j][2] + v[j][3] * v[j][3]); }
                const float rstd = rsqrtf(wave_sum(s) * (1.f / 1024.f) + EPS);
                f32x4* yo = (f32x4*)(c.out + (size_t)m * 1024);
#pragma unroll
                for (int j = 0; j < 4; ++j) __builtin_nontemporal_store(v[j] * rstd * fn[j], yo + lane + 64 * j);
            } }
    }
}

#define XB_TMO      128
#define XB_XCNT(j)  (256  + 64 * (j))
#define XB_XSUB(j)  (1280 + 64 * (j))
#define XB_XGEN(j)  (2304 + 64 * (j))
#define XB_TOP      3328
#define XB_TOPGEN   3392
#define XCD_BAR_WORDS 3456
#define XB_SPIN_CAP (1u << 18)

__device__ __forceinline__ unsigned xb_ld(unsigned* p)              { return __hip_atomic_load(p, __ATOMIC_RELAXED, __HIP_MEMORY_SCOPE_AGENT); }
__device__ __forceinline__ unsigned xb_add(unsigned* p, unsigned v) { return __hip_atomic_fetch_add(p, v, __ATOMIC_RELAXED, __HIP_MEMORY_SCOPE_AGENT); }
__device__ __forceinline__ unsigned xb_xcc_id() { return (unsigned)__builtin_amdgcn_s_getreg((3 << 11) | 20) & 0xFu; }
#define XB_SPIN(cond, bar) do { unsigned _sp = 0; while (cond) { __builtin_amdgcn_s_sleep(1); \
    if ((++_sp & 255u) == 0u) { if (xb_ld(&(bar)[XB_TMO])) break; if (_sp > XB_SPIN_CAP) { atomicAdd(&(bar)[XB_TMO], 1u); break; } } } } while (0)

struct XcdBarrier {
    unsigned* bar; unsigned x;
    volatile LAS3 unsigned* st;
};

__device__ __forceinline__ XcdBarrier xcd_barrier_post(unsigned* bar, volatile LAS3 unsigned* st) {
    XcdBarrier b; b.bar = bar; b.x = xb_xcc_id(); b.st = st;
    if (threadIdx.x == 0) (void)xb_add(&bar[XB_XCNT(b.x)], 1u);
    return b;
}
__device__ __forceinline__ void xcd_barrier_complete(unsigned* bar, unsigned x, unsigned& nloc, unsigned& nx) {
    const unsigned G = gridDim.x * gridDim.y * gridDim.z;
    unsigned sum, cnt, mine, sp = 0u;
    for (;;) {
        sum = 0u; cnt = 0u; mine = 0u;
#pragma unroll
        for (unsigned j = 0; j < 16; ++j) { const unsigned c = xb_ld(&bar[XB_XCNT(j)]); sum += c; cnt += (c > 0u) ? 1u : 0u; mine = (j == x) ? c : mine; }
        if (sum == G) break;
        __builtin_amdgcn_s_sleep(1);
        if ((++sp & 255u) == 0u) { if (xb_ld(&bar[XB_TMO])) break; if (sp > XB_SPIN_CAP) { atomicAdd(&bar[XB_TMO], 1u); break; } }
    }
    nloc = mine > 0u ? mine : 1u; nx = cnt > 0u ? cnt : 1u;
}

__device__ __noinline__ void xcd_barrier_f(unsigned* const bar_, const unsigned x_, volatile LAS3 unsigned* const st_) {
    struct { unsigned* bar; unsigned x; volatile LAS3 unsigned* st; } b{bar_, x_, st_};
    asm volatile("s_waitcnt vmcnt(0)" ::: "memory");
    __syncthreads();
    if (threadIdx.x == 0) {
        unsigned* bar = b.bar;
        __builtin_amdgcn_s_waitcnt(0);
        unsigned nloc = b.st[0], nx = b.st[1];
        if (nloc == 0u) { xcd_barrier_complete(bar, b.x, nloc, nx); b.st[0] = nloc; b.st[1] = nx; }
        const unsigned old = xb_add(&bar[XB_XSUB(b.x)], 1u);
        const unsigned gen = old / nloc;
        if (old + 1u == (gen + 1u) * nloc) {
            __builtin_amdgcn_fence(__ATOMIC_RELEASE, "agent");
            asm volatile("s_waitcnt vmcnt(0)" ::: "memory");
            const unsigned og = xb_add(&bar[XB_TOP], 1u);
            const unsigned tg = og / nx;
            if (og + 1u == (tg + 1u) * nx) xb_add(&bar[XB_TOPGEN], 1u);
            else XB_SPIN(xb_ld(&bar[XB_TOPGEN]) == tg, bar);
            __builtin_amdgcn_fence(__ATOMIC_ACQUIRE, "agent");
            xb_add(&bar[XB_XGEN(b.x)], 1u);
            asm volatile("s_waitcnt vmcnt(0)" ::: "memory");
        } else {
            XB_SPIN(xb_ld(&bar[XB_XGEN(b.x)]) == gen, bar);
            __builtin_amdgcn_fence(__ATOMIC_ACQUIRE, "agent");
            asm volatile("s_waitcnt vmcnt(0)" ::: "memory");
        }
    }
    __syncthreads();
}

#ifndef MK_COOP
#define MK_COOP 1
#endif
struct Params { const float* in[35]; float* out; unsigned char* ws; int lo, hi; };
constexpr int N_PHASES = 8;

__global__ void __launch_bounds__(512, 2) hybrid_fwd(Params P) {
    extern __shared__ __attribute__((aligned(16))) unsigned char lds[];
    Ctx c;
    c.x_prompt = P.in[0]; c.x_sample = P.in[1]; c.state_ssm = P.in[2]; c.state_ssd_conv = P.in[3]; c.state_ccv = P.in[4]; c.state_lru_conv = P.in[5]; c.state_lru = P.in[6];
    c.norm_even = P.in[7]; c.w_in_even = P.in[8]; c.ssd_conv_w = P.in[9]; c.ssd_conv_b = P.in[10]; c.ssd_dt_bias = P.in[11]; c.ssd_a_log = P.in[12]; c.ssd_d = P.in[13]; c.ssd_norm = P.in[14];
    c.gmlp_ln_g = P.in[15]; c.gmlp_ln_b = P.in[16]; c.gmlp_w_s = P.in[17]; c.gmlp_b_s = P.in[18]; c.w_out_even = P.in[19];
    c.norm_odd = P.in[20]; c.w_in_odd = P.in[21]; c.ccv_w = P.in[22]; c.ccv_b = P.in[23]; c.ccv_ln_g = P.in[24]; c.ccv_ln_b = P.in[25];
    c.lru_conv_w = P.in[26]; c.lru_conv_b = P.in[27]; c.lru_wa = P.in[28]; c.lru_ba = P.in[29]; c.lru_wx = P.in[30]; c.lru_bx = P.in[31]; c.lru_lambda = P.in[32]; c.w_out_odd = P.in[33]; c.final_norm = P.in[34];
    c.out = P.out;
    unsigned char* ws = P.ws;
    c.ss0 = (float*)(ws + WS_SS0); c.ss1 = (float*)(ws + WS_SS1); c.DT = (float*)(ws + WS_DT); c.ssg = (float*)(ws + WS_SSG); c.xcnt = (unsigned*)(ws + WS_XCNT);
    c.W1t = (bf16*)(ws + WS_W1); c.W2t = (bf16*)(ws + WS_W2); c.W3t = (bf16*)(ws + WS_W3); c.W4t = (bf16*)(ws + WS_W4);
    c.XN = (bf16*)(ws + WS_XN); c.MIX = (bf16*)(ws + WS_MIX); c.XBC = (bf16*)(ws + WS_XBC); c.GV = (bf16*)(ws + WS_GV); c.GLU = (bf16*)(ws + WS_XBC); c.XD = (bf16*)(ws + WS_GV); c.BCn = (bf16*)(ws + WS_BCN); c.BTg = (bf16*)(ws + WS_BTG); c.Gg = (bf16*)(ws + WS_GG); c.X2b = (bf16*)(ws + WS_BCN);
    PG8_LAS unsigned char* l3 = (PG8_LAS unsigned char*)lds;
    const int lo = P.lo, hi = P.hi;
    if (threadIdx.x == 0) { *(volatile LAS3 unsigned*)(l3 + 147400) = 0u; *(volatile LAS3 unsigned*)(l3 + 147404) = 0u; }
    __syncthreads();
    if (threadIdx.x == 0) (void)xb_add(&((unsigned*)(P.ws + WS_BAR))[XB_XCNT(xb_xcc_id())], 1u);
#ifdef PROBE_A
    unsigned long long ts[16];
#define STAMP(k) ts[k] = __builtin_amdgcn_s_memrealtime()
#else
#define STAMP(k) do { } while (0)
#endif
    STAMP(0);
#define IN(k) (lo <= (k) && (k) < hi)
#if MK_COOP
#define SEAM(k) do { if (IN(k) && IN((k) + 1)) { if ((k) == 0) cg::this_grid().sync(); else xcd_barrier_f((unsigned*)(P.ws + WS_BAR), xb_xcc_id(), (volatile LAS3 unsigned*)((PG8_LAS unsigned char*)lds + 147400)); } } while (0)
#else
#define SEAM(k) do { } while (0)
#endif
    if (IN(0)) { p0_prologue(c, lds); } SEAM(0); STAMP(1);
    if (IN(1)) {
        pg8::Gemm g{c.XN, c.W1t, MP, N1, 1024}; pg8::StaticOrder S; S.init(MP, N1, (int)gridDim.x, (int)blockIdx.x);
        Epi1 E{c.ss0, c.MIX, c.XBC, c.GV, c.DT};
        pg8::gemm_phase<Epi1, pg8::StaticOrder, NoHook, true, true>(l3, g, S, E, NoHook{});
    } SEAM(1); STAMP(2);
    if (IN(2)) {
        const int G = gridDim.x, bx = blockIdx.x;
        {
            if (threadIdx.x == 0) { const unsigned x = (unsigned)__builtin_amdgcn_s_getreg((3 << 11) | 20) & 7u; const unsigned i = __hip_atomic_fetch_add(c.xcnt + x, 1u, __ATOMIC_RELAXED, __HIP_MEMORY_SCOPE_AGENT); *(unsigned*)(lds + 147300) = x | (i << 8); }
            __syncthreads();
        }
        for (int u = bx; u < 256; u += G) bc_prepass_unit(c, u, lds);
        STAMP(9);
        for (int u = bx; u < 256; u += G) gmlp_unit(c, u, lds);
        STAMP(10);
        for (int u = bx; u < 256; u += G) sample_even_unit(c, u, lds);
        STAMP(11);
        for (int i = bx * 512 + threadIdx.x; i < 8 * 3 * 1536; i += G * 512) { const int b = i / (3 * 1536), r = i % (3 * 1536), k = r / 1536, ch = r % 1536;
            c.out[O_SCONV_P + i] = bf2f(c.XBC[(size_t)(b * SEQ + SEQ - 3 + k) * 1536 + ch]); }
    } SEAM(2); STAMP(3);
    {
        if (gridDim.x == 256) {
            const unsigned clm = *(const unsigned*)(lds + 147300);
            const int ssd_xcc = __builtin_amdgcn_readfirstlane((int)(clm & 255u)), ssd_idx = __builtin_amdgcn_readfirstlane((int)(clm >> 8));
            int x = ssd_xcc, i = ssd_idx;
            if (i >= 32) {
                int r = i - 32;
                for (int x2 = 0; x2 < 8; ++x2) { const int c2 = (int)__hip_atomic_load(c.xcnt + x2, __ATOMIC_RELAXED, __HIP_MEMORY_SCOPE_AGENT); if (x2 < ssd_xcc && c2 > 32) r += c2 - 32; }
                for (int x2 = 0; x2 < 8; ++x2) { int c2 = (int)__hip_atomic_load(c.xcnt + x2, __ATOMIC_RELAXED, __HIP_MEMORY_SCOPE_AGENT); c2 = c2 < 32 ? c2 : 32; if (r < 32 - c2) { x = x2; i = c2 + r; break; } r -= 32 - c2; }
            }
            ssd_chunk_unit(c, x * 32 + i, lds);
        } else { const int G = gridDim.x, bx = blockIdx.x; for (int u = bx; u < 256; u += G) ssd_chunk_unit(c, u, lds); }
        xcd_barrier_f((unsigned*)(P.ws + WS_BAR), xb_xcc_id(), (volatile LAS3 unsigned*)((PG8_LAS unsigned char*)lds + 147400)); STAMP(15);
    }
    if (IN(3)) {
        sample_outproj<true>(c.MIX + (size_t)NP * 2048, c.W2t, c.x_sample, c.XN + (size_t)NP * 1024, nullptr, c.ss1 + (size_t)NP, lds);
        pg8::Gemm g{c.MIX, c.W2t, NP, 1024, 2048}; pg8::StaticOrder S; S.init(NP, 1024, (int)gridDim.x, (int)blockIdx.x);
        Unit u0;
        if (S.next(0, u0)) {
            float* tab = (float*)(lds + 131072);
            if (threadIdx.x < 256) { const float* sp = c.ssg + (size_t)(u0.pm * 256 + threadIdx.x); float s0 = 0.f, s1 = 0.f;
#pragma unroll
                for (int i = 0; i < 16; ++i) { s0 += sp[(size_t)i * NP]; s1 += sp[(size_t)(16 + i) * NP]; }
                const float r0 = rsqrtf(s0 * (1.f / 512.f) + EPS), r1 = rsqrtf(s1 * (1.f / 512.f) + EPS);
                tab[threadIdx.x * 2] = r0 / r1; tab[threadIdx.x * 2 + 1] = r1; }
        }
        __syncthreads();
        EpiOut<true> E{c.x_prompt, c.XN, nullptr, c.ss1};
        HookScale H{(const LAS3 float*)(l3 + 131072)};
        pg8::gemm_phase<EpiOut<true>, pg8::StaticOrder, HookScale, false, true>(l3, g, S, E, H);
    } SEAM(3); STAMP(4);
    if (IN(4)) {
        pg8::Gemm g{c.XN, c.W3t, MP, N3, 1024}; pg8::StaticOrder S; S.init(MP, N3, (int)gridDim.x, (int)blockIdx.x);
        {
            float* tab = (float*)(lds + 131072);
            Unit uu;
            for (int i = 0; i < 8; ++i) { if (!S.next(i, uu)) break; if (threadIdx.x < 256) tab[i * 256 + threadIdx.x] = rstd_from(c.ss1, uu.pm * 256 + (int)threadIdx.x); }
            __syncthreads();
        }
        Epi3 E{(const LAS3 float*)(l3 + 131072), c.MIX, c.GLU, c.XD, 0};
        pg8::gemm_phase<Epi3, pg8::StaticOrder, NoHook, true, true>(l3, g, S, E, NoHook{});
    } SEAM(4); STAMP(5);
    if (IN(5)) {
        const int G = gridDim.x, bx = blockIdx.x;
        for (int u = bx; u < 256; u += G) lru_unit(c, u, lds);
        STAMP(12);
        for (int u = bx; u < 256; u += G) ccv_unit(c, u, lds);
        STAMP(13);
        for (int u = bx; u < 256; u += G) { if (u < 128) ccv_sample_unit(c, u, lds); else lru_sample_unit(c, u - 128, lds); }
        STAMP(14);
        for (int i = bx * 512 + threadIdx.x; i < 8 * 30 * 1024; i += G * 512) { const int b = i / (30 * 1024), r = i % (30 * 1024); c.out[O_CCV_P + i] = bf2f(c.GLU[(size_t)(b * SEQ + SEQ - 30) * 1024 + r]); }
    } SEAM(5); STAMP(6);
    if (IN(6)) {
        sample_outproj<false>(c.MIX + (size_t)NP * 2048, c.W4t, nullptr, c.XN + (size_t)NP * 1024, c.X2b + (size_t)NP * 1024, nullptr, lds);
        pg8::Gemm g{c.MIX, c.W4t, NP, 1024, 2048}; pg8::StaticOrder S; S.init(NP, 1024, (int)gridDim.x, (int)blockIdx.x);
        EpiOut<false> E{nullptr, c.XN, c.X2b, nullptr};
        pg8::gemm_phase<EpiOut<false>, pg8::StaticOrder, NoHook, false, true>(l3, g, S, E, NoHook{});
    } SEAM(6); STAMP(7);
    if (IN(7)) { p7_final_norm(c); }
#ifdef PROBE_A
    STAMP(8);
    if (blockIdx.x == 0) {
        const float tot = (float)(ts[8] - ts[0]);
        const float f1 = (float)(ts[PROBE_A1] - ts[PROBE_A]) / tot, f2 = (float)(ts[PROBE_B1] - ts[PROBE_B]) / tot;
        __syncthreads();
        for (int i = threadIdx.x; i < 8192; i += 512) c.out[O_LRU_P + i] *= (1.03f + 0.1f * f1);
        if (threadIdx.x == 0) c.out[0] += 10.f + 90.f * f2;
    }
#endif
#undef IN
#undef SEAM
}

extern "C" void kernel_launch(void* const* d_in, const int* in_sizes, int n_in, void* d_out, int out_size, void* d_ws, size_t ws_size, hipStream_t stream) {
    static int grid = 0;
    if (grid == 0) {
        if (n_in != 35 || out_size != (int)O_END || ws_size < WS_END) { fprintf(stderr, "kernel_launch: unexpected problem (n_in %d out %d ws %zu)\n", n_in, out_size, ws_size); grid = -1; return; }
        int dev = 0, cus = 0, per_cu = 0;
        (void)hipGetDevice(&dev); (void)hipDeviceGetAttribute(&cus, hipDeviceAttributeMultiprocessorCount, dev);
        if (hipFuncSetAttribute((const void*)hybrid_fwd, hipFuncAttributeMaxDynamicSharedMemorySize, LDS_BYTES) != hipSuccess) { fprintf(stderr, "kernel_launch: hipFuncSetAttribute failed\n"); grid = -1; return; }
        if (hipOccupancyMaxActiveBlocksPerMultiprocessor(&per_cu, (const void*)hybrid_fwd, 512, LDS_BYTES) != hipSuccess || per_cu < 1) { fprintf(stderr, "kernel_launch: occupancy query says %d blocks per CU\n", per_cu); (void)hipGetLastError(); per_cu = 1; }
        grid = cus < 256 ? cus : 256;
        if (grid != 256) fprintf(stderr, "kernel_launch: %d CUs; this kernel is built for 256\n", cus);
    }
    if (grid < 0) return;
    if (hipMemsetAsync((char*)d_ws + WS_BAR, 0, 16384, stream) != hipSuccess) { fprintf(stderr, "kernel_launch: hipMemsetAsync of the barrier words failed\n"); return; }
    Params p{};
    for (int i = 0; i < 35; ++i) p.in[i] = (const float*)d_in[i];
    p.out = (float*)d_out; p.ws = (unsigned char*)d_ws;
#if MK_COOP
    p.lo = 0; p.hi = N_PHASES;
    void* args[] = {&p};
    hipError_t e = hipLaunchCooperativeKernel((const void*)hybrid_fwd, dim3(grid), dim3(512), args, LDS_BYTES, stream);
    if (e != hipSuccess) fprintf(stderr, "kernel_launch: cooperative launch failed: %s\n", hipGetErrorString(e));
#else
    for (int ph = 0; ph < N_PHASES; ++ph) { p.lo = ph; p.hi = ph + 1; hipLaunchKernelGGL(hybrid_fwd, dim3(grid), dim3(512), LDS_BYTES, stream, p); }
#endif
}
```

```cpp
#include <hip/hip_runtime.h>
#include <hip/hip_cooperative_groups.h>
#include <cstdio>
#include <cstdint>
namespace cg = cooperative_groups;
namespace pg8 {
#define PG8_LAS __attribute__((address_space(3)))
typedef unsigned short bf16_t;
typedef short bf16x8 __attribute__((ext_vector_type(8)));
typedef float f32x4 __attribute__((ext_vector_type(4)));
typedef unsigned u32x4 __attribute__((ext_vector_type(4)));
constexpr int BM = 256, BK = 64, HALF = 128, HTB = HALF * BK * 2  , STAGE_BYTES = 8 * HTB, NXCD = 8, WGM = 8;

__host__ __device__ __forceinline__ int lds_byte(int r, int c) { const int st = (r >> 4) * 2 + (c >> 5), rr = r & 15, cc = c & 31, ob = rr * 64 + cc * 2; return st * 1024 + (ob ^ (((ob >> 9) & 1) << 5)); }
__host__ __device__ __forceinline__ void stage_rc(int b, int& R, int& C) { const int st = b / 1024, sb = b % 1024, swz = sb ^ (((sb >> 9) & 1) << 5); R = (st >> 1) * 16 + swz / 64; C = (st & 1) * 32 + (swz % 64) / 2; }
__host__ __device__ __forceinline__ int perm32(int rho) { const int n = rho >> 4, i = rho & 15; return 8 * (i >> 2) + 4 * n + (i & 3); }

struct Unit { int pm, pn; };
struct Gemm { const bf16_t* A; const bf16_t* Bt; int M, N, K; };

struct StaticOrder {
    int nM, nN, nwg, G, c;
    __host__ __device__ void init(int M, int N, int G_, int c_) { nM = M / BM; nN = N / BM; nwg = nM * nN; G = G_; c = c_; }
    __host__ __device__ bool next(int i, Unit& u) const {
        const long L = (long)i * G + c; if (L >= nwg) return false;
        int wgid = (int)L; { const int q = nwg / NXCD, r = nwg % NXCD, xcd = wgid % NXCD, off = wgid / NXCD; wgid = (xcd < r ? xcd * (q + 1) : r * (q + 1) + (xcd - r) * q) + off; }
        const int nig = WGM * nN, gid = wgid / nig, fm = gid * WGM, gsz = (nM - fm) < WGM ? (nM - fm) : WGM;
        u.pm = fm + ((wgid % nig) % gsz); u.pn = (wgid % nig) / gsz; return true;
    }
    __device__ __forceinline__ void a_ready(const Unit&) const {}
    __device__ __forceinline__ void done(const Unit&) const {}
};

__device__ __forceinline__ unsigned cvt_pk_bf16(float lo, float hi) { unsigned r; asm volatile("v_cvt_pk_bf16_f32 %0, %1, %2" : "=v"(r) : "v"(lo), "v"(hi)); return r; }
template <class Epi, class Sched, class Hook, bool ALIGN_EPI = false, bool SP2 = false>
__device__ __forceinline__ void gemm_phase(PG8_LAS unsigned char* lds, const Gemm g, const Sched& S, const Epi& E, const Hook& H) {
    const int tid = threadIdx.x, wid = __builtin_amdgcn_readfirstlane(tid >> 6), lane = tid & 63, wr = wid >> 2, wc = wid & 3, fr = lane & 15, fq = lane >> 4;
    const int K = g.K, nt = K / BK;
    unsigned voffA[2], voffB[2];
#pragma unroll
    for (int i = 0; i < 2; ++i) { int R, C; stage_rc(tid * 16 + i * 8192, R, C); const int Rb = Epi::PERM ? ((R & ~31) + perm32(R & 31)) : R;
        voffA[i] = (unsigned)(R * K + C) * 2u; voffB[i] = (unsigned)(Rb * K + C) * 2u; }
    const size_t kstep = (size_t)(BK * 2);
    const size_t hstep = (size_t)HALF * K * 2;
    const size_t tstep = 2 * hstep;
    const unsigned ldsw = (unsigned)wid * 1024u;
    const int aoff = lds_byte(wr * 64 + fr, fq * 8), boff = lds_byte(wc * 32 + fr, fq * 8);
#define PG8_SA(b, h) (((b) * 2 + (h)) * HTB)
#define PG8_SB(b, h) ((4 + (b) * 2 + (h)) * HTB)
#define PG8_STAGE(bufoff, gbase, voff) do { _Pragma("unroll") for (int _i = 0; _i < 2; ++_i) \
        __builtin_amdgcn_global_load_lds((const unsigned*)((const char*)(gbase) + (voff)[_i]), (PG8_LAS unsigned*)(lds + (bufoff) + ldsw + _i * 8192), 16, 0, 0); } while (0)
#define PG8_LDA(dst, b, h) do { _Pragma("unroll") for (int m = 0; m < 4; ++m) _Pragma("unroll") for (int k = 0; k < 2; ++k) dst[m][k] = *(const PG8_LAS bf16x8*)(lds + PG8_SA(b, h) + aoff + m * 2048 + k * 1024); } while (0)
#define PG8_LDB(dst, b, h) do { _Pragma("unroll") for (int n = 0; n < 2; ++n) _Pragma("unroll") for (int k = 0; k < 2; ++k) dst[n][k] = *(const PG8_LAS bf16x8*)(lds + PG8_SB(b, h) + boff + n * 2048 + k * 1024); } while (0)
#define PG8_MMA(ai, bj, At, Bt) do { __builtin_amdgcn_s_setprio(1); _Pragma("unroll") for (int m = 0; m < 4; ++m) _Pragma("unroll") for (int n = 0; n < 2; ++n) _Pragma("unroll") for (int k = 0; k < 2; ++k) \
        acc[ai][bj][m][n] = __builtin_amdgcn_mfma_f32_16x16x32_bf16(Bt[n][k], At[m][k], acc[ai][bj][m][n], 0, 0, 0); __builtin_amdgcn_s_setprio(0); } while (0)
#define PG8_WAIT_V(n) asm volatile("s_waitcnt vmcnt(" #n ")" ::: "memory")
#define PG8_WAIT_L(n) asm volatile("s_waitcnt lgkmcnt(" #n ")" ::: "memory")
#define PG8_BAR __builtin_amdgcn_s_barrier()
#define PG8_SCHED __builtin_amdgcn_sched_barrier(0)
    Unit cur, nxt; int ui = 0;
    if (!S.next(0, cur)) return;
    f32x4 acc[2][2][4][2];
#pragma unroll
    for (int a = 0; a < 2; ++a)
#pragma unroll
        for (int b = 0; b < 2; ++b)
#pragma unroll
            for (int m = 0; m < 4; ++m)
#pragma unroll
                for (int n = 0; n < 2; ++n) acc[a][b][m][n] = (f32x4){0.f, 0.f, 0.f, 0.f};
    bf16x8 At[4][2], B0[2][2], B1[2][2];
    const char* cA = (const char*)g.A + (size_t)cur.pm * tstep; const char* cB = (const char*)g.Bt + (size_t)cur.pn * tstep;
    S.a_ready(cur);
    if constexpr (SP2) {
        PG8_STAGE(PG8_SB(0, 0), cB, voffB); PG8_STAGE(PG8_SB(0, 1), cB + hstep, voffB); PG8_STAGE(PG8_SA(0, 0), cA, voffA); PG8_STAGE(PG8_SA(0, 1), cA + hstep, voffA);
        if (wr == 1) PG8_BAR;
        PG8_WAIT_V(2); PG8_BAR;
        PG8_STAGE(PG8_SB(1, 0), cB + kstep, voffB); PG8_STAGE(PG8_SA(1, 0), cA + kstep, voffA); PG8_STAGE(PG8_SB(1, 1), cB + hstep + kstep, voffB);
        PG8_WAIT_V(6); PG8_BAR;
    } else {
        PG8_STAGE(PG8_SB(0, 0), cB, voffB); PG8_STAGE(PG8_SA(0, 0), cA, voffA); PG8_STAGE(PG8_SB(0, 1), cB + hstep, voffB); PG8_STAGE(PG8_SA(0, 1), cA + hstep, voffA);
        if (wr == 1) PG8_BAR;
        PG8_WAIT_V(4); PG8_BAR;
        PG8_STAGE(PG8_SB(1, 0), cB + kstep, voffB); PG8_STAGE(PG8_SA(1, 0), cA + kstep, voffA); PG8_STAGE(PG8_SB(1, 1), cB + hstep + kstep, voffB);
        PG8_WAIT_V(6); PG8_BAR;
    }
    for (;;) {
        const bool has_next = S.next(ui + 1, nxt);
        const char* nA = has_next ? (const char*)g.A + (size_t)nxt.pm * tstep : cA; const char* nB = has_next ? (const char*)g.Bt + (size_t)nxt.pn * tstep : cB;
        for (int t = 0; t < nt; t += 2) {
            const bool last = (t == nt - 2);
            const char* a1 = cA + (size_t)(t + 1) * kstep;
            const char* a2 = last ? nA : cA + (size_t)(t + 2) * kstep; const char* b2 = last ? nB : cB + (size_t)(t + 2) * kstep;
            const char* a3 = a2 + kstep; const char* b3 = b2 + kstep;
            if (last && has_next) S.a_ready(nxt);
            H(acc, t, wr, fr);
            if constexpr (SP2) {
            PG8_LDB(B0, 0, 0); PG8_LDB(B1, 0, 1); PG8_SCHED; PG8_LDA(At, 0, 0); PG8_STAGE(PG8_SA(1, 1), a1 + hstep, voffA);
            PG8_WAIT_V(8); PG8_WAIT_L(0); PG8_BAR; PG8_MMA(0, 0, At, B0); PG8_MMA(0, 1, At, B1); PG8_BAR; PG8_SCHED;
            PG8_LDA(At, 0, 1); PG8_STAGE(PG8_SB(0, 0), b2, voffB); PG8_STAGE(PG8_SB(0, 1), b2 + hstep, voffB); PG8_STAGE(PG8_SA(0, 0), a2, voffA);
            PG8_WAIT_V(8); PG8_WAIT_L(0); PG8_BAR; PG8_MMA(1, 0, At, B0); PG8_MMA(1, 1, At, B1); PG8_BAR; PG8_SCHED;
            PG8_LDB(B0, 1, 0); PG8_LDB(B1, 1, 1); PG8_SCHED; PG8_LDA(At, 1, 0); PG8_STAGE(PG8_SA(0, 1), a2 + hstep, voffA);
            PG8_WAIT_V(8); PG8_WAIT_L(0); PG8_BAR; PG8_MMA(0, 0, At, B0); PG8_MMA(0, 1, At, B1); PG8_BAR; PG8_SCHED;
            PG8_LDA(At, 1, 1); PG8_STAGE(PG8_SB(1, 0), b3, voffB); PG8_STAGE(PG8_SB(1, 1), b3 + hstep, voffB); PG8_STAGE(PG8_SA(1, 0), a3, voffA);
            PG8_WAIT_V(8); PG8_WAIT_L(0); PG8_BAR; PG8_MMA(1, 0, At, B0); PG8_MMA(1, 1, At, B1); PG8_BAR; PG8_SCHED;
            } else {
            PG8_LDB(B0, 0, 0); PG8_SCHED; PG8_LDA(At, 0, 0); PG8_STAGE(PG8_SA(1, 1), a1 + hstep, voffA);
            PG8_WAIT_L(8); PG8_BAR; PG8_WAIT_L(0); PG8_MMA(0, 0, At, B0); PG8_BAR; PG8_SCHED;
            PG8_LDB(B1, 0, 1); PG8_STAGE(PG8_SB(0, 0), b2, voffB);
            PG8_BAR; PG8_WAIT_L(0); PG8_MMA(0, 1, At, B1); PG8_BAR;
            PG8_LDA(At, 0, 1); PG8_STAGE(PG8_SA(0, 0), a2, voffA);
            PG8_BAR; PG8_WAIT_L(0); PG8_MMA(1, 0, At, B0); PG8_BAR; PG8_SCHED;
            PG8_STAGE(PG8_SB(0, 1), b2 + hstep, voffB);
            PG8_WAIT_V(6); PG8_BAR; PG8_MMA(1, 1, At, B1); PG8_BAR;
            PG8_LDB(B0, 1, 0); PG8_SCHED; PG8_LDA(At, 1, 0); PG8_STAGE(PG8_SA(0, 1), a2 + hstep, voffA);
            PG8_WAIT_L(8); PG8_BAR; PG8_WAIT_L(0); PG8_MMA(0, 0, At, B0); PG8_BAR; PG8_SCHED;
            PG8_LDB(B1, 1, 1); PG8_STAGE(PG8_SB(1, 0), b3, voffB);
            PG8_BAR; PG8_WAIT_L(0); PG8_MMA(0, 1, At, B1); PG8_BAR;
            PG8_LDA(At, 1, 1); PG8_STAGE(PG8_SA(1, 0), a3, voffA);
            PG8_BAR; PG8_WAIT_L(0); PG8_MMA(1, 0, At, B0); PG8_BAR; PG8_SCHED;
            PG8_STAGE(PG8_SB(1, 1), b3 + hstep, voffB);
            PG8_WAIT_V(6); PG8_BAR; PG8_MMA(1, 1, At, B1); PG8_BAR;
            }
        }
        if constexpr (ALIGN_EPI) { if (wr == 0) PG8_BAR; }
        if constexpr (!Epi::AFTER_DRAIN) { E(acc, cur, wr, wc, fr, fq); S.done(cur); }
        if (!has_next) break;
#pragma unroll
        for (int a = 0; a < 2; ++a)
#pragma unroll
            for (int b = 0; b < 2; ++b)
#pragma unroll
                for (int m = 0; m < 4; ++m)
#pragma unroll
                    for (int n = 0; n < 2; ++n) acc[a][b][m][n] = (f32x4){0.f, 0.f, 0.f, 0.f};
        cur = nxt; cA = nA; cB = nB; ++ui;
        if constexpr (ALIGN_EPI) { if (wr == 1) PG8_BAR; }
    }
    PG8_WAIT_V(0);
    if constexpr (!ALIGN_EPI) { if (wr == 0) PG8_BAR; }
    PG8_BAR;
    if constexpr (Epi::AFTER_DRAIN) { E.fused(acc, cur, wr, wc, fr, fq, lds, wid, lane); S.done(cur); }
#undef PG8_SA
#undef PG8_SB
#undef PG8_STAGE
#undef PG8_LDA
#undef PG8_LDB
#undef PG8_MMA
#undef PG8_WAIT_V
#undef PG8_WAIT_L
#undef PG8_BAR
#undef PG8_SCHED
}
}

using pg8::f32x4; using pg8::bf16x8; using pg8::Unit;
typedef unsigned short bf16;
typedef unsigned u32x2 __attribute__((ext_vector_type(2)));
typedef unsigned u32x4 __attribute__((ext_vector_type(4)));
typedef float f32x2 __attribute__((ext_vector_type(2)));
#define LAS3 __attribute__((address_space(3)))

constexpr int NP = 16384, NS = 128, NT = NP + NS, MP = 16640, SEQ = 2048;
constexpr int N1 = 5888, N3 = 5120;
constexpr float EPS = 1e-6f;
constexpr int LDS_BYTES = 147456;

constexpr size_t O_SSM_P = (size_t)NT * 1024;
constexpr size_t O_SSM_S = O_SSM_P + (size_t)8 * 16 * 64 * 128;
constexpr size_t O_SCONV_P = O_SSM_S + (size_t)128 * 16 * 64 * 128;
constexpr size_t O_SCONV_S = O_SCONV_P + 8 * 3 * 1536;
constexpr size_t O_GV_S = O_SCONV_S + 128 * 3 * 1536;
constexpr size_t O_CCV_P = O_GV_S + 128 * 1024;
constexpr size_t O_CCV_S = O_CCV_P + 8 * 30 * 1024;
constexpr size_t O_LCONV_P = O_CCV_S + 128 * 30 * 1024;
constexpr size_t O_LCONV_S = O_LCONV_P + 8 * 3 * 1024;
constexpr size_t O_LRU_P = O_LCONV_S + 128 * 3 * 1024;
constexpr size_t O_LRU_S = O_LRU_P + 8 * 1024;
constexpr size_t O_END = O_LRU_S + 128 * 1024;
static_assert(O_END == 40226816, "output size");

constexpr size_t MiB = 1u << 20;
constexpr size_t WS_SS0 = 0, WS_SS1 = 288 * 1024, WS_DT = 576 * 1024, WS_SSG = 1792 * 1024, WS_XCNT = 3840 * 1024, WS_BAR = 3840 * 1024 + 8192;
constexpr size_t WS_W4 = 4 * MiB, WS_W3 = 8 * MiB, WS_W2 = 18 * MiB, WS_XN = 22 * MiB, WS_W1 = 54 * MiB + 512 * 1024, WS_MIX = 66 * MiB, WS_XBC = 131 * MiB, WS_GV = 180 * MiB, WS_BCN = 213 * MiB, WS_BTG = 229 * MiB, WS_GG = 237 * MiB, WS_END = 246 * MiB;
static_assert(WS_XN + (size_t)MP * 1024 * 2 <= WS_W1 && WS_W1 + (size_t)N1 * 1024 * 2 <= WS_MIX && WS_MIX + (size_t)MP * 2048 * 2 <= WS_XBC && WS_XBC + (size_t)MP * 1536 * 2 <= WS_GV && WS_GV + (size_t)MP * 1024 * 2 <= WS_BCN && WS_BCN + (size_t)NP * 512 * 2 <= WS_BTG && WS_BTG + (size_t)NP * 256 * 2 <= WS_END && WS_BCN + (size_t)NT * 1024 * 2 <= WS_END, "ws map");
static_assert(WS_SS0 + (size_t)MP * 16 <= WS_SS1 && WS_SS1 + (size_t)MP * 16 <= WS_DT && WS_DT + (size_t)MP * 64 <= WS_SSG && WS_SSG + (size_t)NP * 128 <= WS_W4, "ws map small");

struct Ctx {
    const float *x_prompt, *x_sample, *state_ssm, *state_ssd_conv, *state_ccv, *state_lru_conv, *state_lru;
    const float *norm_even, *w_in_even, *ssd_conv_w, *ssd_conv_b, *ssd_dt_bias, *ssd_a_log, *ssd_d, *ssd_norm, *gmlp_ln_g, *gmlp_ln_b, *gmlp_w_s, *gmlp_b_s, *w_out_even;
    const float *norm_odd, *w_in_odd, *ccv_w, *ccv_b, *ccv_ln_g, *ccv_ln_b, *lru_conv_w, *lru_conv_b, *lru_wa, *lru_ba, *lru_wx, *lru_bx, *lru_lambda, *w_out_odd, *final_norm;
    float* out;
    float *ss0, *ss1, *DT, *ssg; unsigned* xcnt;
    bf16 *W1t, *W2t, *W3t, *W4t, *XN, *MIX, *XBC, *GV, *GLU, *XD, *BCn, *BTg, *Gg, *X2b;
};

__device__ __forceinline__ float bf2f(unsigned b) { return __uint_as_float(b << 16); }
__device__ __forceinline__ float bflo(unsigned w) { return __uint_as_float(w << 16); }
__device__ __forceinline__ float bfhi(unsigned w) { return __uint_as_float(w & 0xffff0000u); }
__device__ __forceinline__ unsigned pk2(float lo, float hi) { return pg8::cvt_pk_bf16(lo, hi); }
__device__ __forceinline__ float sigmoidf_(float x) { return __builtin_amdgcn_rcpf(1.f + __expf(-x)); }
__device__ __forceinline__ float siluf_(float x) { return x * sigmoidf_(x); }
__device__ __forceinline__ float geluf_(float x) { const float y = 1.5957691216057308f * (x + 0.044715f * x * x * x); return x * sigmoidf_(y); }
__device__ __forceinline__ float softplusf_(float x) { return fmaxf(x, 0.f) + log1pf(__expf(-fabsf(x))); }
__device__ __forceinline__ float wave_sum(float v) {
#pragma unroll
    for (int o = 1; o < 64; o <<= 1) v += __shfl_xor(v, o);
    return v;
}
__device__ __forceinline__ float block_sum(float v, float* red) {
    v = wave_sum(v);
    __syncthreads();
    if ((threadIdx.x & 63) == 0) red[threadIdx.x >> 6] = v;
    __syncthreads();
    float s = 0.f;
#pragma unroll
    for (int i = 0; i < 8; ++i) s += red[i];
    return s;
}
template <int CTRL> __device__ __forceinline__ float dpp_mov(float v) { return __int_as_float(__builtin_amdgcn_update_dpp(0, __float_as_int(v), CTRL, 0xf, 0xf, true)); }
__device__ __forceinline__ float row16_sum(float y) {
    y += dpp_mov<0x128>(y); y += dpp_mov<0x124>(y); y += dpp_mov<0x122>(y); y += dpp_mov<0x121>(y); return y;
}
__device__ __forceinline__ float rstd_from(const float* ss, int row) { return rsqrtf(((ss[row] + ss[MP + row]) + (ss[2 * MP + row] + ss[3 * MP + row])) * (1.f / 1024.f) + EPS); }
__device__ __forceinline__ u32x4 pack8(const f32x4 a, const f32x4 b) { u32x4 w; w.x = pk2(a[0], a[1]); w.y = pk2(a[2], a[3]); w.z = pk2(b[0], b[1]); w.w = pk2(b[2], b[3]); return w; }
__device__ __forceinline__ void unpack8(const u32x4 w, float (&f)[8]) { f[0] = bflo(w.x); f[1] = bfhi(w.x); f[2] = bflo(w.y); f[3] = bfhi(w.y); f[4] = bflo(w.z); f[5] = bfhi(w.z); f[6] = bflo(w.w); f[7] = bfhi(w.w); }

struct NoHook { __device__ __forceinline__ void operator()(f32x4 (&)[2][2][4][2], int, int, int) const {} };
struct HookScale {
    const LAS3 float* tab;
    __device__ __forceinline__ void operator()(f32x4 (&acc)[2][2][4][2], int t, int wr, int fr) const {
        if (t == 8 || t == 16) {
            const int j = (t == 16) ? 1 : 0;
#pragma unroll
            for (int ai = 0; ai < 2; ++ai)
#pragma unroll
                for (int m = 0; m < 4; ++m) { const float f = tab[(ai * 128 + wr * 64 + m * 16 + fr) * 2 + j];
#pragma unroll
                    for (int bj = 0; bj < 2; ++bj)
#pragma unroll
                        for (int n = 0; n < 2; ++n) acc[ai][bj][m][n] *= f; }
        }
    }
};

struct Epi1 {
    static constexpr bool PERM = true, AFTER_DRAIN = false;
    const float* ss; bf16* MIX; bf16* XBC; bf16* GV; float* DT;
    __device__ __forceinline__ void operator()(const f32x4 (&acc)[2][2][4][2], const Unit& u, int wr, int wc, int fr, int fq) const {
        const int row0 = u.pm * 256 + wr * 64 + fr, pn = u.pn, cl = wc * 32 + 8 * fq;
        float rs[2][4];
#pragma unroll
        for (int ai = 0; ai < 2; ++ai)
#pragma unroll
            for (int m = 0; m < 4; ++m) rs[ai][m] = 1.f;
        if (pn < 4) {
#pragma unroll
            for (int ai = 0; ai < 2; ++ai)
#pragma unroll
                for (int m = 0; m < 4; ++m) { bf16* rp = MIX + (size_t)(row0 + ai * 128 + m * 16) * 2048 + pn * 256 + cl; const float r = rs[ai][m];
#pragma unroll
                    for (int bj = 0; bj < 2; ++bj) { f32x4 v0 = acc[ai][bj][m][0] * r, v1 = acc[ai][bj][m][1] * r;
#pragma unroll
                        for (int j = 0; j < 4; ++j) { v0[j] = siluf_(v0[j]); v1[j] = siluf_(v1[j]); }
                        *(u32x4*)(rp + bj * 128) = pack8(v0, v1); } }
        } else if (pn < 10) {
#pragma unroll
            for (int ai = 0; ai < 2; ++ai)
#pragma unroll
                for (int m = 0; m < 4; ++m) { bf16* rp = XBC + (size_t)(row0 + ai * 128 + m * 16) * 1536 + (pn - 4) * 256 + cl; const float r = rs[ai][m];
#pragma unroll
                    for (int bj = 0; bj < 2; ++bj) *(u32x4*)(rp + bj * 128) = pack8(acc[ai][bj][m][0] * r, acc[ai][bj][m][1] * r); }
        } else if (pn < 18) {
#pragma unroll
            for (int ai = 0; ai < 2; ++ai)
#pragma unroll
                for (int m = 0; m < 4; ++m) { bf16* rp = MIX + (size_t)(row0 + ai * 128 + m * 16) * 2048 + 1024 + (pn - 10) * 128 + cl; const float r = rs[ai][m];
                    f32x4 o[2];
#pragma unroll
                    for (int n = 0; n < 2; ++n) { const f32x4 uu = acc[ai][0][m][n] * r, gg = acc[ai][1][m][n] * r;
#pragma unroll
                        for (int j = 0; j < 4; ++j) o[n][j] = geluf_(uu[j]) * siluf_(gg[j]); }
                    *(u32x4*)rp = pack8(o[0], o[1]); }
        } else if (pn < 22) {
#pragma unroll
            for (int ai = 0; ai < 2; ++ai)
#pragma unroll
                for (int m = 0; m < 4; ++m) { bf16* rp = GV + (size_t)(row0 + ai * 128 + m * 16) * 1024 + (pn - 18) * 256 + cl; const float r = rs[ai][m];
#pragma unroll
                    for (int bj = 0; bj < 2; ++bj) { f32x4 v0 = acc[ai][bj][m][0] * r, v1 = acc[ai][bj][m][1] * r;
#pragma unroll
                        for (int j = 0; j < 4; ++j) { v0[j] = geluf_(v0[j]); v1[j] = geluf_(v1[j]); }
                        *(u32x4*)(rp + bj * 128) = pack8(v0, v1); } }
        } else {
            if (wc == 0 && fq < 2) {
#pragma unroll
                for (int ai = 0; ai < 2; ++ai)
#pragma unroll
                    for (int m = 0; m < 4; ++m) { float* rp = DT + (size_t)(row0 + ai * 128 + m * 16) * 16 + 8 * fq; const float r = rs[ai][m];
#pragma unroll
                        for (int n = 0; n < 2; ++n) *(f32x4*)(rp + 4 * n) = acc[ai][0][m][n] * r; }
            }
        }
    }
};
struct Epi3 {
    static constexpr bool PERM = true, AFTER_DRAIN = false;
    const LAS3 float* tab; bf16* MIX; bf16* GLU; bf16* XD; mutable int ui;
    __device__ __forceinline__ void operator()(const f32x4 (&acc)[2][2][4][2], const Unit& u, int wr, int wc, int fr, int fq) const {
        const int row0 = u.pm * 256 + wr * 64 + fr, pn = u.pn, cl = wc * 32 + 8 * fq;
        float rs[2][4];
#pragma unroll
        for (int ai = 0; ai < 2; ++ai)
#pragma unroll
            for (int m = 0; m < 4; ++m) rs[ai][m] = tab[ui * 256 + ai * 128 + wr * 64 + m * 16 + fr];
        ++ui;
        if (pn < 8) {
#pragma unroll
            for (int ai = 0; ai < 2; ++ai)
#pragma unroll
                for (int m = 0; m < 4; ++m) { bf16* rp = GLU + (size_t)(row0 + ai * 128 + m * 16) * 1024 + pn * 128 + cl; const float r = rs[ai][m];
                    f32x4 o[2];
#pragma unroll
                    for (int n = 0; n < 2; ++n) { const f32x4 aa = acc[ai][0][m][n] * r, bb = acc[ai][1][m][n] * r;
#pragma unroll
                        for (int j = 0; j < 4; ++j) o[n][j] = aa[j] * sigmoidf_(bb[j]); }
                    *(u32x4*)rp = pack8(o[0], o[1]); }
        } else if (pn >= 12 && pn < 16) {
#pragma unroll
            for (int ai = 0; ai < 2; ++ai)
#pragma unroll
                for (int m = 0; m < 4; ++m) { bf16* rp = XD + (size_t)(row0 + ai * 128 + m * 16) * 1024 + (pn - 12) * 256 + cl; const float r = rs[ai][m];
#pragma unroll
                    for (int bj = 0; bj < 2; ++bj) *(u32x4*)(rp + bj * 128) = pack8(acc[ai][bj][m][0] * r, acc[ai][bj][m][1] * r); }
        } else {
            const int cb = pn < 12 ? (pn - 8) * 256 : 1024 + (pn - 16) * 256;
#pragma unroll
            for (int ai = 0; ai < 2; ++ai)
#pragma unroll
                for (int m = 0; m < 4; ++m) { bf16* rp = MIX + (size_t)(row0 + ai * 128 + m * 16) * 2048 + cb + cl; const float r = rs[ai][m];
#pragma unroll
                    for (int bj = 0; bj < 2; ++bj) { f32x4 v0 = acc[ai][bj][m][0] * r, v1 = acc[ai][bj][m][1] * r;
#pragma unroll
                        for (int j = 0; j < 4; ++j) { v0[j] = siluf_(v0[j]); v1[j] = siluf_(v1[j]); }
                        *(u32x4*)(rp + bj * 128) = pack8(v0, v1); } }
        }
    }
};
template <bool L0> struct EpiOut {
    static constexpr bool PERM = false, AFTER_DRAIN = true;
    const float* xold; bf16* XN; bf16* X2; float* ss;
    __device__ __forceinline__ void operator()(const f32x4 (&)[2][2][4][2], const Unit&, int, int, int, int) const {}
    __device__ __forceinline__ void fused(f32x4 (&acc)[2][2][4][2], const Unit& u, int wr, int wc, int fr, int fq, PG8_LAS unsigned char* lds, int wid, int lane) const {
        const int col0 = u.pn * 256 + wc * 32 + 4 * fq;
        PG8_LAS float* red = (PG8_LAS float*)lds;
        f32x4 xo[3][4]; u32x2 xb[3][4];
#define EPO_OFF(G) ((size_t)(u.pm * 256 + ((G) >> 2) * 128 + wr * 64 + ((G) & 3) * 16 + fr) * 1024 + col0)
#define EPO_LOAD(G) do { const size_t off_ = EPO_OFF(G); _Pragma("unroll") for (int bj = 0; bj < 2; ++bj) _Pragma("unroll") for (int n = 0; n < 2; ++n) { \
            if (L0) xo[(G) % 3][bj * 2 + n] = __builtin_nontemporal_load((const f32x4*)(xold + off_ + bj * 128 + n * 16)); else xb[(G) % 3][bj * 2 + n] = *(const u32x2*)(XN + off_ + bj * 128 + n * 16); } } while (0)
        EPO_LOAD(0); EPO_LOAD(1);
#pragma unroll
        for (int gq = 0; gq < 8; ++gq) {
            const int ai = gq >> 2, m = gq & 3;
            if (gq + 2 < 8) EPO_LOAD(gq + 2);
            const int rl = ai * 128 + wr * 64 + m * 16 + fr; const size_t off = EPO_OFF(gq); float q = 0.f;
#pragma unroll
            for (int bj = 0; bj < 2; ++bj)
#pragma unroll
                for (int n = 0; n < 2; ++n) { const size_t o2 = off + bj * 128 + n * 16;
                    if (L0) { const f32x4 v = xo[gq % 3][bj * 2 + n] + acc[ai][bj][m][n];
                        u32x2 w; w.x = pk2(v[0], v[1]); w.y = pk2(v[2], v[3]); *(u32x2*)(XN + o2) = w;
                        q += (v[0] * v[0] + v[1] * v[1]) + (v[2] * v[2] + v[3] * v[3]); }
                    else { const u32x2 xw = xb[gq % 3][bj * 2 + n]; const f32x4 v = (f32x4){bflo(xw.x), bfhi(xw.x), bflo(xw.y), bfhi(xw.y)} + acc[ai][bj][m][n]; u32x2 w; w.x = pk2(v[0], v[1]); w.y = pk2(v[2], v[3]); *(u32x2*)(X2 + o2) = w; } }
            if (L0) { q += __shfl_xor(q, 16); q += __shfl_xor(q, 32); if (fq == 0) red[rl * 4 + wc] = q; }
        }
#undef EPO_LOAD
#undef EPO_OFF
        if (L0) {
            __syncthreads();
            const int t = wid * 64 + lane;
            if (t < 256) ss[(size_t)u.pn * MP + u.pm * 256 + t] = (red[t * 4 + 0] + red[t * 4 + 1]) + (red[t * 4 + 2] + red[t * 4 + 3]);
        }
    }
};

template <int MODE> __device__ __forceinline__ int src_col(int n) {
    const int tile = n >> 8, cl = n & 255;
    if (MODE == 1) {
        if (tile < 10) return n;
        if (tile < 18) { const int q = tile - 10; return cl < 128 ? 2576 + 128 * q + cl : 4624 + 128 * q + (cl - 128); }
        if (tile < 22) return 3600 + (n - 18 * 256);
        return cl < 16 ? 2560 + cl : -1;
    } else if (MODE == 3) {
        if (tile < 8) return cl < 128 ? 128 * tile + cl : 1024 + 128 * tile + (cl - 128);
        return n;
    }
    return n;
}
template <int MODE> __device__ __forceinline__ void transpose_item(const float* W, int K, int Nsrc, bf16* WT, const float* kscale, float* scr, int item, int nblk, int lane) {
    const int kb = item / nblk, nb = item % nblk, k0 = 64 * kb, n0 = 32 * nb;
    const int sc = src_col<MODE>(n0 + (lane & 31));
    float tv[32];
#pragma unroll
    for (int i = 0; i < 32; ++i) { const int kk = 2 * i + (lane >> 5); tv[i] = sc >= 0 ? __builtin_nontemporal_load(W + (size_t)(k0 + kk) * Nsrc + sc) : 0.f; }
    if (kscale != nullptr && k0 < 1024) {
#pragma unroll
        for (int i = 0; i < 32; ++i) tv[i] *= kscale[k0 + 2 * i + (lane >> 5)];
    }
#pragma unroll
    for (int i = 0; i < 32; ++i) scr[(2 * i + (lane >> 5)) * 33 + (lane & 31)] = tv[i];
    asm volatile("s_waitcnt lgkmcnt(0)" ::: "memory");
    const int c = lane & 7;
#pragma unroll
    for (int j = 0; j < 4; ++j) { const int n = (lane >> 3) + 8 * j; const float* s = scr + (8 * c) * 33 + n;
        u32x4 o; o.x = pk2(s[0 * 33], s[1 * 33]); o.y = pk2(s[2 * 33], s[3 * 33]); o.z = pk2(s[4 * 33], s[5 * 33]); o.w = pk2(s[6 * 33], s[7 * 33]);
        *(u32x4*)(WT + (size_t)(n0 + n) * K + k0 + 8 * c) = o; }
    asm volatile("s_waitcnt lgkmcnt(0)" ::: "memory");
}
__device__ __forceinline__ void p0_prologue(const Ctx& c, unsigned char* sm) {
    const int tid = threadIdx.x, lane = tid & 63, wave = tid >> 6;
    const int gw = blockIdx.x * 8 + wave, NGW = gridDim.x * 8;
    float* scr = (float*)(sm + wave * 16384);
    if (blockIdx.x == 0 && tid < 8) c.xcnt[tid] = 0u;
    constexpr int I1 = 16 * (N1 / 32), I2 = 32 * 32, I3 = 16 * (N3 / 32), I4 = 32 * 32;
    for (int it = gw; it < I1 + I2 + I3 + I4; it += NGW) {
        int r = it;
        if (r < I1) { transpose_item<1>(c.w_in_even, 1024, 5648, c.W1t, nullptr, scr, r, N1 / 32, lane); continue; } r -= I1;
        if (r < I2) { transpose_item<0>(c.w_out_even, 2048, 1024, c.W2t, c.ssd_norm, scr, r, 32, lane); continue; } r -= I2;
        if (r < I3) { transpose_item<3>(c.w_in_odd, 1024, 5120, c.W3t, c.norm_odd, scr, r, N3 / 32, lane); continue; } r -= I3;
        transpose_item<0>(c.w_out_odd, 2048, 1024, c.W4t, nullptr, scr, r, 32, lane);
    }
    {
        f32x4 gq[4];
#pragma unroll
        for (int j = 0; j < 4; ++j) gq[j] = ((const f32x4*)c.norm_even)[lane + 64 * j];
        for (int m0 = gw; m0 < MP; m0 += 4 * NGW) {
            f32x4 v[4][4];
#pragma unroll
            for (int r = 0; r < 4; ++r) { const int m = m0 + r * NGW;
                if (m < NT) { const float* xr = m < NP ? c.x_prompt + (size_t)m * 1024 : c.x_sample + (size_t)(m - NP) * 1024;
#pragma unroll
                    for (int j = 0; j < 4; ++j) v[r][j] = __builtin_nontemporal_load((const f32x4*)xr + lane + 64 * j); } }
#pragma unroll
            for (int r = 0; r < 4; ++r) { const int m = m0 + r * NGW;
                if (m < MP) {
                    unsigned long long* o8 = (unsigned long long*)(c.XN + (size_t)m * 1024) + lane;
                    if (m < NT) {
                        float s = 0.f;
#pragma unroll
                        for (int j = 0; j < 4; ++j) s += (v[r][j][0] * v[r][j][0] + v[r][j][1] * v[r][j][1]) + (v[r][j][2] * v[r][j][2] + v[r][j][3] * v[r][j][3]);
                        const float rstd = rsqrtf(wave_sum(s) * (1.f / 1024.f) + EPS);
#pragma unroll
                        for (int j = 0; j < 4; ++j) { const f32x4 g = gq[j] * rstd; o8[64 * j] = (unsigned long long)pk2(v[r][j][0] * g[0], v[r][j][1] * g[1]) | ((unsigned long long)pk2(v[r][j][2] * g[2], v[r][j][3] * g[3]) << 32); }
                    } else {
#pragma unroll
                        for (int j = 0; j < 4; ++j) o8[64 * j] = 0ull;
                    }
                    if (m >= NP && lane < 4) c.ss1[(size_t)lane * MP + m] = 0.f;
                } }
        }
    }
}

__device__ __forceinline__ void bc_prepass_unit(const Ctx& c, int u, unsigned char* sm) {
    const int tid = threadIdx.x, lane = tid & 63, w = tid >> 6, fr = lane & 15, fq = lane >> 4;
    const int b = u >> 5, ck = (u >> 1) & 15, g = u & 1, t0 = ck * 128;
    constexpr int RS = 272;
    unsigned char* Bn = sm; unsigned char* Cn = sm + 34816;
    const int oc = tid & 31, run = tid >> 5;
    const int ch = oc < 16 ? 1024 + g * 128 + oc * 8 : 1280 + g * 128 + (oc - 16) * 8;
    u32x4 raw[11];
#pragma unroll
    for (int j = 0; j < 11; ++j) { const int t = t0 + run * 8 - 3 + j; raw[j] = (t >= 0) ? *(const u32x4*)(c.XBC + (size_t)(b * SEQ + t) * 1536 + ch) : (u32x4){0u, 0u, 0u, 0u}; }
    unsigned char* nat = (oc < 16 ? Bn : Cn) + (oc & 15) * 16;
#pragma unroll
    for (int hf = 0; hf < 2; ++hf) {
        f32x4 wk[5];
#pragma unroll
        for (int k = 0; k < 4; ++k) wk[k] = *(const f32x4*)(c.ssd_conv_w + k * 1536 + ch + 4 * hf);
        wk[4] = *(const f32x4*)(c.ssd_conv_b + ch + 4 * hf);
        float v[8][4];
#pragma unroll
        for (int i = 0; i < 8; ++i)
#pragma unroll
            for (int e = 0; e < 4; ++e) { const int ee = 4 * hf + e; float s = wk[4][e];
#pragma unroll
                for (int k = 0; k < 4; ++k) { const unsigned wd = raw[i + k][ee >> 1]; s += wk[k][e] * ((ee & 1) ? bfhi(wd) : bflo(wd)); }
                v[i][e] = siluf_(s); }
#pragma unroll
        for (int i = 0; i < 8; ++i) { u32x2 o; o.x = pk2(v[i][0], v[i][1]); o.y = pk2(v[i][2], v[i][3]); *(u32x2*)(nat + (8 * run + i) * RS + hf * 8) = o;
            if (oc >= 16) *(u32x2*)(c.BCn + (size_t)(b * SEQ + t0 + 8 * run + i) * 512 + 256 + g * 128 + (oc - 16) * 8 + 4 * hf) = o; }
        if (oc < 16) {
#pragma unroll
            for (int e = 0; e < 4; ++e) *(u32x4*)(c.BTg + ((size_t)((b * 16 + ck) * 2 + g) * 128 + oc * 8 + 4 * hf + e) * 128 + run * 8) = pack8((f32x4){v[0][e], v[1][e], v[2][e], v[3][e]}, (f32x4){v[4][e], v[5][e], v[6][e], v[7][e]});
        }
    }
    __syncthreads();
    {
        bf16x8 cf[4];
#pragma unroll
        for (int kk = 0; kk < 4; ++kk) cf[kk] = *(const bf16x8*)(Cn + (16 * w + fr) * RS + (kk * 32 + fq * 8) * 2);
        for (int j = 0; j <= w; ++j) {
            bf16x8 bf[4];
#pragma unroll
            for (int kk = 0; kk < 4; ++kk) bf[kk] = *(const bf16x8*)(Bn + (16 * j + fr) * RS + (kk * 32 + fq * 8) * 2);
            f32x4 gt = (f32x4){0.f, 0.f, 0.f, 0.f};
#pragma unroll
            for (int kk = 0; kk < 4; ++kk) gt = __builtin_amdgcn_mfma_f32_16x16x32_bf16(bf[kk], cf[kk], gt, 0, 0, 0);
            unsigned r_[4];
#pragma unroll
            for (int e = 0; e < 4; ++e) { const unsigned ub = __float_as_uint(gt[e]); r_[e] = (ub + 0x7fffu + ((ub >> 16) & 1u)) >> 16; }
            u32x2 o; o.x = r_[0] | (r_[1] << 16); o.y = r_[2] | (r_[3] << 16);
            *(u32x2*)(c.Gg + ((size_t)((u * 8 + w) * 8 + j) * 64 + lane) * 4) = o;
        }
    }
    __syncthreads();
}

__device__ __forceinline__ void ssd_chunk_unit(const Ctx& c, int u, unsigned char* sm) {
    const int tid = threadIdx.x, lane = tid & 63, w = tid >> 6, fr = lane & 15, fq = lane >> 4;
    const int pair = u >> 4, sub = u & 15;
    const int b = pair >> 1, g = pair & 1, h = g * 8 + (sub >> 1), ph = sub & 1;
    constexpr int RS = 272;
    unsigned char* Cn = sm + 34816;
    unsigned char* BT = sm + 69632;
    unsigned char* XT = sm + 104448;
    unsigned char* XdT = sm + 113152;
    unsigned char* Sb = sm + 121856;
    unsigned char* Xn = sm + 130560;
    float* csA = (float*)(sm + 138752);
    float* dtA = (float*)(sm + 139776);
    float* wx = (float*)(sm + 140800);
    const int ox = tid & 3, lx = tid >> 2;
    const int chx = h * 64 + ph * 32 + ox * 8;
    if (tid < 160) { const int k = tid >> 5, cc = tid & 31; wx[tid] = k < 4 ? c.ssd_conv_w[k * 1536 + h * 64 + ph * 32 + cc] : c.ssd_conv_b[h * 64 + ph * 32 + cc]; }
    const float a_h = -__expf(c.ssd_a_log[h]), dtb = c.ssd_dt_bias[h], Dh = c.ssd_d[h];
    f32x4 accS[2];
    accS[0] = (f32x4){0.f, 0.f, 0.f, 0.f}; accS[1] = accS[0];
    u32x4 rC[4], rT[4], rx[4]; u32x2 zz[2], gG[8]; float dr0 = 0.f, dr1 = 0.f;
#pragma unroll
    for (int j = 0; j < 8; ++j) gG[j] = (u32x2){0u, 0u};
    const int lrow = 16 * w + fr;
    const int prow = tid >> 4, pc16 = tid & 15;
#define SSD_LOAD_B(CK) do { const size_t gu_ = (size_t)(((b * 16 + (CK)) * 2 + g) * 8 + w) * 8; \
        _Pragma("unroll") for (int j = 0; j < 8; ++j) { if (j <= w) gG[j] = *(const u32x2*)(c.Gg + ((gu_ + j) * 64 + lane) * 4); } } while (0)
#define SSD_LOAD_C(CK) do { const int t0_ = (CK) * 128; \
        _Pragma("unroll") for (int i = 0; i < 4; ++i) rC[i] = *(const u32x4*)(c.BCn + (size_t)(b * SEQ + t0_ + prow + 32 * i) * 512 + 256 + g * 128 + pc16 * 8); } while (0)
#define SSD_LOAD_T(CK) do { \
        _Pragma("unroll") for (int i = 0; i < 4; ++i) rT[i] = *(const u32x4*)(c.BTg + ((size_t)((b * 16 + (CK)) * 2 + g) * 128 + prow + 32 * i) * 128 + pc16 * 8); } while (0)
#define SSD_LOAD_X(CK) do { const int t0_ = (CK) * 128; \
        _Pragma("unroll") for (int j = 0; j < 4; ++j) { const int t = t0_ + lx - 3 + j; rx[j] = (t >= 0) ? *(const u32x4*)(c.XBC + (size_t)(b * SEQ + t) * 1536 + chx) : (u32x4){0u, 0u, 0u, 0u}; } \
        _Pragma("unroll") for (int pt = 0; pt < 2; ++pt) zz[pt] = *(const u32x2*)(c.MIX + (size_t)(b * SEQ + t0_ + lrow) * 2048 + h * 64 + ph * 32 + pt * 16 + 4 * fq); } while (0)
#define SSD_LOAD(CK) do { SSD_LOAD_B(CK); SSD_LOAD_C(CK); SSD_LOAD_T(CK); SSD_LOAD_X(CK); } while (0)
#define SSD_LOAD_DT(CK) do { if (tid < 64) { const size_t r = (size_t)(b * SEQ + (CK) * 128 + 2 * tid) * 16 + h; dr0 = c.DT[r]; dr1 = c.DT[r + 16]; } } while (0)
#define SSD_CUMSUM(BUF) do { if (tid < 64) { const float d0 = softplusf_(dr0 + dtb), d1 = softplusf_(dr1 + dtb); const float a1 = d1 * a_h; float s = d0 * a_h + a1; \
        _Pragma("unroll") for (int o = 1; o < 64; o <<= 1) { const float v = __shfl_up(s, o); if (lane >= o) s += v; } \
        csA[(BUF) * 128 + 2 * tid + 1] = s; csA[(BUF) * 128 + 2 * tid] = s - a1; dtA[(BUF) * 128 + 2 * tid] = d0; dtA[(BUF) * 128 + 2 * tid + 1] = d1; } } while (0)
    SSD_LOAD_DT(0);
    SSD_LOAD(0);
    SSD_CUMSUM(0);
    __syncthreads();
    for (int ck = 0; ck < 16; ++ck) {
        const int t0 = ck * 128;
        const float* cs = csA + (ck & 1) * 128; const float* dts = dtA + (ck & 1) * 128;
        if (ck < 15) SSD_LOAD_DT(ck + 1);
        {
#pragma unroll
            for (int pt = 0; pt < 2; ++pt)
#pragma unroll
                for (int e = 0; e < 4; ++e) *(bf16*)(Sb + (pt * 16 + 4 * fq + e) * RS + (16 * w + fr) * 2) = (bf16)pk2(accS[pt][e], 0.f);
        }
#pragma unroll
        for (int i = 0; i < 4; ++i) { *(u32x4*)(Cn + (prow + 32 * i) * RS + pc16 * 16) = rC[i]; *(u32x4*)(BT + (prow + 32 * i) * RS + pc16 * 16) = rT[i]; }
        {
            const float dl = dts[lx], ddl = dl * __expf(cs[127] - cs[lx]);
            float v[8];
#pragma unroll
            for (int hf = 0; hf < 2; ++hf) {
                f32x4 wk[5];
#pragma unroll
                for (int k = 0; k < 5; ++k) wk[k] = *(const f32x4*)(wx + k * 32 + ox * 8 + 4 * hf);
#pragma unroll
                for (int e = 0; e < 4; ++e) { const int ee = 4 * hf + e; float s = wk[4][e];
#pragma unroll
                    for (int k = 0; k < 4; ++k) { const unsigned wd = rx[k][ee >> 1]; s += wk[k][e] * ((ee & 1) ? bfhi(wd) : bflo(wd)); }
                    v[ee] = siluf_(s); }
            }
            *(u32x4*)(Xn + lx * 64 + ox * 16) = pack8((f32x4){v[0], v[1], v[2], v[3]}, (f32x4){v[4], v[5], v[6], v[7]});
#pragma unroll
            for (int e = 0; e < 8; ++e) { *(bf16*)(XT + (ox * 8 + e) * RS + lx * 2) = (bf16)pk2(v[e] * dl, 0.f); *(bf16*)(XdT + (ox * 8 + e) * RS + lx * 2) = (bf16)pk2(v[e] * ddl, 0.f); }
        }
        __syncthreads();
        const u32x2 zc0 = zz[0], zc1 = zz[1];
        u32x2 gC[8];
#pragma unroll
        for (int j = 0; j < 8; ++j) gC[j] = gG[j];
        if (ck < 15) SSD_LOAD_B(ck + 1);
        __builtin_amdgcn_sched_barrier(0);
        {
            const int l = lrow;
            const float csl = cs[l];
            bf16x8 cf[4];
#pragma unroll
            for (int kk = 0; kk < 4; ++kk) cf[kk] = *(const bf16x8*)(Cn + l * RS + (kk * 32 + fq * 8) * 2);
            f32x4 aoff[2], adiag[2];
            {
                bf16x8 sf[2][4];
#pragma unroll
                for (int pt = 0; pt < 2; ++pt)
#pragma unroll
                    for (int kk = 0; kk < 4; ++kk) sf[pt][kk] = *(const bf16x8*)(Sb + (pt * 16 + fr) * RS + (kk * 32 + fq * 8) * 2);
                aoff[0] = (f32x4){0.f, 0.f, 0.f, 0.f}; aoff[1] = aoff[0]; adiag[0] = aoff[0]; adiag[1] = aoff[0];
#pragma unroll
                for (int kk = 0; kk < 4; ++kk) { aoff[0] = __builtin_amdgcn_mfma_f32_16x16x32_bf16(sf[0][kk], cf[kk], aoff[0], 0, 0, 0); aoff[1] = __builtin_amdgcn_mfma_f32_16x16x32_bf16(sf[1][kk], cf[kk], aoff[1], 0, 0, 0); }
            }
            __builtin_amdgcn_sched_barrier(0);
            if (ck < 15) SSD_LOAD_C(ck + 1);
            __builtin_amdgcn_sched_barrier(0);
#pragma unroll
            for (int jp = 0; jp < 4; ++jp) if (jp <= (w >> 1)) {
                const int j0 = 2 * jp, j1 = 2 * jp + 1;
                const u32x2 ga = gC[2 * jp], gb = gC[2 * jp + 1];
                const f32x4 g0 = (f32x4){bflo(ga.x), bfhi(ga.x), bflo(ga.y), bfhi(ga.y)}, g1 = (f32x4){bflo(gb.x), bfhi(gb.x), bflo(gb.y), bfhi(gb.y)};
                const u32x2 xa0 = *(const u32x2*)(XT + fr * RS + (16 * j0 + 4 * fq) * 2), xb0 = *(const u32x2*)(XT + fr * RS + (16 * j1 + 4 * fq) * 2);
                const u32x2 xa1 = *(const u32x2*)(XT + (16 + fr) * RS + (16 * j0 + 4 * fq) * 2), xb1 = *(const u32x2*)(XT + (16 + fr) * RS + (16 * j1 + 4 * fq) * 2);
                const f32x4 cs0 = *(const f32x4*)(cs + 16 * j0 + 4 * fq), cs1 = *(const f32x4*)(cs + 16 * j1 + 4 * fq);
                f32x4 m0, m1;
#pragma unroll
                for (int e = 0; e < 4; ++e) { const int s0 = 16 * j0 + 4 * fq + e, s1 = 16 * j1 + 4 * fq + e;
                    m0[e] = (s0 <= l) ? g0[e] * __expf(csl - cs0[e]) : 0.f; m1[e] = (s1 <= l) ? g1[e] * __expf(csl - cs1[e]) : 0.f; }
                const bf16x8 mB = __builtin_bit_cast(bf16x8, pack8(m0, m1));
                { u32x4 xv; xv.x = xa0.x; xv.y = xa0.y; xv.z = xb0.x; xv.w = xb0.y; adiag[0] = __builtin_amdgcn_mfma_f32_16x16x32_bf16(__builtin_bit_cast(bf16x8, xv), mB, adiag[0], 0, 0, 0); }
                { u32x4 xv; xv.x = xa1.x; xv.y = xa1.y; xv.z = xb1.x; xv.w = xb1.y; adiag[1] = __builtin_amdgcn_mfma_f32_16x16x32_bf16(__builtin_bit_cast(bf16x8, xv), mB, adiag[1], 0, 0, 0); }
            }
            __builtin_amdgcn_sched_barrier(0);
            if (ck < 15) SSD_LOAD_T(ck + 1);
            __builtin_amdgcn_sched_barrier(0);
            const float decT = __expf(cs[127]);
            {
                bf16x8 xf[2][4], tf[4];
#pragma unroll
                for (int kk = 0; kk < 4; ++kk) { tf[kk] = *(const bf16x8*)(BT + (16 * w + fr) * RS + (kk * 32 + fq * 8) * 2); xf[0][kk] = *(const bf16x8*)(XdT + fr * RS + (kk * 32 + fq * 8) * 2); xf[1][kk] = *(const bf16x8*)(XdT + (16 + fr) * RS + (kk * 32 + fq * 8) * 2); }
                accS[0] *= decT; accS[1] *= decT;
#pragma unroll
                for (int kk = 0; kk < 4; ++kk) { accS[0] = __builtin_amdgcn_mfma_f32_16x16x32_bf16(xf[0][kk], tf[kk], accS[0], 0, 0, 0); accS[1] = __builtin_amdgcn_mfma_f32_16x16x32_bf16(xf[1][kk], tf[kk], accS[1], 0, 0, 0); }
            }
            __builtin_amdgcn_sched_barrier(0);
            if (ck < 15) SSD_LOAD_X(ck + 1);
            __builtin_amdgcn_sched_barrier(0);
            const int row = b * SEQ + t0 + l;
            const float el = __expf(csl);
            float q = 0.f;
#pragma unroll
            for (int pt = 0; pt < 2; ++pt) {
                const u32x2 xr = *(const u32x2*)(Xn + l * 64 + (pt * 16 + 4 * fq) * 2);
                bf16* p = c.MIX + (size_t)row * 2048 + h * 64 + ph * 32 + pt * 16 + 4 * fq;
                const u32x2 zv = pt == 0 ? zc0 : zc1;
                const float y0 = (adiag[pt][0] + el * aoff[pt][0] + Dh * bflo(xr.x)) * bflo(zv.x);
                const float y1 = (adiag[pt][1] + el * aoff[pt][1] + Dh * bfhi(xr.x)) * bfhi(zv.x);
                const float y2 = (adiag[pt][2] + el * aoff[pt][2] + Dh * bflo(xr.y)) * bflo(zv.y);
                const float y3 = (adiag[pt][3] + el * aoff[pt][3] + Dh * bfhi(xr.y)) * bfhi(zv.y);
                u32x2 wv; wv.x = pk2(y0, y1); wv.y = pk2(y2, y3); *(u32x2*)p = wv;
                q += (y0 * y0 + y1 * y1) + (y2 * y2 + y3 * y3);
            }
            q += __shfl_xor(q, 16); q += __shfl_xor(q, 32);
            if (fq == 0) c.ssg[((size_t)(g * 16 + (h & 7) * 2 + ph)) * NP + row] = q;
        }
        if (ck < 15) SSD_CUMSUM((ck + 1) & 1);
        __syncthreads();
    }
#undef SSD_LOAD
#undef SSD_LOAD_B
#undef SSD_LOAD_C
#undef SSD_LOAD_T
#undef SSD_LOAD_X
#undef SSD_LOAD_DT
#undef SSD_CUMSUM
#pragma unroll
    for (int pt = 0; pt < 2; ++pt)
#pragma unroll
        for (int e = 0; e < 4; ++e) __builtin_nontemporal_store(accS[pt][e], c.out + O_SSM_P + ((size_t)(b * 16 + h) * 64 + ph * 32 + pt * 16 + 4 * fq + e) * 128 + 16 * w + fr);
}

__device__ __forceinline__ void gmlp_unit(const Ctx& c, int u, unsigned char* sm) {
    const int tid = threadIdx.x, lane = tid & 63, w = tid >> 6, fr = lane & 15, fq = lane >> 4;
    const int b = u >> 5, ck = (u >> 1) & 15, gh = u & 1;
    const int r0 = b * SEQ + ck * 128;
    float* stat = (float*)sm;
    unsigned char* vbase = sm + 1024;
    {
        u32x4 gq[16][2];
#pragma unroll
        for (int i = 0; i < 16; ++i) { const u32x4* gp = (const u32x4*)(c.GV + (size_t)(r0 + w * 16 + i) * 1024 + lane * 16); gq[i][0] = gp[0]; gq[i][1] = gp[1]; }
#pragma unroll
        for (int i = 0; i < 16; ++i) {
            const int tk = w * 16 + i;
            float f0[8], f1[8]; unpack8(gq[i][0], f0); unpack8(gq[i][1], f1);
            float s = 0.f, q = 0.f;
#pragma unroll
            for (int e = 0; e < 8; ++e) { s += f0[e] + f1[e]; q += f0[e] * f0[e] + f1[e] * f1[e]; }
            s = wave_sum(s); q = wave_sum(q);
            if (lane == 0) { const float mean = s * (1.f / 1024.f); const float var = fmaxf(q * (1.f / 1024.f) - mean * mean, 0.f); stat[tk * 2] = mean; stat[tk * 2 + 1] = rsqrtf(var + EPS); }
        }
    }
    u32x4 gva[2], gvb[2];
#define GMLP_LOADV(GRP) do { _Pragma("unroll") for (int it = 0; it < 2; ++it) { const int item = tid + 512 * it, sp = item & 63, d8 = item >> 6; \
        gva[it] = *(const u32x4*)(c.GV + (size_t)(r0 + 2 * sp) * 1024 + (GRP) * 128 + d8 * 8); gvb[it] = *(const u32x4*)(c.GV + (size_t)(r0 + 2 * sp + 1) * 1024 + (GRP) * 128 + d8 * 8); } } while (0)
    GMLP_LOADV(gh * 4);
    __syncthreads();
    for (int gi = 0; gi < 4; ++gi) {
        const int grp = gh * 4 + gi;
        unsigned char* vnT = vbase + (gi & 1) * 34816;
        const int t = 16 * w + fr, nk = (w >> 1) + 1;
        const float* wrow = c.gmlp_w_s + ((size_t)grp * 128 + t) * 128;
        f32x4 wq[4][2];
#pragma unroll
        for (int kk = 0; kk < 4; ++kk) { if (kk < nk) { wq[kk][0] = *(const f32x4*)(wrow + kk * 32 + fq * 8); wq[kk][1] = *(const f32x4*)(wrow + kk * 32 + fq * 8 + 4); } else { wq[kk][0] = (f32x4){0.f, 0.f, 0.f, 0.f}; wq[kk][1] = wq[kk][0]; } }
        bf16* mp = c.MIX + (size_t)(r0 + t) * 2048 + 1024 + grp * 128 + 4 * fq;
        u32x2 ugv[8];
#pragma unroll
        for (int dt = 0; dt < 8; ++dt) ugv[dt] = *(const u32x2*)(mp + dt * 16);
        const float bs = c.gmlp_b_s[grp * 128 + t];
#pragma unroll
        for (int it = 0; it < 2; ++it) {
            const int item = tid + 512 * it, sp = item & 63, d8 = item >> 6;
            const int s0 = 2 * sp, chn = grp * 128 + d8 * 8;
            float a[8], bq[8]; unpack8(gva[it], a); unpack8(gvb[it], bq);
            const float m0 = stat[s0 * 2], rs0 = stat[s0 * 2 + 1], m1 = stat[s0 * 2 + 2], rs1 = stat[s0 * 2 + 3];
            const f32x4 lg0 = *(const f32x4*)(c.gmlp_ln_g + chn), lg1 = *(const f32x4*)(c.gmlp_ln_g + chn + 4), lb0 = *(const f32x4*)(c.gmlp_ln_b + chn), lb1 = *(const f32x4*)(c.gmlp_ln_b + chn + 4);
#pragma unroll
            for (int e = 0; e < 8; ++e) { const float lg = e < 4 ? lg0[e & 3] : lg1[e & 3], lb = e < 4 ? lb0[e & 3] : lb1[e & 3];
                const float v0 = (a[e] - m0) * rs0 * lg + lb, v1 = (bq[e] - m1) * rs1 * lg + lb;
                *(unsigned*)(vnT + (d8 * 8 + e) * 272 + sp * 4) = pk2(v0, v1); }
        }
        if (gi < 3) GMLP_LOADV(grp + 1);
        __syncthreads();
        f32x4 acc[8];
#pragma unroll
        for (int dt = 0; dt < 8; ++dt) acc[dt] = (f32x4){0.f, 0.f, 0.f, 0.f};
#pragma unroll
        for (int kk = 0; kk < 4; ++kk) {
            if (kk < nk) {
                const int sb = kk * 32 + fq * 8;
                f32x4 m0, m1;
#pragma unroll
                for (int e = 0; e < 4; ++e) { m0[e] = (sb + e <= t) ? wq[kk][0][e] : 0.f; m1[e] = (sb + 4 + e <= t) ? wq[kk][1][e] : 0.f; }
                const bf16x8 wf = __builtin_bit_cast(bf16x8, pack8(m0, m1));
#pragma unroll
                for (int dt = 0; dt < 8; ++dt) {
                    const bf16x8 vf = *(const bf16x8*)(vnT + (dt * 16 + fr) * 272 + sb * 2);
                    acc[dt] = __builtin_amdgcn_mfma_f32_16x16x32_bf16(vf, wf, acc[dt], 0, 0, 0);
                }
            }
        }
#pragma unroll
        for (int dt = 0; dt < 8; ++dt) { const u32x2 ug = ugv[dt];
            u32x2 o; o.x = pk2((acc[dt][0] + bs) * bflo(ug.x), (acc[dt][1] + bs) * bfhi(ug.x)); o.y = pk2((acc[dt][2] + bs) * bflo(ug.y), (acc[dt][3] + bs) * bfhi(ug.y));
            *(u32x2*)(mp + dt * 16) = o; }
    }
#undef GMLP_LOADV
    __syncthreads();
}

__device__ __forceinline__ void sample_even_unit(const Ctx& c, int u, unsigned char* sm) {
    const int tid = threadIdx.x;
    const int bs = u >> 1, g = u & 1, row = NP + bs;
    float* xcs = (float*)sm;
    float* ygs = xcs + 768;
    float* red = ygs + 512;
    float* hsc = red + 8;
    const int p = tid >> 3, nq = tid & 7;
    f32x4 st[8][4];
#pragma unroll
    for (int hh = 0; hh < 8; ++hh)
#pragma unroll
        for (int j = 0; j < 4; ++j) st[hh][j] = __builtin_nontemporal_load((const f32x4*)(c.state_ssm + ((size_t)(bs * 16 + g * 8 + hh) * 64 + p) * 128 + j * 32 + nq * 4));
    const float* buf = c.state_ssd_conv + (size_t)bs * 3 * 1536;
    for (int i = tid; i < 768; i += 512) {
        const int ch = i < 512 ? g * 512 + i : (i < 640 ? 1024 + g * 128 + (i - 512) : 1280 + g * 128 + (i - 640));
        const float xn = bf2f(c.XBC[(size_t)row * 1536 + ch]);
        const float b0 = buf[ch], b1 = buf[1536 + ch], b2 = buf[2 * 1536 + ch];
        float s = c.ssd_conv_b[ch] + c.ssd_conv_w[ch] * b0 + c.ssd_conv_w[1536 + ch] * b1 + c.ssd_conv_w[2 * 1536 + ch] * b2 + c.ssd_conv_w[3 * 1536 + ch] * xn;
        xcs[i] = siluf_(s);
        float* so = c.out + O_SCONV_S + (size_t)bs * 3 * 1536;
        so[ch] = b1; so[1536 + ch] = b2; so[2 * 1536 + ch] = xn;
    }
    if (tid < 8) { const int h = g * 8 + tid; const float dt = softplusf_(c.DT[(size_t)row * 16 + h] + c.ssd_dt_bias[h]); hsc[tid * 4] = dt; hsc[tid * 4 + 1] = __expf(-dt * __expf(c.ssd_a_log[h])); hsc[tid * 4 + 2] = c.ssd_d[h]; }
    float zv[8];
    if (nq == 0) {
#pragma unroll
        for (int hh = 0; hh < 8; ++hh) zv[hh] = bf2f(c.MIX[(size_t)row * 2048 + (g * 8 + hh) * 64 + p]);
    }
    const unsigned gv2 = *(const unsigned*)(c.GV + (size_t)row * 1024 + 2 * tid);
    const int chn = g * 512 + tid, grp = chn >> 7;
    const float gvc = bf2f(c.GV[(size_t)row * 1024 + chn]), lng = c.gmlp_ln_g[chn], lnb = c.gmlp_ln_b[chn], ws0 = c.gmlp_w_s[(size_t)grp * 128 * 128], bs0 = c.gmlp_b_s[grp * 128];
    bf16* mpu = c.MIX + (size_t)row * 2048 + 1024 + chn;
    const float ugv = bf2f(*mpu);
    __syncthreads();
    f32x4 bv[4], cv[4];
#pragma unroll
    for (int j = 0; j < 4; ++j) { bv[j] = *(const f32x4*)(xcs + 512 + j * 32 + nq * 4); cv[j] = *(const f32x4*)(xcs + 640 + j * 32 + nq * 4); }
#pragma unroll
    for (int hh = 0; hh < 8; ++hh) {
        const int h = g * 8 + hh;
        const size_t so = ((size_t)(bs * 16 + h) * 64 + p) * 128 + nq * 4;
        const float dt = hsc[hh * 4], dA = hsc[hh * 4 + 1];
        const float xv = xcs[hh * 64 + p], dtx = dt * xv;
        float y = 0.f;
#pragma unroll
        for (int j = 0; j < 4; ++j) {
            f32x4 hn;
#pragma unroll
            for (int e = 0; e < 4; ++e) { hn[e] = dA * st[hh][j][e] + dtx * bv[j][e]; y += cv[j][e] * hn[e]; }
            __builtin_nontemporal_store(hn, (f32x4*)(c.out + O_SSM_S + so + 32 * j));
        }
        y += __shfl_xor(y, 1); y += __shfl_xor(y, 2); y += __shfl_xor(y, 4);
        if (nq == 0) { y += hsc[hh * 4 + 2] * xv; ygs[hh * 64 + p] = y * zv[hh]; }
    }
    __syncthreads();
    {
        const float v = ygs[tid];
        const float q = block_sum(v * v, red);
        c.MIX[(size_t)row * 2048 + g * 512 + tid] = (bf16)pk2(v * rsqrtf(q * (1.f / 512.f) + EPS), 0.f);
    }
    {
        const float a0 = bflo(gv2), a1 = bfhi(gv2);
        const float s = block_sum(a0 + a1, red);
        const float q = block_sum(a0 * a0 + a1 * a1, red);
        const float mean = s * (1.f / 1024.f), rstd = rsqrtf(fmaxf(q * (1.f / 1024.f) - mean * mean, 0.f) + EPS);
        const float vn = (gvc - mean) * rstd * lng + lnb;
        c.out[O_GV_S + (size_t)bs * 1024 + chn] = vn;
        *mpu = (bf16)pk2(ugv * (ws0 * vn + bs0), 0.f);
    }
    __syncthreads();
}

__device__ __forceinline__ void p2_even_mixers(const Ctx& c, unsigned char* sm) {
    const int G = gridDim.x, bx = blockIdx.x;
    for (int u = bx; u < 256; u += G) ssd_chunk_unit(c, u, sm);
    for (int u = bx; u < 256; u += G) gmlp_unit(c, u, sm);
    for (int u = bx; u < 256; u += G) sample_even_unit(c, u, sm);
    for (int i = bx * 512 + threadIdx.x; i < 8 * 3 * 1536; i += G * 512) { const int b = i / (3 * 1536), r = i % (3 * 1536), k = r / 1536, ch = r % 1536;
        c.out[O_SCONV_P + i] = bf2f(c.XBC[(size_t)(b * SEQ + SEQ - 3 + k) * 1536 + ch]); }
}

template <bool L0> __device__ __forceinline__ void sample_outproj(const bf16* A, const bf16* Wt, const float* xold, bf16* XNs, bf16* X2s, float* ss, unsigned char* sm) {
    const int tid = threadIdx.x, lane = tid & 63, w = tid >> 6, fr = lane & 15, fq = lane >> 4;
    f32x4* red = (f32x4*)sm;
    for (int u = blockIdx.x; u < 256; u += gridDim.x) {
        const int tg = u & 7, cgp = u >> 3;
        const bf16* ap = A + (size_t)(tg * 16 + fr) * 2048 + w * 256 + fq * 8;
        const bf16* bp0 = Wt + (size_t)(cgp * 32 + fr) * 2048 + w * 256 + fq * 8;
        const bf16* bp1 = bp0 + 16 * 2048;
        f32x4 a0 = (f32x4){0.f, 0.f, 0.f, 0.f}, a1 = a0;
#pragma unroll
        for (int kk = 0; kk < 8; ++kk) {
            const bf16x8 af = *(const bf16x8*)(ap + kk * 32), b0 = *(const bf16x8*)(bp0 + kk * 32), b1 = *(const bf16x8*)(bp1 + kk * 32);
            a0 = __builtin_amdgcn_mfma_f32_16x16x32_bf16(b0, af, a0, 0, 0, 0);
            a1 = __builtin_amdgcn_mfma_f32_16x16x32_bf16(b1, af, a1, 0, 0, 0);
        }
        red[(w * 2 + 0) * 64 + lane] = a0; red[(w * 2 + 1) * 64 + lane] = a1;
        __syncthreads();
        if (tid < 128) {
            const int ct = tid >> 6;
            f32x4 s = (f32x4){0.f, 0.f, 0.f, 0.f};
#pragma unroll
            for (int w2 = 0; w2 < 8; ++w2) s += red[(w2 * 2 + ct) * 64 + lane];
            const int trow = tg * 16 + fr, col = cgp * 32 + ct * 16 + 4 * fq;
            const size_t off = (size_t)trow * 1024 + col;
            if (L0) {
                const f32x4 v = *(const f32x4*)(xold + off) + s;
                u32x2 wv; wv.x = pk2(v[0], v[1]); wv.y = pk2(v[2], v[3]); *(u32x2*)(XNs + off) = wv;
                float q = (v[0] * v[0] + v[1] * v[1]) + (v[2] * v[2] + v[3] * v[3]);
                q += __shfl_xor(q, 16); q += __shfl_xor(q, 32);
                if (fq == 0) atomicAdd(ss + (size_t)(cgp >> 3) * MP + trow, q);
            } else {
                const u32x2 xw = *(const u32x2*)(XNs + off);
                const f32x4 v = (f32x4){bflo(xw.x), bfhi(xw.x), bflo(xw.y), bfhi(xw.y)} + s;
                u32x2 wv; wv.x = pk2(v[0], v[1]); wv.y = pk2(v[2], v[3]); *(u32x2*)(X2s + off) = wv;
            }
        }
        __syncthreads();
    }
}

__device__ __forceinline__ void ccv_unit(const Ctx& c, int u, unsigned char* sm) {
    const int tid = threadIdx.x, lane = tid & 63, wv = tid >> 6;
    const int b = u >> 5, t0 = (u & 31) * 64, ch = 2 * tid;
    float* red = (float*)sm;
    f32x2 w[31];
#pragma unroll
    for (int k = 0; k < 31; ++k) w[k] = *(const f32x2*)(c.ccv_w + k * 1024 + ch);
    const f32x2 bias = *(const f32x2*)(c.ccv_b + ch), lg = *(const f32x2*)(c.ccv_ln_g + ch), lb = *(const f32x2*)(c.ccv_ln_b + ch);
    unsigned gwin[38];
#pragma unroll
    for (int j = 0; j < 38; ++j) { const int t = t0 - 30 + j; gwin[j] = (t >= 0) ? *(const unsigned*)(c.GLU + (size_t)(b * SEQ + t) * 1024 + ch) : 0u; }
    for (int og = 0; og < 8; ++og) {
        unsigned nxt[8], gcv[8];
#pragma unroll
        for (int j = 0; j < 8; ++j) { gcv[j] = *(const unsigned*)(c.MIX + (size_t)(b * SEQ + t0 + og * 8 + j) * 2048 + ch);
            nxt[j] = (og < 7) ? *(const unsigned*)(c.GLU + (size_t)(b * SEQ + t0 + og * 8 + 8 + j) * 1024 + ch) : 0u; }
        f32x2 acc[8];
#pragma unroll
        for (int o = 0; o < 8; ++o) acc[o] = bias;
#pragma unroll
        for (int j = 0; j < 38; ++j) {
            const f32x2 gl = (f32x2){bflo(gwin[j]), bfhi(gwin[j])};
#pragma unroll
            for (int o = 0; o < 8; ++o) { const int k = j - o; if (k >= 0 && k <= 30) acc[o] += w[k] * gl; }
        }
        float* rb = red + (og & 1) * 512;
        {
            float mine = 0.f;
#pragma unroll
            for (int o = 0; o < 8; ++o) { const float s = row16_sum(acc[o][0] + acc[o][1]), q = row16_sum(acc[o][0] * acc[o][0] + acc[o][1] * acc[o][1]);
                mine = ((lane & 15) == o) ? s : mine; mine = ((lane & 15) == 8 + o) ? q : mine; }
            rb[(wv * 4 + (lane >> 4)) * 16 + (lane & 15)] = mine;
        }
        __syncthreads();
        float tot;
        {
            float s = 0.f;
#pragma unroll
            for (int i = 0; i < 8; ++i) s += rb[((lane >> 4) * 8 + i) * 16 + (lane & 15)];
            s += __shfl_xor(s, 16); s += __shfl_xor(s, 32);
            tot = s;
        }
#pragma unroll
        for (int o = 0; o < 8; ++o) {
            const float s = __builtin_bit_cast(float, __builtin_amdgcn_readlane(__builtin_bit_cast(int, tot), o)), q = __builtin_bit_cast(float, __builtin_amdgcn_readlane(__builtin_bit_cast(int, tot), 8 + o));
            const float mean = s * (1.f / 1024.f), rstd = rsqrtf(fmaxf(q * (1.f / 1024.f) - mean * mean, 0.f) + EPS);
            const float y0 = siluf_((acc[o][0] - mean) * rstd * lg[0] + lb[0]), y1 = siluf_((acc[o][1] - mean) * rstd * lg[1] + lb[1]);
            *(unsigned*)(c.MIX + (size_t)(b * SEQ + t0 + og * 8 + o) * 2048 + ch) = pk2(y0 * bflo(gcv[o]), y1 * bfhi(gcv[o]));
        }
#pragma unroll
        for (int j = 0; j < 30; ++j) gwin[j] = gwin[j + 8];
#pragma unroll
        for (int j = 0; j < 8; ++j) gwin[30 + j] = nxt[j];
    }
    __syncthreads();
}
__device__ __forceinline__ void ccv_sample_unit(const Ctx& c, int bs, unsigned char* sm) {
    const int tid = threadIdx.x, ch = 2 * tid, row = NP + bs;
    float* red = (float*)sm;
    const float* buf = c.state_ccv + (size_t)bs * 30 * 1024;
    const unsigned gw = *(const unsigned*)(c.GLU + (size_t)row * 1024 + ch);
    const f32x2 gl = (f32x2){bflo(gw), bfhi(gw)};
    f32x2 acc = *(const f32x2*)(c.ccv_b + ch);
    float* so = c.out + O_CCV_S + (size_t)bs * 30 * 1024;
    unsigned* mp = (unsigned*)(c.MIX + (size_t)row * 2048 + ch);
    const unsigned gc = *mp;
    const f32x2 lg = *(const f32x2*)(c.ccv_ln_g + ch), lb = *(const f32x2*)(c.ccv_ln_b + ch);
    f32x2 bvv[30], wv[31];
#pragma unroll
    for (int k = 0; k < 30; ++k) bvv[k] = __builtin_nontemporal_load((const f32x2*)(buf + k * 1024 + ch));
#pragma unroll
    for (int k = 0; k < 31; ++k) wv[k] = *(const f32x2*)(c.ccv_w + k * 1024 + ch);
#pragma unroll
    for (int k = 0; k < 30; ++k) acc += wv[k] * bvv[k];
    acc += wv[30] * gl;
#pragma unroll
    for (int k = 1; k < 30; ++k) __builtin_nontemporal_store(bvv[k], (f32x2*)(so + (k - 1) * 1024 + ch));
    *(f32x2*)(so + 29 * 1024 + ch) = gl;
    const float s = block_sum(acc[0] + acc[1], red);
    const float q = block_sum(acc[0] * acc[0] + acc[1] * acc[1], red);
    const float mean = s * (1.f / 1024.f), rstd = rsqrtf(fmaxf(q * (1.f / 1024.f) - mean * mean, 0.f) + EPS);
    const float y0 = siluf_((acc[0] - mean) * rstd * lg[0] + lb[0]), y1 = siluf_((acc[1] - mean) * rstd * lg[1] + lb[1]);
    *mp = pk2(y0 * bflo(gc), y1 * bfhi(gc));
    __syncthreads();
}

__device__ __forceinline__ float neg_expm1_fast(float x) {
    const float p = -x * (1.f + x * (0.5f + x * (0.16666667f + x * (0.041666668f + x * 0.0083333338f))));
    return x > -0.25f ? p : 1.f - __expf(x);
}
__device__ __forceinline__ void lru_unit(const Ctx& c, int u, unsigned char* sm) {
    const int tid = threadIdx.x, lane = tid & 63, w = tid >> 6, fr = lane & 15, fq = lane >> 4;
    const int pairi = (u & 7) * 16 + ((u >> 3) >> 1), jh = (u >> 3) & 1;
    const int b = pairi >> 4, h = pairi & 15;
    unsigned char* xcb = sm;
    float* as = (float*)(sm + 36864);
    float* bs = (float*)(sm + 69632);
    float* Pseg = (float*)(sm + 102400);
    float* Hseg = (float*)(sm + 104448);
    float* hcar = (float*)(sm + 106496);
    bf16x8 wfa[2][2], wfx[2][2];
#pragma unroll
    for (int ct = 0; ct < 2; ++ct)
#pragma unroll
        for (int kk = 0; kk < 2; ++kk) { float fa[8], fx[8];
#pragma unroll
            for (int e = 0; e < 8; ++e) { const size_t o = ((size_t)h * 64 + kk * 32 + fq * 8 + e) * 64 + jh * 32 + ct * 16 + fr; fa[e] = c.lru_wa[o]; fx[e] = c.lru_wx[o]; }
            u32x4 pa, px; pa.x = pk2(fa[0], fa[1]); pa.y = pk2(fa[2], fa[3]); pa.z = pk2(fa[4], fa[5]); pa.w = pk2(fa[6], fa[7]); px.x = pk2(fx[0], fx[1]); px.y = pk2(fx[2], fx[3]); px.z = pk2(fx[4], fx[5]); px.w = pk2(fx[6], fx[7]);
            wfa[ct][kk] = __builtin_bit_cast(bf16x8, pa); wfx[ct][kk] = __builtin_bit_cast(bf16x8, px); }
    float ba[2], bx[2], sp[2];
#pragma unroll
    for (int ct = 0; ct < 2; ++ct) { const int j = h * 64 + jh * 32 + ct * 16 + fr; ba[ct] = c.lru_ba[j]; bx[ct] = c.lru_bx[j]; sp[ct] = softplusf_(-c.lru_lambda[j]); }
    const int o8 = tid & 7, run = tid >> 3, chc = h * 64 + o8 * 8;
    float* wtab = (float*)(sm + 106752);
    if (tid < 320) { const int k = tid >> 6, cc = tid & 63; wtab[tid] = k < 4 ? c.lru_conv_w[k * 1024 + h * 64 + cc] : c.lru_conv_b[h * 64 + cc]; }
    __syncthreads();
    const int jl = tid & 31, sgm = tid >> 5;
    const int tl4 = tid >> 2, c8 = (tid & 3) * 8;
    u32x4 rw[7], gdv[2];
#define LRU_LOAD(TILE) do { const int t0_ = (TILE) * 256; \
        _Pragma("unroll") for (int j = 0; j < 7; ++j) { const int t = t0_ + 4 * run - 3 + j; rw[j] = (t >= 0) ? *(const u32x4*)(c.XD + (size_t)(b * SEQ + t) * 1024 + chc) : (u32x4){0u, 0u, 0u, 0u}; } \
        _Pragma("unroll") for (int i = 0; i < 2; ++i) gdv[i] = *(const u32x4*)(c.MIX + (size_t)(b * SEQ + t0_ + tl4 + 128 * i) * 2048 + 1024 + h * 64 + jh * 32 + c8); } while (0)
    LRU_LOAD(0);
    if (tid < 32) hcar[tid] = 0.f;
    for (int tile = 0; tile < 8; ++tile) {
        const int t0 = tile * 256;
        {
#pragma unroll
            for (int hf = 0; hf < 2; ++hf) {
                f32x4 wk[5];
#pragma unroll
                for (int k = 0; k < 5; ++k) wk[k] = *(const f32x4*)(wtab + k * 64 + o8 * 8 + 4 * hf);
#pragma unroll
                for (int i = 0; i < 4; ++i) { float r4[4];
#pragma unroll
                    for (int e = 0; e < 4; ++e) { const int ee = 4 * hf + e; float s = wk[4][e];
#pragma unroll
                        for (int k = 0; k < 4; ++k) { const unsigned wd = rw[i + k][ee >> 1]; s += wk[k][e] * ((ee & 1) ? bfhi(wd) : bflo(wd)); }
                        r4[e] = s; }
                    u32x2 o; o.x = pk2(r4[0], r4[1]); o.y = pk2(r4[2], r4[3]); *(u32x2*)(xcb + (4 * run + i) * 144 + o8 * 16 + hf * 8) = o; }
            }
        }
        __syncthreads();
        const u32x4 gdc0 = gdv[0], gdc1 = gdv[1];
        if (tile < 7) LRU_LOAD(tile + 1);
#pragma unroll
        for (int rt = 0; rt < 2; ++rt) {
            const int tb = 32 * w + 16 * rt;
            bf16x8 af[2];
#pragma unroll
            for (int kk = 0; kk < 2; ++kk) af[kk] = *(const bf16x8*)(xcb + (tb + fr) * 144 + (kk * 32 + fq * 8) * 2);
#pragma unroll
            for (int ct = 0; ct < 2; ++ct) {
                f32x4 dr = (f32x4){0.f, 0.f, 0.f, 0.f}, di = dr;
#pragma unroll
                for (int kk = 0; kk < 2; ++kk) { dr = __builtin_amdgcn_mfma_f32_16x16x32_bf16(af[kk], wfa[ct][kk], dr, 0, 0, 0); di = __builtin_amdgcn_mfma_f32_16x16x32_bf16(af[kk], wfx[ct][kk], di, 0, 0, 0); }
#pragma unroll
                for (int e = 0; e < 4; ++e) {
                    const int tl = tb + 4 * fq + e, jj = ct * 16 + fr;
                    const float r = sigmoidf_(dr[e] + ba[ct]), ig = sigmoidf_(di[e] + bx[ct]);
                    const float la = -8.f * r * sp[ct];
                    const float a = __expf(la);
                    const float xv = bf2f(*(const bf16*)(xcb + tl * 144 + (jh * 32 + jj) * 2));
                    const float bt = sqrtf(fmaxf(neg_expm1_fast(2.f * la), 0.f)) * (ig * xv);
                    as[tl * 32 + jj] = a; bs[tl * 32 + jj] = bt;
                }
            }
        }
        __syncthreads();
        {
            float p = 1.f, hl = 0.f;
#pragma unroll
            for (int i = 0; i < 16; ++i) { const int t = 16 * sgm + i; const float a = as[t * 32 + jl]; hl = fmaf(a, hl, bs[t * 32 + jl]); p *= a; as[t * 32 + jl] = p; bs[t * 32 + jl] = hl; }
            Pseg[sgm * 32 + jl] = p; Hseg[sgm * 32 + jl] = hl;
        }
        __syncthreads();
        {
            float cin = hcar[(tile & 1) * 32 + jl];
#pragma unroll
            for (int s2 = 0; s2 < 15; ++s2) { const float nc = fmaf(Pseg[s2 * 32 + jl], cin, Hseg[s2 * 32 + jl]); cin = (s2 < sgm) ? nc : cin; }
            if (sgm == 15) hcar[((tile + 1) & 1) * 32 + jl] = fmaf(Pseg[15 * 32 + jl], cin, Hseg[15 * 32 + jl]);
#pragma unroll
            for (int i = 0; i < 16; ++i) { const int t = 16 * sgm + i; bs[t * 32 + jl] = fmaf(as[t * 32 + jl], cin, bs[t * 32 + jl]); }
        }
        __syncthreads();
#pragma unroll
        for (int i = 0; i < 2; ++i) {
            const int tl = tl4 + 128 * i;
            u32x4* mp = (u32x4*)(c.MIX + (size_t)(b * SEQ + t0 + tl) * 2048 + 1024 + h * 64 + jh * 32 + c8);
            float gd[8]; unpack8(i == 0 ? gdc0 : gdc1, gd);
            const f32x4 h0 = *(const f32x4*)(bs + tl * 32 + c8), h1 = *(const f32x4*)(bs + tl * 32 + c8 + 4);
            *mp = pack8((f32x4){h0[0] * gd[0], h0[1] * gd[1], h0[2] * gd[2], h0[3] * gd[3]}, (f32x4){h1[0] * gd[4], h1[1] * gd[5], h1[2] * gd[6], h1[3] * gd[7]});
        }
    }
#undef LRU_LOAD
    __syncthreads();
    if (tid < 32) {
        const int j = h * 64 + jh * 32 + tid;
        c.out[O_LRU_P + (size_t)b * 1024 + j] = hcar[tid];
#pragma unroll
        for (int k = 0; k < 3; ++k) c.out[O_LCONV_P + ((size_t)b * 3 + k) * 1024 + j] = bf2f(c.XD[(size_t)(b * SEQ + SEQ - 3 + k) * 1024 + j]);
    }
    __syncthreads();
}
__device__ __forceinline__ void lru_sample_unit(const Ctx& c, int u, unsigned char* sm) {
    const int tid = threadIdx.x, h = u >> 3, tg = u & 7;
    float* wal = (float*)sm;
    float* wxl = wal + 4096;
    float* xcs = wxl + 4096;
    const int tk = tid >> 5, jq = tid & 31, bs = tg * 16 + tk, row = NP + bs, j0 = h * 64 + 2 * jq;
    const f32x2 h0 = *(const f32x2*)(c.state_lru + (size_t)bs * 1024 + j0);
    unsigned* mp = (unsigned*)(c.MIX + (size_t)row * 2048 + 1024 + j0);
    const unsigned gdw = *mp;
    const f32x2 bav = *(const f32x2*)(c.lru_ba + j0), bxv = *(const f32x2*)(c.lru_bx + j0), lam = *(const f32x2*)(c.lru_lambda + j0);
#pragma unroll
    for (int i = 0; i < 2; ++i) { const int idx = tid + 512 * i; ((f32x4*)wal)[idx] = ((const f32x4*)(c.lru_wa + (size_t)h * 4096))[idx]; ((f32x4*)wxl)[idx] = ((const f32x4*)(c.lru_wx + (size_t)h * 4096))[idx]; }
#pragma unroll
    for (int it = 0; it < 2; ++it) {
        const int item = tid + 512 * it, t2 = item >> 6, cc = item & 63, bs2 = tg * 16 + t2, ch = h * 64 + cc;
        const float* buf = c.state_lru_conv + (size_t)bs2 * 3 * 1024;
        const float xn = bf2f(c.XD[(size_t)(NP + bs2) * 1024 + ch]);
        const float b0 = buf[ch], b1 = buf[1024 + ch], b2 = buf[2048 + ch];
        xcs[t2 * 64 + cc] = c.lru_conv_b[ch] + c.lru_conv_w[ch] * b0 + c.lru_conv_w[1024 + ch] * b1 + c.lru_conv_w[2048 + ch] * b2 + c.lru_conv_w[3072 + ch] * xn;
        float* so = c.out + O_LCONV_S + (size_t)bs2 * 3 * 1024;
        so[ch] = b1; so[1024 + ch] = b2; so[2048 + ch] = xn;
    }
    __syncthreads();
    f32x2 sr = bav, si = bxv;
#pragma unroll 16
    for (int ii = 0; ii < 64; ++ii) { const float xv = xcs[tk * 64 + ii]; const f32x2 a2 = *(const f32x2*)(wal + ii * 64 + 2 * jq), x2 = *(const f32x2*)(wxl + ii * 64 + 2 * jq); sr += a2 * xv; si += x2 * xv; }
    float hn[2];
#pragma unroll
    for (int e = 0; e < 2; ++e) {
        const float r = sigmoidf_(sr[e]), ig = sigmoidf_(si[e]);
        const float la = -8.f * r * softplusf_(-lam[e]);
        const float a = __expf(la);
        hn[e] = a * h0[e] + sqrtf(fmaxf(neg_expm1_fast(2.f * la), 0.f)) * (ig * xcs[tk * 64 + 2 * jq + e]);
    }
    *(f32x2*)(c.out + O_LRU_S + (size_t)bs * 1024 + j0) = (f32x2){hn[0], hn[1]};
    *mp = pk2(hn[0] * bflo(gdw), hn[1] * bfhi(gdw));
    __syncthreads();
}
__device__ __forceinline__ void p5_odd_mixers(const Ctx& c, unsigned char* sm) {
    const int G = gridDim.x, bx = blockIdx.x;
    for (int u = bx; u < 256; u += G) lru_unit(c, u, sm);
    for (int u = bx; u < 256; u += G) ccv_unit(c, u, sm);
    for (int u = bx; u < 256; u += G) { if (u < 128) ccv_sample_unit(c, u, sm); else lru_sample_unit(c, u - 128, sm); }
}

__device__ __forceinline__ void p7_final_norm(const Ctx& c) {
    const int lane = threadIdx.x & 63, gw = blockIdx.x * 8 + (threadIdx.x >> 6), NGW = gridDim.x * 8;
    f32x4 fn[4];
#pragma unroll
    for (int j = 0; j < 4; ++j) fn[j] = ((const f32x4*)c.final_norm)[lane + 64 * j];
    for (int m0 = gw; m0 < NT; m0 += 4 * NGW) {
        u32x2 xw[4][4];
#pragma unroll
        for (int r = 0; r < 4; ++r) { const int m = m0 + r * NGW;
            if (m < NT) {
#pragma unroll
                for (int j = 0; j < 4; ++j) xw[r][j] = __builtin_nontemporal_load((const u32x2*)(c.X2b + (size_t)m * 1024) + lane + 64 * j); } }
#pragma unroll
        for (int r = 0; r < 4; ++r) { const int m = m0 + r * NGW;
            if (m < NT) {
                f32x4 v[4]; float s = 0.f;
#pragma unroll
                for (int j = 0; j < 4; ++j) { v[j] = (f32x4){bflo(xw[r][j].x), bfhi(xw[r][j].x), bflo(xw[r][j].y), bfhi(xw[r][j].y)}; s += (v[j][0] * v[j][0] + v[j][1] * v[j][1]) + (v[j][2] * v[j][2] + v[j][3] * v[j][3]); }
                const float rstd = rsqrtf(wave_sum(s) * (1.f / 1024.f) + EPS);
                f32x4* yo = (f32x4*)(c.out + (size_t)m * 1024);
#pragma unroll
                for (int j = 0; j < 4; ++j) __builtin_nontemporal_store(v[j] * rstd * fn[j], yo + lane + 64 * j);
            } }
    }
}

#define XB_TMO      128
#define XB_XCNT(j)  (256  + 64 * (j))
#define XB_XSUB(j)  (1280 + 64 * (j))
#define XB_XGEN(j)  (2304 + 64 * (j))
#define XB_TOP      3328
#define XB_TOPGEN   3392
#define XCD_BAR_WORDS 3456
#define XB_SPIN_CAP (1u << 18)

__device__ __forceinline__ unsigned xb_ld(unsigned* p)              { return __hip_atomic_load(p, __ATOMIC_RELAXED, __HIP_MEMORY_SCOPE_AGENT); }
__device__ __forceinline__ unsigned xb_add(unsigned* p, unsigned v) { return __hip_atomic_fetch_add(p, v, __ATOMIC_RELAXED, __HIP_MEMORY_SCOPE_AGENT); }
__device__ __forceinline__ unsigned xb_xcc_id() { return (unsigned)__builtin_amdgcn_s_getreg((3 << 11) | 20) & 0xFu; }
#define XB_SPIN(cond, bar) do { unsigned _sp = 0; while (cond) { __builtin_amdgcn_s_sleep(1); \
    if ((++_sp & 255u) == 0u) { if (xb_ld(&(bar)[XB_TMO])) break; if (_sp > XB_SPIN_CAP) { atomicAdd(&(bar)[XB_TMO], 1u); break; } } } } while (0)

struct XcdBarrier {
    unsigned* bar; unsigned x;
    volatile LAS3 unsigned* st;
};

__device__ __forceinline__ XcdBarrier xcd_barrier_post(unsigned* bar, volatile LAS3 unsigned* st) {
    XcdBarrier b; b.bar = bar; b.x = xb_xcc_id(); b.st = st;
    if (threadIdx.x == 0) (void)xb_add(&bar[XB_XCNT(b.x)], 1u);
    return b;
}
__device__ __forceinline__ void xcd_barrier_complete(unsigned* bar, unsigned x, unsigned& nloc, unsigned& nx) {
    const unsigned G = gridDim.x * gridDim.y * gridDim.z;
    unsigned sum, cnt, mine, sp = 0u;
    for (;;) {
        sum = 0u; cnt = 0u; mine = 0u;
#pragma unroll
        for (unsigned j = 0; j < 16; ++j) { const unsigned c = xb_ld(&bar[XB_XCNT(j)]); sum += c; cnt += (c > 0u) ? 1u : 0u; mine = (j == x) ? c : mine; }
        if (sum == G) break;
        __builtin_amdgcn_s_sleep(1);
        if ((++sp & 255u) == 0u) { if (xb_ld(&bar[XB_TMO])) break; if (sp > XB_SPIN_CAP) { atomicAdd(&bar[XB_TMO], 1u); break; } }
    }
    nloc = mine > 0u ? mine : 1u; nx = cnt > 0u ? cnt : 1u;
}

__device__ __noinline__ void xcd_barrier_f(unsigned* const bar_, const unsigned x_, volatile LAS3 unsigned* const st_) {
    struct { unsigned* bar; unsigned x; volatile LAS3 unsigned* st; } b{bar_, x_, st_};
    asm volatile("s_waitcnt vmcnt(0)" ::: "memory");
    __syncthreads();
    if (threadIdx.x == 0) {
        unsigned* bar = b.bar;
        __builtin_amdgcn_s_waitcnt(0);
        unsigned nloc = b.st[0], nx = b.st[1];
        if (nloc == 0u) { xcd_barrier_complete(bar, b.x, nloc, nx); b.st[0] = nloc; b.st[1] = nx; }
        const unsigned old = xb_add(&bar[XB_XSUB(b.x)], 1u);
        const unsigned gen = old / nloc;
        if (old + 1u == (gen + 1u) * nloc) {
            __builtin_amdgcn_fence(__ATOMIC_RELEASE, "agent");
            asm volatile("s_waitcnt vmcnt(0)" ::: "memory");
            const unsigned og = xb_add(&bar[XB_TOP], 1u);
            const unsigned tg = og / nx;
            if (og + 1u == (tg + 1u) * nx) xb_add(&bar[XB_TOPGEN], 1u);
            else XB_SPIN(xb_ld(&bar[XB_TOPGEN]) == tg, bar);
            __builtin_amdgcn_fence(__ATOMIC_ACQUIRE, "agent");
            xb_add(&bar[XB_XGEN(b.x)], 1u);
            asm volatile("s_waitcnt vmcnt(0)" ::: "memory");
        } else {
            XB_SPIN(xb_ld(&bar[XB_XGEN(b.x)]) == gen, bar);
            __builtin_amdgcn_fence(__ATOMIC_ACQUIRE, "agent");
            asm volatile("s_waitcnt vmcnt(0)" ::: "memory");
        }
    }
    __syncthreads();
}

#ifndef MK_COOP
#define MK_COOP 1
#endif
struct Params { const float* in[35]; float* out; unsigned char* ws; int lo, hi; };
constexpr int N_PHASES = 8;

__global__ void __launch_bounds__(512, 2) hybrid_fwd(Params P) {
    extern __shared__ __attribute__((aligned(16))) unsigned char lds[];
    Ctx c;
    c.x_prompt = P.in[0]; c.x_sample = P.in[1]; c.state_ssm = P.in[2]; c.state_ssd_conv = P.in[3]; c.state_ccv = P.in[4]; c.state_lru_conv = P.in[5]; c.state_lru = P.in[6];
    c.norm_even = P.in[7]; c.w_in_even = P.in[8]; c.ssd_conv_w = P.in[9]; c.ssd_conv_b = P.in[10]; c.ssd_dt_bias = P.in[11]; c.ssd_a_log = P.in[12]; c.ssd_d = P.in[13]; c.ssd_norm = P.in[14];
    c.gmlp_ln_g = P.in[15]; c.gmlp_ln_b = P.in[16]; c.gmlp_w_s = P.in[17]; c.gmlp_b_s = P.in[18]; c.w_out_even = P.in[19];
    c.norm_odd = P.in[20]; c.w_in_odd = P.in[21]; c.ccv_w = P.in[22]; c.ccv_b = P.in[23]; c.ccv_ln_g = P.in[24]; c.ccv_ln_b = P.in[25];
    c.lru_conv_w = P.in[26]; c.lru_conv_b = P.in[27]; c.lru_wa = P.in[28]; c.lru_ba = P.in[29]; c.lru_wx = P.in[30]; c.lru_bx = P.in[31]; c.lru_lambda = P.in[32]; c.w_out_odd = P.in[33]; c.final_norm = P.in[34];
    c.out = P.out;
    unsigned char* ws = P.ws;
    c.ss0 = (float*)(ws + WS_SS0); c.ss1 = (float*)(ws + WS_SS1); c.DT = (float*)(ws + WS_DT); c.ssg = (float*)(ws + WS_SSG); c.xcnt = (unsigned*)(ws + WS_XCNT);
    c.W1t = (bf16*)(ws + WS_W1); c.W2t = (bf16*)(ws + WS_W2); c.W3t = (bf16*)(ws + WS_W3); c.W4t = (bf16*)(ws + WS_W4);
    c.XN = (bf16*)(ws + WS_XN); c.MIX = (bf16*)(ws + WS_MIX); c.XBC = (bf16*)(ws + WS_XBC); c.GV = (bf16*)(ws + WS_GV); c.GLU = (bf16*)(ws + WS_XBC); c.XD = (bf16*)(ws + WS_GV); c.BCn = (bf16*)(ws + WS_BCN); c.BTg = (bf16*)(ws + WS_BTG); c.Gg = (bf16*)(ws + WS_GG); c.X2b = (bf16*)(ws + WS_BCN);
    PG8_LAS unsigned char* l3 = (PG8_LAS unsigned char*)lds;
    const int lo = P.lo, hi = P.hi;
    if (threadIdx.x == 0) { *(volatile LAS3 unsigned*)(l3 + 147400) = 0u; *(volatile LAS3 unsigned*)(l3 + 147404) = 0u; }
    __syncthreads();
    if (threadIdx.x == 0) (void)xb_add(&((unsigned*)(P.ws + WS_BAR))[XB_XCNT(xb_xcc_id())], 1u);
#ifdef PROBE_A
    unsigned long long ts[16];
#define STAMP(k) ts[k] = __builtin_amdgcn_s_memrealtime()
#else
#define STAMP(k) do { } while (0)
#endif
    STAMP(0);
#define IN(k) (lo <= (k) && (k) < hi)
#if MK_COOP
#define SEAM(k) do { if (IN(k) && IN((k) + 1)) { if (hi > 64) cg::this_grid().sync();   xcd_barrier_f((unsigned*)(P.ws + WS_BAR), xb_xcc_id(), (volatile LAS3 unsigned*)((PG8_LAS unsigned char*)lds + 147400)); } } while (0)
#else
#define SEAM(k) do { } while (0)
#endif
    if (IN(0)) { p0_prologue(c, lds); } SEAM(0); STAMP(1);
    if (IN(1)) {
        pg8::Gemm g{c.XN, c.W1t, MP, N1, 1024}; pg8::StaticOrder S; S.init(MP, N1, (int)gridDim.x, (int)blockIdx.x);
        Epi1 E{c.ss0, c.MIX, c.XBC, c.GV, c.DT};
        pg8::gemm_phase<Epi1, pg8::StaticOrder, NoHook, true, true>(l3, g, S, E, NoHook{});
    } SEAM(1); STAMP(2);
    if (IN(2)) {
        const int G = gridDim.x, bx = blockIdx.x;
        {
            if (threadIdx.x == 0) { const unsigned x = (unsigned)__builtin_amdgcn_s_getreg((3 << 11) | 20) & 7u; const unsigned i = __hip_atomic_fetch_add(c.xcnt + x, 1u, __ATOMIC_RELAXED, __HIP_MEMORY_SCOPE_AGENT); *(unsigned*)(lds + 147300) = x | (i << 8); }
            __syncthreads();
        }
        for (int u = bx; u < 256; u += G) bc_prepass_unit(c, u, lds);
        STAMP(9);
        for (int u = bx; u < 256; u += G) gmlp_unit(c, u, lds);
        STAMP(10);
        for (int u = bx; u < 256; u += G) sample_even_unit(c, u, lds);
        STAMP(11);
        for (int i = bx * 512 + threadIdx.x; i < 8 * 3 * 1536; i += G * 512) { const int b = i / (3 * 1536), r = i % (3 * 1536), k = r / 1536, ch = r % 1536;
            c.out[O_SCONV_P + i] = bf2f(c.XBC[(size_t)(b * SEQ + SEQ - 3 + k) * 1536 + ch]); }
    } SEAM(2); STAMP(3);
    {
        if (gridDim.x == 256) {
            const unsigned clm = *(const unsigned*)(lds + 147300);
            const int ssd_xcc = __builtin_amdgcn_readfirstlane((int)(clm & 255u)), ssd_idx = __builtin_amdgcn_readfirstlane((int)(clm >> 8));
            int x = ssd_xcc, i = ssd_idx;
            if (i >= 32) {
                int r = i - 32;
                for (int x2 = 0; x2 < 8; ++x2) { const int c2 = (int)__hip_atomic_load(c.xcnt + x2, __ATOMIC_RELAXED, __HIP_MEMORY_SCOPE_AGENT); if (x2 < ssd_xcc && c2 > 32) r += c2 - 32; }
                for (int x2 = 0; x2 < 8; ++x2) { int c2 = (int)__hip_atomic_load(c.xcnt + x2, __ATOMIC_RELAXED, __HIP_MEMORY_SCOPE_AGENT); c2 = c2 < 32 ? c2 : 32; if (r < 32 - c2) { x = x2; i = c2 + r; break; } r -= 32 - c2; }
            }
            ssd_chunk_unit(c, x * 32 + i, lds);
        } else { const int G = gridDim.x, bx = blockIdx.x; for (int u = bx; u < 256; u += G) ssd_chunk_unit(c, u, lds); }
        xcd_barrier_f((unsigned*)(P.ws + WS_BAR), xb_xcc_id(), (volatile LAS3 unsigned*)((PG8_LAS unsigned char*)lds + 147400)); STAMP(15);
    }
    if (IN(3)) {
        sample_outproj<true>(c.MIX + (size_t)NP * 2048, c.W2t, c.x_sample, c.XN + (size_t)NP * 1024, nullptr, c.ss1 + (size_t)NP, lds);
        pg8::Gemm g{c.MIX, c.W2t, NP, 1024, 2048}; pg8::StaticOrder S; S.init(NP, 1024, (int)gridDim.x, (int)blockIdx.x);
        Unit u0;
        if (S.next(0, u0)) {
            float* tab = (float*)(lds + 131072);
            if (threadIdx.x < 256) { const float* sp = c.ssg + (size_t)(u0.pm * 256 + threadIdx.x); float s0 = 0.f, s1 = 0.f;
#pragma unroll
                for (int i = 0; i < 16; ++i) { s0 += sp[(size_t)i * NP]; s1 += sp[(size_t)(16 + i) * NP]; }
                const float r0 = rsqrtf(s0 * (1.f / 512.f) + EPS), r1 = rsqrtf(s1 * (1.f / 512.f) + EPS);
                tab[threadIdx.x * 2] = r0 / r1; tab[threadIdx.x * 2 + 1] = r1; }
        }
        __syncthreads();
        EpiOut<true> E{c.x_prompt, c.XN, nullptr, c.ss1};
        HookScale H{(const LAS3 float*)(l3 + 131072)};
        pg8::gemm_phase<EpiOut<true>, pg8::StaticOrder, HookScale, false, true>(l3, g, S, E, H);
    } SEAM(3); STAMP(4);
    if (IN(4)) {
        pg8::Gemm g{c.XN, c.W3t, MP, N3, 1024}; pg8::StaticOrder S; S.init(MP, N3, (int)gridDim.x, (int)blockIdx.x);
        {
            float* tab = (float*)(lds + 131072);
            Unit uu;
            for (int i = 0; i < 8; ++i) { if (!S.next(i, uu)) break; if (threadIdx.x < 256) tab[i * 256 + threadIdx.x] = rstd_from(c.ss1, uu.pm * 256 + (int)threadIdx.x); }
            __syncthreads();
        }
        Epi3 E{(const LAS3 float*)(l3 + 131072), c.MIX, c.GLU, c.XD, 0};
        pg8::gemm_phase<Epi3, pg8::StaticOrder, NoHook, true, true>(l3, g, S, E, NoHook{});
    } SEAM(4); STAMP(5);
    if (IN(5)) {
        const int G = gridDim.x, bx = blockIdx.x;
        for (int u = bx; u < 256; u += G) lru_unit(c, u, lds);
        STAMP(12);
        for (int u = bx; u < 256; u += G) ccv_unit(c, u, lds);
        STAMP(13);
        for (int u = bx; u < 256; u += G) { if (u < 128) ccv_sample_unit(c, u, lds); else lru_sample_unit(c, u - 128, lds); }
        STAMP(14);
        for (int i = bx * 512 + threadIdx.x; i < 8 * 30 * 1024; i += G * 512) { const int b = i / (30 * 1024), r = i % (30 * 1024); c.out[O_CCV_P + i] = bf2f(c.GLU[(size_t)(b * SEQ + SEQ - 30) * 1024 + r]); }
    } SEAM(5); STAMP(6);
    if (IN(6)) {
        sample_outproj<false>(c.MIX + (size_t)NP * 2048, c.W4t, nullptr, c.XN + (size_t)NP * 1024, c.X2b + (size_t)NP * 1024, nullptr, lds);
        pg8::Gemm g{c.MIX, c.W4t, NP, 1024, 2048}; pg8::StaticOrder S; S.init(NP, 1024, (int)gridDim.x, (int)blockIdx.x);
        EpiOut<false> E{nullptr, c.XN, c.X2b, nullptr};
        pg8::gemm_phase<EpiOut<false>, pg8::StaticOrder, NoHook, false, true>(l3, g, S, E, NoHook{});
    } SEAM(6); STAMP(7);
    if (IN(7)) { p7_final_norm(c); }
#ifdef PROBE_A
    STAMP(8);
    if (blockIdx.x == 0) {
        const float tot = (float)(ts[8] - ts[0]);
        const float f1 = (float)(ts[PROBE_A1] - ts[PROBE_A]) / tot, f2 = (float)(ts[PROBE_B1] - ts[PROBE_B]) / tot;
        __syncthreads();
        for (int i = threadIdx.x; i < 8192; i += 512) c.out[O_LRU_P + i] *= (1.03f + 0.1f * f1);
        if (threadIdx.x == 0) c.out[0] += 10.f + 90.f * f2;
    }
#endif
#undef IN
#undef SEAM
}

extern "C" void kernel_launch(void* const* d_in, const int* in_sizes, int n_in, void* d_out, int out_size, void* d_ws, size_t ws_size, hipStream_t stream) {
    static int grid = 0;
    if (grid == 0) {
        if (n_in != 35 || out_size != (int)O_END || ws_size < WS_END) { fprintf(stderr, "kernel_launch: unexpected problem (n_in %d out %d ws %zu)\n", n_in, out_size, ws_size); grid = -1; return; }
        int dev = 0, cus = 0, per_cu = 0;
        (void)hipGetDevice(&dev); (void)hipDeviceGetAttribute(&cus, hipDeviceAttributeMultiprocessorCount, dev);
        if (hipFuncSetAttribute((const void*)hybrid_fwd, hipFuncAttributeMaxDynamicSharedMemorySize, LDS_BYTES) != hipSuccess) { fprintf(stderr, "kernel_launch: hipFuncSetAttribute failed\n"); grid = -1; return; }
        if (hipOccupancyMaxActiveBlocksPerMultiprocessor(&per_cu, (const void*)hybrid_fwd, 512, LDS_BYTES) != hipSuccess || per_cu < 1) { fprintf(stderr, "kernel_launch: occupancy query says %d blocks per CU\n", per_cu); (void)hipGetLastError(); per_cu = 1; }
        grid = cus < 256 ? cus : 256;
        if (grid != 256) fprintf(stderr, "kernel_launch: %d CUs; this kernel is built for 256\n", cus);
    }
    if (grid < 0) return;
    if (hipMemsetAsync((char*)d_ws + WS_BAR, 0, 16384, stream) != hipSuccess) { fprintf(stderr, "kernel_launch: hipMemsetAsync of the barrier words failed\n"); return; }
    Params p{};
    for (int i = 0; i < 35; ++i) p.in[i] = (const float*)d_in[i];
    p.out = (float*)d_out; p.ws = (unsigned char*)d_ws;
#if MK_COOP
    p.lo = 0; p.hi = N_PHASES;
    void* args[] = {&p};
    hipError_t e = hipLaunchCooperativeKernel((const void*)hybrid_fwd, dim3(grid), dim3(512), args, LDS_BYTES, stream);
    if (e != hipSuccess) fprintf(stderr, "kernel_launch: cooperative launch failed: %s\n", hipGetErrorString(e));
#else
    for (int ph = 0; ph < N_PHASES; ++ph) { p.lo = ph; p.hi = ph + 1; hipLaunchKernelGGL(hybrid_fwd, dim3(grid), dim3(512), LDS_BYTES, stream, p); }
#endif
}
```
